# Optimizing an MI355X kernel written in HIP

```python
import math
import jax, jax.numpy as jnp
from jax import lax
import numpy as np

D_MODEL = 1024
BATCH = 8
SEQ = 4096
DEPTH = 2

CTX_LEN = 256
GRID_W = 64
D_MIX = D_MODEL
W_BR = D_MIX // 4
EPS = 1e-6

RW_HEAD = 64
RW_HEADS = W_BR // RW_HEAD
RW_DECAY_RANK = 64
RW_A_RANK = 64
RW_SHIFT = 3 * W_BR + 2 * RW_DECAY_RANK + 2 * RW_A_RANK
RW_COLS = RW_SHIFT + W_BR
RW_GN_EPS = 64e-5

S5_CH = 16
S5_GROUPS = W_BR // S5_CH
S5_P = 64
S5_COLS = 2 * W_BR

SSD_HEADDIM = 64
SSD_HEADS = W_BR // SSD_HEADDIM
SSD_NGROUPS = 2
SSD_N = 64
SSD_CONV = 5
SSD_CHUNK = 128
SSD_XBC = W_BR + 2 * SSD_NGROUPS * SSD_N
SSD_COLS = SSD_XBC + 2 * SSD_HEADS + W_BR

GLA_HEADS = 4
GLA_DK = (W_BR // 2) // GLA_HEADS
GLA_DV = W_BR // GLA_HEADS
GLA_RANK = 16
GLA_TAU = 16.0
GLA_CHUNK = 64
GLA_COLS = 2 * GLA_HEADS * GLA_DK + W_BR + 2 * GLA_RANK + W_BR

N_IN = RW_COLS + S5_COLS + SSD_COLS + GLA_COLS

kernel_name = 'hybrid_parallel_heads_rwkv7_s5_ssd_gla_dit'


def split_last(t, sizes):
    idx = np.cumsum(sizes)[:-1].tolist()
    return jnp.split(t, idx, axis=-1)


def flip(t):
    return jnp.flip(t, axis=1)


def rmsnorm(t, g):
    tf = t.astype(jnp.float32)
    tf = tf * lax.rsqrt(jnp.mean(tf * tf, axis=-1, keepdims=True) + EPS)
    return (tf * g.astype(jnp.float32)).astype(t.dtype)


def token_shift(f, grid):
    b, L, C = f.shape
    if grid:
        rows = L // GRID_W
        q = C // 4
        g = f.reshape(b, rows, GRID_W, C)
        left = jnp.pad(g[:, :, :-1, :q], ((0, 0), (0, 0), (1, 0), (0, 0)))
        right = jnp.pad(g[:, :, 1:, q:2 * q], ((0, 0), (0, 0), (0, 1), (0, 0)))
        up = jnp.pad(g[:, :-1, :, 2 * q:3 * q], ((0, 0), (1, 0), (0, 0), (0, 0)))
        down = jnp.pad(g[:, 1:, :, 3 * q:], ((0, 0), (0, 1), (0, 0), (0, 0)))
        return jnp.concatenate([left, right, up, down], axis=-1).reshape(b, L, C)
    half = C // 2
    prev = jnp.pad(f[:, :-1, :half], ((0, 0), (1, 0), (0, 0)))
    nxt = jnp.pad(f[:, 1:, half:], ((0, 0), (0, 1), (0, 0)))
    return jnp.concatenate([prev, nxt], axis=-1)


def dwconv_centred(t, w, bias):
    kw = w.shape[0]
    y = lax.conv_general_dilated(t, w.astype(t.dtype)[:, None, :], window_strides=(1,),
                                 padding=[(kw // 2, kw // 2)], dimension_numbers=('NWC', 'WIO', 'NWC'),
                                 feature_group_count=t.shape[-1])
    return y + bias


def rwkv7_scan(r, w, k, v, kk, a, s0, reverse, need_out):
    def step(S, inp):
        r_t, w_t, k_t, v_t, kk_t, a_t = inp
        sa = jnp.einsum('bhvk,bhk->bhv', S, -kk_t)
        S = S * w_t[:, :, None, :] + sa[..., None] * (kk_t * a_t)[:, :, None, :] + v_t[..., None] * k_t[:, :, None, :]
        y = jnp.einsum('bhvk,bhk->bhv', S, r_t) if need_out else None
        return S, y
    xs = tuple(jnp.moveaxis(t, 1, 0) for t in (r, w, k, v, kk, a))
    s_fin, ys = lax.scan(step, s0, xs, reverse=reverse)
    return (jnp.moveaxis(ys, 0, 1) if need_out else None), s_fin


def rwkv7_mixer(f, p, grid, init, need_out):
    b, L, _ = f.shape
    f = f.astype(jnp.float32)
    z, gate = f[..., :RW_SHIFT], f[..., RW_SHIFT:]
    z = z + p['rw_mu'] * (token_shift(z, grid) - z)
    r, k, v, wl, al = split_last(z, [W_BR, W_BR, W_BR, 2 * RW_DECAY_RANK, 2 * RW_A_RANK])
    heads = lambda t: t.reshape(b, L, RW_HEADS, RW_HEAD)
    r, k, v = heads(r), heads(k), heads(v)
    wl = wl.reshape(b, L, 2, RW_DECAY_RANK)
    al = al.reshape(b, L, 2, RW_A_RANK)
    w_pre = p['rw_w0'] + jnp.einsum('bldr,drc->bldc', jnp.tanh(wl), p['rw_w2'])
    decay = jnp.exp(-jnp.exp(-jax.nn.softplus(-w_pre) - 0.5))
    a = jax.nn.sigmoid(p['rw_a0'] + jnp.einsum('bldr,drc->bldc', al, p['rw_a2']))
    kk = k * p['rw_kk'].reshape(RW_HEADS, RW_HEAD)
    kk = kk * lax.rsqrt(jnp.sum(kk * kk, axis=-1, keepdims=True) + EPS)
    if init is None:
        zero = jnp.zeros((b, RW_HEADS, RW_HEAD, RW_HEAD), jnp.float32)
        init = (zero, zero)
    ys, bonus, finals = [], [], []
    for d, rev in enumerate((False, True)):
        w_d = heads(decay[:, :, d])
        a_d = heads(a[:, :, d])
        k_d = k * (1.0 + (a_d - 1.0) * p['rw_ka'].reshape(RW_HEADS, RW_HEAD))
        y_d, s_d = rwkv7_scan(r, w_d, k_d, v, kk, a_d, init[d], rev, need_out)
        finals.append(s_d)
        if need_out:
            ys.append(y_d)
            bonus.append(jnp.sum(r * k_d * p['rw_rk'], axis=-1, keepdims=True) * v)
    if not need_out:
        return None, (finals[0], finals[1])
    y = ys[0] + ys[1]
    mu = jnp.mean(y, axis=-1, keepdims=True)
    var = jnp.mean(jnp.square(y - mu), axis=-1, keepdims=True)
    y = ((y - mu) * lax.rsqrt(var + RW_GN_EPS)).reshape(b, L, W_BR) * p['rw_ln_w'] + p['rw_ln_b']
    y = y + (bonus[0] + bonus[1]).reshape(b, L, W_BR)
    return y * jax.nn.silu(gate), (finals[0], finals[1])


def s5_combine(e1, e2):
    a1, b1 = e1
    a2, b2 = e2
    return a1 * a2, a2 * b1 + b2


def s5_mixer(f, p, init, need_out):
    b, L, _ = f.shape
    u, gate = split_last(f.astype(jnp.float32), [W_BR, W_BR])
    ug = u.reshape(b, L, S5_GROUPS, S5_CH).astype(jnp.complex64)
    if init is None:
        zero = jnp.zeros((b, S5_GROUPS, S5_P), jnp.complex64)
        init = (zero, zero)
    f32 = jnp.float32
    outs, finals = [], []
    for d, rev in enumerate((False, True)):
        lam = lax.complex(p['s5_a_re'][d].astype(f32), p['s5_a_im'][d].astype(f32))
        dt = jnp.exp(p['s5_log_dt'][d].astype(f32))[:, None]
        lam_bar = jnp.exp(lam * dt)
        b_bar = ((lam_bar - 1.0) / lam)[..., None] * lax.complex(p['s5_b_re'][d].astype(f32), p['s5_b_im'][d].astype(f32))
        bu = jnp.einsum('gpc,blgc->blgp', b_bar, ug)
        edge = L - 1 if rev else 0
        bu = bu.at[:, edge].add(lam_bar * init[d])
        _, xs = lax.associative_scan(s5_combine, (jnp.broadcast_to(lam_bar, bu.shape), bu), reverse=rev, axis=1)
        finals.append(xs[:, 0] if rev else xs[:, L - 1])
        if need_out:
            c_c = lax.complex(p['s5_c_re'][d].astype(f32), p['s5_c_im'][d].astype(f32))
            outs.append(jnp.real(jnp.einsum('gcp,blgp->blgc', c_c, xs)))
    if not need_out:
        return None, (finals[0], finals[1])
    y = (outs[0] + outs[1]).reshape(b, L, W_BR) + p['s5_d'] * u
    y = jax.nn.gelu(y)
    y = y * jax.nn.sigmoid(y @ p['s5_glu_w'] + p['s5_glu_b'])
    return y * jax.nn.silu(gate), (finals[0], finals[1])


def chunk_state_pass(decay, contrib, s0):
    def step(S, inp):
        dec, ctb = inp
        return dec * S + ctb, S
    s_fin, prev = lax.scan(step, s0, (jnp.moveaxis(decay, 1, 0), jnp.moveaxis(contrib, 1, 0)))
    return jnp.moveaxis(prev, 0, 1), s_fin


def ssd_chunked(q, k, v, log_a, s0, need_out):
    b, L, H, _ = q.shape
    nc = L // SSD_CHUNK
    ch = lambda t: t.reshape((b, nc, SSD_CHUNK) + t.shape[2:])
    q, k, v, log_a = ch(q), ch(k), ch(v), ch(log_a)
    cs = jnp.cumsum(log_a, axis=2)
    cs_last = cs[:, :, -1:]
    contrib = jnp.einsum('bcqhn,bcqhp->bchnp', k * jnp.exp(cs_last - cs)[..., None], v)
    prev, s_fin = chunk_state_pass(jnp.exp(cs_last[:, :, 0])[..., None, None], contrib, s0)
    if not need_out:
        return None, s_fin
    cs_h = jnp.moveaxis(cs, 2, 3)
    within = jnp.tril(jnp.ones((SSD_CHUNK, SSD_CHUNK), bool))
    seg = jnp.exp(jnp.where(within, cs_h[..., :, None] - cs_h[..., None, :], -jnp.inf))
    scores = jnp.einsum('bcihn,bcjhn->bchij', q, k) * seg
    y = jnp.einsum('bchij,bcjhp->bcihp', scores, v) + jnp.einsum('bcihn,bchnp->bcihp', q * jnp.exp(cs)[..., None], prev)
    return y.reshape(b, L, H, -1), s_fin


def gla_chunked(q, k, v, log_a, s0, need_out):
    b, L, H, _ = q.shape
    nc = L // GLA_CHUNK
    ch = lambda t: t.reshape((b, nc, GLA_CHUNK) + t.shape[2:])
    q, k, v, log_a = ch(q), ch(k), ch(v), ch(log_a)
    bc = jnp.cumsum(log_a, axis=2)
    b_last = bc[:, :, -1:]
    contrib = jnp.einsum('bcqhk,bcqhv->bchkv', k * jnp.exp(b_last - bc), v)
    prev, s_fin = chunk_state_pass(jnp.exp(b_last[:, :, 0])[..., None], contrib, s0)
    if not need_out:
        return None, s_fin
    b_mid = bc[:, :, GLA_CHUNK // 2:GLA_CHUNK // 2 + 1]
    scores = jnp.einsum('bcihk,bcjhk->bchij', q * jnp.exp(bc - b_mid), k * jnp.exp(b_mid - bc))
    within = jnp.tril(jnp.ones((GLA_CHUNK, GLA_CHUNK), bool))
    scores = jnp.where(within, scores, 0.0)
    y = jnp.einsum('bchij,bcjhv->bcihv', scores, v) + jnp.einsum('bcihk,bchkv->bcihv', q * jnp.exp(bc), prev)
    return y.reshape(b, L, H, -1), s_fin


def ssd_mixer(f, p, init, need_out):
    b, L, _ = f.shape
    xbc, dt_raw, z = split_last(f.astype(jnp.float32), [SSD_XBC, 2 * SSD_HEADS, W_BR])
    xbc = jax.nn.silu(dwconv_centred(xbc, p['ssd_conv_w'], p['ssd_conv_b']))
    xs, bm, cm = split_last(xbc, [W_BR, SSD_NGROUPS * SSD_N, SSD_NGROUPS * SSD_N])
    xh = xs.reshape(b, L, SSD_HEADS, SSD_HEADDIM)
    rep = SSD_HEADS // SSD_NGROUPS
    bh = jnp.repeat(bm.reshape(b, L, SSD_NGROUPS, SSD_N), rep, axis=2)
    chh = jnp.repeat(cm.reshape(b, L, SSD_NGROUPS, SSD_N), rep, axis=2)
    dt = jax.nn.softplus(dt_raw.reshape(b, L, 2, SSD_HEADS) + p['ssd_dt_bias'])
    a_neg = -jnp.exp(p['ssd_a_log'].astype(jnp.float32))
    if init is None:
        zero = jnp.zeros((b, SSD_HEADS, SSD_N, SSD_HEADDIM), jnp.float32)
        init = (zero, zero)
    ys, finals = [], []
    for d, rev in enumerate((False, True)):
        dt_d = dt[:, :, d]
        args = (chh, bh, xh * dt_d[..., None], dt_d * a_neg[d])
        if rev:
            args = tuple(flip(t) for t in args)
        y_d, s_d = ssd_chunked(args[0], args[1], args[2], args[3], init[d], need_out)
        finals.append(s_d)
        if need_out:
            ys.append(flip(y_d) if rev else y_d)
    if not need_out:
        return None, (finals[0], finals[1])
    y = ys[0] + ys[1] + p['ssd_d'][:, None] * xh
    y = rmsnorm(y.reshape(b, L, W_BR) * jax.nn.silu(z), p['ssd_norm'])
    return y, (finals[0], finals[1])


def gla_mixer(f, p, init, need_out):
    b, L, _ = f.shape
    q, k, v, gl, gate = split_last(f.astype(jnp.float32), [GLA_HEADS * GLA_DK, GLA_HEADS * GLA_DK, W_BR, 2 * GLA_RANK, W_BR])
    q = q.reshape(b, L, GLA_HEADS, GLA_DK) * GLA_DK ** -0.5
    k = k.reshape(b, L, GLA_HEADS, GLA_DK)
    v = v.reshape(b, L, GLA_HEADS, GLA_DV)
    log_a = jax.nn.log_sigmoid(jnp.einsum('bldr,drc->bldc', gl.reshape(b, L, 2, GLA_RANK), p['gla_g2']) + p['gla_gb']) / GLA_TAU
    if init is None:
        zero = jnp.zeros((b, GLA_HEADS, GLA_DK, GLA_DV), jnp.float32)
        init = (zero, zero)
    ys, finals = [], []
    for d, rev in enumerate((False, True)):
        la = log_a[:, :, d].reshape(b, L, GLA_HEADS, GLA_DK)
        args = (q, k, v, la)
        if rev:
            args = tuple(flip(t) for t in args)
        y_d, s_d = gla_chunked(args[0], args[1], args[2], args[3], init[d], need_out)
        finals.append(s_d)
        if need_out:
            ys.append(flip(y_d) if rev else y_d)
    if not need_out:
        return None, (finals[0], finals[1])
    y = ys[0] + ys[1]
    y = y * lax.rsqrt(jnp.mean(y * y, axis=-1, keepdims=True) + EPS)
    y = y.reshape(b, L, W_BR) * p['gla_norm']
    return y * jax.nn.silu(gate), (finals[0], finals[1])


def mixer_layer(h, mod, p, grid, init, need_out):
    shift, scale, gate = jnp.split(mod, 3, axis=-1)
    hn = rmsnorm(h, p['norm_pre']) * (1.0 + scale) + shift
    proj = hn @ p['w_in']
    f_rw, f_s5, f_ssd, f_gla = split_last(proj, [RW_COLS, S5_COLS, SSD_COLS, GLA_COLS])
    ini = init if init is not None else (None, None, None, None)
    y_rw, st_rw = rwkv7_mixer(f_rw, p, grid, ini[0], need_out)
    y_s5, st_s5 = s5_mixer(f_s5, p, ini[1], need_out)
    y_ssd, st_ssd = ssd_mixer(f_ssd, p, ini[2], need_out)
    y_gla, st_gla = gla_mixer(f_gla, p, ini[3], need_out)
    states = (st_rw, st_s5, st_ssd, st_gla)
    if not need_out:
        return None, states
    y = jnp.concatenate([y_rw, y_s5, y_ssd, y_gla], axis=-1).astype(h.dtype) @ p['w_out']
    return h + gate * rmsnorm(y, p['norm_post']), states


def setup_inputs(seed: int = 0) -> dict:
    key = jax.random.key(seed)
    ks = iter(jax.random.split(key, 48))
    f32 = jnp.float32

    def nrm(shape, s):
        return jax.random.normal(next(ks), shape, f32) * s

    def unif(shape, lo, hi):
        return jax.random.uniform(next(ks), shape, f32, lo, hi)

    Ld = DEPTH
    x = nrm((BATCH, SEQ, D_MODEL), 1.0)
    c = nrm((BATCH, D_MODEL), 1.0)
    ctx = nrm((BATCH, CTX_LEN, D_MODEL), 1.0)
    c_ctx = nrm((D_MODEL,), 1.0)
    ada_w = nrm((Ld, D_MODEL, 3 * D_MODEL), 0.5 * D_MODEL ** -0.5)
    ada_b = nrm((Ld, 3 * D_MODEL), 0.01)
    norm_pre = 1.0 + nrm((Ld, D_MODEL), 0.05)
    norm_post = 1.0 + nrm((Ld, D_MODEL), 0.05)
    w_in = nrm((Ld, D_MODEL, N_IN), D_MODEL ** -0.5)
    w_out = nrm((Ld, D_MIX, D_MODEL), D_MIX ** -0.5)
    rw_mu = unif((Ld, RW_SHIFT), 0.0, 1.0)
    rw_w0 = unif((Ld, 2, W_BR), -6.0, -1.0)
    rw_w2 = nrm((Ld, 2, RW_DECAY_RANK, W_BR), 0.5 * RW_DECAY_RANK ** -0.5)
    rw_a0 = nrm((Ld, 2, W_BR), 0.1)
    rw_a2 = nrm((Ld, 2, RW_A_RANK, W_BR), 0.5 * RW_A_RANK ** -0.5)
    rw_kk = 0.85 + nrm((Ld, W_BR), 0.05)
    rw_ka = 1.0 + nrm((Ld, W_BR), 0.05)
    rw_rk = nrm((Ld, RW_HEADS, RW_HEAD), 0.1)
    rw_ln_w = 1.0 + nrm((Ld, W_BR), 0.05)
    rw_ln_b = nrm((Ld, W_BR), 0.01)
    s5_a_re = -0.5 + nrm((Ld, 2, S5_GROUPS, S5_P), 0.01)
    s5_a_im = math.pi * jnp.arange(S5_P, dtype=f32) + nrm((Ld, 2, S5_GROUPS, S5_P), 0.01)
    s5_log_dt = unif((Ld, 2, S5_GROUPS), math.log(1e-3), math.log(1e-1))
    s5_b_re = nrm((Ld, 2, S5_GROUPS, S5_P, S5_CH), (2 * S5_CH) ** -0.5)
    s5_b_im = nrm((Ld, 2, S5_GROUPS, S5_P, S5_CH), (2 * S5_CH) ** -0.5)
    s5_c_re = nrm((Ld, 2, S5_GROUPS, S5_CH, S5_P), (2 * S5_P) ** -0.5)
    s5_c_im = nrm((Ld, 2, S5_GROUPS, S5_CH, S5_P), (2 * S5_P) ** -0.5)
    s5_d = nrm((Ld, W_BR), 1.0)
    s5_glu_w = nrm((Ld, W_BR, W_BR), W_BR ** -0.5)
    s5_glu_b = nrm((Ld, W_BR), 0.01)
    ssd_conv_w = nrm((Ld, SSD_CONV, SSD_XBC), SSD_CONV ** -0.5)
    ssd_conv_b = nrm((Ld, SSD_XBC), 0.01)
    dt0 = jnp.exp(unif((Ld, 2, SSD_HEADS), math.log(1e-3), math.log(1e-1)))
    ssd_dt_bias = dt0 + jnp.log(-jnp.expm1(-dt0))
    ssd_a_log = jnp.log(unif((Ld, 2, SSD_HEADS), 1.0, 16.0))
    ssd_d = 1.0 + nrm((Ld, SSD_HEADS), 0.05)
    ssd_norm = 1.0 + nrm((Ld, W_BR), 0.05)
    gla_g2 = nrm((Ld, 2, GLA_RANK, GLA_HEADS * GLA_DK), GLA_RANK ** -0.5)
    gla_gb = nrm((Ld, 2, GLA_HEADS * GLA_DK), 0.5)
    gla_norm = 1.0 + nrm((Ld, W_BR), 0.05)
    return {'x': x, 'c': c, 'ctx': ctx, 'c_ctx': c_ctx, 'ada_w': ada_w, 'ada_b': ada_b,
            'norm_pre': norm_pre, 'norm_post': norm_post, 'w_in': w_in, 'w_out': w_out,
            'rw_mu': rw_mu, 'rw_w0': rw_w0, 'rw_w2': rw_w2, 'rw_a0': rw_a0, 'rw_a2': rw_a2,
            'rw_kk': rw_kk, 'rw_ka': rw_ka, 'rw_rk': rw_rk, 'rw_ln_w': rw_ln_w, 'rw_ln_b': rw_ln_b,
            's5_a_re': s5_a_re, 's5_a_im': s5_a_im, 's5_log_dt': s5_log_dt, 's5_b_re': s5_b_re,
            's5_b_im': s5_b_im, 's5_c_re': s5_c_re, 's5_c_im': s5_c_im, 's5_d': s5_d,
            's5_glu_w': s5_glu_w, 's5_glu_b': s5_glu_b, 'ssd_conv_w': ssd_conv_w, 'ssd_conv_b': ssd_conv_b,
            'ssd_dt_bias': ssd_dt_bias, 'ssd_a_log': ssd_a_log, 'ssd_d': ssd_d, 'ssd_norm': ssd_norm,
            'gla_g2': gla_g2, 'gla_gb': gla_gb, 'gla_norm': gla_norm}


def reference(x, c, ctx, c_ctx, ada_w, ada_b, norm_pre, norm_post, w_in, w_out,
              rw_mu, rw_w0, rw_w2, rw_a0, rw_a2, rw_kk, rw_ka, rw_rk, rw_ln_w, rw_ln_b,
              s5_a_re, s5_a_im, s5_log_dt, s5_b_re, s5_b_im, s5_c_re, s5_c_im, s5_d, s5_glu_w, s5_glu_b,
              ssd_conv_w, ssd_conv_b, ssd_dt_bias, ssd_a_log, ssd_d, ssd_norm,
              gla_g2, gla_gb, gla_norm):
    h, hc = x, ctx
    silu_c = jax.nn.silu(c)
    silu_cc = jax.nn.silu(c_ctx)
    for l in range(DEPTH):
        p = dict(norm_pre=norm_pre[l], norm_post=norm_post[l], w_in=w_in[l], w_out=w_out[l],
                 rw_mu=rw_mu[l], rw_w0=rw_w0[l], rw_w2=rw_w2[l], rw_a0=rw_a0[l], rw_a2=rw_a2[l],
                 rw_kk=rw_kk[l], rw_ka=rw_ka[l], rw_rk=rw_rk[l], rw_ln_w=rw_ln_w[l], rw_ln_b=rw_ln_b[l],
                 s5_a_re=s5_a_re[l], s5_a_im=s5_a_im[l], s5_log_dt=s5_log_dt[l], s5_b_re=s5_b_re[l],
                 s5_b_im=s5_b_im[l], s5_c_re=s5_c_re[l], s5_c_im=s5_c_im[l], s5_d=s5_d[l],
                 s5_glu_w=s5_glu_w[l], s5_glu_b=s5_glu_b[l], ssd_conv_w=ssd_conv_w[l], ssd_conv_b=ssd_conv_b[l],
                 ssd_dt_bias=ssd_dt_bias[l], ssd_a_log=ssd_a_log[l], ssd_d=ssd_d[l], ssd_norm=ssd_norm[l],
                 gla_g2=gla_g2[l], gla_gb=gla_gb[l], gla_norm=gla_norm[l])
        mod = (silu_c @ ada_w[l] + ada_b[l])[:, None, :]
        mod_c = (silu_cc @ ada_w[l] + ada_b[l])[None, None, :]
        last = l == DEPTH - 1
        hc_next, ctx_states = mixer_layer(hc, mod_c, p, False, None, not last)
        h, _ = mixer_layer(h, mod, p, True, ctx_states, True)
        hc = hc_next
    return h
```

```cpp
#ifdef CPU_EMU
#include "hip_emu.h"
#else
#include <hip/hip_runtime.h>
#include <hip/hip_cooperative_groups.h>
#include <stdint.h>
#include <stdio.h>
namespace cg = cooperative_groups;
#endif

#ifndef BATCH
#define BATCH 8
#endif
#ifndef SEQ
#define SEQ 4096
#endif
#ifndef CTX
#define CTX 256
#endif
#ifndef USE_COOP
#define USE_COOP 1
#endif

typedef unsigned short bf16;
typedef __attribute__((ext_vector_type(8))) short bf16x8;
typedef __attribute__((ext_vector_type(16))) float f32x16;
struct alignas(16) U4 { uint32_t a[4]; };
struct alignas(8) U2 { uint32_t a[2]; };
struct alignas(16) F4 { float a[4]; };

constexpr int D = 1024, NIN = 3368, NINP = 3456;
constexpr int ROWS_C = BATCH * CTX, ROWS_L = BATCH * SEQ, ROWS = ROWS_C + ROWS_L;
constexpr int VL = CTX + SEQ;
constexpr int TC = 64;
constexpr int NCH_C = CTX / TC, NCH_L = SEQ / TC, NCH = NCH_C + NCH_L;
constexpr int T5 = 32;
constexpr int NC5 = CTX / T5, NL5 = SEQ / T5, NCH5 = NC5 + NL5;
constexpr int M5 = BATCH * NCH5;
constexpr int NMOD = BATCH + 1;
constexpr int C_RW = 0, C_RWG = 1024, C_S5 = 1280, C_S5G = 1536, C_SSD = 1792, C_SSDDT = 2304, C_SSDZ = 2312;
constexpr int C_GLA = 2568, C_GLAK = 2696, C_GLAV = 2824, C_GLAGL = 3080, C_GLAG = 3112;

constexpr size_t al256(size_t x) { return (x + 255) & ~size_t(255); }
constexpr size_t OFF_WTIN = 0;
constexpr size_t OFF_WTOUT = OFF_WTIN + al256(2ull * NINP * D * 2);
constexpr size_t OFF_W2T = OFF_WTOUT + al256(2ull * D * D * 2);
constexpr size_t OFF_A2T = OFF_W2T + al256(2ull * 2 * 256 * 64 * 2);
constexpr size_t OFF_GLUT = OFF_A2T + al256(2ull * 2 * 256 * 64 * 2);
constexpr size_t OFF_MOD = OFF_GLUT + al256(2ull * 256 * 256 * 2);
constexpr size_t OFF_S5K = OFF_MOD + al256(2ull * NMOD * 3072 * 4);
constexpr size_t OFF_S5LT = OFF_S5K + al256(2ull * 16 * 2 * 32 * 256 * 4);
constexpr size_t OFF_W1T = OFF_S5LT + al256(2ull * 16 * 2 * 64 * 2 * 4);
constexpr size_t OFF_BT2 = OFF_W1T + al256(2ull * 16 * 256 * 512 * 2);
constexpr size_t OFF_PROJ = OFF_BT2 + al256(2ull * 16 * 512 * 768 * 2);
constexpr size_t OFF_R = OFF_PROJ + al256((size_t)ROWS * NIN * 2);
constexpr size_t OFF_XA = OFF_R + al256((size_t)ROWS * 1024 * 2);
constexpr size_t OFF_HC = OFF_XA + al256((size_t)ROWS * 1024 * 2);
constexpr size_t OFF_SSDST = OFF_HC + al256((size_t)ROWS_C * 1024 * 4);
constexpr size_t OFF_SSDDEC = OFF_SSDST + al256(2ull * BATCH * NCH * 4 * 4096 * 2);
constexpr size_t OFF_GLAST = OFF_SSDDEC + al256(2ull * BATCH * NCH * 4 * 4);
constexpr size_t OFF_GLADEC = OFF_GLAST + al256(2ull * BATCH * NCH * 4 * 2048 * 2);
constexpr size_t OFF_S5ST = OFF_GLADEC + al256(2ull * BATCH * NCH * 4 * 32 * 4);
constexpr size_t OFF_SSQ = OFF_S5ST + al256(16ull * M5 * 256 * 4);
constexpr size_t WS_TOTAL = OFF_SSQ + al256((size_t)ROWS * 4 * 4);
#if BATCH == 8 && SEQ == 4096 && CTX == 256
static_assert(WS_TOTAL <= 536870912ull, "workspace too large");
#endif
constexpr int SMEM_BYTES = 64512;

struct Params {
  const float *x, *c, *ctx, *c_ctx, *ada_w, *ada_b, *norm_pre, *norm_post, *w_in, *w_out;
  const float *rw_mu, *rw_w0, *rw_w2, *rw_a0, *rw_a2, *rw_kk, *rw_ka, *rw_rk, *rw_ln_w, *rw_ln_b;
  const float *s5_a_re, *s5_a_im, *s5_log_dt, *s5_b_re, *s5_b_im, *s5_c_re, *s5_c_im, *s5_d, *s5_glu_w, *s5_glu_b;
  const float *ssd_conv_w, *ssd_conv_b, *ssd_dt_bias, *ssd_a_log, *ssd_d, *ssd_norm;
  const float *gla_g2, *gla_gb, *gla_norm;
  float* out;
  unsigned char* ws;
};

__device__ __forceinline__ float bf2f(bf16 v) { return __uint_as_float(((uint32_t)v) << 16); }
__device__ __forceinline__ bf16 f2bf(float f) {
  uint32_t u = __float_as_uint(f);
  u += 0x7fffu + ((u >> 16) & 1u);
  return (bf16)(u >> 16);
}
__device__ __forceinline__ uint32_t pack2(float lo, float hi) { return (uint32_t)f2bf(lo) | ((uint32_t)f2bf(hi) << 16); }
__device__ __forceinline__ float lo2f(uint32_t u) { return __uint_as_float(u << 16); }
__device__ __forceinline__ float hi2f(uint32_t u) { return __uint_as_float(u & 0xffff0000u); }
__device__ __forceinline__ float sigmoid_f(float x) { return 1.f / (1.f + __expf(-x)); }
__device__ __forceinline__ float silu_f(float x) { return x / (1.f + __expf(-x)); }
__device__ __forceinline__ float softplus_f(float x) { return fmaxf(x, 0.f) + __logf(1.f + __expf(-fabsf(x))); }
__device__ __forceinline__ float tanh_f(float x) { return 1.f - 2.f / (1.f + __expf(2.f * x)); }
__device__ __forceinline__ float gelu_f(float x) {
  return 0.5f * x * (1.f + tanh_f(0.7978845608028654f * (x + 0.044715f * x * x * x)));
}
__device__ __forceinline__ U4 zero4() { U4 r; r.a[0] = r.a[1] = r.a[2] = r.a[3] = 0; return r; }
__device__ __forceinline__ f32x16 mfma32(bf16x8 a, bf16x8 b, f32x16 c) {
#ifdef CPU_EMU
  return emu_mfma32(a, b, c);
#else
  return __builtin_amdgcn_mfma_f32_32x32x16_bf16(a, b, c, 0, 0, 0);
#endif
}
__device__ __forceinline__ f32x16 zero16() { f32x16 z; for (int i = 0; i < 16; i++) z[i] = 0.f; return z; }
__device__ __forceinline__ int acc_row(int reg, int lane) { return (reg & 3) + 8 * (reg >> 2) + 4 * (lane >> 5); }
template <int CTRL> __device__ __forceinline__ float dpp_mov(float v) {
#ifdef CPU_EMU
  int l = threadIdx.x & 63, src;
  if (CTRL == 0xB1) src = l ^ 1; else if (CTRL == 0x4E) src = l ^ 2;
  else if (CTRL == 0x141) src = (l & ~7) | (7 - (l & 7)); else src = (l & ~15) | (15 - (l & 15));
  return emu_lane_read(v, src);
#else
  return __int_as_float(__builtin_amdgcn_update_dpp(0, __float_as_int(v), CTRL, 0xF, 0xF, true));
#endif
}
__device__ __forceinline__ float sum16(float v) {
  v += dpp_mov<0xB1>(v); v += dpp_mov<0x4E>(v); v += dpp_mov<0x141>(v); v += dpp_mov<0x140>(v); return v;
}
__device__ __forceinline__ float sum32(float v) {
  v = sum16(v); v += __shfl_xor(v, 16); return v;
}
__device__ __forceinline__ float sum64(float v) { v = sum32(v); v += __shfl_xor(v, 32); return v; }

__device__ __forceinline__ const bf16x8& ldsfrag(const bf16* p) { return *(const bf16x8*)p; }

__device__ __forceinline__ int chunk_row0(int b, int pc, int T, int nC) {
  return pc < nC ? b * CTX + pc * T : ROWS_C + b * SEQ + (pc - nC) * T;
}
__device__ __forceinline__ int ord_chunk(int d, int vc, int nC, int nAll) {
  return d == 0 ? vc : (vc < nC ? nC - 1 - vc : nAll - 1 - (vc - nC));
}
struct RowInfo { int isctx, b, t, seq0, len; };
__device__ __forceinline__ RowInfo row_info(int m) {
  RowInfo r;
  if (m < ROWS_C) { r.isctx = 1; r.b = m / CTX; r.t = m - r.b * CTX; r.seq0 = r.b * CTX; r.len = CTX; }
  else { int q = m - ROWS_C; r.isctx = 0; r.b = q / SEQ; r.t = q - r.b * SEQ; r.seq0 = ROWS_C + r.b * SEQ; r.len = SEQ; }
  return r;
}

template <class AL, class BL, class EP>
__device__ __forceinline__ void gemm_tile(unsigned char* sm, int m0, int n0, int K, AL al, BL bl, EP ep) {
  bf16* sA = (bf16*)sm;
  bf16* sB = sA + 128 * 40;
  const int tid = threadIdx.x, lane = tid & 63, w = tid >> 6, wm = w >> 1, wn = w & 1;
  f32x16 acc[2][2];
#pragma unroll
  for (int i = 0; i < 2; i++)
#pragma unroll
    for (int j = 0; j < 2; j++) acc[i][j] = zero16();
  const int lr = tid >> 2, lk = (tid & 3) * 8;
  U4 ra0 = al(m0 + lr, lk), ra1 = al(m0 + lr + 64, lk), rb0 = bl(n0 + lr, lk), rb1 = bl(n0 + lr + 64, lk);
#pragma unroll 1
  for (int k0 = 0; k0 < K; k0 += 32) {
    *(U4*)&sA[lr * 40 + lk] = ra0; *(U4*)&sA[(lr + 64) * 40 + lk] = ra1;
    *(U4*)&sB[lr * 40 + lk] = rb0; *(U4*)&sB[(lr + 64) * 40 + lk] = rb1;
    __syncthreads();
    if (k0 + 32 < K) {
      ra0 = al(m0 + lr, k0 + 32 + lk); ra1 = al(m0 + lr + 64, k0 + 32 + lk);
      rb0 = bl(n0 + lr, k0 + 32 + lk); rb1 = bl(n0 + lr + 64, k0 + 32 + lk);
    }
#pragma unroll
    for (int ks = 0; ks < 32; ks += 16) {
      bf16x8 fa[2], fb[2];
#pragma unroll
      for (int i = 0; i < 2; i++) fa[i] = ldsfrag(&sA[(wm * 64 + i * 32 + (lane & 31)) * 40 + ks + 8 * (lane >> 5)]);
#pragma unroll
      for (int j = 0; j < 2; j++) fb[j] = ldsfrag(&sB[(wn * 64 + j * 32 + (lane & 31)) * 40 + ks + 8 * (lane >> 5)]);
#pragma unroll
      for (int i = 0; i < 2; i++)
#pragma unroll
        for (int j = 0; j < 2; j++) acc[i][j] = mfma32(fa[i], fb[j], acc[i][j]);
    }
    __syncthreads();
  }
#pragma unroll
  for (int i = 0; i < 2; i++)
#pragma unroll
   for (int j = 0; j < 2; j++)
#pragma unroll
    for (int r = 0; r < 16; r++)
      ep(m0 + wm * 64 + i * 32 + acc_row(r, lane), n0 + wn * 64 + j * 32 + (lane & 31), acc[i][j][r]);
}

#define ITEM_LOOP(var, count, base) _Pragma("unroll 1") for (int var = (int)((blockIdx.x + gridDim.x - ((unsigned)(base) % gridDim.x)) % gridDim.x); var < (count); var += gridDim.x)
#define WS(T, off) ((T*)(P.ws + (off)))

__device__ __forceinline__ void transpose_tile(const float* src, int ld, int Ksz, int Nsz, bf16* dst, int kt, int nt, unsigned char* sm) {
  float* s = (float*)sm;
  const int tid = threadIdx.x;
#pragma unroll 2
  for (int i = tid; i < 4096; i += 256) {
    int kk = i >> 6, nn = i & 63;
    int k = kt * 64 + kk, n = nt * 64 + nn;
    s[kk * 65 + nn] = (n < Nsz && k < Ksz) ? src[(size_t)k * ld + n] : 0.f;
  }
  __syncthreads();
#pragma unroll 2
  for (int i = tid; i < 4096; i += 256) {
    int nn = i >> 6, kk = i & 63;
    dst[(size_t)(nt * 64 + nn) * Ksz + kt * 64 + kk] = f2bf(s[kk * 65 + nn]);
  }
  __syncthreads();
}

struct S5c { float lr, li, dt; };
__device__ __forceinline__ void s5_pow(const Params& P, int l, int d, int g, int p, float e, float& re, float& im) {
  int idx = ((l * 2 + d) * 16 + g) * 64 + p;
  float dt = __expf(P.s5_log_dt[(l * 2 + d) * 16 + g]);
  float ar = P.s5_a_re[idx] * dt * e, ai = P.s5_a_im[idx] * dt * e;
  float m = expf(ar);
  re = m * cosf(ai); im = m * sinf(ai);
}
__device__ __forceinline__ void s5_bbar_coef(const Params& P, int l, int d, int g, int p, float& re, float& im) {
  int idx = ((l * 2 + d) * 16 + g) * 64 + p;
  float lr = P.s5_a_re[idx], li = P.s5_a_im[idx];
  float br, bi; s5_pow(P, l, d, g, p, 1.f, br, bi);
  br -= 1.f;
  float den = lr * lr + li * li;
  re = (br * lr + bi * li) / den;
  im = (bi * lr - br * li) / den;
}

__device__ __forceinline__ void phase_prologue(const Params& P, unsigned char* sm) {
  const int tid = threadIdx.x;
  const int N_TIN = 2 * 16 * (NINP / 64);
  const int N_TOUT = 2 * 16 * 16;
  const int N_TL = 2 * 2 * 4;
  const int N_TA = 2 * 2 * 4;
  const int N_TG = 2 * 16;
  const int N_MOD = 2 * 48;
  const int N_S5K = 2 * 16 * 2 * 32;
  const int N_S5W1 = 2 * 16 * 32;
  const int N_S5B2 = 2 * 16 * 32;
  const int total = N_TIN + N_TOUT + N_TL + N_TA + N_TG + N_MOD + N_S5K + N_S5W1 + N_S5B2;
#pragma unroll 1
  for (int it = blockIdx.x; it < total; it += gridDim.x) {
    int i = it;
    if (i < N_TIN) {
      int l = i / (16 * (NINP / 64)), r = i % (16 * (NINP / 64));
      transpose_tile(P.w_in + (size_t)l * D * NIN, NIN, D, NIN, WS(bf16, OFF_WTIN) + (size_t)l * NINP * D, r % 16, r / 16, sm);
      continue;
    }
    i -= N_TIN;
    if (i < N_TOUT) {
      int l = i / 256, r = i % 256;
      transpose_tile(P.w_out + (size_t)l * D * D, D, D, D, WS(bf16, OFF_WTOUT) + (size_t)l * D * D, r % 16, r / 16, sm);
      continue;
    }
    i -= N_TOUT;
    if (i < N_TL) {
      int ld = i / 4, nt = i % 4;
      transpose_tile(P.rw_w2 + (size_t)ld * 64 * 256, 256, 64, 256, WS(bf16, OFF_W2T) + (size_t)ld * 256 * 64, 0, nt, sm);
      continue;
    }
    i -= N_TL;
    if (i < N_TA) {
      int ld = i / 4, nt = i % 4;
      transpose_tile(P.rw_a2 + (size_t)ld * 64 * 256, 256, 64, 256, WS(bf16, OFF_A2T) + (size_t)ld * 256 * 64, 0, nt, sm);
      continue;
    }
    i -= N_TA;
    if (i < N_TG) {
      int l = i / 16, r = i % 16;
      transpose_tile(P.s5_glu_w + (size_t)l * 256 * 256, 256, 256, 256, WS(bf16, OFF_GLUT) + (size_t)l * 256 * 256, r % 4, r / 4, sm);
      continue;
    }
    i -= N_TG;
    if (i < N_MOD) {
      int l = i / 48, ct = i % 48;
      float* ssil = (float*)sm;
      float* red = ssil + NMOD * 1024;
#pragma unroll 2
      for (int e = tid; e < NMOD * 1024; e += 256) {
        int r = e >> 10, k = e & 1023;
        float v = r < BATCH ? P.c[r * 1024 + k] : P.c_ctx[k];
        ssil[e] = silu_f(v);
      }
      __syncthreads();
      int kq = tid >> 6, jj = tid & 63, j = ct * 64 + jj;
      float acc[NMOD];
      for (int r = 0; r < NMOD; r++) acc[r] = 0.f;
      const float* wp = P.ada_w + (size_t)l * D * 3072 + j;
      for (int k = kq * 256; k < kq * 256 + 256; k++) {
        float wv = wp[(size_t)k * 3072];
#pragma unroll
        for (int r = 0; r < NMOD; r++) acc[r] += ssil[r * 1024 + k] * wv;
      }
#pragma unroll
      for (int r = 0; r < NMOD; r++) red[(kq * NMOD + r) * 64 + jj] = acc[r];
      __syncthreads();
#pragma unroll 2
      for (int e = tid; e < NMOD * 64; e += 256) {
        int r = e >> 6, j2 = e & 63;
        float s = red[(0 * NMOD + r) * 64 + j2] + red[(1 * NMOD + r) * 64 + j2] + red[(2 * NMOD + r) * 64 + j2] + red[(3 * NMOD + r) * 64 + j2];
        WS(float, OFF_MOD)[((size_t)l * NMOD + r) * 3072 + ct * 64 + j2] = s + P.ada_b[l * 3072 + ct * 64 + j2];
      }
      __syncthreads();
      continue;
    }
    i -= N_MOD;
    if (i < N_S5K) {
      int m = i & 31, d = (i >> 5) & 1, g = (i >> 6) & 15, l = i >> 10;
      float* spw = (float*)sm;
      if (tid < 64) {
        float pr, pi, cr, ci;
        s5_pow(P, l, d, g, tid, (float)m, pr, pi);
        s5_bbar_coef(P, l, d, g, tid, cr, ci);
        spw[tid * 2] = pr * cr - pi * ci; spw[tid * 2 + 1] = pr * ci + pi * cr;
      }
      __syncthreads();
      int c = tid >> 4, cp = tid & 15;
      size_t bb = ((size_t)((l * 2 + d) * 16 + g) * 64) * 16;
      size_t cb = ((size_t)((l * 2 + d) * 16 + g) * 16 + c) * 64;
      float s = 0.f;
      for (int p = 0; p < 64; p++) {
        float wr = spw[p * 2], wi = spw[p * 2 + 1];
        float br = P.s5_b_re[bb + p * 16 + cp], bi = P.s5_b_im[bb + p * 16 + cp];
        float zr = wr * br - wi * bi, zi = wr * bi + wi * br;
        float cr = P.s5_c_re[cb + p], ci = P.s5_c_im[cb + p];
        s += cr * zr - ci * zi;
      }
      WS(float, OFF_S5K)[((size_t)(((l * 16 + g) * 2 + d) * 32 + m)) * 256 + tid] = s;
      __syncthreads();
      continue;
    }
    i -= N_S5K;
    if (i < N_S5W1) {
      int j = i & 31, g = (i >> 5) & 15, l = i >> 9;
      int pp = tid, d = pp >> 7, ri = (pp >> 6) & 1, p = pp & 63;
      float e = d == 0 ? (float)(T5 - 1 - j) : (float)j;
      float pr, pi, cr, ci;
      s5_pow(P, l, d, g, p, e, pr, pi);
      s5_bbar_coef(P, l, d, g, p, cr, ci);
      float wr = pr * cr - pi * ci, wi = pr * ci + pi * cr;
      size_t bb = ((size_t)((l * 2 + d) * 16 + g) * 64 + p) * 16;
      bf16* dst = WS(bf16, OFF_W1T) + ((size_t)(l * 16 + g) * 256 + pp) * 512 + j * 16;
      for (int cp = 0; cp < 16; cp++) {
        float br = P.s5_b_re[bb + cp], bi = P.s5_b_im[bb + cp];
        float zr = wr * br - wi * bi, zi = wr * bi + wi * br;
        dst[cp] = f2bf(ri == 0 ? zr : zi);
      }
      if (j == 0 && ri == 0) {
        float tr, ti; s5_pow(P, l, d, g, p, (float)T5, tr, ti);
        float* lt = WS(float, OFF_S5LT) + ((size_t)((l * 16 + g) * 2 + d) * 64 + p) * 2;
        lt[0] = tr; lt[1] = ti;
      }
      continue;
    }
    i -= N_S5W1;
    {
      int t = i & 31, g = (i >> 5) & 15, l = i >> 9;
      int kk = tid, d = kk >> 7, ri = (kk >> 6) & 1, p = kk & 63;
      float e = d == 0 ? (float)(t + 1) : (float)(T5 - t);
      float pr, pi; s5_pow(P, l, d, g, p, e, pr, pi);
      for (int c = 0; c < 16; c++) {
        size_t cb = ((size_t)((l * 2 + d) * 16 + g) * 16 + c) * 64 + p;
        float cr = P.s5_c_re[cb], ci = P.s5_c_im[cb];
        float zr = cr * pr - ci * pi, zi = cr * pi + ci * pr;
        WS(bf16, OFF_BT2)[((size_t)(l * 16 + g) * 512 + t * 16 + c) * 768 + 512 + kk] = f2bf(ri == 0 ? zr : -zi);
      }
    }
  }
}

__device__ __forceinline__ void s5_toeplitz_items(const Params& P, int item) {
  int t = item & 31, g = (item >> 5) & 15, l = item >> 9;
  const float* K = WS(float, OFF_S5K) + (size_t)((l * 16 + g) * 2) * 32 * 256;
  bf16* dst = WS(bf16, OFF_BT2) + ((size_t)(l * 16 + g) * 512 + t * 16) * 768;
#pragma unroll 2
  for (int e = threadIdx.x; e < 16 * 512; e += 256) {
    int c = e >> 9, k = e & 511, j = k >> 4, cp = k & 15;
    float v;
    if (j < t) v = K[((0 * 32) + (t - j)) * 256 + c * 16 + cp];
    else if (j > t) v = K[((1 * 32) + (j - t)) * 256 + c * 16 + cp];
    else v = K[(0 * 32) * 256 + c * 16 + cp] + K[(1 * 32) * 256 + c * 16 + cp];
    dst[(size_t)c * 768 + k] = f2bf(v);
  }
}

__device__ __forceinline__ void phase_normmod(const Params& P, int l) {
  const int lane = threadIdx.x & 63, w = threadIdx.x >> 6;
  const int nrow_items = ROWS / 4;
  const int n_toe = (l == 0) ? 2 * 16 * 32 : 0;
#pragma unroll 1
  for (int it = blockIdx.x; it < nrow_items + n_toe; it += gridDim.x) {
    if (it >= nrow_items) { s5_toeplitz_items(P, it - nrow_items); continue; }
    int m = it * 4 + w;
    RowInfo ri = row_info(m);
    const float* src;
    if (ri.isctx) src = (l == 0 ? P.ctx : WS(float, OFF_HC)) + (size_t)m * D;
    else src = (l == 0 ? P.x : P.out) + (size_t)(m - ROWS_C) * D;
    const float* mod = WS(float, OFF_MOD) + ((size_t)l * NMOD + (ri.isctx ? BATCH : ri.b)) * 3072;
    F4 v[4]; float ss = 0.f;
    for (int q = 0; q < 4; q++) {
      v[q] = *(const F4*)(src + q * 256 + lane * 4);
      for (int e = 0; e < 4; e++) ss += v[q].a[e] * v[q].a[e];
    }
    ss = sum64(ss);
    float rstd = rsqrtf(ss * (1.f / 1024.f) + 1e-6f);
    bf16* dst = WS(bf16, OFF_R) + (size_t)m * D;
    for (int q = 0; q < 4; q++) {
      int c0 = q * 256 + lane * 4;
      float o[4];
      for (int e = 0; e < 4; e++) {
        int c = c0 + e;
        o[e] = v[q].a[e] * rstd * P.norm_pre[l * D + c] * (1.f + mod[1024 + c]) + mod[c];
      }
      U2 pk; pk.a[0] = pack2(o[0], o[1]); pk.a[1] = pack2(o[2], o[3]);
      *(U2*)(dst + c0) = pk;
    }
  }
}

__device__ __forceinline__ void phase_inproj(const Params& P, int l, unsigned char* sm) {
  const bf16* A = WS(bf16, OFF_R);
  const bf16* Bt = WS(bf16, OFF_WTIN) + (size_t)l * NINP * D;
  bf16* C = WS(bf16, OFF_PROJ);
  const int NT = NINP / 128, MT = ROWS / 128;
#pragma unroll 1
  for (int it = blockIdx.x; it < MT * NT; it += gridDim.x) {
    int mt = it / NT, nt = it % NT;
    gemm_tile(sm, mt * 128, nt * 128, D,
      [&](int m, int k) { return *(const U4*)(A + (size_t)m * D + k); },
      [&](int n, int k) { return *(const U4*)(Bt + (size_t)n * D + k); },
      [&](int m, int n, float v) { if (n < NIN) C[(size_t)m * NIN + n] = f2bf(v); });
  }
}

__device__ __forceinline__ void rw_lerp4(const Params& P, int l, int m, int ms, int col, float* o) {
  const bf16* pr = WS(bf16, OFF_PROJ);
  U2 z = *(const U2*)(pr + (size_t)m * NIN + col);
  U2 zs; zs.a[0] = zs.a[1] = 0;
  if (ms >= 0) zs = *(const U2*)(pr + (size_t)ms * NIN + col);
  const float* mu = P.rw_mu + l * 1024 + col;
#pragma unroll
  for (int e = 0; e < 2; e++) {
    float a0 = lo2f(z.a[e]), a1 = hi2f(z.a[e]), s0 = lo2f(zs.a[e]), s1 = hi2f(zs.a[e]);
    o[2 * e] = a0 + mu[2 * e] * (s0 - a0);
    o[2 * e + 1] = a1 + mu[2 * e + 1] * (s1 - a1);
  }
}
__device__ __forceinline__ void phase_rwprep(const Params& P, int l, unsigned char* sm) {
  const int lane = threadIdx.x & 63, w = threadIdx.x >> 6;
  const int MT = ROWS / 128;
  const int n_gemm = MT * 2 * 4;
  const int n_rows = ROWS / 4;
  bf16* XA = WS(bf16, OFF_XA);
#pragma unroll 1
  for (int it = blockIdx.x; it < n_gemm + n_rows; it += gridDim.x) {
    if (it < n_gemm) {
      int kind = it & 3, nt = (it >> 2) & 1, mt = it >> 3;
      int isA = kind >> 1, d = kind & 1;
      const bf16* Bt = (isA ? WS(bf16, OFF_A2T) : WS(bf16, OFF_W2T)) + (size_t)(l * 2 + d) * 256 * 64;
      const float* bias = (isA ? P.rw_a0 : P.rw_w0) + (l * 2 + d) * 256;
      gemm_tile(sm, mt * 128, nt * 128, 64,
        [&](int m, int k) {
          RowInfo ri = row_info(m);
          int ms;
          if (ri.isctx) ms = ri.t < CTX - 1 ? m + 1 : -1; else ms = ri.t < SEQ - 64 ? m + 64 : -1;
          int col = 768 + isA * 128 + d * 64 + k;
          const bf16* prj = WS(bf16, OFF_PROJ);
          U4 z = *(const U4*)(prj + (size_t)m * NIN + col);
          U4 zs = ms >= 0 ? *(const U4*)(prj + (size_t)ms * NIN + col) : zero4();
          const float* mu = P.rw_mu + l * 1024 + col;
          U4 r;
#pragma unroll
          for (int e = 0; e < 4; e++) {
            float a0 = lo2f(z.a[e]), a1 = hi2f(z.a[e]), s0 = lo2f(zs.a[e]), s1 = hi2f(zs.a[e]);
            float o0 = a0 + mu[2 * e] * (s0 - a0), o1 = a1 + mu[2 * e + 1] * (s1 - a1);
            if (!isA) { o0 = tanh_f(o0); o1 = tanh_f(o1); }
            r.a[e] = pack2(o0, o1);
          }
          return r;
        },
        [&](int n, int k) { return *(const U4*)(Bt + (size_t)n * 64 + k); },
        [&](int m, int n, float v) {
          v += bias[n];
          float o;
          if (!isA) { float lw = -__expf(-softplus_f(-v) - 0.5f); o = 1.f - __expf(lw); }
          else o = sigmoid_f(v);
          XA[(size_t)m * 1024 + isA * 512 + d * 256 + n] = f2bf(o);
        });
      continue;
    }
    int m = (it - n_gemm) * 4 + w;
    RowInfo ri = row_info(m);
    int ms_r, ms_k, ms_v;
    if (ri.isctx) { ms_r = ms_k = ri.t > 0 ? m - 1 : -1; ms_v = ri.t < CTX - 1 ? m + 1 : -1; }
    else {
      int gx = ri.t & 63;
      ms_r = gx > 0 ? m - 1 : -1; ms_k = gx < 63 ? m + 1 : -1; ms_v = ri.t >= 64 ? m - 64 : -1;
    }
    bf16* R = WS(bf16, OFF_R) + (size_t)m * 1024;
    float rr[4], kk[4], vv[4], kap[4];
    rw_lerp4(P, l, m, ms_r, lane * 4, rr);
    rw_lerp4(P, l, m, ms_k, 256 + lane * 4, kk);
    rw_lerp4(P, l, m, ms_v, 512 + lane * 4, vv);
    float ss = 0.f;
    for (int e = 0; e < 4; e++) { kap[e] = kk[e] * P.rw_kk[l * 256 + lane * 4 + e]; ss += kap[e] * kap[e]; }
    ss = sum16(ss);
    float rs = rsqrtf(ss + 1e-6f);
    U2 o;
    o.a[0] = pack2(rr[0], rr[1]); o.a[1] = pack2(rr[2], rr[3]); *(U2*)(R + lane * 4) = o;
    o.a[0] = pack2(kk[0], kk[1]); o.a[1] = pack2(kk[2], kk[3]); *(U2*)(R + 256 + lane * 4) = o;
    o.a[0] = pack2(vv[0], vv[1]); o.a[1] = pack2(vv[2], vv[3]); *(U2*)(R + 512 + lane * 4) = o;
    o.a[0] = pack2(kap[0] * rs, kap[1] * rs); o.a[1] = pack2(kap[2] * rs, kap[3] * rs); *(U2*)(R + 768 + lane * 4) = o;
  }
}

__device__ __forceinline__ int virt_row(int b, int d, int j) {
  if (j < CTX) return b * CTX + (d == 0 ? j : CTX - 1 - j);
  int q = j - CTX;
  return ROWS_C + b * SEQ + (d == 0 ? q : SEQ - 1 - q);
}
__device__ __forceinline__ void rwkv_scan_item(const Params& P, int l, int item, unsigned char* sm) {
  const int tid = threadIdx.x;
  const int rg = item & 3, d = (item >> 2) & 1, h = (item >> 3) & 3, b = item >> 5;
  float* sr = (float*)sm;
  float* sk = sr + 1024;
  float* sw = sk + 1024;
  float* sb = sw + 1024;
  float* skd = sb + 1024;
  float* sv = skd + 1024;
  const bf16* R = WS(bf16, OFF_R);
  const bf16* XA = WS(bf16, OFF_XA);
  bf16* Y = WS(bf16, OFF_PROJ);
  const int tt = tid >> 4, s4 = (tid & 15) * 4;
  const int vrow = tid >> 4, sl = tid & 15;
  float ka[4];
  for (int e = 0; e < 4; e++) ka[e] = P.rw_ka[l * 256 + h * 64 + s4 + e];
  float S0 = 0.f, S1 = 0.f, S2 = 0.f, S3 = 0.f;
  U2 gr, gk, gkap, gx, ga; bf16 gv;
  auto prefetch = [&](int tile) {
    int row = virt_row(b, d, tile * 16 + tt);
    const bf16* rp = R + (size_t)row * 1024 + h * 64;
    gr = *(const U2*)(rp + s4); gk = *(const U2*)(rp + 256 + s4); gkap = *(const U2*)(rp + 768 + s4);
    gv = rp[512 + rg * 16 + sl];
    const bf16* xp = XA + (size_t)row * 1024 + d * 256 + h * 64 + s4;
    gx = *(const U2*)(xp); ga = *(const U2*)(xp + 512);
  };
  prefetch(0);
  const int ntiles = VL / 16;
  for (int tile = 0; tile < ntiles; tile++) {
    {
      float rv[4] = {lo2f(gr.a[0]), hi2f(gr.a[0]), lo2f(gr.a[1]), hi2f(gr.a[1])};
      float kv[4] = {lo2f(gk.a[0]), hi2f(gk.a[0]), lo2f(gk.a[1]), hi2f(gk.a[1])};
      float kp[4] = {lo2f(gkap.a[0]), hi2f(gkap.a[0]), lo2f(gkap.a[1]), hi2f(gkap.a[1])};
      float xv[4] = {lo2f(gx.a[0]), hi2f(gx.a[0]), lo2f(gx.a[1]), hi2f(gx.a[1])};
      float av[4] = {lo2f(ga.a[0]), hi2f(ga.a[0]), lo2f(ga.a[1]), hi2f(ga.a[1])};
      F4 o;
      for (int e = 0; e < 4; e++) o.a[e] = rv[e]; *(F4*)&sr[tt * 64 + s4] = o;
      for (int e = 0; e < 4; e++) o.a[e] = kp[e]; *(F4*)&sk[tt * 64 + s4] = o;
      for (int e = 0; e < 4; e++) o.a[e] = 1.f - xv[e]; *(F4*)&sw[tt * 64 + s4] = o;
      for (int e = 0; e < 4; e++) o.a[e] = kp[e] * av[e]; *(F4*)&sb[tt * 64 + s4] = o;
      for (int e = 0; e < 4; e++) o.a[e] = kv[e] * (1.f + (av[e] - 1.f) * ka[e]); *(F4*)&skd[tt * 64 + s4] = o;
      sv[tt * 16 + sl] = bf2f(gv);
    }
    __syncthreads();
    if (tile + 1 < ntiles) prefetch(tile + 1);
    for (int t = 0; t < 16; t++) {
      F4 r4 = *(const F4*)&sr[t * 64 + sl * 4];
      F4 k4 = *(const F4*)&sk[t * 64 + sl * 4];
      F4 w4 = *(const F4*)&sw[t * 64 + sl * 4];
      F4 b4 = *(const F4*)&sb[t * 64 + sl * 4];
      F4 d4 = *(const F4*)&skd[t * 64 + sl * 4];
      float vv = sv[t * 16 + vrow];
      float sa = -(S0 * k4.a[0] + S1 * k4.a[1] + S2 * k4.a[2] + S3 * k4.a[3]);
      sa = sum16(sa);
      S0 = S0 * w4.a[0] + sa * b4.a[0] + vv * d4.a[0];
      S1 = S1 * w4.a[1] + sa * b4.a[1] + vv * d4.a[1];
      S2 = S2 * w4.a[2] + sa * b4.a[2] + vv * d4.a[2];
      S3 = S3 * w4.a[3] + sa * b4.a[3] + vv * d4.a[3];
      float y = S0 * r4.a[0] + S1 * r4.a[1] + S2 * r4.a[2] + S3 * r4.a[3];
      y = sum16(y);
      if (sl == 0) {
        int row = virt_row(b, d, tile * 16 + t);
        Y[(size_t)row * NIN + d * 256 + h * 64 + rg * 16 + vrow] = f2bf(y);
      }
    }
    __syncthreads();
  }
}

__device__ __forceinline__ float ssd_aneg(const Params& P, int l, int d, int h) { return -__expf(P.ssd_a_log[(l * 2 + d) * 4 + h]); }
__device__ __forceinline__ void ssd_state_item(const Params& P, int l, int item, unsigned char* sm) {
  const int tid = threadIdx.x, lane = tid & 63, w = tid >> 6;
  const int d = item & 1, h = (item >> 1) & 3, rest = item >> 3;
  const int pc = rest % NCH, b = rest / NCH;
  const int isctx = pc < NCH_C, len = isctx ? CTX : SEQ, t0 = (isctx ? pc : pc - NCH_C) * TC;
  const int seq0 = isctx ? b * CTX : ROWS_C + b * SEQ;
  bf16* sRaw = (bf16*)sm;
  bf16* sVt = sRaw + 2 * 68 * 64;
  bf16* sBt = sVt + 64 * 72;
  float* sdt = (float*)(sBt + 64 * 72);
  float* sdw = sdt + 64;
  const bf16* pr = WS(bf16, OFF_PROJ);
#pragma unroll 2
  for (int idx = tid; idx < 2 * 68 * 8; idx += 256) {
    int which = idx / (68 * 8), rem = idx % (68 * 8), tr = rem >> 3, c8 = rem & 7;
    int t = t0 - 2 + tr;
    int col = C_SSD + (which == 0 ? h * 64 : 256 + (h >> 1) * 64) + c8 * 8;
    U4 v = (t >= 0 && t < len) ? *(const U4*)(pr + (size_t)(seq0 + t) * NIN + col) : zero4();
    *(U4*)&sRaw[(which * 68 + tr) * 64 + c8 * 8] = v;
  }
  if (tid < 64) {
    float raw = bf2f(pr[(size_t)(seq0 + t0 + tid) * NIN + C_SSDDT + d * 4 + h]);
    sdt[tid] = softplus_f(raw + P.ssd_dt_bias[(l * 2 + d) * 4 + h]);
  }
  __syncthreads();
  if (tid == 0) {
    float an = ssd_aneg(P, l, d, h), run = 0.f;
    if (d == 0) { for (int t = TC - 1; t >= 0; t--) { sdw[t] = __expf(run); run += sdt[t] * an; } }
    else { for (int t = 0; t < TC; t++) { sdw[t] = __expf(run); run += sdt[t] * an; } }
    WS(float, OFF_SSDDEC)[((size_t)(d * BATCH + b) * NCH + pc) * 4 + h] = __expf(run);
  }
  __syncthreads();
#pragma unroll 2
  for (int idx = tid; idx < 2 * 64 * 64; idx += 256) {
    int which = idx >> 12, t = (idx >> 6) & 63, c = idx & 63;
    int ch = which == 0 ? h * 64 + c : 256 + (h >> 1) * 64 + c;
    float acc = P.ssd_conv_b[l * 512 + ch];
    for (int i = 0; i < 5; i++) acc += bf2f(sRaw[(which * 68 + t + i) * 64 + c]) * P.ssd_conv_w[(l * 5 + i) * 512 + ch];
    float v = silu_f(acc);
    if (which == 0) sVt[c * 72 + t] = f2bf(v * sdt[t] * sdw[t]);
    else sBt[c * 72 + t] = f2bf(v);
  }
  __syncthreads();
  {
    int ti = w >> 1, tj = w & 1;
    f32x16 acc = zero16();
    for (int ks = 0; ks < 64; ks += 16)
      acc = mfma32(ldsfrag(&sVt[(ti * 32 + (lane & 31)) * 72 + ks + 8 * (lane >> 5)]),
                   ldsfrag(&sBt[(tj * 32 + (lane & 31)) * 72 + ks + 8 * (lane >> 5)]), acc);
    bf16* st = WS(bf16, OFF_SSDST) + ((size_t)((d * BATCH + b) * NCH + pc) * 4 + h) * 4096;
    for (int r = 0; r < 16; r++) st[(ti * 32 + acc_row(r, lane)) * 64 + tj * 32 + (lane & 31)] = f2bf(acc[r]);
  }
  __syncthreads();
}

__device__ __forceinline__ void gla_la(const Params& P, int l, int d, int h, const float* sGl, float* dst) {
#pragma unroll 2
  for (int idx = threadIdx.x; idx < 64 * 32; idx += 256) {
    int t = idx >> 5, k = idx & 31;
    float acc = P.gla_gb[(l * 2 + d) * 128 + h * 32 + k];
    const float* g2 = P.gla_g2 + (size_t)(l * 2 + d) * 16 * 128 + h * 32 + k;
    for (int r = 0; r < 16; r++) acc += sGl[t * 32 + d * 16 + r] * g2[r * 128];
    dst[idx] = -softplus_f(-acc) * (1.f / 16.f);
  }
}
__device__ __forceinline__ void gla_state_item(const Params& P, int l, int item, unsigned char* sm) {
  const int tid = threadIdx.x, lane = tid & 63, w = tid >> 6;
  const int d = item & 1, h = (item >> 1) & 3, rest = item >> 3;
  const int pc = rest % NCH, b = rest / NCH;
  const int row0 = chunk_row0(b, pc, TC, NCH_C);
  float* sGl = (float*)sm;
  float* sLa = sGl + 2048;
  bf16* sVt = (bf16*)(sLa + 2048);
  bf16* sKt = sVt + 64 * 72;
  const bf16* pr = WS(bf16, OFF_PROJ);
#pragma unroll 2
  for (int idx = tid; idx < 64 * 32; idx += 256) {
    int t = idx >> 5, c = idx & 31;
    sGl[idx] = bf2f(pr[(size_t)(row0 + t) * NIN + C_GLAGL + c]);
  }
  __syncthreads();
  gla_la(P, l, d, h, sGl, sLa);
  __syncthreads();
  if (tid < 32) {
    float run = 0.f;
    if (d == 0) { for (int t = TC - 1; t >= 0; t--) { float la = sLa[t * 32 + tid]; sLa[t * 32 + tid] = run; run += la; } }
    else { for (int t = 0; t < TC; t++) { float la = sLa[t * 32 + tid]; sLa[t * 32 + tid] = run; run += la; } }
    WS(float, OFF_GLADEC)[(((size_t)(d * BATCH + b) * NCH + pc) * 4 + h) * 32 + tid] = __expf(run);
  }
  __syncthreads();
#pragma unroll 2
  for (int idx = tid; idx < 64 * 64; idx += 256) {
    int t = idx >> 6, c = idx & 63;
    sVt[c * 72 + t] = pr[(size_t)(row0 + t) * NIN + C_GLAV + h * 64 + c];
  }
#pragma unroll 2
  for (int idx = tid; idx < 64 * 32; idx += 256) {
    int t = idx >> 5, k = idx & 31;
    float kv = bf2f(pr[(size_t)(row0 + t) * NIN + C_GLAK + h * 32 + k]);
    sKt[k * 72 + t] = f2bf(kv * __expf(sLa[t * 32 + k]));
  }
  __syncthreads();
  if (w < 2) {
    f32x16 acc = zero16();
    for (int ks = 0; ks < 64; ks += 16)
      acc = mfma32(ldsfrag(&sVt[(w * 32 + (lane & 31)) * 72 + ks + 8 * (lane >> 5)]),
                   ldsfrag(&sKt[(lane & 31) * 72 + ks + 8 * (lane >> 5)]), acc);
    bf16* st = WS(bf16, OFF_GLAST) + ((size_t)((d * BATCH + b) * NCH + pc) * 4 + h) * 2048;
    for (int r = 0; r < 16; r++) st[(w * 32 + acc_row(r, lane)) * 32 + (lane & 31)] = f2bf(acc[r]);
  }
  __syncthreads();
}

__device__ __forceinline__ U4 s5_u_load(const Params& P, int g, int n, int k8) {
  if (n >= M5) return zero4();
  int b = n / NCH5, pc = n - b * NCH5;
  int row = chunk_row0(b, pc, T5, NC5) + (k8 >> 4);
  return *(const U4*)(WS(bf16, OFF_PROJ) + (size_t)row * NIN + C_S5 + g * 16 + (k8 & 15));
}
__device__ __forceinline__ void s5_state_tile(const Params& P, int l, int item, unsigned char* sm) {
  const int MT5 = (M5 + 127) / 128;
  int nt = item & 1, mt = (item >> 1) % MT5, g = (item >> 1) / MT5;
  const bf16* Bt = WS(bf16, OFF_W1T) + (size_t)(l * 16 + g) * 256 * 512;
  float* S = WS(float, OFF_S5ST) + (size_t)g * M5 * 256;
  gemm_tile(sm, mt * 128, nt * 128, 512,
    [&](int m, int k) { return s5_u_load(P, g, m, k); },
    [&](int n, int k) { return *(const U4*)(Bt + (size_t)n * 512 + k); },
    [&](int m, int n, float v) { if (m < M5) S[(size_t)m * 256 + n] = v; });
}

__device__ __forceinline__ void phase_D(const Params& P, int l, unsigned char* sm) {
  const int n_rw = BATCH * 32, n_ssd = BATCH * NCH * 8, n_gla = BATCH * NCH * 8;
  const int n_s5 = 16 * ((M5 + 127) / 128) * 2;
  ITEM_LOOP(i, n_rw, 0) rwkv_scan_item(P, l, i, sm);
  ITEM_LOOP(i, n_ssd, n_rw) ssd_state_item(P, l, i, sm);
  ITEM_LOOP(i, n_gla, n_rw + n_ssd) gla_state_item(P, l, i, sm);
  ITEM_LOOP(i, n_s5, n_rw + n_ssd + n_gla) s5_state_tile(P, l, i, sm);
}

__device__ __forceinline__ void rwkv_final_row(const Params& P, int l, int m) {
  const int lane = threadIdx.x & 63;
  const bf16* pr = WS(bf16, OFF_PROJ) + (size_t)m * NIN;
  bf16* R = WS(bf16, OFF_R) + (size_t)m * 1024;
  const bf16* XA = WS(bf16, OFF_XA) + (size_t)m * 1024;
  for (int h = 0; h < 4; h++) {
    int c = h * 64 + lane;
    float y = bf2f(pr[c]) + bf2f(pr[256 + c]);
    float mu = sum64(y) * (1.f / 64.f);
    float dv = y - mu;
    float var = sum64(dv * dv) * (1.f / 64.f);
    float yn = dv * rsqrtf(var + 64e-5f) * P.rw_ln_w[l * 256 + c] + P.rw_ln_b[l * 256 + c];
    float r = bf2f(R[c]), k = bf2f(R[256 + c]), v = bf2f(R[512 + c]);
    float a0 = bf2f(XA[512 + c]), a1 = bf2f(XA[768 + c]);
    float ka = P.rw_ka[l * 256 + c];
    float dot = r * k * P.rw_rk[l * 256 + c] * ((1.f + (a0 - 1.f) * ka) + (1.f + (a1 - 1.f) * ka));
    dot = sum64(dot);
    float g = bf2f(pr[C_RWG + c]);
    R[c] = f2bf((yn + dot * v) * silu_f(g));
  }
}
__device__ __forceinline__ void phase_E(const Params& P, int l) {
  const int tid = threadIdx.x, w = tid >> 6;
  const int n_ssd = 2 * BATCH * 4 * 4, n_gla = 2 * BATCH * 4 * 2, n_s5 = 16 * BATCH, n_fin = ROWS / 4;
#pragma unroll 1
  for (int it = blockIdx.x; it < n_ssd + n_gla + n_s5 + n_fin; it += gridDim.x) {
    int i = it;
    if (i < n_ssd) {
      int q = i & 3, h = (i >> 2) & 3, rest = i >> 4, b = rest % BATCH, d = rest / BATCH;
      float S[4] = {0.f, 0.f, 0.f, 0.f};
      for (int vc = 0; vc < NCH; vc++) {
        int pc = ord_chunk(d, vc, NCH_C, NCH);
        size_t ci = ((size_t)(d * BATCH + b) * NCH + pc) * 4 + h;
        bf16* p = WS(bf16, OFF_SSDST) + ci * 4096 + q * 1024 + tid * 4;
        float dec = WS(float, OFF_SSDDEC)[ci];
        U2 cv = *(U2*)p;
        U2 o; o.a[0] = pack2(S[0], S[1]); o.a[1] = pack2(S[2], S[3]);
        *(U2*)p = o;
        S[0] = dec * S[0] + lo2f(cv.a[0]); S[1] = dec * S[1] + hi2f(cv.a[0]);
        S[2] = dec * S[2] + lo2f(cv.a[1]); S[3] = dec * S[3] + hi2f(cv.a[1]);
      }
      continue;
    }
    i -= n_ssd;
    if (i < n_gla) {
      int q = i & 1, h = (i >> 1) & 3, rest = i >> 3, b = rest % BATCH, d = rest / BATCH;
      float S[4] = {0.f, 0.f, 0.f, 0.f};
      int e0 = q * 1024 + tid * 4, k0 = e0 & 31;
      for (int vc = 0; vc < NCH; vc++) {
        int pc = ord_chunk(d, vc, NCH_C, NCH);
        size_t ci = ((size_t)(d * BATCH + b) * NCH + pc) * 4 + h;
        bf16* p = WS(bf16, OFF_GLAST) + ci * 2048 + e0;
        F4 dec = *(const F4*)(WS(float, OFF_GLADEC) + ci * 32 + k0);
        U2 cv = *(U2*)p;
        U2 o; o.a[0] = pack2(S[0], S[1]); o.a[1] = pack2(S[2], S[3]);
        *(U2*)p = o;
        S[0] = dec.a[0] * S[0] + lo2f(cv.a[0]); S[1] = dec.a[1] * S[1] + hi2f(cv.a[0]);
        S[2] = dec.a[2] * S[2] + lo2f(cv.a[1]); S[3] = dec.a[3] * S[3] + hi2f(cv.a[1]);
      }
      continue;
    }
    i -= n_gla;
    if (i < n_s5) {
      int b = i % BATCH, g = i / BATCH;
      if (tid < 128) {
        int d = tid >> 6, p = tid & 63;
        const float* lt = WS(float, OFF_S5LT) + ((size_t)((l * 16 + g) * 2 + d) * 64 + p) * 2;
        float lr = lt[0], li = lt[1], xr = 0.f, xi = 0.f;
        for (int vc = 0; vc < NCH5; vc++) {
          int pc = ord_chunk(d, vc, NC5, NCH5);
          float* sp = WS(float, OFF_S5ST) + ((size_t)g * M5 + b * NCH5 + pc) * 256 + d * 128 + p;
          float sr = sp[0], si = sp[64];
          sp[0] = xr; sp[64] = xi;
          float nr = lr * xr - li * xi + sr, ni = lr * xi + li * xr + si;
          xr = nr; xi = ni;
        }
      }
      continue;
    }
    i -= n_s5;
    rwkv_final_row(P, l, i * 4 + w);
  }
}

__device__ __forceinline__ void ssd_out_item(const Params& P, int l, int item, unsigned char* sm) {
  const int tid = threadIdx.x, lane = tid & 63, w = tid >> 6;
  const int h = item & 3, rest = item >> 2, pc = rest % NCH, b = rest / NCH;
  const int isctx = pc < NCH_C, len = isctx ? CTX : SEQ, t0 = (isctx ? pc : pc - NCH_C) * TC;
  const int seq0 = isctx ? b * CTX : ROWS_C + b * SEQ;
  bf16* sRaw = (bf16*)sm;
  bf16* sA2 = (bf16*)sm;
  bf16* sB2 = (bf16*)(sm + 26112);
  bf16* sC = (bf16*)(sm + 26112 + 25600);
  float* sdt = (float*)(sm + 26112 + 25600 + 9216);
  float* scf = sdt + 128; float* scr = scf + 64; float* spart = scr + 64;
  const bf16* pr = WS(bf16, OFF_PROJ);
#pragma unroll 2
  for (int idx = tid; idx < 3 * 68 * 8; idx += 256) {
    int which = idx / (68 * 8), rem = idx % (68 * 8), tr = rem >> 3, c8 = rem & 7;
    int t = t0 - 2 + tr;
    int col = C_SSD + (which == 0 ? h * 64 : which == 1 ? 256 + (h >> 1) * 64 : 384 + (h >> 1) * 64) + c8 * 8;
    U4 v = (t >= 0 && t < len) ? *(const U4*)(pr + (size_t)(seq0 + t) * NIN + col) : zero4();
    *(U4*)&sRaw[(which * 68 + tr) * 64 + c8 * 8] = v;
  }
  if (tid < 128) {
    int d = tid >> 6, t = tid & 63;
    float raw = bf2f(pr[(size_t)(seq0 + t0 + t) * NIN + C_SSDDT + d * 4 + h]);
    sdt[tid] = softplus_f(raw + P.ssd_dt_bias[(l * 2 + d) * 4 + h]);
  }
  __syncthreads();
  if (tid == 0) { float an = ssd_aneg(P, l, 0, h), run = 0.f; for (int t = 0; t < TC; t++) { run += sdt[t] * an; scf[t] = run; } }
  if (tid == 64) { float an = ssd_aneg(P, l, 1, h), run = 0.f; for (int t = TC - 1; t >= 0; t--) { run += sdt[64 + t] * an; scr[t] = run; } }
#pragma unroll 2
  for (int idx = tid; idx < 3 * 64 * 64; idx += 256) {
    int which = idx >> 12, t = (idx >> 6) & 63, c = idx & 63;
    int ch = which == 0 ? h * 64 + c : which == 1 ? 256 + (h >> 1) * 64 + c : 384 + (h >> 1) * 64 + c;
    float acc = P.ssd_conv_b[l * 512 + ch];
    for (int i = 0; i < 5; i++) acc += bf2f(sRaw[(which * 68 + t + i) * 64 + c]) * P.ssd_conv_w[(l * 5 + i) * 512 + ch];
    bf16 v = f2bf(silu_f(acc));
    if (which == 0) sB2[c * 200 + t] = v;
    else if (which == 1) sB2[t * 200 + 64 + c] = v;
    else sC[t * 72 + c] = v;
  }
  __syncthreads();
  const int ti = w >> 1, tj = w & 1;
  {
    f32x16 g = zero16();
    for (int ks = 0; ks < 64; ks += 16)
      g = mfma32(ldsfrag(&sC[(ti * 32 + (lane & 31)) * 72 + ks + 8 * (lane >> 5)]),
                 ldsfrag(&sB2[(tj * 32 + (lane & 31)) * 200 + 64 + ks + 8 * (lane >> 5)]), g);
    int j = tj * 32 + (lane & 31);
    float cfj = scf[j], crj = scr[j], d0j = sdt[j], d1j = sdt[64 + j];
    for (int r = 0; r < 16; r++) {
      int i = ti * 32 + acc_row(r, lane);
      float mlt = 0.f;
      if (j <= i) mlt += __expf(scf[i] - cfj) * d0j;
      if (j >= i) mlt += __expf(scr[i] - crj) * d1j;
      sA2[i * 200 + j] = f2bf(g[r] * mlt);
    }
  }
#pragma unroll 2
  for (int idx = tid; idx < 64 * 64; idx += 256) {
    int i = idx >> 6, n = idx & 63;
    float cv = bf2f(sC[i * 72 + n]);
    sA2[i * 200 + 64 + n] = f2bf(cv * __expf(scf[i]));
    sA2[i * 200 + 128 + n] = f2bf(cv * __expf(scr[i]));
  }
  __syncthreads();
#pragma unroll 2
  for (int idx = tid; idx < 2 * 64 * 8; idx += 256) {
    int d = idx >> 9, p = (idx >> 3) & 63, c8 = idx & 7;
    const bf16* st = WS(bf16, OFF_SSDST) + ((size_t)((d * BATCH + b) * NCH + pc) * 4 + h) * 4096;
    *(U4*)&sB2[p * 200 + 64 + d * 64 + c8 * 8] = *(const U4*)(st + p * 64 + c8 * 8);
  }
  __syncthreads();
  {
    f32x16 acc = zero16();
    for (int ks = 0; ks < 192; ks += 16)
      acc = mfma32(ldsfrag(&sA2[(ti * 32 + (lane & 31)) * 200 + ks + 8 * (lane >> 5)]),
                   ldsfrag(&sB2[(tj * 32 + (lane & 31)) * 200 + ks + 8 * (lane >> 5)]), acc);
    int p = tj * 32 + (lane & 31);
    float dd = P.ssd_d[l * 4 + h];
    bf16* yc = WS(bf16, OFF_R);
    for (int r = 0; r < 16; r++) {
      int i = ti * 32 + acc_row(r, lane);
      int row = seq0 + t0 + i;
      float xv = bf2f(sB2[p * 200 + i]);
      float y = acc[r] + dd * xv;
      float z = bf2f(pr[(size_t)row * NIN + C_SSDZ + h * 64 + p]);
      y *= silu_f(z);
      yc[(size_t)row * 1024 + 512 + h * 64 + p] = f2bf(y);
      float s2 = sum32(y * y);
      if ((lane & 31) == 0) spart[i * 2 + tj] = s2;
    }
  }
  __syncthreads();
  if (tid < 64) WS(float, OFF_SSQ)[(size_t)(seq0 + t0 + tid) * 4 + h] = spart[tid * 2] + spart[tid * 2 + 1];
  __syncthreads();
}

__device__ __forceinline__ void gla_out_item(const Params& P, int l, int item, unsigned char* sm) {
  const int tid = threadIdx.x, lane = tid & 63, w = tid >> 6;
  const int h = item & 3, rest = item >> 2, pc = rest % NCH, b = rest / NCH;
  const int row0 = chunk_row0(b, pc, TC, NCH_C);
  bf16* sA2 = (bf16*)sm;
  bf16* sB2 = sA2 + 64 * 136;
  bf16* sKf = sB2 + 64 * 136;
  bf16* sKr = sKf + 64 * 40;
  float* sbf = (float*)(sKr + 64 * 40);
  float* sbr = sbf + 2048;
  float* spart = sbr + 2048;
  float* sGl = (float*)sB2;
  const bf16* pr = WS(bf16, OFF_PROJ);
#pragma unroll 2
  for (int idx = tid; idx < 64 * 32; idx += 256) {
    int t = idx >> 5, c = idx & 31;
    sGl[idx] = bf2f(pr[(size_t)(row0 + t) * NIN + C_GLAGL + c]);
  }
  __syncthreads();
  gla_la(P, l, 0, h, sGl, sbf);
  gla_la(P, l, 1, h, sGl, sbr);
  __syncthreads();
  if (tid < 32) { float run = 0.f; for (int t = 0; t < TC; t++) { run += sbf[t * 32 + tid]; sbf[t * 32 + tid] = run; } }
  else if (tid < 64) { int k = tid - 32; float run = 0.f; for (int t = TC - 1; t >= 0; t--) { run += sbr[t * 32 + k]; sbr[t * 32 + k] = run; } }
  __syncthreads();
#pragma unroll 2
  for (int idx = tid; idx < 64 * 32; idx += 256) {
    int t = idx >> 5, k = idx & 31;
    float q = bf2f(pr[(size_t)(row0 + t) * NIN + C_GLA + h * 32 + k]) * 0.17677669529663687f;
    float kv = bf2f(pr[(size_t)(row0 + t) * NIN + C_GLAK + h * 32 + k]);
    float bf_ = sbf[idx], br_ = sbr[idx];
    sA2[t * 136 + 64 + k] = f2bf(q * __expf(bf_));
    sA2[t * 136 + 96 + k] = f2bf(q * __expf(br_));
    sKf[t * 40 + k] = f2bf(kv * __expf(-bf_));
    sKr[t * 40 + k] = f2bf(kv * __expf(-br_));
  }
#pragma unroll 2
  for (int idx = tid; idx < 64 * 64; idx += 256) {
    int t = idx >> 6, c = idx & 63;
    sB2[c * 136 + t] = pr[(size_t)(row0 + t) * NIN + C_GLAV + h * 64 + c];
  }
#pragma unroll 2
  for (int idx = tid; idx < 2 * 64 * 4; idx += 256) {
    int d = idx >> 8, v = (idx >> 2) & 63, c8 = idx & 3;
    const bf16* st = WS(bf16, OFF_GLAST) + ((size_t)((d * BATCH + b) * NCH + pc) * 4 + h) * 2048;
    *(U4*)&sB2[v * 136 + 64 + d * 32 + c8 * 8] = *(const U4*)(st + v * 32 + c8 * 8);
  }
  __syncthreads();
  const int ti = w >> 1, tj = w & 1;
  {
    f32x16 pf = zero16(), pv = zero16();
    for (int ks = 0; ks < 32; ks += 16) {
      pf = mfma32(ldsfrag(&sA2[(ti * 32 + (lane & 31)) * 136 + 64 + ks + 8 * (lane >> 5)]),
                  ldsfrag(&sKf[(tj * 32 + (lane & 31)) * 40 + ks + 8 * (lane >> 5)]), pf);
      pv = mfma32(ldsfrag(&sA2[(ti * 32 + (lane & 31)) * 136 + 96 + ks + 8 * (lane >> 5)]),
                  ldsfrag(&sKr[(tj * 32 + (lane & 31)) * 40 + ks + 8 * (lane >> 5)]), pv);
    }
    int j = tj * 32 + (lane & 31);
    for (int r = 0; r < 16; r++) {
      int i = ti * 32 + acc_row(r, lane);
      float v = (j < i) ? pf[r] : (j > i) ? pv[r] : pf[r] + pv[r];
      sA2[i * 136 + j] = f2bf(v);
    }
  }
  __syncthreads();
  {
    f32x16 acc = zero16();
    for (int ks = 0; ks < 128; ks += 16)
      acc = mfma32(ldsfrag(&sA2[(ti * 32 + (lane & 31)) * 136 + ks + 8 * (lane >> 5)]),
                   ldsfrag(&sB2[(tj * 32 + (lane & 31)) * 136 + ks + 8 * (lane >> 5)]), acc);
    for (int r = 0; r < 16; r++) {
      int i = ti * 32 + acc_row(r, lane);
      float s2 = sum32(acc[r] * acc[r]);
      if ((lane & 31) == 0) spart[i * 2 + tj] = s2;
    }
    __syncthreads();
    int v = tj * 32 + (lane & 31);
    float gn = P.gla_norm[l * 256 + h * 64 + v];
    bf16* yc = WS(bf16, OFF_R);
    for (int r = 0; r < 16; r++) {
      int i = ti * 32 + acc_row(r, lane);
      int row = row0 + i;
      float rstd = rsqrtf((spart[i * 2] + spart[i * 2 + 1]) * (1.f / 64.f) + 1e-6f);
      float g = bf2f(pr[(size_t)row * NIN + C_GLAG + h * 64 + v]);
      yc[(size_t)row * 1024 + 768 + h * 64 + v] = f2bf(acc[r] * rstd * gn * silu_f(g));
    }
  }
  __syncthreads();
}

__device__ __forceinline__ void s5_out_tile(const Params& P, int l, int item, unsigned char* sm) {
  const int MT5 = (M5 + 127) / 128;
  int nt = item & 3, mt = (item >> 2) % MT5, g = (item >> 2) / MT5;
  const bf16* Bt = WS(bf16, OFF_BT2) + (size_t)(l * 16 + g) * 512 * 768;
  const float* X = WS(float, OFF_S5ST) + (size_t)g * M5 * 256;
  const bf16* pr = WS(bf16, OFF_PROJ);
  bf16* ys = WS(bf16, OFF_XA);
  gemm_tile(sm, mt * 128, nt * 128, 768,
    [&](int m, int k) {
      if (k < 512) return s5_u_load(P, g, m, k);
      if (m >= M5) return zero4();
      const float* xp = X + (size_t)m * 256 + (k - 512);
      F4 a = *(const F4*)xp, b2 = *(const F4*)(xp + 4);
      U4 r; r.a[0] = pack2(a.a[0], a.a[1]); r.a[1] = pack2(a.a[2], a.a[3]); r.a[2] = pack2(b2.a[0], b2.a[1]); r.a[3] = pack2(b2.a[2], b2.a[3]);
      return r;
    },
    [&](int n, int k) { return *(const U4*)(Bt + (size_t)n * 768 + k); },
    [&](int m, int n, float v) {
      if (m >= M5) return;
      int b = m / NCH5, pc = m - b * NCH5;
      int row = chunk_row0(b, pc, T5, NC5) + (n >> 4);
      int ch = g * 16 + (n & 15);
      float u = bf2f(pr[(size_t)row * NIN + C_S5 + ch]);
      ys[(size_t)row * 256 + ch] = f2bf(gelu_f(v + P.s5_d[l * 256 + ch] * u));
    });
}

__device__ __forceinline__ void phase_F(const Params& P, int l, unsigned char* sm) {
  const int n_ssd = BATCH * NCH * 4, n_gla = BATCH * NCH * 4, n_s5 = 16 * ((M5 + 127) / 128) * 4;
  ITEM_LOOP(i, n_ssd, 0) ssd_out_item(P, l, i, sm);
  ITEM_LOOP(i, n_gla, n_ssd) gla_out_item(P, l, i, sm);
  ITEM_LOOP(i, n_s5, n_ssd + n_gla) s5_out_tile(P, l, i, sm);
}

__device__ __forceinline__ void phase_G(const Params& P, int l, unsigned char* sm) {
  const int lane = threadIdx.x & 63, w = threadIdx.x >> 6;
  const int n_glu = (ROWS / 128) * 2, n_rows = ROWS / 4;
  const bf16* ys = WS(bf16, OFF_XA);
  const bf16* Bt = WS(bf16, OFF_GLUT) + (size_t)l * 256 * 256;
  const bf16* pr = WS(bf16, OFF_PROJ);
  bf16* yc = WS(bf16, OFF_R);
#pragma unroll 1
  for (int it = blockIdx.x; it < n_glu + n_rows; it += gridDim.x) {
    if (it < n_glu) {
      int nt = it & 1, mt = it >> 1;
      gemm_tile(sm, mt * 128, nt * 128, 256,
        [&](int m, int k) { return *(const U4*)(ys + (size_t)m * 256 + k); },
        [&](int n, int k) { return *(const U4*)(Bt + (size_t)n * 256 + k); },
        [&](int m, int n, float v) {
          float y = bf2f(ys[(size_t)m * 256 + n]);
          float g = bf2f(pr[(size_t)m * NIN + C_S5G + n]);
          yc[(size_t)m * 1024 + 256 + n] = f2bf(y * sigmoid_f(v + P.s5_glu_b[l * 256 + n]) * silu_f(g));
        });
      continue;
    }
    int m = (it - n_glu) * 4 + w;
    const float* sq = WS(float, OFF_SSQ) + (size_t)m * 4;
    float rstd = rsqrtf((sq[0] + sq[1] + sq[2] + sq[3]) * (1.f / 256.f) + 1e-6f);
    bf16* p = yc + (size_t)m * 1024 + 512 + lane * 4;
    U2 v = *(U2*)p;
    const float* gn = P.ssd_norm + l * 256 + lane * 4;
    U2 o;
    o.a[0] = pack2(lo2f(v.a[0]) * rstd * gn[0], hi2f(v.a[0]) * rstd * gn[1]);
    o.a[1] = pack2(lo2f(v.a[1]) * rstd * gn[2], hi2f(v.a[1]) * rstd * gn[3]);
    *(U2*)p = o;
  }
}

__device__ __forceinline__ void phase_outproj(const Params& P, int l, unsigned char* sm) {
  const bf16* A = WS(bf16, OFF_R);
  const bf16* Bt = WS(bf16, OFF_WTOUT) + (size_t)l * D * D;
  float* Y = WS(float, OFF_PROJ);
  const int NT = D / 128, MT = ROWS / 128;
#pragma unroll 1
  for (int it = blockIdx.x; it < MT * NT; it += gridDim.x) {
    int mt = it / NT, nt = it % NT;
    gemm_tile(sm, mt * 128, nt * 128, D,
      [&](int m, int k) { return *(const U4*)(A + (size_t)m * D + k); },
      [&](int n, int k) { return *(const U4*)(Bt + (size_t)n * D + k); },
      [&](int m, int n, float v) { Y[(size_t)m * D + n] = v; });
  }
}

__device__ __forceinline__ void phase_post(const Params& P, int l) {
  const int lane = threadIdx.x & 63, w = threadIdx.x >> 6;
  const int first = (l == 1) ? ROWS_C / 4 : 0;
#pragma unroll 1
  for (int it = first + blockIdx.x; it < ROWS / 4; it += gridDim.x) {
    int m = it * 4 + w;
    RowInfo ri = row_info(m);
    const float* y = WS(float, OFF_PROJ) + (size_t)m * D;
    const float* hres; float* dst;
    if (ri.isctx) { hres = P.ctx + (size_t)m * D; dst = WS(float, OFF_HC) + (size_t)m * D; }
    else { hres = (l == 0 ? P.x : P.out) + (size_t)(m - ROWS_C) * D; dst = P.out + (size_t)(m - ROWS_C) * D; }
    const float* mod = WS(float, OFF_MOD) + ((size_t)l * NMOD + (ri.isctx ? BATCH : ri.b)) * 3072 + 2048;
    F4 v[4]; float ss = 0.f;
    for (int q = 0; q < 4; q++) {
      v[q] = *(const F4*)(y + q * 256 + lane * 4);
      for (int e = 0; e < 4; e++) ss += v[q].a[e] * v[q].a[e];
    }
    ss = sum64(ss);
    float rstd = rsqrtf(ss * (1.f / 1024.f) + 1e-6f);
    for (int q = 0; q < 4; q++) {
      int c0 = q * 256 + lane * 4;
      F4 hr = *(const F4*)(hres + c0), o;
      for (int e = 0; e < 4; e++) o.a[e] = hr.a[e] + mod[c0 + e] * (v[q].a[e] * rstd * P.norm_post[l * D + c0 + e]);
      *(F4*)(dst + c0) = o;
    }
  }
}

constexpr int NPHASE = 19;
__device__ __forceinline__ void run_phase(const Params& P, int ph, unsigned char* sm) {
  if (ph == 0) { phase_prologue(P, sm); return; }
  int l = (ph - 1) / 9, s = (ph - 1) % 9;
  switch (s) {
    case 0: phase_normmod(P, l); break;
    case 1: phase_inproj(P, l, sm); break;
    case 2: phase_rwprep(P, l, sm); break;
    case 3: phase_D(P, l, sm); break;
    case 4: phase_E(P, l); break;
    case 5: phase_F(P, l, sm); break;
    case 6: phase_G(P, l, sm); break;
    case 7: phase_outproj(P, l, sm); break;
    default: phase_post(P, l); break;
  }
}

#ifndef CPU_EMU
template <int L> __device__ __forceinline__ void run_layer(const Params& P, unsigned char* sm, cg::grid_group& grid) {
  phase_normmod(P, L); grid.sync();
  phase_inproj(P, L, sm); grid.sync();
  phase_rwprep(P, L, sm); grid.sync();
  phase_D(P, L, sm); grid.sync();
  phase_E(P, L); grid.sync();
  phase_F(P, L, sm); grid.sync();
  phase_G(P, L, sm); grid.sync();
  phase_outproj(P, L, sm); grid.sync();
  phase_post(P, L);
}
__global__ void __launch_bounds__(256, 2) mega_kernel(Params P) {
  __shared__ __attribute__((aligned(16))) unsigned char sm[SMEM_BYTES];
  cg::grid_group grid = cg::this_grid();
  phase_prologue(P, sm); grid.sync();
  run_layer<0>(P, sm, grid); grid.sync();
  run_layer<1>(P, sm, grid);
}
__global__ void __launch_bounds__(256, 2) phase_kernel(Params P, int ph) {
  __shared__ __attribute__((aligned(16))) unsigned char sm[SMEM_BYTES];
  run_phase(P, ph, sm);
}

extern "C" void kernel_launch(void* const* d_in, const int* in_sizes, int n_in, void* d_out, int out_size,
                              void* d_ws, size_t ws_size, hipStream_t stream) {
  Params P{};
  const float** pp = (const float**)&P;
  for (int i = 0; i < 39; i++) pp[i] = (const float*)d_in[i];
  P.out = (float*)d_out;
  P.ws = (unsigned char*)d_ws;
  if (ws_size < WS_TOTAL) fprintf(stderr, "workspace too small: %zu < %zu\n", ws_size, (size_t)WS_TOTAL);
#if USE_COOP
  static int grid_blocks = 0;
  if (!grid_blocks) {
    int dev = 0, cus = 0, per_cu = 0;
    hipGetDevice(&dev);
    hipDeviceGetAttribute(&cus, hipDeviceAttributeMultiprocessorCount, dev);
    hipOccupancyMaxActiveBlocksPerMultiprocessor(&per_cu, mega_kernel, 256, 0);
    if (per_cu > 2) per_cu = 2;
    grid_blocks = cus * per_cu;
  }
  void* args[] = {&P};
  hipError_t e = hipLaunchCooperativeKernel((void*)mega_kernel, dim3(grid_blocks), dim3(256), args, 0, stream);
  if (e != hipSuccess) fprintf(stderr, "cooperative launch failed: %s (grid %d)\n", hipGetErrorString(e), grid_blocks);
#else
  for (int ph = 0; ph < NPHASE; ph++) phase_kernel<<<1024, 256, 0, stream>>>(P, ph);
#endif
}
#endif
```

```cpp
#ifdef CPU_EMU
#include "hip_emu.h"
#else
#include <hip/hip_runtime.h>
#include <hip/hip_cooperative_groups.h>
#include <stdint.h>
#include <stdio.h>
namespace cg = cooperative_groups;
#endif

#ifndef BATCH
#define BATCH 8
#endif
#ifndef SEQ
#define SEQ 4096
#endif
#ifndef CTX
#define CTX 256
#endif
#ifndef USE_COOP
#define USE_COOP 1
#endif

typedef unsigned short bf16;
typedef __attribute__((ext_vector_type(8))) short bf16x8;
typedef __attribute__((ext_vector_type(16))) float f32x16;
struct alignas(16) U4 { uint32_t a[4]; };
struct alignas(8) U2 { uint32_t a[2]; };
struct alignas(16) F4 { float a[4]; };

constexpr int D = 1024, NIN = 3368, NINP = 3456;
constexpr int ROWS_C = BATCH * CTX, ROWS_L = BATCH * SEQ, ROWS = ROWS_C + ROWS_L;
constexpr int VL = CTX + SEQ;
constexpr int TC = 64;
constexpr int NCH_C = CTX / TC, NCH_L = SEQ / TC, NCH = NCH_C + NCH_L;
constexpr int T5 = 32;
constexpr int NC5 = CTX / T5, NL5 = SEQ / T5, NCH5 = NC5 + NL5;
constexpr int M5 = BATCH * NCH5;
constexpr int NMOD = BATCH + 1;
constexpr int C_RW = 0, C_RWG = 1024, C_S5 = 1280, C_S5G = 1536, C_SSD = 1792, C_SSDDT = 2304, C_SSDZ = 2312;
constexpr int C_GLA = 2568, C_GLAK = 2696, C_GLAV = 2824, C_GLAGL = 3080, C_GLAG = 3112;

constexpr size_t al256(size_t x) { return (x + 255) & ~size_t(255); }
constexpr size_t OFF_WTIN = 0;
constexpr size_t OFF_WTOUT = OFF_WTIN + al256(2ull * NINP * D * 2);
constexpr size_t OFF_W2T = OFF_WTOUT + al256(2ull * D * D * 2);
constexpr size_t OFF_A2T = OFF_W2T + al256(2ull * 2 * 256 * 64 * 2);
constexpr size_t OFF_GLUT = OFF_A2T + al256(2ull * 2 * 256 * 64 * 2);
constexpr size_t OFF_MOD = OFF_GLUT + al256(2ull * 256 * 256 * 2);
constexpr size_t OFF_S5K = OFF_MOD + al256(2ull * NMOD * 3072 * 4);
constexpr size_t OFF_S5LT = OFF_S5K + al256(2ull * 16 * 2 * 32 * 256 * 4);
constexpr size_t OFF_W1T = OFF_S5LT + al256(2ull * 16 * 2 * 64 * 2 * 4);
constexpr size_t OFF_BT2 = OFF_W1T + al256(2ull * 16 * 256 * 512 * 2);
constexpr size_t OFF_PROJ = OFF_BT2 + al256(2ull * 16 * 512 * 768 * 2);
constexpr size_t OFF_R = OFF_PROJ + al256((size_t)ROWS * NIN * 2);
constexpr size_t OFF_XA = OFF_R + al256((size_t)ROWS * 1024 * 2);
constexpr size_t OFF_HC = OFF_XA + al256((size_t)ROWS * 1024 * 2);
constexpr size_t OFF_SSDST = OFF_HC + al256((size_t)ROWS_C * 1024 * 4);
constexpr size_t OFF_SSDDEC = OFF_SSDST + al256(2ull * BATCH * NCH * 4 * 4096 * 2);
constexpr size_t OFF_GLAST = OFF_SSDDEC + al256(2ull * BATCH * NCH * 4 * 4);
constexpr size_t OFF_GLADEC = OFF_GLAST + al256(2ull * BATCH * NCH * 4 * 2048 * 2);
constexpr size_t OFF_S5ST = OFF_GLADEC + al256(2ull * BATCH * NCH * 4 * 32 * 4);
constexpr size_t OFF_SSQ = OFF_S5ST + al256(16ull * M5 * 256 * 4);
constexpr size_t OFF_BON = OFF_SSQ + al256((size_t)ROWS * 4 * 4);
constexpr size_t WS_TOTAL = OFF_BON + al256((size_t)ROWS * 8 * 4);
#if BATCH == 8 && SEQ == 4096 && CTX == 256
static_assert(WS_TOTAL <= 536870912ull, "workspace too large");
#endif
constexpr int SMEM_BYTES = 64512;

struct Params {
  const float *x, *c, *ctx, *c_ctx, *ada_w, *ada_b, *norm_pre, *norm_post, *w_in, *w_out;
  const float *rw_mu, *rw_w0, *rw_w2, *rw_a0, *rw_a2, *rw_kk, *rw_ka, *rw_rk, *rw_ln_w, *rw_ln_b;
  const float *s5_a_re, *s5_a_im, *s5_log_dt, *s5_b_re, *s5_b_im, *s5_c_re, *s5_c_im, *s5_d, *s5_glu_w, *s5_glu_b;
  const float *ssd_conv_w, *ssd_conv_b, *ssd_dt_bias, *ssd_a_log, *ssd_d, *ssd_norm;
  const float *gla_g2, *gla_gb, *gla_norm;
  float* out;
  unsigned char* ws;
};

#ifdef CPU_EMU
#define OPAQUE(x)
#else
#define OPAQUE(x) asm volatile("" : "+v"(x))
#endif
__device__ __forceinline__ float bf2f(bf16 v) { return __uint_as_float(((uint32_t)v) << 16); }
__device__ __forceinline__ bf16 f2bf(float f) {
  uint32_t u = __float_as_uint(f);
  u += 0x7fffu + ((u >> 16) & 1u);
  return (bf16)(u >> 16);
}
__device__ __forceinline__ uint32_t pack2(float lo, float hi) { return (uint32_t)f2bf(lo) | ((uint32_t)f2bf(hi) << 16); }
__device__ __forceinline__ float lo2f(uint32_t u) { return __uint_as_float(u << 16); }
__device__ __forceinline__ float hi2f(uint32_t u) { return __uint_as_float(u & 0xffff0000u); }
__device__ __forceinline__ float sigmoid_f(float x) { return 1.f / (1.f + __expf(-x)); }
__device__ __forceinline__ float silu_f(float x) { return x / (1.f + __expf(-x)); }
__device__ __forceinline__ float softplus_f(float x) { return fmaxf(x, 0.f) + __logf(1.f + __expf(-fabsf(x))); }
__device__ __forceinline__ float tanh_f(float x) { return 1.f - 2.f / (1.f + __expf(2.f * x)); }
__device__ __forceinline__ float gelu_f(float x) {
  return 0.5f * x * (1.f + tanh_f(0.7978845608028654f * (x + 0.044715f * x * x * x)));
}
__device__ __forceinline__ U4 zero4() { U4 r; r.a[0] = r.a[1] = r.a[2] = r.a[3] = 0; return r; }
__device__ __forceinline__ f32x16 mfma32(bf16x8 a, bf16x8 b, f32x16 c) {
#ifdef CPU_EMU
  return emu_mfma32(a, b, c);
#else
  return __builtin_amdgcn_mfma_f32_32x32x16_bf16(a, b, c, 0, 0, 0);
#endif
}
__device__ __forceinline__ f32x16 zero16() { f32x16 z; for (int i = 0; i < 16; i++) z[i] = 0.f; return z; }
__device__ __forceinline__ int acc_row(int reg, int lane) { return (reg & 3) + 8 * (reg >> 2) + 4 * (lane >> 5); }
template <int CTRL> __device__ __forceinline__ float dpp_mov(float v) {
#ifdef CPU_EMU
  int l = threadIdx.x & 63, src;
  if (CTRL == 0xB1) src = l ^ 1; else if (CTRL == 0x4E) src = l ^ 2;
  else if (CTRL == 0x141) src = (l & ~7) | (7 - (l & 7)); else src = (l & ~15) | (15 - (l & 15));
  return emu_lane_read(v, src);
#else
  return __int_as_float(__builtin_amdgcn_update_dpp(0, __float_as_int(v), CTRL, 0xF, 0xF, true));
#endif
}
__device__ __forceinline__ float sum16(float v) {
  v += dpp_mov<0xB1>(v); v += dpp_mov<0x4E>(v); v += dpp_mov<0x141>(v); v += dpp_mov<0x140>(v); return v;
}
__device__ __forceinline__ float sum32(float v) {
  v = sum16(v); v += __shfl_xor(v, 16); return v;
}
__device__ __forceinline__ float sum64(float v) { v = sum32(v); v += __shfl_xor(v, 32); return v; }

__device__ __forceinline__ const bf16x8& ldsfrag(const bf16* p) { return *(const bf16x8*)p; }

__device__ __forceinline__ int chunk_row0(int b, int pc, int T, int nC) {
  return pc < nC ? b * CTX + pc * T : ROWS_C + b * SEQ + (pc - nC) * T;
}
__device__ __forceinline__ int ord_chunk(int d, int vc, int nC, int nAll) {
  return d == 0 ? vc : (vc < nC ? nC - 1 - vc : nAll - 1 - (vc - nC));
}
struct RowInfo { int isctx, b, t, seq0, len; };
__device__ __forceinline__ RowInfo row_info(int m) {
  RowInfo r;
  if (m < ROWS_C) { r.isctx = 1; r.b = m / CTX; r.t = m - r.b * CTX; r.seq0 = r.b * CTX; r.len = CTX; }
  else { int q = m - ROWS_C; r.isctx = 0; r.b = q / SEQ; r.t = q - r.b * SEQ; r.seq0 = ROWS_C + r.b * SEQ; r.len = SEQ; }
  return r;
}

template <class AL, class BL, class EP>
__device__ __forceinline__ void gemm_tile(unsigned char* sm, int m0, int n0, int K, AL al, BL bl, EP ep) {
  bf16* sA = (bf16*)sm;
  bf16* sB = sA + 128 * 40;
  int tid_ = threadIdx.x; OPAQUE(tid_);
  const int tid = tid_, lane = tid & 63, w = tid >> 6, wm = w >> 1, wn = w & 1;
  f32x16 acc[2][2];
#pragma unroll
  for (int i = 0; i < 2; i++)
#pragma unroll
    for (int j = 0; j < 2; j++) acc[i][j] = zero16();
  const int lr = tid >> 2, lk = (tid & 3) * 8;
  U4 ra0 = al(m0 + lr, lk), ra1 = al(m0 + lr + 64, lk), rb0 = bl(n0 + lr, lk), rb1 = bl(n0 + lr + 64, lk);
#pragma unroll 1
  for (int k0 = 0; k0 < K; k0 += 32) {
    *(U4*)&sA[lr * 40 + lk] = ra0; *(U4*)&sA[(lr + 64) * 40 + lk] = ra1;
    *(U4*)&sB[lr * 40 + lk] = rb0; *(U4*)&sB[(lr + 64) * 40 + lk] = rb1;
    __syncthreads();
    if (k0 + 32 < K) {
      ra0 = al(m0 + lr, k0 + 32 + lk); ra1 = al(m0 + lr + 64, k0 + 32 + lk);
      rb0 = bl(n0 + lr, k0 + 32 + lk); rb1 = bl(n0 + lr + 64, k0 + 32 + lk);
    }
#pragma unroll
    for (int ks = 0; ks < 32; ks += 16) {
      bf16x8 fa[2], fb[2];
#pragma unroll
      for (int i = 0; i < 2; i++) fa[i] = ldsfrag(&sA[(wm * 64 + i * 32 + (lane & 31)) * 40 + ks + 8 * (lane >> 5)]);
#pragma unroll
      for (int j = 0; j < 2; j++) fb[j] = ldsfrag(&sB[(wn * 64 + j * 32 + (lane & 31)) * 40 + ks + 8 * (lane >> 5)]);
#pragma unroll
      for (int i = 0; i < 2; i++)
#pragma unroll
        for (int j = 0; j < 2; j++) acc[i][j] = mfma32(fa[i], fb[j], acc[i][j]);
    }
    __syncthreads();
  }
#pragma unroll
  for (int i = 0; i < 2; i++)
#pragma unroll
   for (int j = 0; j < 2; j++)
#pragma unroll
    for (int r = 0; r < 16; r++)
      ep(m0 + wm * 64 + i * 32 + acc_row(r, lane), n0 + wn * 64 + j * 32 + (lane & 31), acc[i][j][r]);
}

#define ITEM_LOOP(var, count, base) _Pragma("unroll 1") for (int var = (int)((blockIdx.x + gridDim.x - ((unsigned)(base) % gridDim.x)) % gridDim.x); var < (count); var += gridDim.x)
template <class AL, class BL, class EP>
__device__ __forceinline__ void gemm_tile_big(unsigned char* sm, int m0, int n0, int K, AL al, BL bl, EP ep) {
  bf16* sA = (bf16*)sm;
  bf16* sB = sA + 256 * 40;
  int tid_ = threadIdx.x; OPAQUE(tid_);
  const int tid = tid_, lane = tid & 63, w = tid >> 6, wm = w >> 1, wn = w & 1;
  f32x16 acc[4][2];
#pragma unroll
  for (int i = 0; i < 4; i++)
#pragma unroll
    for (int j = 0; j < 2; j++) acc[i][j] = zero16();
  const int lr = tid >> 2, lk = (tid & 3) * 8;
  U4 ra[4], rb[2];
#pragma unroll
  for (int i = 0; i < 4; i++) ra[i] = al(m0 + lr + 64 * i, lk);
#pragma unroll
  for (int i = 0; i < 2; i++) rb[i] = bl(n0 + lr + 64 * i, lk);
#pragma unroll 1
  for (int k0 = 0; k0 < K; k0 += 32) {
#pragma unroll
    for (int i = 0; i < 4; i++) *(U4*)&sA[(lr + 64 * i) * 40 + lk] = ra[i];
#pragma unroll
    for (int i = 0; i < 2; i++) *(U4*)&sB[(lr + 64 * i) * 40 + lk] = rb[i];
    __syncthreads();
    if (k0 + 32 < K) {
#pragma unroll
      for (int i = 0; i < 4; i++) ra[i] = al(m0 + lr + 64 * i, k0 + 32 + lk);
#pragma unroll
      for (int i = 0; i < 2; i++) rb[i] = bl(n0 + lr + 64 * i, k0 + 32 + lk);
    }
#pragma unroll
    for (int ks = 0; ks < 32; ks += 16) {
      bf16x8 fa[4], fb[2];
#pragma unroll
      for (int i = 0; i < 4; i++) fa[i] = ldsfrag(&sA[(wm * 128 + i * 32 + (lane & 31)) * 40 + ks + 8 * (lane >> 5)]);
#pragma unroll
      for (int j = 0; j < 2; j++) fb[j] = ldsfrag(&sB[(wn * 64 + j * 32 + (lane & 31)) * 40 + ks + 8 * (lane >> 5)]);
#pragma unroll
      for (int i = 0; i < 4; i++)
#pragma unroll
        for (int j = 0; j < 2; j++) acc[i][j] = mfma32(fa[i], fb[j], acc[i][j]);
    }
    __syncthreads();
  }
#pragma unroll
  for (int i = 0; i < 4; i++)
#pragma unroll
    for (int j = 0; j < 2; j++)
#pragma unroll
      for (int r = 0; r < 16; r++)
        ep(m0 + wm * 128 + i * 32 + acc_row(r, lane), n0 + wn * 64 + j * 32 + (lane & 31), acc[i][j][r]);
}

#define WS(T, off) ((T*)(P.ws + (off)))

__device__ __forceinline__ void transpose_tile(const float* src, int ld, int Ksz, int Nsz, bf16* dst, int kt, int nt, unsigned char* sm, bool perm = false) {
  float* s = (float*)sm;
  const int tid = threadIdx.x;
#pragma unroll 2
  for (int i = tid; i < 4096; i += 256) {
    int kk = i >> 6, nn = i & 63;
    int k = kt * 64 + kk, n = nt * 64 + nn;
    s[kk * 65 + nn] = (n < Nsz && k < Ksz) ? src[(size_t)k * ld + n] : 0.f;
  }
  __syncthreads();
#pragma unroll 2
  for (int i = tid; i < 4096; i += 256) {
    int nn = i >> 6, kk = i & 63;
    int ktd = perm ? (kt < 4 ? kt + 8 : (kt >= 8 && kt < 12) ? kt - 8 : kt) : kt;
    dst[(size_t)(nt * 64 + nn) * Ksz + ktd * 64 + kk] = f2bf(s[kk * 65 + nn]);
  }
  __syncthreads();
}

struct S5c { float lr, li, dt; };
__device__ __forceinline__ void s5_pow(const Params& P, int l, int d, int g, int p, float e, float& re, float& im) {
  int idx = ((l * 2 + d) * 16 + g) * 64 + p;
  float dt = __expf(P.s5_log_dt[(l * 2 + d) * 16 + g]);
  float ar = P.s5_a_re[idx] * dt * e, ai = P.s5_a_im[idx] * dt * e;
  float m = expf(ar);
  re = m * cosf(ai); im = m * sinf(ai);
}
__device__ __forceinline__ void s5_bbar_coef(const Params& P, int l, int d, int g, int p, float& re, float& im) {
  int idx = ((l * 2 + d) * 16 + g) * 64 + p;
  float lr = P.s5_a_re[idx], li = P.s5_a_im[idx];
  float br, bi; s5_pow(P, l, d, g, p, 1.f, br, bi);
  br -= 1.f;
  float den = lr * lr + li * li;
  re = (br * lr + bi * li) / den;
  im = (bi * lr - br * li) / den;
}

__device__ __forceinline__ void phase_prologue(const Params& P, unsigned char* sm) {
  const int tid = threadIdx.x;
  const int N_TIN = 2 * 16 * (NINP / 64);
  const int N_TOUT = 2 * 16 * 16;
  const int N_TL = 2 * 2 * 4;
  const int N_TA = 2 * 2 * 4;
  const int N_TG = 2 * 16;
  const int N_MOD = 2 * 48;
  const int N_S5K = 2 * 16 * 2 * 32;
  const int N_S5W1 = 2 * 16 * 32;
  const int N_S5B2 = 2 * 16 * 32;
  const int total = N_TIN + N_TOUT + N_TL + N_TA + N_TG + N_MOD + N_S5K + N_S5W1 + N_S5B2;
#pragma unroll 1
  for (int it = blockIdx.x; it < total; it += gridDim.x) {
    int i = it;
    if (i < N_TIN) {
      int l = i / (16 * (NINP / 64)), r = i % (16 * (NINP / 64));
      transpose_tile(P.w_in + (size_t)l * D * NIN, NIN, D, NIN, WS(bf16, OFF_WTIN) + (size_t)l * NINP * D, r % 16, r / 16, sm);
      continue;
    }
    i -= N_TIN;
    if (i < N_TOUT) {
      int l = i / 256, r = i % 256;
      transpose_tile(P.w_out + (size_t)l * D * D, D, D, D, WS(bf16, OFF_WTOUT) + (size_t)l * D * D, r % 16, r / 16, sm, true);
      continue;
    }
    i -= N_TOUT;
    if (i < N_TL) {
      int ld = i / 4, nt = i % 4;
      transpose_tile(P.rw_w2 + (size_t)ld * 64 * 256, 256, 64, 256, WS(bf16, OFF_W2T) + (size_t)ld * 256 * 64, 0, nt, sm);
      continue;
    }
    i -= N_TL;
    if (i < N_TA) {
      int ld = i / 4, nt = i % 4;
      transpose_tile(P.rw_a2 + (size_t)ld * 64 * 256, 256, 64, 256, WS(bf16, OFF_A2T) + (size_t)ld * 256 * 64, 0, nt, sm);
      continue;
    }
    i -= N_TA;
    if (i < N_TG) {
      int l = i / 16, r = i % 16;
      transpose_tile(P.s5_glu_w + (size_t)l * 256 * 256, 256, 256, 256, WS(bf16, OFF_GLUT) + (size_t)l * 256 * 256, r % 4, r / 4, sm);
      continue;
    }
    i -= N_TG;
    if (i < N_MOD) {
      int l = i / 48, ct = i % 48;
      float* ssil = (float*)sm;
      float* red = ssil + NMOD * 1024;
#pragma unroll 2
      for (int e = tid; e < NMOD * 1024; e += 256) {
        int r = e >> 10, k = e & 1023;
        float v = r < BATCH ? P.c[r * 1024 + k] : P.c_ctx[k];
        ssil[e] = silu_f(v);
      }
      __syncthreads();
      int kq = tid >> 6, jj = tid & 63, j = ct * 64 + jj;
      float acc[NMOD];
      for (int r = 0; r < NMOD; r++) acc[r] = 0.f;
      const float* wp = P.ada_w + (size_t)l * D * 3072 + j;
      for (int k = kq * 256; k < kq * 256 + 256; k++) {
        float wv = wp[(size_t)k * 3072];
#pragma unroll
        for (int r = 0; r < NMOD; r++) acc[r] += ssil[r * 1024 + k] * wv;
      }
#pragma unroll
      for (int r = 0; r < NMOD; r++) red[(kq * NMOD + r) * 64 + jj] = acc[r];
      __syncthreads();
#pragma unroll 2
      for (int e = tid; e < NMOD * 64; e += 256) {
        int r = e >> 6, j2 = e & 63;
        float s = red[(0 * NMOD + r) * 64 + j2] + red[(1 * NMOD + r) * 64 + j2] + red[(2 * NMOD + r) * 64 + j2] + red[(3 * NMOD + r) * 64 + j2];
        WS(float, OFF_MOD)[((size_t)l * NMOD + r) * 3072 + ct * 64 + j2] = s + P.ada_b[l * 3072 + ct * 64 + j2];
      }
      __syncthreads();
      continue;
    }
    i -= N_MOD;
    if (i < N_S5K) {
      int m = i & 31, d = (i >> 5) & 1, g = (i >> 6) & 15, l = i >> 10;
      float* spw = (float*)sm;
      if (tid < 64) {
        float pr, pi, cr, ci;
        s5_pow(P, l, d, g, tid, (float)m, pr, pi);
        s5_bbar_coef(P, l, d, g, tid, cr, ci);
        spw[tid * 2] = pr * cr - pi * ci; spw[tid * 2 + 1] = pr * ci + pi * cr;
      }
      __syncthreads();
      int c = tid >> 4, cp = tid & 15;
      size_t bb = ((size_t)((l * 2 + d) * 16 + g) * 64) * 16;
      size_t cb = ((size_t)((l * 2 + d) * 16 + g) * 16 + c) * 64;
      float s = 0.f;
      for (int p = 0; p < 64; p++) {
        float wr = spw[p * 2], wi = spw[p * 2 + 1];
        float br = P.s5_b_re[bb + p * 16 + cp], bi = P.s5_b_im[bb + p * 16 + cp];
        float zr = wr * br - wi * bi, zi = wr * bi + wi * br;
        float cr = P.s5_c_re[cb + p], ci = P.s5_c_im[cb + p];
        s += cr * zr - ci * zi;
      }
      WS(float, OFF_S5K)[((size_t)(((l * 16 + g) * 2 + d) * 32 + m)) * 256 + tid] = s;
      __syncthreads();
      continue;
    }
    i -= N_S5K;
    if (i < N_S5W1) {
      int j = i & 31, g = (i >> 5) & 15, l = i >> 9;
      int pp = tid, d = pp >> 7, ri = (pp >> 6) & 1, p = pp & 63;
      float e = d == 0 ? (float)(T5 - 1 - j) : (float)j;
      float pr, pi, cr, ci;
      s5_pow(P, l, d, g, p, e, pr, pi);
      s5_bbar_coef(P, l, d, g, p, cr, ci);
      float wr = pr * cr - pi * ci, wi = pr * ci + pi * cr;
      size_t bb = ((size_t)((l * 2 + d) * 16 + g) * 64 + p) * 16;
      bf16* dst = WS(bf16, OFF_W1T) + ((size_t)(l * 16 + g) * 256 + pp) * 512 + j * 16;
      for (int cp = 0; cp < 16; cp++) {
        float br = P.s5_b_re[bb + cp], bi = P.s5_b_im[bb + cp];
        float zr = wr * br - wi * bi, zi = wr * bi + wi * br;
        dst[cp] = f2bf(ri == 0 ? zr : zi);
      }
      if (j == 0 && ri == 0) {
        float tr, ti; s5_pow(P, l, d, g, p, (float)T5, tr, ti);
        float* lt = WS(float, OFF_S5LT) + ((size_t)((l * 16 + g) * 2 + d) * 64 + p) * 2;
        lt[0] = tr; lt[1] = ti;
      }
      continue;
    }
    i -= N_S5W1;
    {
      int t = i & 31, g = (i >> 5) & 15, l = i >> 9;
      int kk = tid, d = kk >> 7, ri = (kk >> 6) & 1, p = kk & 63;
      float e = d == 0 ? (float)(t + 1) : (float)(T5 - t);
      float pr, pi; s5_pow(P, l, d, g, p, e, pr, pi);
      for (int c = 0; c < 16; c++) {
        size_t cb = ((size_t)((l * 2 + d) * 16 + g) * 16 + c) * 64 + p;
        float cr = P.s5_c_re[cb], ci = P.s5_c_im[cb];
        float zr = cr * pr - ci * pi, zi = cr * pi + ci * pr;
        WS(bf16, OFF_BT2)[((size_t)(l * 16 + g) * 512 + t * 16 + c) * 768 + 512 + kk] = f2bf(ri == 0 ? zr : -zi);
      }
    }
  }
}

__device__ __forceinline__ void s5_toeplitz_items(const Params& P, int item) {
  int t = item & 31, g = (item >> 5) & 15, l = item >> 9;
  const float* K = WS(float, OFF_S5K) + (size_t)((l * 16 + g) * 2) * 32 * 256;
  bf16* dst = WS(bf16, OFF_BT2) + ((size_t)(l * 16 + g) * 512 + t * 16) * 768;
#pragma unroll 2
  for (int e = threadIdx.x; e < 16 * 512; e += 256) {
    int c = e >> 9, k = e & 511, j = k >> 4, cp = k & 15;
    float v;
    if (j < t) v = K[((0 * 32) + (t - j)) * 256 + c * 16 + cp];
    else if (j > t) v = K[((1 * 32) + (j - t)) * 256 + c * 16 + cp];
    else v = K[(0 * 32) * 256 + c * 16 + cp] + K[(1 * 32) * 256 + c * 16 + cp];
    dst[(size_t)c * 768 + k] = f2bf(v);
  }
}

__device__ __forceinline__ void phase_normmod(const Params& P, int l) {
  const int lane = threadIdx.x & 63, w = threadIdx.x >> 6;
  const int nrow_items = ROWS / 4;
  const int n_toe = (l == 0) ? 2 * 16 * 32 : 0;
#pragma unroll 1
  for (int it = blockIdx.x; it < nrow_items + n_toe; it += gridDim.x) {
    if (it >= nrow_items) { s5_toeplitz_items(P, it - nrow_items); continue; }
    int m = it * 4 + w;
    RowInfo ri = row_info(m);
    const float* src;
    if (ri.isctx) src = (l == 0 ? P.ctx : WS(float, OFF_HC)) + (size_t)m * D;
    else src = (l == 0 ? P.x : P.out) + (size_t)(m - ROWS_C) * D;
    const float* mod = WS(float, OFF_MOD) + ((size_t)l * NMOD + (ri.isctx ? BATCH : ri.b)) * 3072;
    F4 v[4]; float ss = 0.f;
    for (int q = 0; q < 4; q++) {
      v[q] = *(const F4*)(src + q * 256 + lane * 4);
      for (int e = 0; e < 4; e++) ss += v[q].a[e] * v[q].a[e];
    }
    ss = sum64(ss);
    float rstd = rsqrtf(ss * (1.f / 1024.f) + 1e-6f);
    bf16* dst = WS(bf16, OFF_R) + (size_t)m * D;
    for (int q = 0; q < 4; q++) {
      int c0 = q * 256 + lane * 4;
      float o[4];
      for (int e = 0; e < 4; e++) {
        int c = c0 + e;
        o[e] = v[q].a[e] * rstd * P.norm_pre[l * D + c] * (1.f + mod[1024 + c]) + mod[c];
      }
      U2 pk; pk.a[0] = pack2(o[0], o[1]); pk.a[1] = pack2(o[2], o[3]);
      *(U2*)(dst + c0) = pk;
    }
  }
}

__device__ __forceinline__ void phase_inproj(const Params& P, int l, unsigned char* sm) {
  const bf16* A = WS(bf16, OFF_R);
  const bf16* Bt = WS(bf16, OFF_WTIN) + (size_t)l * NINP * D;
  bf16* C = WS(bf16, OFF_PROJ);
  const int NT = NINP / 128, MT = ROWS / 256;
#pragma unroll 1
  for (int it = blockIdx.x; it < MT * NT; it += gridDim.x) {
    int mt = it / NT, nt = it % NT;
    gemm_tile_big(sm, mt * 256, nt * 128, D,
      [&](int m, int k) { return *(const U4*)(A + (size_t)m * D + k); },
      [&](int n, int k) { return *(const U4*)(Bt + (size_t)n * D + k); },
      [&](int m, int n, float v) { if (n < NIN) C[(size_t)m * NIN + n] = f2bf(v); });
  }
}

__device__ __forceinline__ void rw_lerp4(const Params& P, int l, int m, int ms, int col, float* o) {
  const bf16* pr = WS(bf16, OFF_PROJ);
  U2 z = *(const U2*)(pr + (size_t)m * NIN + col);
  U2 zs; zs.a[0] = zs.a[1] = 0;
  if (ms >= 0) zs = *(const U2*)(pr + (size_t)ms * NIN + col);
  const float* mu = P.rw_mu + l * 1024 + col;
#pragma unroll
  for (int e = 0; e < 2; e++) {
    float a0 = lo2f(z.a[e]), a1 = hi2f(z.a[e]), s0 = lo2f(zs.a[e]), s1 = hi2f(zs.a[e]);
    o[2 * e] = a0 + mu[2 * e] * (s0 - a0);
    o[2 * e + 1] = a1 + mu[2 * e + 1] * (s1 - a1);
  }
}
__device__ __forceinline__ void phase_rwprep(const Params& P, int l, unsigned char* sm) {
  const int lane = threadIdx.x & 63, w = threadIdx.x >> 6;
  const int MT = ROWS / 128;
  const int n_gemm = MT * 2 * 4;
  const int n_rows = ROWS / 4;
  bf16* XA = WS(bf16, OFF_XA);
#pragma unroll 1
  for (int it = blockIdx.x; it < n_gemm + n_rows; it += gridDim.x) {
    if (it < n_gemm) {
      int kind = it & 3, nt = (it >> 2) & 1, mt = it >> 3;
      int isA = kind >> 1, d = kind & 1;
      const bf16* Bt = (isA ? WS(bf16, OFF_A2T) : WS(bf16, OFF_W2T)) + (size_t)(l * 2 + d) * 256 * 64;
      const float* bias = (isA ? P.rw_a0 : P.rw_w0) + (l * 2 + d) * 256;
      gemm_tile(sm, mt * 128, nt * 128, 64,
        [&](int m, int k) {
          RowInfo ri = row_info(m);
          int ms;
          if (ri.isctx) ms = ri.t < CTX - 1 ? m + 1 : -1; else ms = ri.t < SEQ - 64 ? m + 64 : -1;
          int col = 768 + isA * 128 + d * 64 + k;
          const bf16* prj = WS(bf16, OFF_PROJ);
          U4 z = *(const U4*)(prj + (size_t)m * NIN + col);
          U4 zs = ms >= 0 ? *(const U4*)(prj + (size_t)ms * NIN + col) : zero4();
          const float* mu = P.rw_mu + l * 1024 + col;
          U4 r;
#pragma unroll
          for (int e = 0; e < 4; e++) {
            float a0 = lo2f(z.a[e]), a1 = hi2f(z.a[e]), s0 = lo2f(zs.a[e]), s1 = hi2f(zs.a[e]);
            float o0 = a0 + mu[2 * e] * (s0 - a0), o1 = a1 + mu[2 * e + 1] * (s1 - a1);
            if (!isA) { o0 = tanh_f(o0); o1 = tanh_f(o1); }
            r.a[e] = pack2(o0, o1);
          }
          return r;
        },
        [&](int n, int k) { return *(const U4*)(Bt + (size_t)n * 64 + k); },
        [&](int m, int n, float v) {
          v += bias[n];
          float o;
          if (!isA) { o = -__expf(-softplus_f(-v) - 0.5f); }
          else o = sigmoid_f(v);
          XA[(size_t)m * 1024 + isA * 512 + d * 256 + n] = f2bf(o);
        });
      continue;
    }
    int m = (it - n_gemm) * 4 + w;
    RowInfo ri = row_info(m);
    int ms_r, ms_k, ms_v;
    if (ri.isctx) { ms_r = ms_k = ri.t > 0 ? m - 1 : -1; ms_v = ri.t < CTX - 1 ? m + 1 : -1; }
    else {
      int gx = ri.t & 63;
      ms_r = gx > 0 ? m - 1 : -1; ms_k = gx < 63 ? m + 1 : -1; ms_v = ri.t >= 64 ? m - 64 : -1;
    }
    bf16* R = WS(bf16, OFF_R) + (size_t)m * 1024;
    float rr[4], kk[4], vv[4], kap[4];
    rw_lerp4(P, l, m, ms_r, lane * 4, rr);
    rw_lerp4(P, l, m, ms_k, 256 + lane * 4, kk);
    rw_lerp4(P, l, m, ms_v, 512 + lane * 4, vv);
    float ss = 0.f;
    for (int e = 0; e < 4; e++) { kap[e] = kk[e] * P.rw_kk[l * 256 + lane * 4 + e]; ss += kap[e] * kap[e]; }
    ss = sum16(ss);
    float rs = rsqrtf(ss + 1e-6f);
    U2 o;
    o.a[0] = pack2(rr[0], rr[1]); o.a[1] = pack2(rr[2], rr[3]); *(U2*)(R + lane * 4) = o;
    o.a[0] = pack2(kk[0], kk[1]); o.a[1] = pack2(kk[2], kk[3]); *(U2*)(R + 256 + lane * 4) = o;
    o.a[0] = pack2(vv[0], vv[1]); o.a[1] = pack2(vv[2], vv[3]); *(U2*)(R + 512 + lane * 4) = o;
    o.a[0] = pack2(kap[0] * rs, kap[1] * rs); o.a[1] = pack2(kap[2] * rs, kap[3] * rs); *(U2*)(R + 768 + lane * 4) = o;
  }
}

__device__ __forceinline__ bf16x8 gfrag(const bf16* base, int ld, int row, int k) {
  return *(const bf16x8*)(base + (size_t)row * ld + k);
}
__device__ __forceinline__ void wave_sync() {
#ifdef CPU_EMU
  pthread_barrier_wait(&g_wavebar[threadIdx.x >> 6]);
#else
  __builtin_amdgcn_wave_barrier();
#endif
}
__device__ __forceinline__ void store_acc_T(bf16* dst, int ld, int row_base, int col, const f32x16& acc, int lane) {
#pragma unroll
  for (int g = 0; g < 4; g++) {
    U2 o; o.a[0] = pack2(acc[4 * g], acc[4 * g + 1]); o.a[1] = pack2(acc[4 * g + 2], acc[4 * g + 3]);
    *(U2*)&dst[col * ld + row_base + 8 * g + 4 * (lane >> 5)] = o;
  }
}
__device__ __forceinline__ void rwkv_chunk_item(const Params& P, int l, int item, unsigned char* sm) {
  int tid_ = threadIdx.x; OPAQUE(tid_);
  const int tid = tid_, lane = tid & 63, w = tid >> 6, ti = w >> 1, tj = w & 1;
  const int lr = lane & 31, lh = lane >> 5;
  const int d = item & 1, h = (item >> 1) & 3, rest = item >> 3;
  const int pc = rest % NCH, b = rest / NCH;
  const int row0 = chunk_row0(b, pc, TC, NCH_C);
  float* sL = (float*)sm;
  bf16* sG1t = (bf16*)sm;
  bf16* sKT = (bf16*)(sm + 16640);
  bf16* sBT = sKT + 64 * 72;
  bf16* sKD = sBT + 64 * 72;
  bf16* sRT = sKD + 64 * 72;
  bf16* sVt = sRT + 64 * 72;
  float* sGT = (float*)(sVt + 64 * 72);
  bf16* X0 = WS(bf16, OFF_XA) + (size_t)row0 * 1024 + d * 256 + h * 64;
  bf16* X1 = X0 + 512;
  bf16* P0 = WS(bf16, OFF_PROJ) + (size_t)row0 * NIN + (h * 2 + d) * 128;
  bf16* P1 = P0 + 64;
  const bf16* Rb = WS(bf16, OFF_R) + (size_t)row0 * 1024 + h * 64;
#pragma unroll 2
  for (int idx = tid; idx < 4096; idx += 256) {
    int p = idx >> 6, k = idx & 63;
    sL[p * 65 + k] = bf2f(X0[(size_t)p * 1024 + k]);
    sVt[idx] = X1[(size_t)p * 1024 + k];
  }
  __syncthreads();
  if (tid < 64) {
    float run = 0.f;
    if (d == 0) { for (int p = 0; p < 64; p++) { run += sL[p * 65 + tid]; sL[p * 65 + tid] = run; } }
    else { for (int p = 63; p >= 0; p--) { run += sL[p * 65 + tid]; sL[p * 65 + tid] = run; } }
    sGT[tid] = run;
  }
  __syncthreads();
  {
    const int k = lane;
    const float ka = P.rw_ka[l * 256 + h * 64 + k], rk = P.rw_rk[l * 256 + h * 64 + k];
#pragma unroll 2
    for (int p = w; p < 64; p += 4) {
      float incl = sL[p * 65 + k];
      int pp = d == 0 ? p - 1 : p + 1;
      float excl = (pp < 0 || pp > 63) ? 0.f : sL[pp * 65 + k];
      float rr = bf2f(Rb[(size_t)p * 1024 + k]), kk = bf2f(Rb[(size_t)p * 1024 + 256 + k]), kap = bf2f(Rb[(size_t)p * 1024 + 768 + k]);
      float a = bf2f(sVt[p * 64 + k]);
      float kd = kk * (1.f + (a - 1.f) * ka), beta = kap * a;
      float ei = __expf(incl), eni = __expf(-incl), ee = __expf(excl);
      sKT[p * 72 + k] = f2bf(kap * ee);
      sBT[p * 72 + k] = f2bf(beta * eni);
      sKD[p * 72 + k] = f2bf(kd * eni);
      sRT[p * 72 + k] = f2bf(rr * ei);
      float bs = sum64(rr * kd * rk);
      if (lane == 0) WS(float, OFF_BON)[(size_t)(row0 + p) * 8 + h * 2 + d] = bs;
    }
  }
  __syncthreads();
#pragma unroll 2
  for (int idx = tid; idx < 4096; idx += 256) {
    int kk = idx >> 6, p = idx & 63;
    P0[(size_t)kk * NIN + p] = sKT[p * 72 + kk];
    P1[(size_t)kk * NIN + p] = sBT[p * 72 + kk];
    X1[(size_t)kk * 1024 + p] = sKD[p * 72 + kk];
    X0[(size_t)kk * 1024 + p] = sRT[kk * 72 + p];
  }
  f32x16 aA = zero16(), aB = zero16(), aC = zero16(), aD = zero16();
#pragma unroll
  for (int ks = 0; ks < 64; ks += 16) {
    bf16x8 fK = ldsfrag(&sKT[(ti * 32 + lr) * 72 + ks + 8 * lh]);
    bf16x8 fR = ldsfrag(&sRT[(ti * 32 + lr) * 72 + ks + 8 * lh]);
    bf16x8 fB = ldsfrag(&sBT[(tj * 32 + lr) * 72 + ks + 8 * lh]);
    bf16x8 fD = ldsfrag(&sKD[(tj * 32 + lr) * 72 + ks + 8 * lh]);
    aA = mfma32(fK, fB, aA); aB = mfma32(fK, fD, aB); aC = mfma32(fR, fB, aC); aD = mfma32(fR, fD, aD);
  }
  __syncthreads();
  {
    int s_ = tj * 32 + lr;
#pragma unroll
    for (int r = 0; r < 16; r++) {
      int p = ti * 32 + acc_row(r, lane);
      bool earlier = d == 0 ? s_ < p : s_ > p;
      bool eq = s_ == p;
      sL[p * 65 + s_] = earlier ? aA[r] : 0.f;
      sKT[p * 72 + s_] = f2bf(earlier ? aB[r] : 0.f);
      sBT[p * 72 + s_] = f2bf((earlier || eq) ? aC[r] : 0.f);
      sKD[p * 72 + s_] = f2bf((earlier || eq) ? aD[r] : 0.f);
    }
  }
#pragma unroll 2
  for (int idx = tid; idx < 4096; idx += 256) {
    int p = idx >> 6, v = idx & 63;
    sVt[v * 72 + p] = Rb[(size_t)p * 1024 + 512 + v];
  }
  __syncthreads();
  bf16* sTinv = sRT;
  {
    const int q = tid >> 2, seg = tid & 3;
    float* srow = sGT + 64;
    float x[16];
#pragma unroll
    for (int i = 0; i < 16; i++) x[i] = (q == seg * 16 + i) ? 1.f : 0.f;
#pragma unroll 1
    for (int st = 0; st < 64; st++) {
      const int p = d == 0 ? st : 63 - st;
      float* buf = srow + (st & 1) * 64;
      if (q == p) {
#pragma unroll
        for (int i = 0; i < 4; i++) { F4 o; o.a[0] = x[4 * i]; o.a[1] = x[4 * i + 1]; o.a[2] = x[4 * i + 2]; o.a[3] = x[4 * i + 3]; *(F4*)&buf[seg * 16 + 4 * i] = o; }
      }
      __syncthreads();
      const bool later = d == 0 ? q > p : q < p;
      if (later) {
        const float m = sL[q * 65 + p];
#pragma unroll
        for (int i = 0; i < 4; i++) {
          F4 o = *(const F4*)&buf[seg * 16 + 4 * i];
          x[4 * i] -= m * o.a[0]; x[4 * i + 1] -= m * o.a[1]; x[4 * i + 2] -= m * o.a[2]; x[4 * i + 3] -= m * o.a[3];
        }
      }
    }
#pragma unroll
    for (int i = 0; i < 8; i++) *(uint32_t*)&sTinv[q * 72 + seg * 16 + 2 * i] = pack2(x[2 * i], x[2 * i + 1]);
  }
  __syncthreads();
  {
    f32x16 aBV = zero16(), aG1 = zero16();
#pragma unroll
    for (int ks = 0; ks < 64; ks += 16) {
      aBV = mfma32(ldsfrag(&sKT[(ti * 32 + lr) * 72 + ks + 8 * lh]), ldsfrag(&sVt[(tj * 32 + lr) * 72 + ks + 8 * lh]), aBV);
      aG1 = mfma32(ldsfrag(&sTinv[(ti * 32 + lr) * 72 + ks + 8 * lh]), gfrag(P0, NIN, tj * 32 + lr, ks + 8 * lh), aG1);
    }
    __syncthreads();
    store_acc_T(sKT, 72, ti * 32, tj * 32 + lr, aBV, lane);
    store_acc_T(sG1t, 72, ti * 32, tj * 32 + lr, aG1, lane);
  }
  __syncthreads();
  {
    f32x16 aG2 = zero16();
#pragma unroll
    for (int ks = 0; ks < 64; ks += 16)
      aG2 = mfma32(ldsfrag(&sTinv[(ti * 32 + lr) * 72 + ks + 8 * lh]), ldsfrag(&sKT[(tj * 32 + lr) * 72 + ks + 8 * lh]), aG2);
    __syncthreads();
    store_acc_T(sRT, 72, ti * 32, tj * 32 + lr, aG2, lane);
  }
  __syncthreads();
  bf16* sG2t = sRT;
  {
    f32x16 a1 = zero16(), a2 = zero16(), a3 = zero16();
#pragma unroll
    for (int ks = 0; ks < 64; ks += 16) {
      bf16x8 fC = ldsfrag(&sBT[(ti * 32 + lr) * 72 + ks + 8 * lh]);
      bf16x8 fDy = ldsfrag(&sKD[(ti * 32 + lr) * 72 + ks + 8 * lh]);
      a1 = mfma32(fC, ldsfrag(&sG1t[(tj * 32 + lr) * 72 + ks + 8 * lh]), a1);
      a2 = mfma32(fDy, ldsfrag(&sVt[(tj * 32 + lr) * 72 + ks + 8 * lh]), a2);
      a3 = mfma32(fC, ldsfrag(&sG2t[(tj * 32 + lr) * 72 + ks + 8 * lh]), a3);
    }
    int c = tj * 32 + lr;
#pragma unroll
    for (int r = 0; r < 16; r++) {
      int p = ti * 32 + acc_row(r, lane);
      bf16* hp = X0 + (size_t)p * 1024 + c;
      *hp = f2bf(bf2f(*hp) - a1[r]);
      P0[(size_t)p * NIN + c] = f2bf(a2[r] - a3[r]);
    }
  }
  {
    f32x16 a1 = zero16(), a2 = zero16(), a3 = zero16();
#pragma unroll
    for (int ks = 0; ks < 64; ks += 16) {
      bf16x8 fKd = gfrag(X1, 1024, ti * 32 + lr, ks + 8 * lh);
      bf16x8 fBt = gfrag(P1, NIN, ti * 32 + lr, ks + 8 * lh);
      a1 = mfma32(fKd, ldsfrag(&sVt[(tj * 32 + lr) * 72 + ks + 8 * lh]), a1);
      a2 = mfma32(fBt, ldsfrag(&sG2t[(tj * 32 + lr) * 72 + ks + 8 * lh]), a2);
      a3 = mfma32(fBt, ldsfrag(&sG1t[(tj * 32 + lr) * 72 + ks + 8 * lh]), a3);
    }
    __syncthreads();
    int c = tj * 32 + lr;
#pragma unroll
    for (int r = 0; r < 16; r++) {
      int kp = ti * 32 + acc_row(r, lane);
      float gt = __expf(sGT[kp]);
      P1[(size_t)kp * NIN + c] = f2bf(gt * (a1[r] - a2[r]));
      X1[(size_t)kp * 1024 + c] = f2bf(gt * ((kp == c ? 1.f : 0.f) - a3[r]));
    }
  }
  __syncthreads();
}

__device__ __forceinline__ void rwkv_scan2_item(const Params& P, int l, int item, unsigned char* sm) {
  int tid_ = threadIdx.x; OPAQUE(tid_);
  const int tid = tid_, lane = tid & 63, w = tid >> 6, ti = w >> 1, tj = w & 1;
  const int lr = lane & 31, lh = lane >> 5;
  const int d = item & 1, h = (item >> 1) & 3, b = item >> 3;
  bf16* sS = (bf16*)sm;
  f32x16 acc = zero16();
  bf16x8 pm[4]; float lm[16];
  auto load = [&](int vc) {
    int pc = ord_chunk(d, vc, NCH_C, NCH);
    int row0 = chunk_row0(b, pc, TC, NCH_C);
    const bf16* X1 = WS(bf16, OFF_XA) + (size_t)row0 * 1024 + 512 + d * 256 + h * 64;
    const bf16* P1 = WS(bf16, OFF_PROJ) + (size_t)row0 * NIN + (h * 2 + d) * 128 + 64;
#pragma unroll
    for (int q = 0; q < 4; q++) pm[q] = gfrag(X1, 1024, ti * 32 + lr, q * 16 + 8 * lh);
#pragma unroll
    for (int r = 0; r < 16; r++) lm[r] = bf2f(P1[(size_t)(ti * 32 + acc_row(r, lane)) * NIN + tj * 32 + lr]);
  };
  load(0);
#pragma unroll 1
  for (int vc = 0; vc < NCH; vc++) {
    int pc = ord_chunk(d, vc, NCH_C, NCH);
    int row0 = chunk_row0(b, pc, TC, NCH_C);
    bf16* X1 = WS(bf16, OFF_XA) + (size_t)row0 * 1024 + 512 + d * 256 + h * 64;
    store_acc_T(sS, 72, ti * 32, tj * 32 + lr, acc, lane);
    bf16x8 cpm[4]; float clm[16];
#pragma unroll
    for (int q = 0; q < 4; q++) cpm[q] = pm[q];
#pragma unroll
    for (int r = 0; r < 16; r++) clm[r] = lm[r];
    __syncthreads();
    if (vc + 1 < NCH) load(vc + 1);
    for (int idx = tid; idx < 512; idx += 256) {
      int v = idx >> 3, c8 = idx & 7;
      *(U4*)(X1 + (size_t)v * 1024 + c8 * 8) = *(const U4*)(sS + v * 72 + c8 * 8);
    }
    f32x16 nw;
#pragma unroll
    for (int r = 0; r < 16; r++) nw[r] = clm[r];
#pragma unroll
    for (int q = 0; q < 4; q++) nw = mfma32(cpm[q], ldsfrag(&sS[(tj * 32 + lr) * 72 + q * 16 + 8 * lh]), nw);
    acc = nw;
    __syncthreads();
  }
}

__device__ __forceinline__ void rwkv_out_item(const Params& P, int l, int item, unsigned char* sm) {
  int tid_ = threadIdx.x; OPAQUE(tid_);
  const int tid = tid_, lane = tid & 63, w = tid >> 6, ti = w >> 1, tj = w & 1;
  const int lr = lane & 31, lh = lane >> 5;
  const int h = item & 3, rest = item >> 2, pc = rest % NCH, b = rest / NCH;
  const int row0 = chunk_row0(b, pc, TC, NCH_C);
  float* spart = (float*)sm;
  f32x16 acc = zero16();
#pragma unroll
  for (int d = 0; d < 2; d++) {
    const bf16* X0 = WS(bf16, OFF_XA) + (size_t)row0 * 1024 + d * 256 + h * 64;
    const bf16* X1 = X0 + 512;
    const bf16* P0 = WS(bf16, OFF_PROJ) + (size_t)row0 * NIN + (h * 2 + d) * 128;
#pragma unroll
    for (int ks = 0; ks < 64; ks += 16)
      acc = mfma32(gfrag(X0, 1024, ti * 32 + lr, ks + 8 * lh), gfrag(X1, 1024, tj * 32 + lr, ks + 8 * lh), acc);
#pragma unroll
    for (int r = 0; r < 16; r++) acc[r] += bf2f(P0[(size_t)(ti * 32 + acc_row(r, lane)) * NIN + tj * 32 + lr]);
  }
#pragma unroll
  for (int r = 0; r < 16; r++) {
    int p = ti * 32 + acc_row(r, lane);
    float s1 = sum32(acc[r]), s2 = sum32(acc[r] * acc[r]);
    if (lr == 0) { spart[(p * 2 + tj) * 2] = s1; spart[(p * 2 + tj) * 2 + 1] = s2; }
  }
  __syncthreads();
  {
    int c = h * 64 + tj * 32 + lr;
    float lw_ = P.rw_ln_w[l * 256 + c], lb_ = P.rw_ln_b[l * 256 + c];
    bf16* yc = WS(bf16, OFF_R);
    const bf16* pr = WS(bf16, OFF_PROJ);
#pragma unroll
    for (int r = 0; r < 16; r++) {
      int p = ti * 32 + acc_row(r, lane);
      int row = row0 + p;
      float mu = (spart[(p * 2) * 2] + spart[(p * 2 + 1) * 2]) * (1.f / 64.f);
      float ex2 = (spart[(p * 2) * 2 + 1] + spart[(p * 2 + 1) * 2 + 1]) * (1.f / 64.f);
      float var = fmaxf(ex2 - mu * mu, 0.f);
      float yn = (acc[r] - mu) * rsqrtf(var + 64e-5f) * lw_ + lb_;
      const float* bon = WS(float, OFF_BON) + (size_t)row * 8 + h * 2;
      bf16* vp = yc + (size_t)row * 1024 + 512 + c;
      float vv = bf2f(*vp);
      float g = bf2f(pr[(size_t)row * NIN + C_RWG + c]);
      *vp = f2bf((yn + (bon[0] + bon[1]) * vv) * silu_f(g));
    }
  }
  __syncthreads();
}

__device__ __forceinline__ float ssd_aneg(const Params& P, int l, int d, int h) { return -__expf(P.ssd_a_log[(l * 2 + d) * 4 + h]); }
__device__ __forceinline__ void ssd_state_item(const Params& P, int l, int item, unsigned char* sm) {
  int tid_ = threadIdx.x; OPAQUE(tid_);
  const int tid = tid_, lane = tid & 63, w = tid >> 6;
  const int d = item & 1, h = (item >> 1) & 3, rest = item >> 3;
  const int pc = rest % NCH, b = rest / NCH;
  const int isctx = pc < NCH_C, len = isctx ? CTX : SEQ, t0 = (isctx ? pc : pc - NCH_C) * TC;
  const int seq0 = isctx ? b * CTX : ROWS_C + b * SEQ;
  bf16* sRaw = (bf16*)sm;
  bf16* sVt = sRaw + 2 * 68 * 64;
  bf16* sBt = sVt + 64 * 72;
  float* sdt = (float*)(sBt + 64 * 72);
  float* sdw = sdt + 64;
  const bf16* pr = WS(bf16, OFF_PROJ);
#pragma unroll 2
  for (int idx = tid; idx < 2 * 68 * 8; idx += 256) {
    int which = idx / (68 * 8), rem = idx % (68 * 8), tr = rem >> 3, c8 = rem & 7;
    int t = t0 - 2 + tr;
    int col = C_SSD + (which == 0 ? h * 64 : 256 + (h >> 1) * 64) + c8 * 8;
    U4 v = (t >= 0 && t < len) ? *(const U4*)(pr + (size_t)(seq0 + t) * NIN + col) : zero4();
    *(U4*)&sRaw[(which * 68 + tr) * 64 + c8 * 8] = v;
  }
  if (tid < 64) {
    float raw = bf2f(pr[(size_t)(seq0 + t0 + tid) * NIN + C_SSDDT + d * 4 + h]);
    sdt[tid] = softplus_f(raw + P.ssd_dt_bias[(l * 2 + d) * 4 + h]);
  }
  __syncthreads();
  if (tid == 0) {
    float an = ssd_aneg(P, l, d, h), run = 0.f;
    if (d == 0) { for (int t = TC - 1; t >= 0; t--) { sdw[t] = __expf(run); run += sdt[t] * an; } }
    else { for (int t = 0; t < TC; t++) { sdw[t] = __expf(run); run += sdt[t] * an; } }
    WS(float, OFF_SSDDEC)[((size_t)(d * BATCH + b) * NCH + pc) * 4 + h] = __expf(run);
  }
  __syncthreads();
#pragma unroll 2
  for (int idx = tid; idx < 2 * 64 * 64; idx += 256) {
    int which = idx >> 12, t = (idx >> 6) & 63, c = idx & 63;
    int ch = which == 0 ? h * 64 + c : 256 + (h >> 1) * 64 + c;
    float acc = P.ssd_conv_b[l * 512 + ch];
    for (int i = 0; i < 5; i++) acc += bf2f(sRaw[(which * 68 + t + i) * 64 + c]) * P.ssd_conv_w[(l * 5 + i) * 512 + ch];
    float v = silu_f(acc);
    if (which == 0) sVt[c * 72 + t] = f2bf(v * sdt[t] * sdw[t]);
    else sBt[c * 72 + t] = f2bf(v);
  }
  __syncthreads();
  {
    int ti = w >> 1, tj = w & 1;
    f32x16 acc = zero16();
    for (int ks = 0; ks < 64; ks += 16)
      acc = mfma32(ldsfrag(&sVt[(ti * 32 + (lane & 31)) * 72 + ks + 8 * (lane >> 5)]),
                   ldsfrag(&sBt[(tj * 32 + (lane & 31)) * 72 + ks + 8 * (lane >> 5)]), acc);
    bf16* st = WS(bf16, OFF_SSDST) + ((size_t)((d * BATCH + b) * NCH + pc) * 4 + h) * 4096;
    for (int r = 0; r < 16; r++) st[(ti * 32 + acc_row(r, lane)) * 64 + tj * 32 + (lane & 31)] = f2bf(acc[r]);
  }
  __syncthreads();
}

__device__ __forceinline__ void gla_la(const Params& P, int l, int d, int h, const float* sGl, float* dst) {
#pragma unroll 2
  for (int idx = threadIdx.x; idx < 64 * 32; idx += 256) {
    int t = idx >> 5, k = idx & 31;
    float acc = P.gla_gb[(l * 2 + d) * 128 + h * 32 + k];
    const float* g2 = P.gla_g2 + (size_t)(l * 2 + d) * 16 * 128 + h * 32 + k;
    for (int r = 0; r < 16; r++) acc += sGl[t * 32 + d * 16 + r] * g2[r * 128];
    dst[idx] = -softplus_f(-acc) * (1.f / 16.f);
  }
}
__device__ __forceinline__ void gla_state_item(const Params& P, int l, int item, unsigned char* sm) {
  int tid_ = threadIdx.x; OPAQUE(tid_);
  const int tid = tid_, lane = tid & 63, w = tid >> 6;
  const int d = item & 1, h = (item >> 1) & 3, rest = item >> 3;
  const int pc = rest % NCH, b = rest / NCH;
  const int row0 = chunk_row0(b, pc, TC, NCH_C);
  float* sGl = (float*)sm;
  float* sLa = sGl + 2048;
  bf16* sVt = (bf16*)(sLa + 2048);
  bf16* sKt = sVt + 64 * 72;
  const bf16* pr = WS(bf16, OFF_PROJ);
#pragma unroll 2
  for (int idx = tid; idx < 64 * 32; idx += 256) {
    int t = idx >> 5, c = idx & 31;
    sGl[idx] = bf2f(pr[(size_t)(row0 + t) * NIN + C_GLAGL + c]);
  }
  __syncthreads();
  gla_la(P, l, d, h, sGl, sLa);
  __syncthreads();
  if (tid < 32) {
    float run = 0.f;
    if (d == 0) { for (int t = TC - 1; t >= 0; t--) { float la = sLa[t * 32 + tid]; sLa[t * 32 + tid] = run; run += la; } }
    else { for (int t = 0; t < TC; t++) { float la = sLa[t * 32 + tid]; sLa[t * 32 + tid] = run; run += la; } }
    WS(float, OFF_GLADEC)[(((size_t)(d * BATCH + b) * NCH + pc) * 4 + h) * 32 + tid] = __expf(run);
  }
  __syncthreads();
#pragma unroll 2
  for (int idx = tid; idx < 64 * 64; idx += 256) {
    int t = idx >> 6, c = idx & 63;
    sVt[c * 72 + t] = pr[(size_t)(row0 + t) * NIN + C_GLAV + h * 64 + c];
  }
#pragma unroll 2
  for (int idx = tid; idx < 64 * 32; idx += 256) {
    int t = idx >> 5, k = idx & 31;
    float kv = bf2f(pr[(size_t)(row0 + t) * NIN + C_GLAK + h * 32 + k]);
    sKt[k * 72 + t] = f2bf(kv * __expf(sLa[t * 32 + k]));
  }
  __syncthreads();
  if (w < 2) {
    f32x16 acc = zero16();
    for (int ks = 0; ks < 64; ks += 16)
      acc = mfma32(ldsfrag(&sVt[(w * 32 + (lane & 31)) * 72 + ks + 8 * (lane >> 5)]),
                   ldsfrag(&sKt[(lane & 31) * 72 + ks + 8 * (lane >> 5)]), acc);
    bf16* st = WS(bf16, OFF_GLAST) + ((size_t)((d * BATCH + b) * NCH + pc) * 4 + h) * 2048;
    for (int r = 0; r < 16; r++) st[(w * 32 + acc_row(r, lane)) * 32 + (lane & 31)] = f2bf(acc[r]);
  }
  __syncthreads();
}

__device__ __forceinline__ U4 s5_u_load(const Params& P, int g, int n, int k8) {
  if (n >= M5) return zero4();
  int b = n / NCH5, pc = n - b * NCH5;
  int row = chunk_row0(b, pc, T5, NC5) + (k8 >> 4);
  return *(const U4*)(WS(bf16, OFF_PROJ) + (size_t)row * NIN + C_S5 + g * 16 + (k8 & 15));
}
__device__ __forceinline__ void s5_state_tile(const Params& P, int l, int item, unsigned char* sm) {
  const int MT5 = (M5 + 127) / 128;
  int nt = item & 1, mt = (item >> 1) % MT5, g = (item >> 1) / MT5;
  const bf16* Bt = WS(bf16, OFF_W1T) + (size_t)(l * 16 + g) * 256 * 512;
  float* S = WS(float, OFF_S5ST) + (size_t)g * M5 * 256;
  gemm_tile(sm, mt * 128, nt * 128, 512,
    [&](int m, int k) { return s5_u_load(P, g, m, k); },
    [&](int n, int k) { return *(const U4*)(Bt + (size_t)n * 512 + k); },
    [&](int m, int n, float v) { if (m < M5) S[(size_t)m * 256 + n] = v; });
}

__device__ __forceinline__ void phase_D(const Params& P, int l, unsigned char* sm) {
  const int n_rw = BATCH * NCH * 8, n_ssd = BATCH * NCH * 8, n_gla = BATCH * NCH * 8;
  const int n_s5 = 16 * ((M5 + 127) / 128) * 2;
  ITEM_LOOP(i, n_rw, 0) rwkv_chunk_item(P, l, i, sm);
  ITEM_LOOP(i, n_ssd, n_rw) ssd_state_item(P, l, i, sm);
  ITEM_LOOP(i, n_gla, n_rw + n_ssd) gla_state_item(P, l, i, sm);
  ITEM_LOOP(i, n_s5, n_rw + n_ssd + n_gla) s5_state_tile(P, l, i, sm);
}

__device__ __forceinline__ void phase_E(const Params& P, int l, unsigned char* sm) {
  const int tid = threadIdx.x, w = tid >> 6;
  const int n_rw = BATCH * 8;
  ITEM_LOOP(i, n_rw, 0) rwkv_scan2_item(P, l, i, sm);
  const int n_ssd = 2 * BATCH * 4 * 4, n_gla = 2 * BATCH * 4 * 2, n_s5 = 16 * BATCH;
#pragma unroll 1
  for (int it = (int)((blockIdx.x + gridDim.x - ((unsigned)n_rw % gridDim.x)) % gridDim.x); it < n_ssd + n_gla + n_s5; it += gridDim.x) {
    int i = it;
    if (i < n_ssd) {
      int q = i & 3, h = (i >> 2) & 3, rest = i >> 4, b = rest % BATCH, d = rest / BATCH;
      float S[4] = {0.f, 0.f, 0.f, 0.f};
      for (int vc = 0; vc < NCH; vc++) {
        int pc = ord_chunk(d, vc, NCH_C, NCH);
        size_t ci = ((size_t)(d * BATCH + b) * NCH + pc) * 4 + h;
        bf16* p = WS(bf16, OFF_SSDST) + ci * 4096 + q * 1024 + tid * 4;
        float dec = WS(float, OFF_SSDDEC)[ci];
        U2 cv = *(U2*)p;
        U2 o; o.a[0] = pack2(S[0], S[1]); o.a[1] = pack2(S[2], S[3]);
        *(U2*)p = o;
        S[0] = dec * S[0] + lo2f(cv.a[0]); S[1] = dec * S[1] + hi2f(cv.a[0]);
        S[2] = dec * S[2] + lo2f(cv.a[1]); S[3] = dec * S[3] + hi2f(cv.a[1]);
      }
      continue;
    }
    i -= n_ssd;
    if (i < n_gla) {
      int q = i & 1, h = (i >> 1) & 3, rest = i >> 3, b = rest % BATCH, d = rest / BATCH;
      float S[4] = {0.f, 0.f, 0.f, 0.f};
      int e0 = q * 1024 + tid * 4, k0 = e0 & 31;
      for (int vc = 0; vc < NCH; vc++) {
        int pc = ord_chunk(d, vc, NCH_C, NCH);
        size_t ci = ((size_t)(d * BATCH + b) * NCH + pc) * 4 + h;
        bf16* p = WS(bf16, OFF_GLAST) + ci * 2048 + e0;
        F4 dec = *(const F4*)(WS(float, OFF_GLADEC) + ci * 32 + k0);
        U2 cv = *(U2*)p;
        U2 o; o.a[0] = pack2(S[0], S[1]); o.a[1] = pack2(S[2], S[3]);
        *(U2*)p = o;
        S[0] = dec.a[0] * S[0] + lo2f(cv.a[0]); S[1] = dec.a[1] * S[1] + hi2f(cv.a[0]);
        S[2] = dec.a[2] * S[2] + lo2f(cv.a[1]); S[3] = dec.a[3] * S[3] + hi2f(cv.a[1]);
      }
      continue;
    }
    i -= n_gla;
    if (i < n_s5) {
      int b = i % BATCH, g = i / BATCH;
      if (tid < 128) {
        int d = tid >> 6, p = tid & 63;
        const float* lt = WS(float, OFF_S5LT) + ((size_t)((l * 16 + g) * 2 + d) * 64 + p) * 2;
        float lr = lt[0], li = lt[1], xr = 0.f, xi = 0.f;
        for (int vc = 0; vc < NCH5; vc++) {
          int pc = ord_chunk(d, vc, NC5, NCH5);
          float* sp = WS(float, OFF_S5ST) + ((size_t)g * M5 + b * NCH5 + pc) * 256 + d * 128 + p;
          float sr = sp[0], si = sp[64];
          sp[0] = xr; sp[64] = xi;
          float nr = lr * xr - li * xi + sr, ni = lr * xi + li * xr + si;
          xr = nr; xi = ni;
        }
      }
      continue;
    }
  }
}

__device__ __forceinline__ void ssd_out_item(const Params& P, int l, int item, unsigned char* sm) {
  int tid_ = threadIdx.x; OPAQUE(tid_);
  const int tid = tid_, lane = tid & 63, w = tid >> 6;
  const int h = item & 3, rest = item >> 2, pc = rest % NCH, b = rest / NCH;
  const int isctx = pc < NCH_C, len = isctx ? CTX : SEQ, t0 = (isctx ? pc : pc - NCH_C) * TC;
  const int seq0 = isctx ? b * CTX : ROWS_C + b * SEQ;
  bf16* sRaw = (bf16*)sm;
  bf16* sA2 = (bf16*)sm;
  bf16* sB2 = (bf16*)(sm + 26112);
  bf16* sC = (bf16*)(sm + 26112 + 25600);
  float* sdt = (float*)(sm + 26112 + 25600 + 9216);
  float* scf = sdt + 128; float* scr = scf + 64; float* spart = scr + 64;
  const bf16* pr = WS(bf16, OFF_PROJ);
#pragma unroll 2
  for (int idx = tid; idx < 3 * 68 * 8; idx += 256) {
    int which = idx / (68 * 8), rem = idx % (68 * 8), tr = rem >> 3, c8 = rem & 7;
    int t = t0 - 2 + tr;
    int col = C_SSD + (which == 0 ? h * 64 : which == 1 ? 256 + (h >> 1) * 64 : 384 + (h >> 1) * 64) + c8 * 8;
    U4 v = (t >= 0 && t < len) ? *(const U4*)(pr + (size_t)(seq0 + t) * NIN + col) : zero4();
    *(U4*)&sRaw[(which * 68 + tr) * 64 + c8 * 8] = v;
  }
  if (tid < 128) {
    int d = tid >> 6, t = tid & 63;
    float raw = bf2f(pr[(size_t)(seq0 + t0 + t) * NIN + C_SSDDT + d * 4 + h]);
    sdt[tid] = softplus_f(raw + P.ssd_dt_bias[(l * 2 + d) * 4 + h]);
  }
  __syncthreads();
  if (tid == 0) { float an = ssd_aneg(P, l, 0, h), run = 0.f; for (int t = 0; t < TC; t++) { run += sdt[t] * an; scf[t] = run; } }
  if (tid == 64) { float an = ssd_aneg(P, l, 1, h), run = 0.f; for (int t = TC - 1; t >= 0; t--) { run += sdt[64 + t] * an; scr[t] = run; } }
#pragma unroll 2
  for (int idx = tid; idx < 3 * 64 * 64; idx += 256) {
    int which = idx >> 12, t = (idx >> 6) & 63, c = idx & 63;
    int ch = which == 0 ? h * 64 + c : which == 1 ? 256 + (h >> 1) * 64 + c : 384 + (h >> 1) * 64 + c;
    float acc = P.ssd_conv_b[l * 512 + ch];
    for (int i = 0; i < 5; i++) acc += bf2f(sRaw[(which * 68 + t + i) * 64 + c]) * P.ssd_conv_w[(l * 5 + i) * 512 + ch];
    bf16 v = f2bf(silu_f(acc));
    if (which == 0) sB2[c * 200 + t] = v;
    else if (which == 1) sB2[t * 200 + 64 + c] = v;
    else sC[t * 72 + c] = v;
  }
  __syncthreads();
  const int ti = w >> 1, tj = w & 1;
  {
    f32x16 g = zero16();
    for (int ks = 0; ks < 64; ks += 16)
      g = mfma32(ldsfrag(&sC[(ti * 32 + (lane & 31)) * 72 + ks + 8 * (lane >> 5)]),
                 ldsfrag(&sB2[(tj * 32 + (lane & 31)) * 200 + 64 + ks + 8 * (lane >> 5)]), g);
    int j = tj * 32 + (lane & 31);
    float cfj = scf[j], crj = scr[j], d0j = sdt[j], d1j = sdt[64 + j];
    for (int r = 0; r < 16; r++) {
      int i = ti * 32 + acc_row(r, lane);
      float mlt = 0.f;
      if (j <= i) mlt += __expf(scf[i] - cfj) * d0j;
      if (j >= i) mlt += __expf(scr[i] - crj) * d1j;
      sA2[i * 200 + j] = f2bf(g[r] * mlt);
    }
  }
#pragma unroll 2
  for (int idx = tid; idx < 64 * 64; idx += 256) {
    int i = idx >> 6, n = idx & 63;
    float cv = bf2f(sC[i * 72 + n]);
    sA2[i * 200 + 64 + n] = f2bf(cv * __expf(scf[i]));
    sA2[i * 200 + 128 + n] = f2bf(cv * __expf(scr[i]));
  }
  __syncthreads();
#pragma unroll 2
  for (int idx = tid; idx < 2 * 64 * 8; idx += 256) {
    int d = idx >> 9, p = (idx >> 3) & 63, c8 = idx & 7;
    const bf16* st = WS(bf16, OFF_SSDST) + ((size_t)((d * BATCH + b) * NCH + pc) * 4 + h) * 4096;
    *(U4*)&sB2[p * 200 + 64 + d * 64 + c8 * 8] = *(const U4*)(st + p * 64 + c8 * 8);
  }
  __syncthreads();
  {
    f32x16 acc = zero16();
    for (int ks = 0; ks < 192; ks += 16)
      acc = mfma32(ldsfrag(&sA2[(ti * 32 + (lane & 31)) * 200 + ks + 8 * (lane >> 5)]),
                   ldsfrag(&sB2[(tj * 32 + (lane & 31)) * 200 + ks + 8 * (lane >> 5)]), acc);
    int p = tj * 32 + (lane & 31);
    float dd = P.ssd_d[l * 4 + h];
    bf16* yc = WS(bf16, OFF_R);
    for (int r = 0; r < 16; r++) {
      int i = ti * 32 + acc_row(r, lane);
      int row = seq0 + t0 + i;
      float xv = bf2f(sB2[p * 200 + i]);
      float y = acc[r] + dd * xv;
      float z = bf2f(pr[(size_t)row * NIN + C_SSDZ + h * 64 + p]);
      y *= silu_f(z);
      yc[(size_t)row * 1024 + h * 64 + p] = f2bf(y);
      float s2 = sum32(y * y);
      if ((lane & 31) == 0) spart[i * 2 + tj] = s2;
    }
  }
  __syncthreads();
  if (tid < 64) WS(float, OFF_SSQ)[(size_t)(seq0 + t0 + tid) * 4 + h] = spart[tid * 2] + spart[tid * 2 + 1];
  __syncthreads();
}

__device__ __forceinline__ void gla_out_item(const Params& P, int l, int item, unsigned char* sm) {
  int tid_ = threadIdx.x; OPAQUE(tid_);
  const int tid = tid_, lane = tid & 63, w = tid >> 6;
  const int h = item & 3, rest = item >> 2, pc = rest % NCH, b = rest / NCH;
  const int row0 = chunk_row0(b, pc, TC, NCH_C);
  bf16* sA2 = (bf16*)sm;
  bf16* sB2 = sA2 + 64 * 136;
  bf16* sKf = sB2 + 64 * 136;
  bf16* sKr = sKf + 64 * 40;
  float* sbf = (float*)(sKr + 64 * 40);
  float* sbr = sbf + 2048;
  float* spart = sbr + 2048;
  float* sGl = (float*)sB2;
  const bf16* pr = WS(bf16, OFF_PROJ);
#pragma unroll 2
  for (int idx = tid; idx < 64 * 32; idx += 256) {
    int t = idx >> 5, c = idx & 31;
    sGl[idx] = bf2f(pr[(size_t)(row0 + t) * NIN + C_GLAGL + c]);
  }
  __syncthreads();
  gla_la(P, l, 0, h, sGl, sbf);
  gla_la(P, l, 1, h, sGl, sbr);
  __syncthreads();
  if (tid < 32) { float run = 0.f; for (int t = 0; t < TC; t++) { run += sbf[t * 32 + tid]; sbf[t * 32 + tid] = run; } }
  else if (tid < 64) { int k = tid - 32; float run = 0.f; for (int t = TC - 1; t >= 0; t--) { run += sbr[t * 32 + k]; sbr[t * 32 + k] = run; } }
  __syncthreads();
#pragma unroll 2
  for (int idx = tid; idx < 64 * 32; idx += 256) {
    int t = idx >> 5, k = idx & 31;
    float q = bf2f(pr[(size_t)(row0 + t) * NIN + C_GLA + h * 32 + k]) * 0.17677669529663687f;
    float kv = bf2f(pr[(size_t)(row0 + t) * NIN + C_GLAK + h * 32 + k]);
    float bf_ = sbf[idx], br_ = sbr[idx];
    sA2[t * 136 + 64 + k] = f2bf(q * __expf(bf_));
    sA2[t * 136 + 96 + k] = f2bf(q * __expf(br_));
    sKf[t * 40 + k] = f2bf(kv * __expf(-bf_));
    sKr[t * 40 + k] = f2bf(kv * __expf(-br_));
  }
#pragma unroll 2
  for (int idx = tid; idx < 64 * 64; idx += 256) {
    int t = idx >> 6, c = idx & 63;
    sB2[c * 136 + t] = pr[(size_t)(row0 + t) * NIN + C_GLAV + h * 64 + c];
  }
#pragma unroll 2
  for (int idx = tid; idx < 2 * 64 * 4; idx += 256) {
    int d = idx >> 8, v = (idx >> 2) & 63, c8 = idx & 3;
    const bf16* st = WS(bf16, OFF_GLAST) + ((size_t)((d * BATCH + b) * NCH + pc) * 4 + h) * 2048;
    *(U4*)&sB2[v * 136 + 64 + d * 32 + c8 * 8] = *(const U4*)(st + v * 32 + c8 * 8);
  }
  __syncthreads();
  const int ti = w >> 1, tj = w & 1;
  {
    f32x16 pf = zero16(), pv = zero16();
    for (int ks = 0; ks < 32; ks += 16) {
      pf = mfma32(ldsfrag(&sA2[(ti * 32 + (lane & 31)) * 136 + 64 + ks + 8 * (lane >> 5)]),
                  ldsfrag(&sKf[(tj * 32 + (lane & 31)) * 40 + ks + 8 * (lane >> 5)]), pf);
      pv = mfma32(ldsfrag(&sA2[(ti * 32 + (lane & 31)) * 136 + 96 + ks + 8 * (lane >> 5)]),
                  ldsfrag(&sKr[(tj * 32 + (lane & 31)) * 40 + ks + 8 * (lane >> 5)]), pv);
    }
    int j = tj * 32 + (lane & 31);
    for (int r = 0; r < 16; r++) {
      int i = ti * 32 + acc_row(r, lane);
      float v = (j < i) ? pf[r] : (j > i) ? pv[r] : pf[r] + pv[r];
      sA2[i * 136 + j] = f2bf(v);
    }
  }
  __syncthreads();
  {
    f32x16 acc = zero16();
    for (int ks = 0; ks < 128; ks += 16)
      acc = mfma32(ldsfrag(&sA2[(ti * 32 + (lane & 31)) * 136 + ks + 8 * (lane >> 5)]),
                   ldsfrag(&sB2[(tj * 32 + (lane & 31)) * 136 + ks + 8 * (lane >> 5)]), acc);
    for (int r = 0; r < 16; r++) {
      int i = ti * 32 + acc_row(r, lane);
      float s2 = sum32(acc[r] * acc[r]);
      if ((lane & 31) == 0) spart[i * 2 + tj] = s2;
    }
    __syncthreads();
    int v = tj * 32 + (lane & 31);
    float gn = P.gla_norm[l * 256 + h * 64 + v];
    bf16* yc = WS(bf16, OFF_R);
    for (int r = 0; r < 16; r++) {
      int i = ti * 32 + acc_row(r, lane);
      int row = row0 + i;
      float rstd = rsqrtf((spart[i * 2] + spart[i * 2 + 1]) * (1.f / 64.f) + 1e-6f);
      float g = bf2f(pr[(size_t)row * NIN + C_GLAG + h * 64 + v]);
      yc[(size_t)row * 1024 + 768 + h * 64 + v] = f2bf(acc[r] * rstd * gn * silu_f(g));
    }
  }
  __syncthreads();
}

__device__ __forceinline__ void s5_out_tile(const Params& P, int l, int item, unsigned char* sm) {
  const int MT5 = (M5 + 127) / 128;
  int nt = item & 3, mt = (item >> 2) % MT5, g = (item >> 2) / MT5;
  const bf16* Bt = WS(bf16, OFF_BT2) + (size_t)(l * 16 + g) * 512 * 768;
  const float* X = WS(float, OFF_S5ST) + (size_t)g * M5 * 256;
  const bf16* pr = WS(bf16, OFF_PROJ);
  bf16* ys = WS(bf16, OFF_PROJ);
  gemm_tile(sm, mt * 128, nt * 128, 768,
    [&](int m, int k) {
      if (k < 512) return s5_u_load(P, g, m, k);
      if (m >= M5) return zero4();
      const float* xp = X + (size_t)m * 256 + (k - 512);
      F4 a = *(const F4*)xp, b2 = *(const F4*)(xp + 4);
      U4 r; r.a[0] = pack2(a.a[0], a.a[1]); r.a[1] = pack2(a.a[2], a.a[3]); r.a[2] = pack2(b2.a[0], b2.a[1]); r.a[3] = pack2(b2.a[2], b2.a[3]);
      return r;
    },
    [&](int n, int k) { return *(const U4*)(Bt + (size_t)n * 768 + k); },
    [&](int m, int n, float v) {
      if (m >= M5) return;
      int b = m / NCH5, pc = m - b * NCH5;
      int row = chunk_row0(b, pc, T5, NC5) + (n >> 4);
      int ch = g * 16 + (n & 15);
      float u = bf2f(pr[(size_t)row * NIN + C_S5 + ch]);
      ys[(size_t)row * NIN + (ch >> 6) * 128 + 64 + (ch & 63)] = f2bf(gelu_f(v + P.s5_d[l * 256 + ch] * u));
    });
}

__device__ __forceinline__ void phase_F(const Params& P, int l, unsigned char* sm) {
  const int n_ssd = BATCH * NCH * 4, n_gla = BATCH * NCH * 4, n_s5 = 16 * ((M5 + 127) / 128) * 4, n_rw = BATCH * NCH * 4;
  ITEM_LOOP(i, n_ssd, 0) ssd_out_item(P, l, i, sm);
  ITEM_LOOP(i, n_gla, n_ssd) gla_out_item(P, l, i, sm);
  ITEM_LOOP(i, n_s5, n_ssd + n_gla) s5_out_tile(P, l, i, sm);
  ITEM_LOOP(i, n_rw, n_ssd + n_gla + n_s5) rwkv_out_item(P, l, i, sm);
}

__device__ __forceinline__ void phase_G(const Params& P, int l, unsigned char* sm) {
  const int lane = threadIdx.x & 63, w = threadIdx.x >> 6;
  const int n_glu = (ROWS / 128) * 2, n_rows = ROWS / 4;
  const bf16* Bt = WS(bf16, OFF_GLUT) + (size_t)l * 256 * 256;
  const bf16* pr = WS(bf16, OFF_PROJ);
  bf16* yc = WS(bf16, OFF_R);
#pragma unroll 1
  for (int it = blockIdx.x; it < n_glu + n_rows; it += gridDim.x) {
    if (it < n_glu) {
      int nt = it & 1, mt = it >> 1;
      gemm_tile(sm, mt * 128, nt * 128, 256,
        [&](int m, int k) { return *(const U4*)(pr + (size_t)m * NIN + (k >> 6) * 128 + 64 + (k & 63)); },
        [&](int n, int k) { return *(const U4*)(Bt + (size_t)n * 256 + k); },
        [&](int m, int n, float v) {
          float y = bf2f(pr[(size_t)m * NIN + (n >> 6) * 128 + 64 + (n & 63)]);
          float g = bf2f(pr[(size_t)m * NIN + C_S5G + n]);
          yc[(size_t)m * 1024 + 256 + n] = f2bf(y * sigmoid_f(v + P.s5_glu_b[l * 256 + n]) * silu_f(g));
        });
      continue;
    }
    int m = (it - n_glu) * 4 + w;
    const float* sq = WS(float, OFF_SSQ) + (size_t)m * 4;
    float rstd = rsqrtf((sq[0] + sq[1] + sq[2] + sq[3]) * (1.f / 256.f) + 1e-6f);
    bf16* p = yc + (size_t)m * 1024 + lane * 4;
    U2 v = *(U2*)p;
    const float* gn = P.ssd_norm + l * 256 + lane * 4;
    U2 o;
    o.a[0] = pack2(lo2f(v.a[0]) * rstd * gn[0], hi2f(v.a[0]) * rstd * gn[1]);
    o.a[1] = pack2(lo2f(v.a[1]) * rstd * gn[2], hi2f(v.a[1]) * rstd * gn[3]);
    *(U2*)p = o;
  }
}

__device__ __forceinline__ void phase_outproj(const Params& P, int l, unsigned char* sm) {
  const bf16* A = WS(bf16, OFF_R);
  const bf16* Bt = WS(bf16, OFF_WTOUT) + (size_t)l * D * D;
  float* Y = WS(float, OFF_PROJ);
  const int NT = D / 128, MT = ROWS / 128;
#pragma unroll 1
  for (int it = blockIdx.x; it < MT * NT; it += gridDim.x) {
    int mt = it / NT, nt = it % NT;
    gemm_tile(sm, mt * 128, nt * 128, D,
      [&](int m, int k) { return *(const U4*)(A + (size_t)m * D + k); },
      [&](int n, int k) { return *(const U4*)(Bt + (size_t)n * D + k); },
      [&](int m, int n, float v) { Y[(size_t)m * D + n] = v; });
  }
}

__device__ __forceinline__ void phase_post(const Params& P, int l) {
  const int lane = threadIdx.x & 63, w = threadIdx.x >> 6;
  const int first = (l == 1) ? ROWS_C / 4 : 0;
#pragma unroll 1
  for (int it = first + blockIdx.x; it < ROWS / 4; it += gridDim.x) {
    int m = it * 4 + w;
    RowInfo ri = row_info(m);
    const float* y = WS(float, OFF_PROJ) + (size_t)m * D;
    const float* hres; float* dst;
    if (ri.isctx) { hres = P.ctx + (size_t)m * D; dst = WS(float, OFF_HC) + (size_t)m * D; }
    else { hres = (l == 0 ? P.x : P.out) + (size_t)(m - ROWS_C) * D; dst = P.out + (size_t)(m - ROWS_C) * D; }
    const float* mod = WS(float, OFF_MOD) + ((size_t)l * NMOD + (ri.isctx ? BATCH : ri.b)) * 3072 + 2048;
    F4 v[4]; float ss = 0.f;
    for (int q = 0; q < 4; q++) {
      v[q] = *(const F4*)(y + q * 256 + lane * 4);
      for (int e = 0; e < 4; e++) ss += v[q].a[e] * v[q].a[e];
    }
    ss = sum64(ss);
    float rstd = rsqrtf(ss * (1.f / 1024.f) + 1e-6f);
    for (int q = 0; q < 4; q++) {
      int c0 = q * 256 + lane * 4;
      F4 hr = *(const F4*)(hres + c0), o;
      for (int e = 0; e < 4; e++) o.a[e] = hr.a[e] + mod[c0 + e] * (v[q].a[e] * rstd * P.norm_post[l * D + c0 + e]);
      *(F4*)(dst + c0) = o;
    }
  }
}

constexpr int NPHASE = 19;
__device__ __forceinline__ void run_phase(const Params& P, int ph, unsigned char* sm) {
  if (ph == 0) { phase_prologue(P, sm); return; }
  int l = (ph - 1) / 9, s = (ph - 1) % 9;
  switch (s) {
    case 0: phase_normmod(P, l); break;
    case 1: phase_inproj(P, l, sm); break;
    case 2: phase_rwprep(P, l, sm); break;
    case 3: phase_D(P, l, sm); break;
    case 4: phase_E(P, l, sm); break;
    case 5: phase_F(P, l, sm); break;
    case 6: phase_G(P, l, sm); break;
    case 7: phase_outproj(P, l, sm); break;
    default: phase_post(P, l); break;
  }
}

#ifndef CPU_EMU
#ifndef PROBE_MASK
#define PROBE_MASK 0
#endif
#define PROBE_REP(bit, call) if (PROBE_MASK & (1 << (bit))) { call; grid.sync(); }
template <int L> __device__ __forceinline__ void run_layer(const Params& P, unsigned char* sm, cg::grid_group& grid) {
  PROBE_REP(0, phase_normmod(P, L)) phase_normmod(P, L); grid.sync();
  PROBE_REP(1, phase_inproj(P, L, sm)) phase_inproj(P, L, sm); grid.sync();
  PROBE_REP(2, phase_rwprep(P, L, sm)) phase_rwprep(P, L, sm); grid.sync();
  PROBE_REP(3, phase_D(P, L, sm)) phase_D(P, L, sm); grid.sync();
  phase_E(P, L, sm); grid.sync();
  PROBE_REP(5, phase_F(P, L, sm)) phase_F(P, L, sm); grid.sync();
  phase_G(P, L, sm); grid.sync();
  PROBE_REP(7, phase_outproj(P, L, sm)) phase_outproj(P, L, sm); grid.sync();
  phase_post(P, L);
}
__global__ void __launch_bounds__(256, 2) mega_kernel(Params P) {
  __shared__ __attribute__((aligned(16))) unsigned char sm[SMEM_BYTES];
  cg::grid_group grid = cg::this_grid();
  PROBE_REP(9, phase_prologue(P, sm)) phase_prologue(P, sm); grid.sync();
  run_layer<0>(P, sm, grid); grid.sync();
  run_layer<1>(P, sm, grid);
}
__global__ void __launch_bounds__(256, 2) phase_kernel(Params P, int ph) {
  __shared__ __attribute__((aligned(16))) unsigned char sm[SMEM_BYTES];
  run_phase(P, ph, sm);
}

extern "C" void kernel_launch(void* const* d_in, const int* in_sizes, int n_in, void* d_out, int out_size,
                              void* d_ws, size_t ws_size, hipStream_t stream) {
  Params P{};
  const float** pp = (const float**)&P;
  for (int i = 0; i < 39; i++) pp[i] = (const float*)d_in[i];
  P.out = (float*)d_out;
  P.ws = (unsigned char*)d_ws;
  if (ws_size < WS_TOTAL) fprintf(stderr, "workspace too small: %zu < %zu\n", ws_size, (size_t)WS_TOTAL);
#if USE_COOP
  static int grid_blocks = 0;
  if (!grid_blocks) {
    int dev = 0, cus = 0, per_cu = 0;
    hipGetDevice(&dev);
    hipDeviceGetAttribute(&cus, hipDeviceAttributeMultiprocessorCount, dev);
    hipOccupancyMaxActiveBlocksPerMultiprocessor(&per_cu, mega_kernel, 256, 0);
    if (per_cu > 2) per_cu = 2;
    grid_blocks = cus * per_cu;
  }
  void* args[] = {&P};
  hipError_t e = hipLaunchCooperativeKernel((void*)mega_kernel, dim3(grid_blocks), dim3(256), args, 0, stream);
  if (e != hipSuccess) fprintf(stderr, "cooperative launch failed: %s (grid %d)\n", hipGetErrorString(e), grid_blocks);
#else
  for (int ph = 0; ph < NPHASE; ph++) phase_kernel<<<1024, 256, 0, stream>>>(P, ph);
#endif
}
#endif
```

```cpp
#ifdef CPU_EMU
#include "hip_emu.h"
#else
#include <hip/hip_runtime.h>
#include <hip/hip_cooperative_groups.h>
#include <stdint.h>
#include <stdio.h>
namespace cg = cooperative_groups;
#endif

#ifndef BATCH
#define BATCH 8
#endif
#ifndef SEQ
#define SEQ 4096
#endif
#ifndef CTX
#define CTX 256
#endif
#ifndef USE_COOP
#define USE_COOP 1
#endif
#ifndef PROBE_PHASE
#define PROBE_PHASE -1
#endif

typedef unsigned short bf16;
typedef __attribute__((ext_vector_type(8))) short bf16x8;
typedef __attribute__((ext_vector_type(16))) float f32x16;
struct alignas(16) U4 { uint32_t a[4]; };
typedef uint32_t u32x4 __attribute__((ext_vector_type(4)));
struct alignas(8) U2 { uint32_t a[2]; };
struct alignas(16) F4 { float a[4]; };

constexpr int D = 1024, NIN = 3368, NINP = 3456;
constexpr int ROWS_C = BATCH * CTX, ROWS_L = BATCH * SEQ, ROWS = ROWS_C + ROWS_L;
constexpr int VL = CTX + SEQ;
constexpr int TC = 64;
constexpr int NCH_C = CTX / TC, NCH_L = SEQ / TC, NCH = NCH_C + NCH_L;
constexpr int T5 = 32;
constexpr int NC5 = CTX / T5, NL5 = SEQ / T5, NCH5 = NC5 + NL5;
constexpr int M5 = BATCH * NCH5;
constexpr int NMOD = BATCH + 1;
constexpr int C_RW = 0, C_RWG = 1024, C_S5 = 1280, C_S5G = 1536, C_SSD = 1792, C_SSDDT = 2304, C_SSDZ = 2312;
constexpr int C_GLA = 2568, C_GLAK = 2696, C_GLAV = 2824, C_GLAGL = 3080, C_GLAG = 3112;

constexpr size_t al256(size_t x) { return (x + 255) & ~size_t(255); }
constexpr size_t OFF_WTIN = 0;
constexpr size_t OFF_WTOUT = OFF_WTIN + al256(2ull * NINP * D * 2);
constexpr size_t OFF_W2T = OFF_WTOUT + al256(2ull * D * D * 2);
constexpr size_t OFF_A2T = OFF_W2T + al256(2ull * 2 * 256 * 64 * 2);
constexpr size_t OFF_GLUT = OFF_A2T + al256(2ull * 2 * 256 * 64 * 2);
constexpr size_t OFF_MOD = OFF_GLUT + al256(2ull * 256 * 256 * 2);
constexpr size_t OFF_S5K = OFF_MOD + al256(2ull * NMOD * 3072 * 4);
constexpr size_t OFF_S5LT = OFF_S5K + al256(2ull * 16 * 2 * 32 * 256 * 4);
constexpr size_t OFF_W1T = OFF_S5LT + al256(2ull * 16 * 2 * 64 * 2 * 4);
constexpr size_t OFF_BT2 = OFF_W1T + al256(2ull * 16 * 256 * 512 * 2);
constexpr size_t OFF_PROJ = OFF_BT2 + al256(2ull * 16 * 512 * 768 * 2);
constexpr size_t OFF_R = OFF_PROJ + al256((size_t)ROWS * NIN * 2);
constexpr size_t OFF_XA = OFF_R + al256((size_t)ROWS * 1024 * 2);
constexpr size_t OFF_HC = OFF_XA + al256((size_t)ROWS * 1024 * 2);
constexpr size_t OFF_SSDST = OFF_HC + al256((size_t)ROWS_C * 1024 * 4);
constexpr size_t OFF_SSDDEC = OFF_SSDST + al256(2ull * BATCH * NCH * 4 * 4096 * 2);
constexpr size_t OFF_GLAST = OFF_SSDDEC + al256(2ull * BATCH * NCH * 4 * 4);
constexpr size_t OFF_GLADEC = OFF_GLAST + al256(2ull * BATCH * NCH * 4 * 2048 * 2);
constexpr size_t OFF_S5ST = OFF_GLADEC + al256(2ull * BATCH * NCH * 4 * 32 * 4);
constexpr size_t OFF_SSQ = OFF_S5ST + al256(16ull * M5 * 256 * 4);
constexpr size_t OFF_BON = OFF_SSQ + al256((size_t)ROWS * 4 * 4);
constexpr size_t OFF_BAR = OFF_BON + al256((size_t)ROWS * 8 * 4);
constexpr size_t WS_TOTAL = OFF_BAR + al256(3456 * 4);
#if BATCH == 8 && SEQ == 4096 && CTX == 256
static_assert(WS_TOTAL <= 536870912ull, "workspace too large");
#endif
constexpr int SMEM_BYTES = 64512;

struct Params {
  const float *x, *c, *ctx, *c_ctx, *ada_w, *ada_b, *norm_pre, *norm_post, *w_in, *w_out;
  const float *rw_mu, *rw_w0, *rw_w2, *rw_a0, *rw_a2, *rw_kk, *rw_ka, *rw_rk, *rw_ln_w, *rw_ln_b;
  const float *s5_a_re, *s5_a_im, *s5_log_dt, *s5_b_re, *s5_b_im, *s5_c_re, *s5_c_im, *s5_d, *s5_glu_w, *s5_glu_b;
  const float *ssd_conv_w, *ssd_conv_b, *ssd_dt_bias, *ssd_a_log, *ssd_d, *ssd_norm;
  const float *gla_g2, *gla_gb, *gla_norm;
  float* out;
  unsigned char* ws;
};

#ifdef CPU_EMU
#define OPAQUE(x)
#else
#define OPAQUE(x) asm volatile("" : "+v"(x))
#endif
__device__ __forceinline__ float bf2f(bf16 v) { return __uint_as_float(((uint32_t)v) << 16); }
__device__ __forceinline__ bf16 f2bf(float f) {
  uint32_t u = __float_as_uint(f);
  u += 0x7fffu + ((u >> 16) & 1u);
  return (bf16)(u >> 16);
}
__device__ __forceinline__ uint32_t pack2(float lo, float hi) { return (uint32_t)f2bf(lo) | ((uint32_t)f2bf(hi) << 16); }
__device__ __forceinline__ float lo2f(uint32_t u) { return __uint_as_float(u << 16); }
__device__ __forceinline__ float hi2f(uint32_t u) { return __uint_as_float(u & 0xffff0000u); }
__device__ __forceinline__ float sigmoid_f(float x) { return 1.f / (1.f + __expf(-x)); }
__device__ __forceinline__ float silu_f(float x) { return x / (1.f + __expf(-x)); }
__device__ __forceinline__ float softplus_f(float x) { return fmaxf(x, 0.f) + __logf(1.f + __expf(-fabsf(x))); }
__device__ __forceinline__ float tanh_f(float x) { return 1.f - 2.f / (1.f + __expf(2.f * x)); }
__device__ __forceinline__ float gelu_f(float x) {
  return 0.5f * x * (1.f + tanh_f(0.7978845608028654f * (x + 0.044715f * x * x * x)));
}
__device__ __forceinline__ U4 zero4() { U4 r; r.a[0] = r.a[1] = r.a[2] = r.a[3] = 0; return r; }
__device__ __forceinline__ f32x16 mfma32(bf16x8 a, bf16x8 b, f32x16 c) {
#ifdef CPU_EMU
  return emu_mfma32(a, b, c);
#else
  return __builtin_amdgcn_mfma_f32_32x32x16_bf16(a, b, c, 0, 0, 0);
#endif
}
__device__ __forceinline__ f32x16 zero16() { f32x16 z; for (int i = 0; i < 16; i++) z[i] = 0.f; return z; }
__device__ __forceinline__ int acc_row(int reg, int lane) { return (reg & 3) + 8 * (reg >> 2) + 4 * (lane >> 5); }
template <int CTRL> __device__ __forceinline__ float dpp_mov(float v) {
#ifdef CPU_EMU
  int l = threadIdx.x & 63, src;
  if (CTRL == 0xB1) src = l ^ 1; else if (CTRL == 0x4E) src = l ^ 2;
  else if (CTRL == 0x141) src = (l & ~7) | (7 - (l & 7)); else src = (l & ~15) | (15 - (l & 15));
  return emu_lane_read(v, src);
#else
  return __int_as_float(__builtin_amdgcn_update_dpp(0, __float_as_int(v), CTRL, 0xF, 0xF, true));
#endif
}
__device__ __forceinline__ float sum16(float v) {
  v += dpp_mov<0xB1>(v); v += dpp_mov<0x4E>(v); v += dpp_mov<0x141>(v); v += dpp_mov<0x140>(v); return v;
}
__device__ __forceinline__ float sum32(float v) {
  v = sum16(v);
#ifdef CPU_EMU
  int l = threadIdx.x & 63; float o = emu_lane_read(v, ((l >> 4) > 0 ? ((l >> 4) - 1) * 16 + 15 : 0));
  if ((l >> 4) & 1) v += o;
#else
  v += __int_as_float(__builtin_amdgcn_update_dpp(0, __float_as_int(v), 0x142, 0xA, 0xF, false));
#endif
  return v;
}
__device__ __forceinline__ float sum64(float v) {
  v = sum16(v);
#ifdef CPU_EMU
  return emu_lane_read(v, 0) + emu_lane_read(v, 16) + emu_lane_read(v, 32) + emu_lane_read(v, 48);
#else
  int iv = __float_as_int(v);
  return __int_as_float(__builtin_amdgcn_readlane(iv, 0)) + __int_as_float(__builtin_amdgcn_readlane(iv, 16)) +
         __int_as_float(__builtin_amdgcn_readlane(iv, 32)) + __int_as_float(__builtin_amdgcn_readlane(iv, 48));
#endif
}

__device__ __forceinline__ const bf16x8& ldsfrag(const bf16* p) { return *(const bf16x8*)p; }

__device__ __forceinline__ int chunk_row0(int b, int pc, int T, int nC) {
  return pc < nC ? b * CTX + pc * T : ROWS_C + b * SEQ + (pc - nC) * T;
}
__device__ __forceinline__ int ord_chunk(int d, int vc, int nC, int nAll) {
  return d == 0 ? vc : (vc < nC ? nC - 1 - vc : nAll - 1 - (vc - nC));
}
struct RowInfo { int isctx, b, t, seq0, len; };
__device__ __forceinline__ RowInfo row_info(int m) {
  RowInfo r;
  if (m < ROWS_C) { r.isctx = 1; r.b = m / CTX; r.t = m - r.b * CTX; r.seq0 = r.b * CTX; r.len = CTX; }
  else { int q = m - ROWS_C; r.isctx = 0; r.b = q / SEQ; r.t = q - r.b * SEQ; r.seq0 = ROWS_C + r.b * SEQ; r.len = SEQ; }
  return r;
}

template <class AL, class BL, class EP>
__device__ __forceinline__ void gemm_tile(unsigned char* sm, int m0, int n0, int K, AL al, BL bl, EP ep) {
  bf16* sA0 = (bf16*)sm;
  int tid_ = threadIdx.x; OPAQUE(tid_);
  const int tid = tid_, lane = tid & 63, w = tid >> 6, wm = w >> 1, wn = w & 1;
  f32x16 acc[2][2];
#pragma unroll
  for (int i = 0; i < 2; i++)
#pragma unroll
    for (int j = 0; j < 2; j++) acc[i][j] = zero16();
  const int lr = tid >> 2, lk = (tid & 3) * 8;
  U4 ra0 = al(m0 + lr, lk), ra1 = al(m0 + lr + 64, lk), rb0 = bl(n0 + lr, lk), rb1 = bl(n0 + lr + 64, lk);
  {
    bf16* sA = sA0; bf16* sB = sA + 128 * 40;
    *(U4*)&sA[lr * 40 + lk] = ra0; *(U4*)&sA[(lr + 64) * 40 + lk] = ra1;
    *(U4*)&sB[lr * 40 + lk] = rb0; *(U4*)&sB[(lr + 64) * 40 + lk] = rb1;
  }
  if (32 < K) { ra0 = al(m0 + lr, 32 + lk); ra1 = al(m0 + lr + 64, 32 + lk); rb0 = bl(n0 + lr, 32 + lk); rb1 = bl(n0 + lr + 64, 32 + lk); }
  __syncthreads();
  int cur = 0;
#pragma unroll 1
  for (int k0 = 0; k0 < K; k0 += 32) {
    bf16* sA = sA0 + cur * (256 * 40); bf16* sB = sA + 128 * 40;
    if (k0 + 32 < K) {
      bf16* nA = sA0 + (cur ^ 1) * (256 * 40); bf16* nB = nA + 128 * 40;
      *(U4*)&nA[lr * 40 + lk] = ra0; *(U4*)&nA[(lr + 64) * 40 + lk] = ra1;
      *(U4*)&nB[lr * 40 + lk] = rb0; *(U4*)&nB[(lr + 64) * 40 + lk] = rb1;
      if (k0 + 64 < K) {
        ra0 = al(m0 + lr, k0 + 64 + lk); ra1 = al(m0 + lr + 64, k0 + 64 + lk);
        rb0 = bl(n0 + lr, k0 + 64 + lk); rb1 = bl(n0 + lr + 64, k0 + 64 + lk);
      }
    }
#pragma unroll
    for (int ks = 0; ks < 32; ks += 16) {
      bf16x8 fa[2], fb[2];
#pragma unroll
      for (int i = 0; i < 2; i++) fa[i] = ldsfrag(&sA[(wm * 64 + i * 32 + (lane & 31)) * 40 + ks + 8 * (lane >> 5)]);
#pragma unroll
      for (int j = 0; j < 2; j++) fb[j] = ldsfrag(&sB[(wn * 64 + j * 32 + (lane & 31)) * 40 + ks + 8 * (lane >> 5)]);
#pragma unroll
      for (int i = 0; i < 2; i++)
#pragma unroll
        for (int j = 0; j < 2; j++) acc[i][j] = mfma32(fa[i], fb[j], acc[i][j]);
    }
    __syncthreads();
    cur ^= 1;
  }
#pragma unroll
  for (int i = 0; i < 2; i++)
#pragma unroll
   for (int j = 0; j < 2; j++)
#pragma unroll
    for (int r = 0; r < 16; r++)
      ep(m0 + wm * 64 + i * 32 + acc_row(r, lane), n0 + wn * 64 + j * 32 + (lane & 31), acc[i][j][r]);
}

template <class AL, class BL, class EP>
__device__ __forceinline__ void gemm_tile_big(unsigned char* sm, int m0, int n0, int K, AL al, BL bl, EP ep) {
  bf16* sA0 = (bf16*)sm;
  int tid_ = threadIdx.x; OPAQUE(tid_);
  const int tid = tid_, lane = tid & 63, w = tid >> 6, wm = w >> 1, wn = w & 1;
  f32x16 acc[4][2];
#pragma unroll
  for (int i = 0; i < 4; i++)
#pragma unroll
    for (int j = 0; j < 2; j++) acc[i][j] = zero16();
  const int lr = tid >> 2, lk = (tid & 3) * 8;
  U4 ra[4], rb[2];
#pragma unroll
  for (int i = 0; i < 4; i++) ra[i] = al(m0 + lr + 64 * i, lk);
#pragma unroll
  for (int i = 0; i < 2; i++) rb[i] = bl(n0 + lr + 64 * i, lk);
  {
    bf16* sA = sA0; bf16* sB = sA + 256 * 40;
#pragma unroll
    for (int i = 0; i < 4; i++) *(U4*)&sA[(lr + 64 * i) * 40 + lk] = ra[i];
#pragma unroll
    for (int i = 0; i < 2; i++) *(U4*)&sB[(lr + 64 * i) * 40 + lk] = rb[i];
  }
  if (32 < K) {
#pragma unroll
    for (int i = 0; i < 4; i++) ra[i] = al(m0 + lr + 64 * i, 32 + lk);
#pragma unroll
    for (int i = 0; i < 2; i++) rb[i] = bl(n0 + lr + 64 * i, 32 + lk);
  }
  __syncthreads();
  int cur = 0;
#pragma unroll 2
  for (int k0 = 0; k0 < K; k0 += 32) {
    bf16* sA = sA0 + cur * (384 * 40); bf16* sB = sA + 256 * 40;
    if (k0 + 32 < K) {
      bf16* nA = sA0 + (cur ^ 1) * (384 * 40); bf16* nB = nA + 256 * 40;
#pragma unroll
      for (int i = 0; i < 4; i++) *(U4*)&nA[(lr + 64 * i) * 40 + lk] = ra[i];
#pragma unroll
      for (int i = 0; i < 2; i++) *(U4*)&nB[(lr + 64 * i) * 40 + lk] = rb[i];
      if (k0 + 64 < K) {
#pragma unroll
        for (int i = 0; i < 4; i++) ra[i] = al(m0 + lr + 64 * i, k0 + 64 + lk);
#pragma unroll
        for (int i = 0; i < 2; i++) rb[i] = bl(n0 + lr + 64 * i, k0 + 64 + lk);
      }
    }
#pragma unroll
    for (int ks = 0; ks < 32; ks += 16) {
      bf16x8 fa[4], fb[2];
#pragma unroll
      for (int i = 0; i < 4; i++) fa[i] = ldsfrag(&sA[(wm * 128 + i * 32 + (lane & 31)) * 40 + ks + 8 * (lane >> 5)]);
#pragma unroll
      for (int j = 0; j < 2; j++) fb[j] = ldsfrag(&sB[(wn * 64 + j * 32 + (lane & 31)) * 40 + ks + 8 * (lane >> 5)]);
#pragma unroll
      for (int i = 0; i < 4; i++)
#pragma unroll
        for (int j = 0; j < 2; j++) acc[i][j] = mfma32(fa[i], fb[j], acc[i][j]);
    }
    __syncthreads();
    cur ^= 1;
  }
#pragma unroll
  for (int i = 0; i < 4; i++)
#pragma unroll
    for (int j = 0; j < 2; j++)
#pragma unroll
      for (int r = 0; r < 16; r++)
        ep(m0 + wm * 128 + i * 32 + acc_row(r, lane), n0 + wn * 64 + j * 32 + (lane & 31), acc[i][j][r]);
}

#define ITEM_LOOP(var, count, base) _Pragma("unroll 1") for (int var = (int)((blockIdx.x + gridDim.x - ((unsigned)(base) % gridDim.x)) % gridDim.x); var < (count); var += gridDim.x)
#define WS(T, off) ((T*)(P.ws + (off)))

__device__ __forceinline__ void transpose_tile(const float* src, int ld, int Ksz, int Nsz, bf16* dst, int kt, int nt, unsigned char* sm, bool perm = false) {
  float* s = (float*)sm;
  const int tid = threadIdx.x;
#pragma unroll 8
  for (int i = tid; i < 4096; i += 256) {
    int kk = i >> 6, nn = i & 63;
    int k = kt * 64 + kk, n = nt * 64 + nn;
    s[kk * 65 + nn] = (n < Nsz && k < Ksz) ? src[(size_t)k * ld + n] : 0.f;
  }
  __syncthreads();
#pragma unroll 8
  for (int i = tid; i < 4096; i += 256) {
    int nn = i >> 6, kk = i & 63;
    int ktd = perm ? (kt < 4 ? kt + 8 : (kt >= 8 && kt < 12) ? kt - 8 : kt) : kt;
    dst[(size_t)(nt * 64 + nn) * Ksz + ktd * 64 + kk] = f2bf(s[kk * 65 + nn]);
  }
  __syncthreads();
}

struct S5c { float lr, li, dt; };
__device__ __forceinline__ void s5_pow(const Params& P, int l, int d, int g, int p, float e, float& re, float& im) {
  int idx = ((l * 2 + d) * 16 + g) * 64 + p;
  float dt = __expf(P.s5_log_dt[(l * 2 + d) * 16 + g]);
  float ar = P.s5_a_re[idx] * dt * e, ai = P.s5_a_im[idx] * dt * e;
  float m = expf(ar);
  re = m * cosf(ai); im = m * sinf(ai);
}
__device__ __forceinline__ void s5_bbar_coef(const Params& P, int l, int d, int g, int p, float& re, float& im) {
  int idx = ((l * 2 + d) * 16 + g) * 64 + p;
  float lr = P.s5_a_re[idx], li = P.s5_a_im[idx];
  float br, bi; s5_pow(P, l, d, g, p, 1.f, br, bi);
  br -= 1.f;
  float den = lr * lr + li * li;
  re = (br * lr + bi * li) / den;
  im = (bi * lr - br * li) / den;
}

__device__ __forceinline__ void phase_prologue(const Params& P, unsigned char* sm) {
  const int tid = threadIdx.x;
  const int N_TIN = 2 * 16 * (NINP / 64);
  const int N_TOUT = 2 * 16 * 16;
  const int N_TL = 2 * 2 * 4;
  const int N_TA = 2 * 2 * 4;
  const int N_TG = 2 * 16;
  const int N_MOD = 2 * 48;
  const int N_S5K = 2 * 16 * 2 * 32;
  const int N_S5W1 = 2 * 16 * 32;
  const int N_S5B2 = 2 * 16 * 32;
  const int total = N_TIN + N_TOUT + N_TL + N_TA + N_TG + N_MOD + N_S5K + N_S5W1 + N_S5B2;
#pragma unroll 1
  for (int it = blockIdx.x; it < total; it += gridDim.x) {
    int i = it;
    if (i < N_TIN) {
      int l = i / (16 * (NINP / 64)), r = i % (16 * (NINP / 64));
      transpose_tile(P.w_in + (size_t)l * D * NIN, NIN, D, NIN, WS(bf16, OFF_WTIN) + (size_t)l * NINP * D, r % 16, r / 16, sm);
      continue;
    }
    i -= N_TIN;
    if (i < N_TOUT) {
      int l = i / 256, r = i % 256;
      transpose_tile(P.w_out + (size_t)l * D * D, D, D, D, WS(bf16, OFF_WTOUT) + (size_t)l * D * D, r % 16, r / 16, sm, true);
      continue;
    }
    i -= N_TOUT;
    if (i < N_TL) {
      int ld = i / 4, nt = i % 4;
      transpose_tile(P.rw_w2 + (size_t)ld * 64 * 256, 256, 64, 256, WS(bf16, OFF_W2T) + (size_t)ld * 256 * 64, 0, nt, sm);
      continue;
    }
    i -= N_TL;
    if (i < N_TA) {
      int ld = i / 4, nt = i % 4;
      transpose_tile(P.rw_a2 + (size_t)ld * 64 * 256, 256, 64, 256, WS(bf16, OFF_A2T) + (size_t)ld * 256 * 64, 0, nt, sm);
      continue;
    }
    i -= N_TA;
    if (i < N_TG) {
      int l = i / 16, r = i % 16;
      transpose_tile(P.s5_glu_w + (size_t)l * 256 * 256, 256, 256, 256, WS(bf16, OFF_GLUT) + (size_t)l * 256 * 256, r % 4, r / 4, sm);
      continue;
    }
    i -= N_TG;
    if (i < N_MOD) {
      int l = i / 48, ct = i % 48;
      float* ssil = (float*)sm;
      float* red = ssil + NMOD * 1024;
#pragma unroll 8
      for (int e = tid; e < NMOD * 1024; e += 256) {
        int r = e >> 10, k = e & 1023;
        float v = r < BATCH ? P.c[r * 1024 + k] : P.c_ctx[k];
        ssil[e] = silu_f(v);
      }
      __syncthreads();
      int kq = tid >> 6, jj = tid & 63, j = ct * 64 + jj;
      float acc[NMOD];
      for (int r = 0; r < NMOD; r++) acc[r] = 0.f;
      const float* wp = P.ada_w + (size_t)l * D * 3072 + j;
#pragma unroll 16
      for (int k = kq * 256; k < kq * 256 + 256; k++) {
        float wv = wp[(size_t)k * 3072];
#pragma unroll
        for (int r = 0; r < NMOD; r++) acc[r] += ssil[r * 1024 + k] * wv;
      }
#pragma unroll
      for (int r = 0; r < NMOD; r++) red[(kq * NMOD + r) * 64 + jj] = acc[r];
      __syncthreads();
#pragma unroll 8
      for (int e = tid; e < NMOD * 64; e += 256) {
        int r = e >> 6, j2 = e & 63;
        float s = red[(0 * NMOD + r) * 64 + j2] + red[(1 * NMOD + r) * 64 + j2] + red[(2 * NMOD + r) * 64 + j2] + red[(3 * NMOD + r) * 64 + j2];
        WS(float, OFF_MOD)[((size_t)l * NMOD + r) * 3072 + ct * 64 + j2] = s + P.ada_b[l * 3072 + ct * 64 + j2];
      }
      __syncthreads();
      continue;
    }
    i -= N_MOD;
    if (i < N_S5K) {
      int m = i & 31, d = (i >> 5) & 1, g = (i >> 6) & 15, l = i >> 10;
      float* spw = (float*)sm;
      if (tid < 64) {
        float pr, pi, cr, ci;
        s5_pow(P, l, d, g, tid, (float)m, pr, pi);
        s5_bbar_coef(P, l, d, g, tid, cr, ci);
        spw[tid * 2] = pr * cr - pi * ci; spw[tid * 2 + 1] = pr * ci + pi * cr;
      }
      __syncthreads();
      int c = tid >> 4, cp = tid & 15;
      size_t bb = ((size_t)((l * 2 + d) * 16 + g) * 64) * 16;
      size_t cb = ((size_t)((l * 2 + d) * 16 + g) * 16 + c) * 64;
      float s = 0.f;
#pragma unroll 8
      for (int p = 0; p < 64; p++) {
        float wr = spw[p * 2], wi = spw[p * 2 + 1];
        float br = P.s5_b_re[bb + p * 16 + cp], bi = P.s5_b_im[bb + p * 16 + cp];
        float zr = wr * br - wi * bi, zi = wr * bi + wi * br;
        float cr = P.s5_c_re[cb + p], ci = P.s5_c_im[cb + p];
        s += cr * zr - ci * zi;
      }
      WS(float, OFF_S5K)[((size_t)(((l * 16 + g) * 2 + d) * 32 + m)) * 256 + tid] = s;
      __syncthreads();
      continue;
    }
    i -= N_S5K;
    if (i < N_S5W1) {
      int j = i & 31, g = (i >> 5) & 15, l = i >> 9;
      int pp = tid, d = pp >> 7, ri = (pp >> 6) & 1, p = pp & 63;
      float e = d == 0 ? (float)(T5 - 1 - j) : (float)j;
      float pr, pi, cr, ci;
      s5_pow(P, l, d, g, p, e, pr, pi);
      s5_bbar_coef(P, l, d, g, p, cr, ci);
      float wr = pr * cr - pi * ci, wi = pr * ci + pi * cr;
      size_t bb = ((size_t)((l * 2 + d) * 16 + g) * 64 + p) * 16;
      bf16* dst = WS(bf16, OFF_W1T) + ((size_t)(l * 16 + g) * 256 + pp) * 512 + j * 16;
      for (int cp = 0; cp < 16; cp++) {
        float br = P.s5_b_re[bb + cp], bi = P.s5_b_im[bb + cp];
        float zr = wr * br - wi * bi, zi = wr * bi + wi * br;
        dst[cp] = f2bf(ri == 0 ? zr : zi);
      }
      if (j == 0 && ri == 0) {
        float tr, ti; s5_pow(P, l, d, g, p, (float)T5, tr, ti);
        float* lt = WS(float, OFF_S5LT) + ((size_t)((l * 16 + g) * 2 + d) * 64 + p) * 2;
        lt[0] = tr; lt[1] = ti;
      }
      continue;
    }
    i -= N_S5W1;
    {
      int t = i & 31, g = (i >> 5) & 15, l = i >> 9;
      int kk = tid, d = kk >> 7, ri = (kk >> 6) & 1, p = kk & 63;
      float e = d == 0 ? (float)(t + 1) : (float)(T5 - t);
      float pr, pi; s5_pow(P, l, d, g, p, e, pr, pi);
      for (int c = 0; c < 16; c++) {
        size_t cb = ((size_t)((l * 2 + d) * 16 + g) * 16 + c) * 64 + p;
        float cr = P.s5_c_re[cb], ci = P.s5_c_im[cb];
        float zr = cr * pr - ci * pi, zi = cr * pi + ci * pr;
        WS(bf16, OFF_BT2)[((size_t)(l * 16 + g) * 512 + t * 16 + c) * 768 + 512 + kk] = f2bf(ri == 0 ? zr : -zi);
      }
    }
  }
}

__device__ __forceinline__ void s5_toeplitz_items(const Params& P, int item) {
  int t = item & 31, g = (item >> 5) & 15, l = item >> 9;
  const float* K = WS(float, OFF_S5K) + (size_t)((l * 16 + g) * 2) * 32 * 256;
  bf16* dst = WS(bf16, OFF_BT2) + ((size_t)(l * 16 + g) * 512 + t * 16) * 768;
#pragma unroll 8
  for (int e = threadIdx.x; e < 16 * 512; e += 256) {
    int c = e >> 9, k = e & 511, j = k >> 4, cp = k & 15;
    float v;
    if (j < t) v = K[((0 * 32) + (t - j)) * 256 + c * 16 + cp];
    else if (j > t) v = K[((1 * 32) + (j - t)) * 256 + c * 16 + cp];
    else v = K[(0 * 32) * 256 + c * 16 + cp] + K[(1 * 32) * 256 + c * 16 + cp];
    dst[(size_t)c * 768 + k] = f2bf(v);
  }
}

__device__ __forceinline__ void phase_normmod(const Params& P, int l) {
  const int lane = threadIdx.x & 63, w = threadIdx.x >> 6;
  const int nrow_items = ROWS / 4;
  const int n_toe = (l == 0) ? 2 * 16 * 32 : 0;
#pragma unroll 1
  for (int it = blockIdx.x; it < nrow_items + n_toe; it += gridDim.x) {
    if (it >= nrow_items) { s5_toeplitz_items(P, it - nrow_items); continue; }
    int m = it * 4 + w;
    RowInfo ri = row_info(m);
    const float* src;
    if (ri.isctx) src = (l == 0 ? P.ctx : WS(float, OFF_HC)) + (size_t)m * D;
    else src = (l == 0 ? P.x : P.out) + (size_t)(m - ROWS_C) * D;
    const float* mod = WS(float, OFF_MOD) + ((size_t)l * NMOD + (ri.isctx ? BATCH : ri.b)) * 3072;
    F4 v[4]; float ss = 0.f;
    for (int q = 0; q < 4; q++) {
      v[q] = *(const F4*)(src + q * 256 + lane * 4);
      for (int e = 0; e < 4; e++) ss += v[q].a[e] * v[q].a[e];
    }
    ss = sum64(ss);
    float rstd = rsqrtf(ss * (1.f / 1024.f) + 1e-6f);
    bf16* dst = WS(bf16, OFF_R) + (size_t)m * D;
    for (int q = 0; q < 4; q++) {
      int c0 = q * 256 + lane * 4;
      float o[4];
      for (int e = 0; e < 4; e++) {
        int c = c0 + e;
        o[e] = v[q].a[e] * rstd * P.norm_pre[l * D + c] * (1.f + mod[1024 + c]) + mod[c];
      }
      U2 pk; pk.a[0] = pack2(o[0], o[1]); pk.a[1] = pack2(o[2], o[3]);
      *(U2*)(dst + c0) = pk;
    }
  }
}

__device__ __forceinline__ void phase_inproj(const Params& P, int l, unsigned char* sm) {
  const bf16* A = WS(bf16, OFF_R);
  const bf16* Bt = WS(bf16, OFF_WTIN) + (size_t)l * NINP * D;
  bf16* C = WS(bf16, OFF_PROJ);
  const int NT = NINP / 128, MT = ROWS / 256;
#pragma unroll 1
  for (int it0 = blockIdx.x; it0 < MT * NT; it0 += gridDim.x) {
    const int per = (MT * NT) / 8;
    int it = (MT * NT) % 8 == 0 ? (it0 & 7) * per + (it0 >> 3) : it0;
    int mt = it / NT, nt = it % NT;
    gemm_tile_big(sm, mt * 256, nt * 128, D,
      [&](int m, int k) { return *(const U4*)(A + (size_t)m * D + k); },
      [&](int n, int k) { return *(const U4*)(Bt + (size_t)n * D + k); },
      [&](int m, int n, float v) { if (n < NIN) C[(size_t)m * NIN + n] = f2bf(v); });
  }
}

__device__ __forceinline__ void rw_lerp4(const Params& P, int l, int m, int ms, int col, float* o) {
  const bf16* pr = WS(bf16, OFF_PROJ);
  U2 z = *(const U2*)(pr + (size_t)m * NIN + col);
  U2 zs; zs.a[0] = zs.a[1] = 0;
  if (ms >= 0) zs = *(const U2*)(pr + (size_t)ms * NIN + col);
  const float* mu = P.rw_mu + l * 1024 + col;
#pragma unroll
  for (int e = 0; e < 2; e++) {
    float a0 = lo2f(z.a[e]), a1 = hi2f(z.a[e]), s0 = lo2f(zs.a[e]), s1 = hi2f(zs.a[e]);
    o[2 * e] = a0 + mu[2 * e] * (s0 - a0);
    o[2 * e + 1] = a1 + mu[2 * e + 1] * (s1 - a1);
  }
}
__device__ __forceinline__ void phase_rwprep(const Params& P, int l, unsigned char* sm) {
  const int lane = threadIdx.x & 63, w = threadIdx.x >> 6;
  const int MT = ROWS / 128;
  const int n_gemm = MT * 2 * 4;
  const int n_rows = ROWS / 4;
  bf16* XA = WS(bf16, OFF_XA);
#pragma unroll 1
  for (int it = blockIdx.x; it < n_gemm + n_rows; it += gridDim.x) {
    if (it < n_gemm) {
      int kind = it & 3, nt = (it >> 2) & 1, mt = it >> 3;
      int isA = kind >> 1, d = kind & 1;
      const bf16* Bt = (isA ? WS(bf16, OFF_A2T) : WS(bf16, OFF_W2T)) + (size_t)(l * 2 + d) * 256 * 64;
      const float* bias = (isA ? P.rw_a0 : P.rw_w0) + (l * 2 + d) * 256;
      gemm_tile(sm, mt * 128, nt * 128, 64,
        [&](int m, int k) {
          RowInfo ri = row_info(m);
          int ms;
          if (ri.isctx) ms = ri.t < CTX - 1 ? m + 1 : -1; else ms = ri.t < SEQ - 64 ? m + 64 : -1;
          int col = 768 + isA * 128 + d * 64 + k;
          const bf16* prj = WS(bf16, OFF_PROJ);
          U4 z = *(const U4*)(prj + (size_t)m * NIN + col);
          U4 zs = ms >= 0 ? *(const U4*)(prj + (size_t)ms * NIN + col) : zero4();
          const float* mu = P.rw_mu + l * 1024 + col;
          U4 r;
#pragma unroll
          for (int e = 0; e < 4; e++) {
            float a0 = lo2f(z.a[e]), a1 = hi2f(z.a[e]), s0 = lo2f(zs.a[e]), s1 = hi2f(zs.a[e]);
            float o0 = a0 + mu[2 * e] * (s0 - a0), o1 = a1 + mu[2 * e + 1] * (s1 - a1);
            if (!isA) { o0 = tanh_f(o0); o1 = tanh_f(o1); }
            r.a[e] = pack2(o0, o1);
          }
          return r;
        },
        [&](int n, int k) { return *(const U4*)(Bt + (size_t)n * 64 + k); },
        [&](int m, int n, float v) {
          v += bias[n];
          float o;
          if (!isA) { o = -__expf(-softplus_f(-v) - 0.5f); }
          else o = sigmoid_f(v);
          XA[(size_t)m * 1024 + isA * 512 + d * 256 + n] = f2bf(o);
        });
      continue;
    }
    int m = (it - n_gemm) * 4 + w;
    RowInfo ri = row_info(m);
    int ms_r, ms_k, ms_v;
    if (ri.isctx) { ms_r = ms_k = ri.t > 0 ? m - 1 : -1; ms_v = ri.t < CTX - 1 ? m + 1 : -1; }
    else {
      int gx = ri.t & 63;
      ms_r = gx > 0 ? m - 1 : -1; ms_k = gx < 63 ? m + 1 : -1; ms_v = ri.t >= 64 ? m - 64 : -1;
    }
    bf16* R = WS(bf16, OFF_R) + (size_t)m * 1024;
    float rr[4], kk[4], vv[4], kap[4];
    rw_lerp4(P, l, m, ms_r, lane * 4, rr);
    rw_lerp4(P, l, m, ms_k, 256 + lane * 4, kk);
    rw_lerp4(P, l, m, ms_v, 512 + lane * 4, vv);
    float ss = 0.f;
    for (int e = 0; e < 4; e++) { kap[e] = kk[e] * P.rw_kk[l * 256 + lane * 4 + e]; ss += kap[e] * kap[e]; }
    ss = sum16(ss);
    float rs = rsqrtf(ss + 1e-6f);
    U2 o;
    o.a[0] = pack2(rr[0], rr[1]); o.a[1] = pack2(rr[2], rr[3]); *(U2*)(R + lane * 4) = o;
    o.a[0] = pack2(kk[0], kk[1]); o.a[1] = pack2(kk[2], kk[3]); *(U2*)(R + 256 + lane * 4) = o;
    o.a[0] = pack2(vv[0], vv[1]); o.a[1] = pack2(vv[2], vv[3]); *(U2*)(R + 512 + lane * 4) = o;
    o.a[0] = pack2(kap[0] * rs, kap[1] * rs); o.a[1] = pack2(kap[2] * rs, kap[3] * rs); *(U2*)(R + 768 + lane * 4) = o;
  }
}

__device__ __forceinline__ bf16x8 gfrag(const bf16* base, int ld, int row, int k) {
  return *(const bf16x8*)(base + (size_t)row * ld + k);
}
__device__ __forceinline__ void wave_sync() {
#ifdef CPU_EMU
  pthread_barrier_wait(&g_wavebar[threadIdx.x >> 6]);
#else
  __builtin_amdgcn_wave_barrier();
#endif
}
__device__ __forceinline__ void store_acc_T(bf16* dst, int ld, int row_base, int col, const f32x16& acc, int lane) {
#pragma unroll
  for (int g = 0; g < 4; g++) {
    U2 o; o.a[0] = pack2(acc[4 * g], acc[4 * g + 1]); o.a[1] = pack2(acc[4 * g + 2], acc[4 * g + 3]);
    *(U2*)&dst[col * ld + row_base + 8 * g + 4 * (lane >> 5)] = o;
  }
}
__device__ __forceinline__ void rwkv_chunk_item(const Params& P, int l, int item, unsigned char* sm, long long& pacc) {
  long long tp0_ = 0; if (PROBE_PHASE >= 33 && PROBE_PHASE <= 36) tp0_ = wall_clock64();
  int tid_ = threadIdx.x; OPAQUE(tid_);
  const int tid = tid_, lane = tid & 63, w = tid >> 6, ti = w >> 1, tj = w & 1;
  const int lr = lane & 31, lh = lane >> 5;
  const int d = item & 1, h = (item >> 1) & 3, rest = item >> 3;
  const int pc = rest % NCH, b = rest / NCH;
  const int row0 = chunk_row0(b, pc, TC, NCH_C);
  float* sL = (float*)sm;
  bf16* sG1t = (bf16*)sm;
  bf16* sKT = (bf16*)(sm + 16640);
  bf16* sBT = sKT + 64 * 72;
  bf16* sKD = sBT + 64 * 72;
  bf16* sRT = sKD + 64 * 72;
  bf16* sVt = sRT + 64 * 72;
  float* sGT = (float*)(sVt + 64 * 72);
  bf16* X0 = WS(bf16, OFF_XA) + (size_t)row0 * 1024 + d * 256 + h * 64;
  bf16* X1 = X0 + 512;
  bf16* P0 = WS(bf16, OFF_PROJ) + (size_t)row0 * NIN + (h * 2 + d) * 128;
  bf16* P1 = P0 + 64;
  const bf16* Rb = WS(bf16, OFF_R) + (size_t)row0 * 1024 + h * 64;
  float rq[16], kq[16], pq[16], vq[16];
#pragma unroll
  for (int i = 0; i < 16; i++) {
    const bf16* rp = Rb + (size_t)(w + 4 * i) * 1024 + lane;
    rq[i] = bf2f(rp[0]); kq[i] = bf2f(rp[256]); vq[i] = bf2f(rp[512]); pq[i] = bf2f(rp[768]);
  }
#pragma unroll 8
  for (int idx = tid; idx < 4096; idx += 256) {
    int p = idx >> 6, k = idx & 63;
    sL[p * 65 + k] = bf2f(X0[(size_t)p * 1024 + k]);
    sVt[idx] = X1[(size_t)p * 1024 + k];
  }
  __syncthreads();
  {
    const int k = tid & 63, qq = tid >> 6;
    float* qt = sGT + 64 + 128;
    float run = 0.f;
    if (d == 0) { for (int p = qq * 16; p < qq * 16 + 16; p++) { run += sL[p * 65 + k]; sL[p * 65 + k] = run; } }
    else { for (int p = qq * 16 + 15; p >= qq * 16; p--) { run += sL[p * 65 + k]; sL[p * 65 + k] = run; } }
    qt[qq * 64 + k] = run;
    __syncthreads();
    float off = 0.f;
    if (d == 0) { for (int j = 0; j < qq; j++) off += qt[j * 64 + k]; }
    else { for (int j = 3; j > qq; j--) off += qt[j * 64 + k]; }
    for (int p = qq * 16; p < qq * 16 + 16; p++) sL[p * 65 + k] += off;
    if (qq == 0) sGT[k] = qt[k] + qt[64 + k] + qt[128 + k] + qt[192 + k];
  }
  __syncthreads();
  if (PROBE_PHASE == 35) pacc += wall_clock64() - tp0_;
  {
    const int k = lane;
    const float ka = P.rw_ka[l * 256 + h * 64 + k], rk = P.rw_rk[l * 256 + h * 64 + k];
#pragma unroll
    for (int i = 0; i < 16; i++) {
      const int p = w + 4 * i;
      float incl = sL[p * 65 + k];
      int pp = d == 0 ? p - 1 : p + 1;
      float excl = (pp < 0 || pp > 63) ? 0.f : sL[pp * 65 + k];
      float rr = rq[i], kk = kq[i], kap = pq[i];
      float a = bf2f(sVt[p * 64 + k]);
      float kd = kk * (1.f + (a - 1.f) * ka), beta = kap * a;
      float ei = __expf(incl), eni = __expf(-incl), ee = __expf(excl);
      sKT[p * 72 + k] = f2bf(kap * ee);
      sBT[p * 72 + k] = f2bf(beta * eni);
      sKD[p * 72 + k] = f2bf(kd * eni);
      sRT[p * 72 + k] = f2bf(rr * ei);
      float bs = sum64(rr * kd * rk);
      if (lane == 0) WS(float, OFF_BON)[(size_t)(row0 + p) * 8 + h * 2 + d] = bs;
    }
  }
  __syncthreads();
#pragma unroll 8
  for (int idx = tid; idx < 4096; idx += 256) {
    int kk = idx >> 6, p = idx & 63;
    P0[(size_t)kk * NIN + p] = sKT[p * 72 + kk];
    P1[(size_t)kk * NIN + p] = sBT[p * 72 + kk];
    X1[(size_t)kk * 1024 + p] = sKD[p * 72 + kk];
    X0[(size_t)kk * 1024 + p] = sRT[kk * 72 + p];
  }
  if (PROBE_PHASE == 36) pacc += wall_clock64() - tp0_;
  f32x16 aA = zero16(), aB = zero16(), aC = zero16(), aD = zero16();
#pragma unroll
  for (int ks = 0; ks < 64; ks += 16) {
    bf16x8 fK = ldsfrag(&sKT[(ti * 32 + lr) * 72 + ks + 8 * lh]);
    bf16x8 fR = ldsfrag(&sRT[(ti * 32 + lr) * 72 + ks + 8 * lh]);
    bf16x8 fB = ldsfrag(&sBT[(tj * 32 + lr) * 72 + ks + 8 * lh]);
    bf16x8 fD = ldsfrag(&sKD[(tj * 32 + lr) * 72 + ks + 8 * lh]);
    aA = mfma32(fK, fB, aA); aB = mfma32(fK, fD, aB); aC = mfma32(fR, fB, aC); aD = mfma32(fR, fD, aD);
  }
  __syncthreads();
  {
    int s_ = tj * 32 + lr;
#pragma unroll
    for (int r = 0; r < 16; r++) {
      int p = ti * 32 + acc_row(r, lane);
      bool earlier = d == 0 ? s_ < p : s_ > p;
      bool eq = s_ == p;
      sL[p * 65 + s_] = earlier ? aA[r] : 0.f;
      sKT[p * 72 + s_] = f2bf(earlier ? aB[r] : 0.f);
      sBT[p * 72 + s_] = f2bf((earlier || eq) ? aC[r] : 0.f);
      sKD[p * 72 + s_] = f2bf((earlier || eq) ? aD[r] : 0.f);
    }
  }
#pragma unroll
  for (int i = 0; i < 16; i++) sVt[lane * 72 + w + 4 * i] = f2bf(vq[i]);
  __syncthreads();
  if (PROBE_PHASE == 33) pacc += wall_clock64() - tp0_;
  bf16x8 fKt[4];
#pragma unroll
  for (int q4 = 0; q4 < 4; q4++) fKt[q4] = gfrag(P0, NIN, tj * 32 + lr, q4 * 16 + 8 * lh);
  bf16* sTinv = sRT;
  {
    const int q = tid >> 2, seg = tid & 3;
    float x[16];
#pragma unroll
    for (int i = 0; i < 16; i++) x[i] = (q == seg * 16 + i) ? 1.f : 0.f;
    float* rowbuf = (float*)sRT;
#pragma unroll 1
    for (int Bi = 0; Bi < 4; Bi++) {
      const int B = d == 0 ? Bi : 3 - Bi;
      float* rb = rowbuf + (Bi & 1) * 1024;
      if (w == B) {
#pragma unroll 1
        for (int s_ = 0; s_ < 16; s_++) {
          const int pl = d == 0 ? s_ : 15 - s_, p = B * 16 + pl;
          if (q == p) {
#pragma unroll
            for (int i = 0; i < 4; i++) { F4 o; o.a[0] = x[4 * i]; o.a[1] = x[4 * i + 1]; o.a[2] = x[4 * i + 2]; o.a[3] = x[4 * i + 3]; *(F4*)&rb[pl * 64 + seg * 16 + 4 * i] = o; }
          }
          wave_sync();
          const bool later = d == 0 ? q > p : q < p;
          if (later) {
            const float m = sL[q * 65 + p];
#pragma unroll
            for (int i = 0; i < 4; i++) {
              F4 o = *(const F4*)&rb[pl * 64 + seg * 16 + 4 * i];
              x[4 * i] -= m * o.a[0]; x[4 * i + 1] -= m * o.a[1]; x[4 * i + 2] -= m * o.a[2]; x[4 * i + 3] -= m * o.a[3];
            }
          }
        }
      }
      __syncthreads();
      const bool laterblock = d == 0 ? w > B : w < B;
      if (laterblock) {
#pragma unroll 4
        for (int pl = 0; pl < 16; pl++) {
          const float m = sL[q * 65 + B * 16 + pl];
#pragma unroll
          for (int i = 0; i < 4; i++) {
            F4 o = *(const F4*)&rb[pl * 64 + seg * 16 + 4 * i];
            x[4 * i] -= m * o.a[0]; x[4 * i + 1] -= m * o.a[1]; x[4 * i + 2] -= m * o.a[2]; x[4 * i + 3] -= m * o.a[3];
          }
        }
      }
    }
    __syncthreads();
#pragma unroll
    for (int i = 0; i < 8; i++) *(uint32_t*)&sTinv[q * 72 + seg * 16 + 2 * i] = pack2(x[2 * i], x[2 * i + 1]);
  }
  __syncthreads();
  if (PROBE_PHASE == 34) pacc += wall_clock64() - tp0_;
  {
    f32x16 aBV = zero16(), aG1 = zero16();
#pragma unroll
    for (int ks = 0; ks < 64; ks += 16) {
      aBV = mfma32(ldsfrag(&sKT[(ti * 32 + lr) * 72 + ks + 8 * lh]), ldsfrag(&sVt[(tj * 32 + lr) * 72 + ks + 8 * lh]), aBV);
      aG1 = mfma32(ldsfrag(&sTinv[(ti * 32 + lr) * 72 + ks + 8 * lh]), fKt[ks >> 4], aG1);
    }
    __syncthreads();
    store_acc_T(sKT, 72, ti * 32, tj * 32 + lr, aBV, lane);
    store_acc_T(sG1t, 72, ti * 32, tj * 32 + lr, aG1, lane);
  }
  __syncthreads();
  bf16x8 fKd4[4], fBt4[4]; float rtc[16];
#pragma unroll
  for (int q4 = 0; q4 < 4; q4++) { fKd4[q4] = gfrag(X1, 1024, ti * 32 + lr, q4 * 16 + 8 * lh); fBt4[q4] = gfrag(P1, NIN, ti * 32 + lr, q4 * 16 + 8 * lh); }
#pragma unroll
  for (int r = 0; r < 16; r++) rtc[r] = bf2f(X0[(size_t)(ti * 32 + acc_row(r, lane)) * 1024 + tj * 32 + lr]);
  {
    f32x16 aG2 = zero16();
#pragma unroll
    for (int ks = 0; ks < 64; ks += 16)
      aG2 = mfma32(ldsfrag(&sTinv[(ti * 32 + lr) * 72 + ks + 8 * lh]), ldsfrag(&sKT[(tj * 32 + lr) * 72 + ks + 8 * lh]), aG2);
    __syncthreads();
    store_acc_T(sRT, 72, ti * 32, tj * 32 + lr, aG2, lane);
  }
  __syncthreads();
  bf16* sG2t = sRT;
  {
    f32x16 a1 = zero16(), a2 = zero16(), a3 = zero16();
#pragma unroll
    for (int ks = 0; ks < 64; ks += 16) {
      bf16x8 fC = ldsfrag(&sBT[(ti * 32 + lr) * 72 + ks + 8 * lh]);
      bf16x8 fDy = ldsfrag(&sKD[(ti * 32 + lr) * 72 + ks + 8 * lh]);
      a1 = mfma32(fC, ldsfrag(&sG1t[(tj * 32 + lr) * 72 + ks + 8 * lh]), a1);
      a2 = mfma32(fDy, ldsfrag(&sVt[(tj * 32 + lr) * 72 + ks + 8 * lh]), a2);
      a3 = mfma32(fC, ldsfrag(&sG2t[(tj * 32 + lr) * 72 + ks + 8 * lh]), a3);
    }
    int c = tj * 32 + lr;
#pragma unroll
    for (int r = 0; r < 16; r++) {
      int p = ti * 32 + acc_row(r, lane);
      X0[(size_t)p * 1024 + c] = f2bf(rtc[r] - a1[r]);
      P0[(size_t)p * NIN + c] = f2bf(a2[r] - a3[r]);
    }
  }
  {
    f32x16 a1 = zero16(), a2 = zero16(), a3 = zero16();
#pragma unroll
    for (int ks = 0; ks < 64; ks += 16) {
      bf16x8 fKd = fKd4[ks >> 4];
      bf16x8 fBt = fBt4[ks >> 4];
      a1 = mfma32(fKd, ldsfrag(&sVt[(tj * 32 + lr) * 72 + ks + 8 * lh]), a1);
      a2 = mfma32(fBt, ldsfrag(&sG2t[(tj * 32 + lr) * 72 + ks + 8 * lh]), a2);
      a3 = mfma32(fBt, ldsfrag(&sG1t[(tj * 32 + lr) * 72 + ks + 8 * lh]), a3);
    }
    __syncthreads();
    int c = tj * 32 + lr;
#pragma unroll
    for (int r = 0; r < 16; r++) {
      int kp = ti * 32 + acc_row(r, lane);
      float gt = __expf(sGT[kp]);
      a1[r] = gt * (a1[r] - a2[r]);
      X1[(size_t)kp * 1024 + c] = f2bf(gt * ((kp == c ? 1.f : 0.f) - a3[r]));
    }
    U4 o0, o1;
#pragma unroll
    for (int e = 0; e < 4; e++) { o0.a[e] = pack2(a1[2 * e], a1[2 * e + 1]); o1.a[e] = pack2(a1[8 + 2 * e], a1[8 + 2 * e + 1]); }
    bf16* lp = P1 + (size_t)(tid >> 2) * NIN + (tid & 3) * 16;
    *(U4*)lp = o0; *(U4*)(lp + 8) = o1;
  }
  __syncthreads();
}

struct RwStage { bf16x8 pm[4]; U4 l0, l1; };
__device__ __forceinline__ void rwkv_scan2_item(const Params& P, int l, int item, unsigned char* sm) {
  int tid_ = threadIdx.x; OPAQUE(tid_);
  const int tid = tid_, lane = tid & 63, w = tid >> 6, ti = w >> 1, tj = w & 1;
  const int lr = lane & 31, lh = lane >> 5;
  const int d = item & 1, h = (item >> 1) & 3, b = item >> 3;
  bf16* sS = (bf16*)sm;
  f32x16 acc = zero16();
  RwStage st[4];
  auto load = [&](RwStage& s_, int vc) {
    int pc = ord_chunk(d, vc < NCH ? vc : NCH - 1, NCH_C, NCH);
    int row0 = chunk_row0(b, pc, TC, NCH_C);
    const bf16* X1 = WS(bf16, OFF_XA) + (size_t)row0 * 1024 + 512 + d * 256 + h * 64;
    const bf16* P1 = WS(bf16, OFF_PROJ) + (size_t)row0 * NIN + (h * 2 + d) * 128 + 64;
#pragma unroll
    for (int q = 0; q < 4; q++) s_.pm[q] = gfrag(X1, 1024, ti * 32 + lr, q * 16 + 8 * lh);
    const bf16* lp = P1 + (size_t)(tid >> 2) * NIN + (tid & 3) * 16;
    s_.l0 = *(const U4*)lp; s_.l1 = *(const U4*)(lp + 8);
  };
#pragma unroll
  for (int j = 0; j < 4; j++) load(st[j], j);
#pragma unroll 1
  for (int v0 = 0; v0 < NCH; v0 += 4) {
#pragma unroll
    for (int j = 0; j < 4; j++) {
      const int vc = v0 + j;
      if (vc < NCH) {
        int pc = ord_chunk(d, vc, NCH_C, NCH);
        int row0 = chunk_row0(b, pc, TC, NCH_C);
        bf16* X1 = WS(bf16, OFF_XA) + (size_t)row0 * 1024 + 512 + d * 256 + h * 64;
        store_acc_T(sS, 72, ti * 32, tj * 32 + lr, acc, lane);
        RwStage cur = st[j];
        __syncthreads();
        load(st[j], vc + 4);
        for (int idx = tid; idx < 512; idx += 256) {
          int v = idx >> 3, c8 = idx & 7;
          *(U4*)(X1 + (size_t)v * 1024 + c8 * 8) = *(const U4*)(sS + v * 72 + c8 * 8);
        }
        f32x16 nw;
#pragma unroll
        for (int e = 0; e < 4; e++) {
          nw[2 * e] = lo2f(cur.l0.a[e]); nw[2 * e + 1] = hi2f(cur.l0.a[e]);
          nw[8 + 2 * e] = lo2f(cur.l1.a[e]); nw[8 + 2 * e + 1] = hi2f(cur.l1.a[e]);
        }
#pragma unroll
        for (int q = 0; q < 4; q++) nw = mfma32(cur.pm[q], ldsfrag(&sS[(tj * 32 + lr) * 72 + q * 16 + 8 * lh]), nw);
        acc = nw;
        __syncthreads();
      }
    }
  }
}

__device__ __forceinline__ void rwkv_out_item(const Params& P, int l, int item, unsigned char* sm) {
  int tid_ = threadIdx.x; OPAQUE(tid_);
  const int tid = tid_, lane = tid & 63, w = tid >> 6, ti = w >> 1, tj = w & 1;
  const int lr = lane & 31, lh = lane >> 5;
  const int h = item & 3, rest = item >> 2, pc = rest % NCH, b = rest / NCH;
  if (l == 1 && pc < NCH_C) return;
  const int row0 = chunk_row0(b, pc, TC, NCH_C);
  float* spart = (float*)sm;
  float vvh[16], ggh[16], bnh[16];
#pragma unroll
  for (int r = 0; r < 16; r++) {
    const int row = row0 + ti * 32 + acc_row(r, lane), c = h * 64 + tj * 32 + lr;
    vvh[r] = bf2f(WS(bf16, OFF_R)[(size_t)row * 1024 + 512 + c]);
    ggh[r] = bf2f(WS(bf16, OFF_PROJ)[(size_t)row * NIN + C_RWG + c]);
    const float* bon = WS(float, OFF_BON) + (size_t)row * 8 + h * 2;
    bnh[r] = bon[0] + bon[1];
  }
  f32x16 acc = zero16();
#pragma unroll
  for (int d = 0; d < 2; d++) {
    const bf16* X0 = WS(bf16, OFF_XA) + (size_t)row0 * 1024 + d * 256 + h * 64;
    const bf16* X1 = X0 + 512;
    const bf16* P0 = WS(bf16, OFF_PROJ) + (size_t)row0 * NIN + (h * 2 + d) * 128;
#pragma unroll
    for (int ks = 0; ks < 64; ks += 16)
      acc = mfma32(gfrag(X0, 1024, ti * 32 + lr, ks + 8 * lh), gfrag(X1, 1024, tj * 32 + lr, ks + 8 * lh), acc);
#pragma unroll
    for (int r = 0; r < 16; r++) acc[r] += bf2f(P0[(size_t)(ti * 32 + acc_row(r, lane)) * NIN + tj * 32 + lr]);
  }
#pragma unroll
  for (int r = 0; r < 16; r++) {
    int p = ti * 32 + acc_row(r, lane);
    float s1 = sum32(acc[r]), s2 = sum32(acc[r] * acc[r]);
    if (lr == 31) { spart[(p * 2 + tj) * 2] = s1; spart[(p * 2 + tj) * 2 + 1] = s2; }
  }
  __syncthreads();
  {
    int c = h * 64 + tj * 32 + lr;
    float lw_ = P.rw_ln_w[l * 256 + c], lb_ = P.rw_ln_b[l * 256 + c];
    bf16* yc = WS(bf16, OFF_R);
    const bf16* pr = WS(bf16, OFF_PROJ);
#pragma unroll
    for (int r = 0; r < 16; r++) {
      int p = ti * 32 + acc_row(r, lane);
      int row = row0 + p;
      float mu = (spart[(p * 2) * 2] + spart[(p * 2 + 1) * 2]) * (1.f / 64.f);
      float ex2 = (spart[(p * 2) * 2 + 1] + spart[(p * 2 + 1) * 2 + 1]) * (1.f / 64.f);
      float var = fmaxf(ex2 - mu * mu, 0.f);
      float yn = (acc[r] - mu) * rsqrtf(var + 64e-5f) * lw_ + lb_;
      yc[(size_t)row * 1024 + 512 + c] = f2bf((yn + bnh[r] * vvh[r]) * silu_f(ggh[r]));
    }
  }
  __syncthreads();
}

__device__ __forceinline__ float wave_scan64(float v, float* tmp, int lane, bool reverse) {
  const int idx = reverse ? 63 - lane : lane;
#pragma unroll
  for (int off = 1; off < 64; off <<= 1) {
    tmp[idx] = v; wave_sync();
    float o = idx >= off ? tmp[idx - off] : 0.f; wave_sync();
    v += o;
  }
  return v;
}
__device__ __forceinline__ float ssd_aneg(const Params& P, int l, int d, int h) { return -__expf(P.ssd_a_log[(l * 2 + d) * 4 + h]); }
__device__ __forceinline__ void ssd_state_item(const Params& P, int l, int item, unsigned char* sm) {
  int tid_ = threadIdx.x; OPAQUE(tid_);
  const int tid = tid_, lane = tid & 63, w = tid >> 6;
  const int d = item & 1, h = (item >> 1) & 3, rest = item >> 3;
  const int pc = rest % NCH, b = rest / NCH;
  const int isctx = pc < NCH_C, len = isctx ? CTX : SEQ, t0 = (isctx ? pc : pc - NCH_C) * TC;
  const int seq0 = isctx ? b * CTX : ROWS_C + b * SEQ;
  bf16* sRaw = (bf16*)sm;
  bf16* sVt = sRaw + 2 * 68 * 64;
  bf16* sBt = sVt + 64 * 72;
  float* sdt = (float*)(sBt + 64 * 72);
  float* sdw = sdt + 64;
  const bf16* pr = WS(bf16, OFF_PROJ);
#pragma unroll 8
  for (int idx = tid; idx < 2 * 68 * 8; idx += 256) {
    int which = idx / (68 * 8), rem = idx % (68 * 8), tr = rem >> 3, c8 = rem & 7;
    int t = t0 - 2 + tr;
    int col = C_SSD + (which == 0 ? h * 64 : 256 + (h >> 1) * 64) + c8 * 8;
    U4 v = (t >= 0 && t < len) ? *(const U4*)(pr + (size_t)(seq0 + t) * NIN + col) : zero4();
    *(U4*)&sRaw[(which * 68 + tr) * 64 + c8 * 8] = v;
  }
  if (tid < 64) {
    float raw = bf2f(pr[(size_t)(seq0 + t0 + tid) * NIN + C_SSDDT + d * 4 + h]);
    sdt[tid] = softplus_f(raw + P.ssd_dt_bias[(l * 2 + d) * 4 + h]);
  }
  __syncthreads();
  if (w == 0) {
    float la = sdt[lane] * ssd_aneg(P, l, d, h);
    float incl = wave_scan64(la, sdw, lane, d == 0);
    wave_sync();
    sdw[lane] = __expf(incl - la);
    if (lane == (d == 0 ? 0 : 63)) WS(float, OFF_SSDDEC)[((size_t)(d * BATCH + b) * NCH + pc) * 4 + h] = __expf(incl);
  }
  __syncthreads();
#pragma unroll
  for (int which = 0; which < 2; which++) {
    const int c = tid & 63;
    const int ch = which == 0 ? h * 64 + c : 256 + (h >> 1) * 64 + c;
    float cw[5], cb = P.ssd_conv_b[l * 512 + ch];
#pragma unroll
    for (int i = 0; i < 5; i++) cw[i] = P.ssd_conv_w[(l * 5 + i) * 512 + ch];
    const int tb = (tid >> 6) * 16;
    float w0 = bf2f(sRaw[(which * 68 + tb) * 64 + c]), w1 = bf2f(sRaw[(which * 68 + tb + 1) * 64 + c]);
    float w2 = bf2f(sRaw[(which * 68 + tb + 2) * 64 + c]), w3 = bf2f(sRaw[(which * 68 + tb + 3) * 64 + c]);
#pragma unroll 4
    for (int t = tb; t < tb + 16; t++) {
      float w4 = bf2f(sRaw[(which * 68 + t + 4) * 64 + c]);
      float acc = cb + w0 * cw[0] + w1 * cw[1] + w2 * cw[2] + w3 * cw[3] + w4 * cw[4];
      w0 = w1; w1 = w2; w2 = w3; w3 = w4;
      float v = silu_f(acc);
      if (which == 0) sVt[c * 72 + t] = f2bf(v * sdt[t] * sdw[t]);
      else sBt[c * 72 + t] = f2bf(v);
    }
  }
  __syncthreads();
  {
    int ti = w >> 1, tj = w & 1;
    f32x16 acc = zero16();
    for (int ks = 0; ks < 64; ks += 16)
      acc = mfma32(ldsfrag(&sVt[(ti * 32 + (lane & 31)) * 72 + ks + 8 * (lane >> 5)]),
                   ldsfrag(&sBt[(tj * 32 + (lane & 31)) * 72 + ks + 8 * (lane >> 5)]), acc);
    bf16* st = WS(bf16, OFF_SSDST) + ((size_t)((d * BATCH + b) * NCH + pc) * 4 + h) * 4096;
    for (int r = 0; r < 16; r++) st[(ti * 32 + acc_row(r, lane)) * 64 + tj * 32 + (lane & 31)] = f2bf(acc[r]);
  }
  __syncthreads();
}

__device__ __forceinline__ void gla_la(const Params& P, int l, int d, int h, const float* sGl, float* dst) {
  const int k = threadIdx.x & 31;
  float gw[16], gb = P.gla_gb[(l * 2 + d) * 128 + h * 32 + k];
  const float* g2 = P.gla_g2 + (size_t)(l * 2 + d) * 16 * 128 + h * 32 + k;
#pragma unroll
  for (int r = 0; r < 16; r++) gw[r] = g2[r * 128];
#pragma unroll 2
  for (int t = threadIdx.x >> 5; t < 64; t += 8) {
    float acc = gb;
#pragma unroll
    for (int r = 0; r < 16; r++) acc += sGl[t * 32 + d * 16 + r] * gw[r];
    dst[t * 32 + k] = -softplus_f(-acc) * (1.f / 16.f);
  }
}
__device__ __forceinline__ void gla_state_item(const Params& P, int l, int item, unsigned char* sm) {
  int tid_ = threadIdx.x; OPAQUE(tid_);
  const int tid = tid_, lane = tid & 63, w = tid >> 6;
  const int d = item & 1, h = (item >> 1) & 3, rest = item >> 3;
  const int pc = rest % NCH, b = rest / NCH;
  const int row0 = chunk_row0(b, pc, TC, NCH_C);
  float* sGl = (float*)sm;
  float* sLa = sGl + 2048;
  bf16* sVt = (bf16*)(sLa + 2048);
  bf16* sKt = sVt + 64 * 72;
  const bf16* pr = WS(bf16, OFF_PROJ);
  float kh[8], vh[16];
#pragma unroll
  for (int i = 0; i < 8; i++) kh[i] = bf2f(pr[(size_t)(row0 + (tid >> 5) + 8 * i) * NIN + C_GLAK + h * 32 + (tid & 31)]);
#pragma unroll
  for (int i = 0; i < 16; i++) vh[i] = bf2f(pr[(size_t)(row0 + (tid >> 6) + 4 * i) * NIN + C_GLAV + h * 64 + (tid & 63)]);
#pragma unroll 8
  for (int idx = tid; idx < 64 * 32; idx += 256) {
    int t = idx >> 5, c = idx & 31;
    sGl[idx] = bf2f(pr[(size_t)(row0 + t) * NIN + C_GLAGL + c]);
  }
  __syncthreads();
  gla_la(P, l, d, h, sGl, sLa);
  __syncthreads();
  {
    float* segtot = (float*)(sKt + 32 * 72);
    const int k = tid & 31, sg = tid >> 5;
    float run = 0.f, loc[8];
#pragma unroll
    for (int j = 0; j < 8; j++) {
      int tau = sg * 8 + j, t = d == 0 ? 63 - tau : tau;
      float la = sLa[t * 32 + k]; loc[j] = run; run += la;
    }
    segtot[sg * 32 + k] = run;
    __syncthreads();
    float off = 0.f, tot = 0.f;
#pragma unroll
    for (int j = 0; j < 8; j++) { float v = segtot[j * 32 + k]; tot += v; if (j < sg) off += v; }
#pragma unroll
    for (int j = 0; j < 8; j++) {
      int tau = sg * 8 + j, t = d == 0 ? 63 - tau : tau;
      sLa[t * 32 + k] = loc[j] + off;
    }
    if (sg == 0) WS(float, OFF_GLADEC)[(((size_t)(d * BATCH + b) * NCH + pc) * 4 + h) * 32 + k] = __expf(tot);
  }
  __syncthreads();
#pragma unroll
  for (int i = 0; i < 16; i++) sVt[(tid & 63) * 72 + (tid >> 6) + 4 * i] = f2bf(vh[i]);
#pragma unroll
  for (int i = 0; i < 8; i++) {
    const int t = (tid >> 5) + 8 * i, k = tid & 31;
    sKt[k * 72 + t] = f2bf(kh[i] * __expf(sLa[t * 32 + k]));
  }
  __syncthreads();
  if (w < 2) {
    f32x16 acc = zero16();
    for (int ks = 0; ks < 64; ks += 16)
      acc = mfma32(ldsfrag(&sVt[(w * 32 + (lane & 31)) * 72 + ks + 8 * (lane >> 5)]),
                   ldsfrag(&sKt[(lane & 31) * 72 + ks + 8 * (lane >> 5)]), acc);
    bf16* st = WS(bf16, OFF_GLAST) + ((size_t)((d * BATCH + b) * NCH + pc) * 4 + h) * 2048;
    for (int r = 0; r < 16; r++) st[(w * 32 + acc_row(r, lane)) * 32 + (lane & 31)] = f2bf(acc[r]);
  }
  __syncthreads();
}

__device__ __forceinline__ U4 s5_u_load(const Params& P, int g, int n, int k8) {
  if (n >= M5) return zero4();
  int b = n / NCH5, pc = n - b * NCH5;
  int row = chunk_row0(b, pc, T5, NC5) + (k8 >> 4);
  return *(const U4*)(WS(bf16, OFF_PROJ) + (size_t)row * NIN + C_S5 + g * 16 + (k8 & 15));
}
__device__ __forceinline__ void s5_state_tile(const Params& P, int l, int item, unsigned char* sm) {
  const int MT5 = (M5 + 127) / 128;
  int nt = item & 1, mt = (item >> 1) % MT5, g = (item >> 1) / MT5;
  const bf16* Bt = WS(bf16, OFF_W1T) + (size_t)(l * 16 + g) * 256 * 512;
  float* S = WS(float, OFF_S5ST) + (size_t)g * M5 * 256;
  gemm_tile(sm, mt * 128, nt * 128, 512,
    [&](int m, int k) { return s5_u_load(P, g, m, k); },
    [&](int n, int k) { return *(const U4*)(Bt + (size_t)n * 512 + k); },
    [&](int m, int n, float v) { if (m < M5) S[(size_t)m * 256 + n] = v; });
}

__device__ __forceinline__ void phase_D(const Params& P, int l, unsigned char* sm, long long& pacc) {
  const int n_rw = BATCH * NCH * 8, n_ssd = BATCH * NCH * 8, n_gla = BATCH * NCH * 8;
  const int n_s5 = 16 * ((M5 + 127) / 128) * 2;
  { long long t0_ = 0; if (PROBE_PHASE == 30) t0_ = wall_clock64();
  ITEM_LOOP(i, n_rw, 0) rwkv_chunk_item(P, l, i, sm, pacc);
  if (PROBE_PHASE == 30) pacc += wall_clock64() - t0_; }
  { long long t0_ = 0; if (PROBE_PHASE == 31) t0_ = wall_clock64();
  ITEM_LOOP(i, n_ssd, n_rw) ssd_state_item(P, l, i, sm);
  if (PROBE_PHASE == 31) pacc += wall_clock64() - t0_; }
  { long long t0_ = 0; if (PROBE_PHASE == 32) t0_ = wall_clock64();
  ITEM_LOOP(i, n_gla, n_rw + n_ssd) gla_state_item(P, l, i, sm);
  if (PROBE_PHASE == 32) pacc += wall_clock64() - t0_; }
  ITEM_LOOP(i, n_s5, n_rw + n_ssd + n_gla) s5_state_tile(P, l, i, sm);
}

__device__ __forceinline__ void phase_E(const Params& P, int l, unsigned char* sm) {
  const int tid = threadIdx.x, w = tid >> 6;
  const int n_rw = BATCH * 8;
  ITEM_LOOP(i, n_rw, 0) rwkv_scan2_item(P, l, i, sm);
  const int n_ssd = 2 * BATCH * 4 * 4, n_gla = 2 * BATCH * 4 * 2, n_s5 = 16 * BATCH;
#pragma unroll 1
  for (int it = (int)((blockIdx.x + gridDim.x - ((unsigned)n_rw % gridDim.x)) % gridDim.x); it < n_ssd + n_gla + n_s5; it += gridDim.x) {
    int i = it;
    if (i < n_ssd) {
      int q = i & 3, h = (i >> 2) & 3, rest = i >> 4, b = rest % BATCH, d = rest / BATCH;
      float S[4] = {0.f, 0.f, 0.f, 0.f};
#pragma unroll 1
      for (int v0 = 0; v0 < NCH; v0 += 8) {
        U2 cv[8]; float dec[8];
#pragma unroll
        for (int j = 0; j < 8; j++) {
          int vc = v0 + j < NCH ? v0 + j : NCH - 1;
          size_t ci = ((size_t)(d * BATCH + b) * NCH + ord_chunk(d, vc, NCH_C, NCH)) * 4 + h;
          cv[j] = *(const U2*)(WS(bf16, OFF_SSDST) + ci * 4096 + q * 1024 + tid * 4);
          dec[j] = WS(float, OFF_SSDDEC)[ci];
        }
#pragma unroll
        for (int j = 0; j < 8; j++) {
          if (v0 + j < NCH) {
            size_t ci = ((size_t)(d * BATCH + b) * NCH + ord_chunk(d, v0 + j, NCH_C, NCH)) * 4 + h;
            U2 o; o.a[0] = pack2(S[0], S[1]); o.a[1] = pack2(S[2], S[3]);
            *(U2*)(WS(bf16, OFF_SSDST) + ci * 4096 + q * 1024 + tid * 4) = o;
            S[0] = dec[j] * S[0] + lo2f(cv[j].a[0]); S[1] = dec[j] * S[1] + hi2f(cv[j].a[0]);
            S[2] = dec[j] * S[2] + lo2f(cv[j].a[1]); S[3] = dec[j] * S[3] + hi2f(cv[j].a[1]);
          }
        }
      }
      continue;
    }
    i -= n_ssd;
    if (i < n_gla) {
      int q = i & 1, h = (i >> 1) & 3, rest = i >> 3, b = rest % BATCH, d = rest / BATCH;
      float S[4] = {0.f, 0.f, 0.f, 0.f};
      int e0 = q * 1024 + tid * 4, k0 = e0 & 31;
#pragma unroll 1
      for (int v0 = 0; v0 < NCH; v0 += 8) {
        U2 cv[8]; F4 dec[8];
#pragma unroll
        for (int j = 0; j < 8; j++) {
          int vc = v0 + j < NCH ? v0 + j : NCH - 1;
          size_t ci = ((size_t)(d * BATCH + b) * NCH + ord_chunk(d, vc, NCH_C, NCH)) * 4 + h;
          cv[j] = *(const U2*)(WS(bf16, OFF_GLAST) + ci * 2048 + e0);
          dec[j] = *(const F4*)(WS(float, OFF_GLADEC) + ci * 32 + k0);
        }
#pragma unroll
        for (int j = 0; j < 8; j++) {
          if (v0 + j < NCH) {
            size_t ci = ((size_t)(d * BATCH + b) * NCH + ord_chunk(d, v0 + j, NCH_C, NCH)) * 4 + h;
            U2 o; o.a[0] = pack2(S[0], S[1]); o.a[1] = pack2(S[2], S[3]);
            *(U2*)(WS(bf16, OFF_GLAST) + ci * 2048 + e0) = o;
            S[0] = dec[j].a[0] * S[0] + lo2f(cv[j].a[0]); S[1] = dec[j].a[1] * S[1] + hi2f(cv[j].a[0]);
            S[2] = dec[j].a[2] * S[2] + lo2f(cv[j].a[1]); S[3] = dec[j].a[3] * S[3] + hi2f(cv[j].a[1]);
          }
        }
      }
      continue;
    }
    i -= n_gla;
    if (i < n_s5) {
      int b = i % BATCH, g = i / BATCH;
      if (tid < 128) {
        int d = tid >> 6, p = tid & 63;
        const float* lt = WS(float, OFF_S5LT) + ((size_t)((l * 16 + g) * 2 + d) * 64 + p) * 2;
        float lr = lt[0], li = lt[1], xr = 0.f, xi = 0.f;
#pragma unroll 1
        for (int v0 = 0; v0 < NCH5; v0 += 8) {
          float sr[8], si[8];
#pragma unroll
          for (int j = 0; j < 8; j++) {
            int vc = v0 + j < NCH5 ? v0 + j : NCH5 - 1;
            const float* sp = WS(float, OFF_S5ST) + ((size_t)g * M5 + b * NCH5 + ord_chunk(d, vc, NC5, NCH5)) * 256 + d * 128 + p;
            sr[j] = sp[0]; si[j] = sp[64];
          }
#pragma unroll
          for (int j = 0; j < 8; j++) {
            if (v0 + j < NCH5) {
              float* sp = WS(float, OFF_S5ST) + ((size_t)g * M5 + b * NCH5 + ord_chunk(d, v0 + j, NC5, NCH5)) * 256 + d * 128 + p;
              sp[0] = xr; sp[64] = xi;
              float nr = lr * xr - li * xi + sr[j], ni = lr * xi + li * xr + si[j];
              xr = nr; xi = ni;
            }
          }
        }
      }
      continue;
    }
  }
}

__device__ __forceinline__ void ssd_out_item(const Params& P, int l, int item, unsigned char* sm, long long& pacc) {
  long long tp0_ = 0; if (PROBE_PHASE == 55 || PROBE_PHASE == 56) tp0_ = wall_clock64();
  int tid_ = threadIdx.x; OPAQUE(tid_);
  const int tid = tid_, lane = tid & 63, w = tid >> 6;
  const int h = item & 3, rest = item >> 2, pc = rest % NCH, b = rest / NCH;
  if (l == 1 && pc < NCH_C) return;
  const int isctx = pc < NCH_C, len = isctx ? CTX : SEQ, t0 = (isctx ? pc : pc - NCH_C) * TC;
  const int seq0 = isctx ? b * CTX : ROWS_C + b * SEQ;
  bf16* sRaw = (bf16*)sm;
  bf16* sA2 = (bf16*)sm;
  bf16* sB2 = (bf16*)(sm + 26112);
  bf16* sC = (bf16*)(sm + 26112 + 25600);
  float* sdt = (float*)(sm + 26112 + 25600 + 9216);
  float* scf = sdt + 128; float* scr = scf + 64; float* spart = scr + 64;
  const bf16* pr = WS(bf16, OFF_PROJ);
#pragma unroll 8
  for (int idx = tid; idx < 3 * 68 * 8; idx += 256) {
    int which = idx / (68 * 8), rem = idx % (68 * 8), tr = rem >> 3, c8 = rem & 7;
    int t = t0 - 2 + tr;
    int col = C_SSD + (which == 0 ? h * 64 : which == 1 ? 256 + (h >> 1) * 64 : 384 + (h >> 1) * 64) + c8 * 8;
    U4 v = (t >= 0 && t < len) ? *(const U4*)(pr + (size_t)(seq0 + t) * NIN + col) : zero4();
    *(U4*)&sRaw[(which * 68 + tr) * 64 + c8 * 8] = v;
  }
  u32x4 stv0, stv1, stv2, stv3;
  {
    const bf16* stb = WS(bf16, OFF_SSDST);
    const size_t o0 = ((size_t)((0 * BATCH + b) * NCH + pc) * 4 + h) * 4096, o1 = ((size_t)((1 * BATCH + b) * NCH + pc) * 4 + h) * 4096;
    const int p_ = (tid >> 3) & 31, c8_ = tid & 7;
    stv0 = *(const u32x4*)(stb + o0 + p_ * 64 + c8_ * 8);
    stv1 = *(const u32x4*)(stb + o0 + (p_ + 32) * 64 + c8_ * 8);
    stv2 = *(const u32x4*)(stb + o1 + p_ * 64 + c8_ * 8);
    stv3 = *(const u32x4*)(stb + o1 + (p_ + 32) * 64 + c8_ * 8);
  }
  float zv[16];
#pragma unroll
  for (int r = 0; r < 16; r++)
    zv[r] = bf2f(pr[(size_t)(seq0 + t0 + (w >> 1) * 32 + acc_row(r, lane)) * NIN + C_SSDZ + h * 64 + (w & 1) * 32 + (lane & 31)]);
  if (tid < 128) {
    int d = tid >> 6, t = tid & 63;
    float raw = bf2f(pr[(size_t)(seq0 + t0 + t) * NIN + C_SSDDT + d * 4 + h]);
    sdt[tid] = softplus_f(raw + P.ssd_dt_bias[(l * 2 + d) * 4 + h]);
  }
  __syncthreads();
  if (w == 0) { float v = wave_scan64(sdt[lane] * ssd_aneg(P, l, 0, h), scf, lane, false); wave_sync(); scf[lane] = v; }
  if (w == 1) { float v = wave_scan64(sdt[64 + lane] * ssd_aneg(P, l, 1, h), scr, lane, true); wave_sync(); scr[lane] = v; }
#pragma unroll
  for (int which = 0; which < 3; which++) {
    const int c = tid & 63;
    const int ch = which == 0 ? h * 64 + c : which == 1 ? 256 + (h >> 1) * 64 + c : 384 + (h >> 1) * 64 + c;
    float cw[5], cb = P.ssd_conv_b[l * 512 + ch];
#pragma unroll
    for (int i = 0; i < 5; i++) cw[i] = P.ssd_conv_w[(l * 5 + i) * 512 + ch];
    const int tb = (tid >> 6) * 16;
    float w0 = bf2f(sRaw[(which * 68 + tb) * 64 + c]), w1 = bf2f(sRaw[(which * 68 + tb + 1) * 64 + c]);
    float w2 = bf2f(sRaw[(which * 68 + tb + 2) * 64 + c]), w3 = bf2f(sRaw[(which * 68 + tb + 3) * 64 + c]);
#pragma unroll 4
    for (int t = tb; t < tb + 16; t++) {
      float w4 = bf2f(sRaw[(which * 68 + t + 4) * 64 + c]);
      float acc = cb + w0 * cw[0] + w1 * cw[1] + w2 * cw[2] + w3 * cw[3] + w4 * cw[4];
      w0 = w1; w1 = w2; w2 = w3; w3 = w4;
      bf16 v = f2bf(silu_f(acc));
      if (which == 0) sB2[c * 200 + t] = v;
      else if (which == 1) sB2[t * 200 + 64 + c] = v;
      else sC[t * 72 + c] = v;
    }
  }
  __syncthreads();
  const int ti = w >> 1, tj = w & 1;
  {
    f32x16 g = zero16();
    for (int ks = 0; ks < 64; ks += 16)
      g = mfma32(ldsfrag(&sC[(ti * 32 + (lane & 31)) * 72 + ks + 8 * (lane >> 5)]),
                 ldsfrag(&sB2[(tj * 32 + (lane & 31)) * 200 + 64 + ks + 8 * (lane >> 5)]), g);
    int j = tj * 32 + (lane & 31);
    float cfj = scf[j], crj = scr[j], d0j = sdt[j], d1j = sdt[64 + j];
    for (int r = 0; r < 16; r++) {
      int i = ti * 32 + acc_row(r, lane);
      float mlt = 0.f;
      if (j <= i) mlt += __expf(scf[i] - cfj) * d0j;
      if (j >= i) mlt += __expf(scr[i] - crj) * d1j;
      sA2[i * 200 + j] = f2bf(g[r] * mlt);
    }
  }
#pragma unroll 8
  for (int idx = tid; idx < 64 * 64; idx += 256) {
    int i = idx >> 6, n = idx & 63;
    float cv = bf2f(sC[i * 72 + n]);
    sA2[i * 200 + 64 + n] = f2bf(cv * __expf(scf[i]));
    sA2[i * 200 + 128 + n] = f2bf(cv * __expf(scr[i]));
  }
  __syncthreads();
  {
    const int p_ = (tid >> 3) & 31, c8_ = tid & 7;
    *(u32x4*)&sB2[p_ * 200 + 64 + c8_ * 8] = stv0;
    *(u32x4*)&sB2[(p_ + 32) * 200 + 64 + c8_ * 8] = stv1;
    *(u32x4*)&sB2[p_ * 200 + 128 + c8_ * 8] = stv2;
    *(u32x4*)&sB2[(p_ + 32) * 200 + 128 + c8_ * 8] = stv3;
  }
  __syncthreads();
  {
    f32x16 acc = zero16();
    for (int ks = 0; ks < 192; ks += 16)
      acc = mfma32(ldsfrag(&sA2[(ti * 32 + (lane & 31)) * 200 + ks + 8 * (lane >> 5)]),
                   ldsfrag(&sB2[(tj * 32 + (lane & 31)) * 200 + ks + 8 * (lane >> 5)]), acc);
    int p = tj * 32 + (lane & 31);
    float dd = P.ssd_d[l * 4 + h];
    bf16* yc = WS(bf16, OFF_R);
    for (int r = 0; r < 16; r++) {
      int i = ti * 32 + acc_row(r, lane);
      int row = seq0 + t0 + i;
      float xv = bf2f(sB2[p * 200 + i]);
      float y = acc[r] + dd * xv;
      float z = zv[r];
      y *= silu_f(z);
      yc[(size_t)row * 1024 + h * 64 + p] = f2bf(y);
      float s2 = sum32(y * y);
      if ((lane & 31) == 31) spart[i * 2 + tj] = s2;
    }
  }
  __syncthreads();
  if (tid < 64) WS(float, OFF_SSQ)[(size_t)(seq0 + t0 + tid) * 4 + h] = spart[tid * 2] + spart[tid * 2 + 1];
  __syncthreads();
}

__device__ __forceinline__ void gla_out_item(const Params& P, int l, int item, unsigned char* sm) {
  int tid_ = threadIdx.x; OPAQUE(tid_);
  const int tid = tid_, lane = tid & 63, w = tid >> 6;
  const int h = item & 3, rest = item >> 2, pc = rest % NCH, b = rest / NCH;
  if (l == 1 && pc < NCH_C) return;
  const int row0 = chunk_row0(b, pc, TC, NCH_C);
  bf16* sA2 = (bf16*)sm;
  bf16* sB2 = sA2 + 64 * 136;
  bf16* sKf = sB2 + 64 * 136;
  bf16* sKr = sKf + 64 * 40;
  float* sbf = (float*)(sKr + 64 * 40);
  float* sbr = sbf + 2048;
  float* spart = sbr + 2048;
  float* sGl = (float*)sB2;
  const bf16* pr = WS(bf16, OFF_PROJ);
  float qh[8], kh[8], vh[16], gh[16];
  u32x4 sth0, sth1;
#pragma unroll
  for (int i = 0; i < 8; i++) {
    const bf16* rp = pr + (size_t)(row0 + (tid >> 5) + 8 * i) * NIN + h * 32 + (tid & 31);
    qh[i] = bf2f(rp[C_GLA]); kh[i] = bf2f(rp[C_GLAK]);
  }
#pragma unroll
  for (int i = 0; i < 16; i++) vh[i] = bf2f(pr[(size_t)(row0 + (tid >> 6) + 4 * i) * NIN + C_GLAV + h * 64 + (tid & 63)]);
#pragma unroll
  for (int r = 0; r < 16; r++)
    gh[r] = bf2f(pr[(size_t)(row0 + (w >> 1) * 32 + acc_row(r, lane)) * NIN + C_GLAG + h * 64 + (w & 1) * 32 + (lane & 31)]);
  {
    const bf16* st0 = WS(bf16, OFF_GLAST) + ((size_t)((0 * BATCH + b) * NCH + pc) * 4 + h) * 2048;
    const bf16* st1 = WS(bf16, OFF_GLAST) + ((size_t)((1 * BATCH + b) * NCH + pc) * 4 + h) * 2048;
    sth0 = *(const u32x4*)(st0 + (tid >> 2) * 32 + (tid & 3) * 8);
    sth1 = *(const u32x4*)(st1 + (tid >> 2) * 32 + (tid & 3) * 8);
  }
#pragma unroll 8
  for (int idx = tid; idx < 64 * 32; idx += 256) {
    int t = idx >> 5, c = idx & 31;
    sGl[idx] = bf2f(pr[(size_t)(row0 + t) * NIN + C_GLAGL + c]);
  }
  __syncthreads();
  gla_la(P, l, 0, h, sGl, sbf);
  gla_la(P, l, 1, h, sGl, sbr);
  __syncthreads();
  {
    float* segtot = spart + 128;
    const int k = tid & 31, sg = tid >> 5;
    float rf = 0.f, rr_ = 0.f, lf[8], lr_[8];
#pragma unroll
    for (int j = 0; j < 8; j++) {
      int tf = sg * 8 + j, tr = 63 - tf;
      rf += sbf[tf * 32 + k]; lf[j] = rf;
      rr_ += sbr[tr * 32 + k]; lr_[j] = rr_;
    }
    segtot[sg * 32 + k] = rf; segtot[256 + sg * 32 + k] = rr_;
    __syncthreads();
    float of = 0.f, orr = 0.f;
#pragma unroll
    for (int j = 0; j < 8; j++) { if (j < sg) { of += segtot[j * 32 + k]; orr += segtot[256 + j * 32 + k]; } }
#pragma unroll
    for (int j = 0; j < 8; j++) {
      int tf = sg * 8 + j, tr = 63 - tf;
      sbf[tf * 32 + k] = lf[j] + of;
      sbr[tr * 32 + k] = lr_[j] + orr;
    }
  }
  __syncthreads();
#pragma unroll
  for (int i = 0; i < 8; i++) {
    const int idx = tid + 256 * i, t = idx >> 5, k = idx & 31;
    float q = qh[i] * 0.17677669529663687f;
    float kv = kh[i];
    float bf_ = sbf[idx], br_ = sbr[idx];
    sA2[t * 136 + 64 + k] = f2bf(q * __expf(bf_));
    sA2[t * 136 + 96 + k] = f2bf(q * __expf(br_));
    sKf[t * 40 + k] = f2bf(kv * __expf(-bf_));
    sKr[t * 40 + k] = f2bf(kv * __expf(-br_));
  }
#pragma unroll
  for (int i = 0; i < 16; i++) sB2[(tid & 63) * 136 + (tid >> 6) + 4 * i] = f2bf(vh[i]);
  *(u32x4*)&sB2[(tid >> 2) * 136 + 64 + (tid & 3) * 8] = sth0;
  *(u32x4*)&sB2[(tid >> 2) * 136 + 96 + (tid & 3) * 8] = sth1;
  __syncthreads();
  const int ti = w >> 1, tj = w & 1;
  {
    f32x16 pf = zero16(), pv = zero16();
    for (int ks = 0; ks < 32; ks += 16) {
      pf = mfma32(ldsfrag(&sA2[(ti * 32 + (lane & 31)) * 136 + 64 + ks + 8 * (lane >> 5)]),
                  ldsfrag(&sKf[(tj * 32 + (lane & 31)) * 40 + ks + 8 * (lane >> 5)]), pf);
      pv = mfma32(ldsfrag(&sA2[(ti * 32 + (lane & 31)) * 136 + 96 + ks + 8 * (lane >> 5)]),
                  ldsfrag(&sKr[(tj * 32 + (lane & 31)) * 40 + ks + 8 * (lane >> 5)]), pv);
    }
    int j = tj * 32 + (lane & 31);
    for (int r = 0; r < 16; r++) {
      int i = ti * 32 + acc_row(r, lane);
      float v = (j < i) ? pf[r] : (j > i) ? pv[r] : pf[r] + pv[r];
      sA2[i * 136 + j] = f2bf(v);
    }
  }
  __syncthreads();
  {
    f32x16 acc = zero16();
    for (int ks = 0; ks < 128; ks += 16)
      acc = mfma32(ldsfrag(&sA2[(ti * 32 + (lane & 31)) * 136 + ks + 8 * (lane >> 5)]),
                   ldsfrag(&sB2[(tj * 32 + (lane & 31)) * 136 + ks + 8 * (lane >> 5)]), acc);
    for (int r = 0; r < 16; r++) {
      int i = ti * 32 + acc_row(r, lane);
      float s2 = sum32(acc[r] * acc[r]);
      if ((lane & 31) == 31) spart[i * 2 + tj] = s2;
    }
    __syncthreads();
    int v = tj * 32 + (lane & 31);
    float gn = P.gla_norm[l * 256 + h * 64 + v];
    bf16* yc = WS(bf16, OFF_R);
    for (int r = 0; r < 16; r++) {
      int i = ti * 32 + acc_row(r, lane);
      int row = row0 + i;
      float rstd = rsqrtf((spart[i * 2] + spart[i * 2 + 1]) * (1.f / 64.f) + 1e-6f);
      float g = gh[r];
      yc[(size_t)row * 1024 + 768 + h * 64 + v] = f2bf(acc[r] * rstd * gn * silu_f(g));
    }
  }
  __syncthreads();
}

__device__ __forceinline__ void s5_out_tile(const Params& P, int l, int item, unsigned char* sm) {
  const int MT5 = (M5 + 127) / 128;
  int nt = item & 3, mt = (item >> 2) % MT5, g = (item >> 2) / MT5;
  const bf16* Bt = WS(bf16, OFF_BT2) + (size_t)(l * 16 + g) * 512 * 768;
  const float* X = WS(float, OFF_S5ST) + (size_t)g * M5 * 256;
  const bf16* pr = WS(bf16, OFF_PROJ);
  bf16* ys = WS(bf16, OFF_PROJ);
  gemm_tile(sm, mt * 128, nt * 128, 768,
    [&](int m, int k) {
      if (k < 512) return s5_u_load(P, g, m, k);
      if (m >= M5) return zero4();
      const float* xp = X + (size_t)m * 256 + (k - 512);
      F4 a = *(const F4*)xp, b2 = *(const F4*)(xp + 4);
      U4 r; r.a[0] = pack2(a.a[0], a.a[1]); r.a[1] = pack2(a.a[2], a.a[3]); r.a[2] = pack2(b2.a[0], b2.a[1]); r.a[3] = pack2(b2.a[2], b2.a[3]);
      return r;
    },
    [&](int n, int k) { return *(const U4*)(Bt + (size_t)n * 768 + k); },
    [&](int m, int n, float v) {
      if (m >= M5) return;
      int b = m / NCH5, pc = m - b * NCH5;
      int row = chunk_row0(b, pc, T5, NC5) + (n >> 4);
      int ch = g * 16 + (n & 15);
      float u = bf2f(pr[(size_t)row * NIN + C_S5 + ch]);
      ys[(size_t)row * NIN + (ch >> 6) * 128 + 64 + (ch & 63)] = f2bf(gelu_f(v + P.s5_d[l * 256 + ch] * u));
    });
}

__device__ __forceinline__ void phase_F(const Params& P, int l, unsigned char* sm, long long& pacc) {
  const int n_ssd = BATCH * NCH * 4, n_gla = BATCH * NCH * 4, n_s5 = 16 * ((M5 + 127) / 128) * 4, n_rw = BATCH * NCH * 4;
#define SUBP(id, stmt) { long long t0_ = 0; if (PROBE_PHASE == (id)) t0_ = wall_clock64(); stmt; if (PROBE_PHASE == (id)) pacc += wall_clock64() - t0_; }
  SUBP(51, ITEM_LOOP(i, n_ssd, 0) ssd_out_item(P, l, i, sm, pacc))
  SUBP(52, ITEM_LOOP(i, n_gla, n_ssd) gla_out_item(P, l, i, sm))
  SUBP(53, ITEM_LOOP(i, n_s5, n_ssd + n_gla) s5_out_tile(P, l, i, sm))
  SUBP(54, ITEM_LOOP(i, n_rw, n_ssd + n_gla + n_s5) rwkv_out_item(P, l, i, sm))
}

__device__ __forceinline__ void phase_G(const Params& P, int l, unsigned char* sm) {
  const int lane = threadIdx.x & 63, w = threadIdx.x >> 6;
  const int n_glu = (ROWS / 128) * 2, n_rows = ROWS / 4;
  const bf16* Bt = WS(bf16, OFF_GLUT) + (size_t)l * 256 * 256;
  const bf16* pr = WS(bf16, OFF_PROJ);
  bf16* yc = WS(bf16, OFF_R);
#pragma unroll 1
  for (int it = blockIdx.x; it < n_glu + n_rows; it += gridDim.x) {
    if (it < n_glu) {
      int nt = it & 1, mt = it >> 1;
      if (l == 1 && mt < ROWS_C / 128) continue;
      gemm_tile(sm, mt * 128, nt * 128, 256,
        [&](int m, int k) { return *(const U4*)(pr + (size_t)m * NIN + (k >> 6) * 128 + 64 + (k & 63)); },
        [&](int n, int k) { return *(const U4*)(Bt + (size_t)n * 256 + k); },
        [&](int m, int n, float v) {
          float y = bf2f(pr[(size_t)m * NIN + (n >> 6) * 128 + 64 + (n & 63)]);
          float g = bf2f(pr[(size_t)m * NIN + C_S5G + n]);
          yc[(size_t)m * 1024 + 256 + n] = f2bf(y * sigmoid_f(v + P.s5_glu_b[l * 256 + n]) * silu_f(g));
        });
      continue;
    }
    int m = (it - n_glu) * 4 + w;
    const float* sq = WS(float, OFF_SSQ) + (size_t)m * 4;
    float rstd = rsqrtf((sq[0] + sq[1] + sq[2] + sq[3]) * (1.f / 256.f) + 1e-6f);
    bf16* p = yc + (size_t)m * 1024 + lane * 4;
    U2 v = *(U2*)p;
    const float* gn = P.ssd_norm + l * 256 + lane * 4;
    U2 o;
    o.a[0] = pack2(lo2f(v.a[0]) * rstd * gn[0], hi2f(v.a[0]) * rstd * gn[1]);
    o.a[1] = pack2(lo2f(v.a[1]) * rstd * gn[2], hi2f(v.a[1]) * rstd * gn[3]);
    *(U2*)p = o;
  }
}

__device__ __forceinline__ void phase_outproj(const Params& P, int l, unsigned char* sm) {
  const bf16* A = WS(bf16, OFF_R);
  const bf16* Bt = WS(bf16, OFF_WTOUT) + (size_t)l * D * D;
  bf16* Y = WS(bf16, OFF_PROJ);
  const int NT = D / 128, MT = ROWS / 128;
#pragma unroll 1
  for (int it0 = blockIdx.x; it0 < MT * NT; it0 += gridDim.x) {
    const int per = (MT * NT) / 8;
    int it = (MT * NT) % 8 == 0 ? (it0 & 7) * per + (it0 >> 3) : it0;
    int mt = it / NT, nt = it % NT;
    if (l == 1 && mt < ROWS_C / 128) continue;
    gemm_tile(sm, mt * 128, nt * 128, D,
      [&](int m, int k) { return *(const U4*)(A + (size_t)m * D + k); },
      [&](int n, int k) { return *(const U4*)(Bt + (size_t)n * D + k); },
      [&](int m, int n, float v) { Y[(size_t)m * D + n] = f2bf(v); });
  }
}

__device__ __forceinline__ void phase_post(const Params& P, int l) {
  const int lane = threadIdx.x & 63, w = threadIdx.x >> 6;
  const int first = (l == 1) ? ROWS_C / 4 : 0;
#pragma unroll 1
  for (int it = first + blockIdx.x; it < ROWS / 4; it += gridDim.x) {
    int m = it * 4 + w;
    RowInfo ri = row_info(m);
    const bf16* y = WS(bf16, OFF_PROJ) + (size_t)m * D + lane * 16;
    const float* hres; float* dst;
    if (ri.isctx) { hres = P.ctx + (size_t)m * D; dst = WS(float, OFF_HC) + (size_t)m * D; }
    else { hres = (l == 0 ? P.x : P.out) + (size_t)(m - ROWS_C) * D; dst = P.out + (size_t)(m - ROWS_C) * D; }
    const int mrow = ri.isctx ? BATCH : ri.b;
    const float* mod = WS(float, OFF_MOD) + ((size_t)l * NMOD + mrow) * 3072 + 2048;
    const int c0 = lane * 16;
    U4 y0 = *(const U4*)y, y1 = *(const U4*)(y + 8);
    float v[16]; float ss = 0.f;
#pragma unroll
    for (int e = 0; e < 4; e++) { v[2 * e] = lo2f(y0.a[e]); v[2 * e + 1] = hi2f(y0.a[e]); v[8 + 2 * e] = lo2f(y1.a[e]); v[8 + 2 * e + 1] = hi2f(y1.a[e]); }
#pragma unroll
    for (int e = 0; e < 16; e++) ss += v[e] * v[e];
    ss = sum64(ss);
    float rstd = rsqrtf(ss * (1.f / 1024.f) + 1e-6f);
    float hn[16]; float ss2 = 0.f;
#pragma unroll
    for (int q = 0; q < 4; q++) {
      F4 hr = *(const F4*)(hres + c0 + 4 * q), gm = *(const F4*)(mod + c0 + 4 * q), np = *(const F4*)(P.norm_post + l * D + c0 + 4 * q), o;
#pragma unroll
      for (int e = 0; e < 4; e++) { o.a[e] = hr.a[e] + gm.a[e] * (v[4 * q + e] * rstd * np.a[e]); hn[4 * q + e] = o.a[e]; ss2 += o.a[e] * o.a[e]; }
      *(F4*)(dst + c0 + 4 * q) = o;
    }
    if (l == 0) {
      ss2 = sum64(ss2);
      float rstd2 = rsqrtf(ss2 * (1.f / 1024.f) + 1e-6f);
      const float* mod1 = WS(float, OFF_MOD) + ((size_t)1 * NMOD + mrow) * 3072;
      bf16* hd = WS(bf16, OFF_R) + (size_t)m * D + c0;
      U4 o0, o1;
#pragma unroll
      for (int q = 0; q < 4; q++) {
        F4 np = *(const F4*)(P.norm_pre + 1 * D + c0 + 4 * q), sc = *(const F4*)(mod1 + 1024 + c0 + 4 * q), sh = *(const F4*)(mod1 + c0 + 4 * q);
        float t0 = hn[4 * q] * rstd2 * np.a[0] * (1.f + sc.a[0]) + sh.a[0], t1 = hn[4 * q + 1] * rstd2 * np.a[1] * (1.f + sc.a[1]) + sh.a[1];
        float t2 = hn[4 * q + 2] * rstd2 * np.a[2] * (1.f + sc.a[2]) + sh.a[2], t3 = hn[4 * q + 3] * rstd2 * np.a[3] * (1.f + sc.a[3]) + sh.a[3];
        if (q < 2) { o0.a[2 * q] = pack2(t0, t1); o0.a[2 * q + 1] = pack2(t2, t3); }
        else { o1.a[2 * (q - 2)] = pack2(t0, t1); o1.a[2 * (q - 2) + 1] = pack2(t2, t3); }
      }
      *(U4*)hd = o0; *(U4*)(hd + 8) = o1;
    }
  }
}

constexpr int NPHASE = 19;
__device__ __forceinline__ void run_phase(const Params& P, int ph, unsigned char* sm) {
  if (ph == 0) { phase_prologue(P, sm); return; }
  int l = (ph - 1) / 9, s = (ph - 1) % 9;
  switch (s) {
    case 0: if (l == 0) phase_normmod(P, l); break;
    case 1: phase_inproj(P, l, sm); break;
    case 2: phase_rwprep(P, l, sm); break;
    case 3: { long long dummy = 0; phase_D(P, l, sm, dummy); } break;
    case 4: phase_E(P, l, sm); break;
    case 5: { long long dummy = 0; phase_F(P, l, sm, dummy); } break;
    case 6: phase_G(P, l, sm); break;
    case 7: phase_outproj(P, l, sm); break;
    default: phase_post(P, l); break;
  }
}

#ifndef CPU_EMU
#define XB_TMO      128
#define XB_XCNT(j)  (256  + 64 * (j))
#define XB_XSUB(j)  (1280 + 64 * (j))
#define XB_XGEN(j)  (2304 + 64 * (j))
#define XB_TOP      3328
#define XB_TOPGEN   3392
#define XCD_BAR_WORDS 3456
#define XB_SPIN_CAP (1u << 18)
#define LAS __attribute__((address_space(3)))

__device__ __forceinline__ unsigned xb_ld(unsigned* p)              { return __hip_atomic_load(p, __ATOMIC_RELAXED, __HIP_MEMORY_SCOPE_AGENT); }
__device__ __forceinline__ unsigned xb_add(unsigned* p, unsigned v) { return __hip_atomic_fetch_add(p, v, __ATOMIC_RELAXED, __HIP_MEMORY_SCOPE_AGENT); }
__device__ __forceinline__ unsigned xb_xcc_id() { return (unsigned)__builtin_amdgcn_s_getreg((3 << 11) | 20) & 0xFu; }
#define XB_SPIN(cond, bar) do { unsigned _sp = 0; while (cond) { __builtin_amdgcn_s_sleep(1); \
    if ((++_sp & 255u) == 0u) { if (xb_ld(&(bar)[XB_TMO])) break; if (_sp > XB_SPIN_CAP) { atomicAdd(&(bar)[XB_TMO], 1u); break; } } } } while (0)

struct XcdBarrier {
    unsigned* bar; unsigned x;
    volatile LAS unsigned* st;
};

__device__ __forceinline__ XcdBarrier xcd_barrier_post(unsigned* bar, volatile LAS unsigned* st) {
    XcdBarrier b; b.bar = bar; b.x = xb_xcc_id(); b.st = st;
    if (threadIdx.x == 0) (void)xb_add(&bar[XB_XCNT(b.x)], 1u);
    return b;
}
__device__ __forceinline__ void xcd_barrier_complete(unsigned* bar, unsigned x, unsigned& nloc, unsigned& nx) {
    const unsigned G = gridDim.x * gridDim.y * gridDim.z;
    unsigned sum, cnt, mine, sp = 0u;
    for (;;) {
        sum = 0u; cnt = 0u; mine = 0u;
#pragma unroll
        for (unsigned j = 0; j < 16; ++j) { const unsigned c = xb_ld(&bar[XB_XCNT(j)]); sum += c; cnt += (c > 0u) ? 1u : 0u; mine = (j == x) ? c : mine; }
        if (sum == G) break;
        __builtin_amdgcn_s_sleep(1);
        if ((++sp & 255u) == 0u) { if (xb_ld(&bar[XB_TMO])) break; if (sp > XB_SPIN_CAP) { atomicAdd(&bar[XB_TMO], 1u); break; } }
    }
    nloc = mine > 0u ? mine : 1u; nx = cnt > 0u ? cnt : 1u;
}

__device__ __forceinline__ void xcd_barrier(const XcdBarrier& b) {
    asm volatile("s_waitcnt vmcnt(0)" ::: "memory");
    __syncthreads();
    if (threadIdx.x == 0) {
        unsigned* bar = b.bar;
        __builtin_amdgcn_s_waitcnt(0);
        unsigned nloc = b.st[0], nx = b.st[1];
        if (nloc == 0u) { xcd_barrier_complete(bar, b.x, nloc, nx); b.st[0] = nloc; b.st[1] = nx; }
        const unsigned old = xb_add(&bar[XB_XSUB(b.x)], 1u);
        const unsigned gen = old / nloc;
        if (old + 1u == (gen + 1u) * nloc) {
            __builtin_amdgcn_fence(__ATOMIC_RELEASE, "agent");
            asm volatile("s_waitcnt vmcnt(0)" ::: "memory");
            const unsigned og = xb_add(&bar[XB_TOP], 1u);
            const unsigned tg = og / nx;
            if (og + 1u == (tg + 1u) * nx) xb_add(&bar[XB_TOPGEN], 1u);
            else XB_SPIN(xb_ld(&bar[XB_TOPGEN]) == tg, bar);
            __builtin_amdgcn_fence(__ATOMIC_ACQUIRE, "agent");
            xb_add(&bar[XB_XGEN(b.x)], 1u);
            asm volatile("s_waitcnt vmcnt(0)" ::: "memory");
        } else {
            XB_SPIN(xb_ld(&bar[XB_XGEN(b.x)]) == gen, bar);
            __builtin_amdgcn_fence(__ATOMIC_ACQUIRE, "agent");
            asm volatile("s_waitcnt vmcnt(0)" ::: "memory");
        }
    }
    __syncthreads();
}


#define PH(bit, call) { long long t0_ = 0; if (PROBE_PHASE == (bit)) t0_ = wall_clock64(); call; xcd_barrier(xb); if (PROBE_PHASE == (bit)) pacc += wall_clock64() - t0_; }
template <int L> __device__ __forceinline__ void run_layer(const Params& P, unsigned char* sm, const XcdBarrier& xb, long long& pacc) {
  if (L == 0) PH(0, phase_normmod(P, L))
  PH(1, phase_inproj(P, L, sm))
  PH(2, phase_rwprep(P, L, sm))
  PH(3, phase_D(P, L, sm, pacc))
  PH(4, phase_E(P, L, sm))
  PH(5, phase_F(P, L, sm, pacc))
  PH(6, phase_G(P, L, sm))
  PH(7, phase_outproj(P, L, sm))
  if (L == 0) PH(8, phase_post(P, L))
  else phase_post(P, L);
}
__global__ void __launch_bounds__(256, 2) mega_kernel(Params P) {
  __shared__ __attribute__((aligned(16))) unsigned char sm[SMEM_BYTES];
  __shared__ uint4 xb_words;
  cg::grid_group grid = cg::this_grid();
  long long pacc = 0;
  if (threadIdx.x == 0) xb_words = make_uint4(0u, 0u, 0u, 0u);
  __syncthreads();
  XcdBarrier xb = xcd_barrier_post((unsigned*)(P.ws + OFF_BAR), (volatile LAS unsigned*)&xb_words);
  if (P.ws == nullptr) grid.sync();
  PH(9, phase_prologue(P, sm))
  run_layer<0>(P, sm, xb, pacc);
  run_layer<1>(P, sm, xb, pacc);
  if (PROBE_PHASE >= 0 && blockIdx.x == 0 && threadIdx.x == 0) {
    long long t1 = wall_clock64();
    while (wall_clock64() - t1 < pacc) { __builtin_amdgcn_s_sleep(10); }
  }
}
__global__ void __launch_bounds__(256, 2) phase_kernel(Params P, int ph) {
  __shared__ __attribute__((aligned(16))) unsigned char sm[SMEM_BYTES];
  run_phase(P, ph, sm);
}

extern "C" void kernel_launch(void* const* d_in, const int* in_sizes, int n_in, void* d_out, int out_size,
                              void* d_ws, size_t ws_size, hipStream_t stream) {
  Params P{};
  const float** pp = (const float**)&P;
  for (int i = 0; i < 39; i++) pp[i] = (const float*)d_in[i];
  P.out = (float*)d_out;
  P.ws = (unsigned char*)d_ws;
  if (ws_size < WS_TOTAL) fprintf(stderr, "workspace too small: %zu < %zu\n", ws_size, (size_t)WS_TOTAL);
#if USE_COOP
  static int grid_blocks = 0;
  if (!grid_blocks) {
    int dev = 0, cus = 0, per_cu = 0;
    hipGetDevice(&dev);
    hipDeviceGetAttribute(&cus, hipDeviceAttributeMultiprocessorCount, dev);
    hipOccupancyMaxActiveBlocksPerMultiprocessor(&per_cu, mega_kernel, 256, 0);
    if (per_cu > 2) per_cu = 2;
    grid_blocks = cus * per_cu;
  }
  hipMemsetAsync((unsigned char*)d_ws + OFF_BAR, 0, 3456 * 4, stream);
  void* args[] = {&P};
  hipError_t e = hipLaunchCooperativeKernel((void*)mega_kernel, dim3(grid_blocks), dim3(256), args, 0, stream);
  if (e != hipSuccess) fprintf(stderr, "cooperative launch failed: %s (grid %d)\n", hipGetErrorString(e), grid_blocks);
#else
  for (int ph = 0; ph < NPHASE; ph++) phase_kernel<<<1024, 256, 0, stream>>>(P, ph);
#endif
}
#endif
```

```cpp
#ifdef CPU_EMU
#include "hip_emu.h"
#else
#include <hip/hip_runtime.h>
#include <hip/hip_cooperative_groups.h>
#include <stdint.h>
#include <stdio.h>
namespace cg = cooperative_groups;
#endif

#ifndef BATCH
#define BATCH 8
#endif
#ifndef SEQ
#define SEQ 4096
#endif
#ifndef CTX
#define CTX 256
#endif
#ifndef USE_COOP
#define USE_COOP 1
#endif
#ifndef PROBE_PHASE
#define PROBE_PHASE -1
#endif

typedef unsigned short bf16;
typedef __attribute__((ext_vector_type(8))) short bf16x8;
typedef __attribute__((ext_vector_type(16))) float f32x16;
struct alignas(16) U4 { uint32_t a[4]; };
typedef uint32_t u32x4 __attribute__((ext_vector_type(4)));
struct alignas(8) U2 { uint32_t a[2]; };
struct alignas(16) F4 { float a[4]; };

constexpr int D = 1024, NIN = 3368, NINP = 3456;
constexpr int ROWS_C = BATCH * CTX, ROWS_L = BATCH * SEQ, ROWS = ROWS_C + ROWS_L;
constexpr int VL = CTX + SEQ;
constexpr int TC = 64;
constexpr int NCH_C = CTX / TC, NCH_L = SEQ / TC, NCH = NCH_C + NCH_L;
constexpr int T5 = 32;
constexpr int NC5 = CTX / T5, NL5 = SEQ / T5, NCH5 = NC5 + NL5;
constexpr int M5 = BATCH * NCH5;
constexpr int NMOD = BATCH + 1;
constexpr int C_RW = 0, C_RWG = 1024, C_S5 = 1280, C_S5G = 1536, C_SSD = 1792, C_SSDDT = 2304, C_SSDZ = 2312;
constexpr int C_GLA = 2568, C_GLAK = 2696, C_GLAV = 2824, C_GLAGL = 3080, C_GLAG = 3112;

constexpr size_t al256(size_t x) { return (x + 255) & ~size_t(255); }
constexpr size_t OFF_WTIN = 0;
constexpr size_t OFF_WTOUT = OFF_WTIN + al256(2ull * NINP * D * 2);
constexpr size_t OFF_W2T = OFF_WTOUT + al256(2ull * D * D * 2);
constexpr size_t OFF_A2T = OFF_W2T + al256(2ull * 2 * 256 * 64 * 2);
constexpr size_t OFF_GLUT = OFF_A2T + al256(2ull * 2 * 256 * 64 * 2);
constexpr size_t OFF_MOD = OFF_GLUT + al256(2ull * 256 * 256 * 2);
constexpr size_t OFF_S5K = OFF_MOD + al256(2ull * NMOD * 3072 * 4);
constexpr size_t OFF_S5LT = OFF_S5K + al256(2ull * 16 * 2 * 32 * 256 * 4);
constexpr size_t OFF_W1T = OFF_S5LT + al256(2ull * 16 * 2 * 64 * 2 * 4);
constexpr size_t OFF_BT2 = OFF_W1T + al256(2ull * 16 * 256 * 512 * 2);
constexpr size_t OFF_PROJ = OFF_BT2 + al256(2ull * 16 * 512 * 768 * 2);
constexpr size_t OFF_R = OFF_PROJ + al256((size_t)ROWS * NIN * 2);
constexpr size_t OFF_XA = OFF_R + al256((size_t)ROWS * 1024 * 2);
constexpr size_t OFF_HC = OFF_XA + al256((size_t)ROWS * 1024 * 2);
constexpr size_t OFF_SSDST = OFF_HC + al256((size_t)ROWS_C * 1024 * 4);
constexpr size_t OFF_SSDDEC = OFF_SSDST + al256(2ull * BATCH * NCH * 4 * 4096 * 2);
constexpr size_t OFF_GLAST = OFF_SSDDEC + al256(2ull * BATCH * NCH * 4 * 4);
constexpr size_t OFF_GLADEC = OFF_GLAST + al256(2ull * BATCH * NCH * 4 * 2048 * 2);
constexpr size_t OFF_S5ST = OFF_GLADEC + al256(2ull * BATCH * NCH * 4 * 32 * 4);
constexpr size_t OFF_SSQ = OFF_S5ST + al256(16ull * M5 * 256 * 4);
constexpr size_t OFF_BON = OFF_SSQ + al256((size_t)ROWS * 4 * 4);
constexpr size_t OFF_BAR = OFF_BON + al256((size_t)ROWS * 8 * 4);
constexpr size_t WS_TOTAL = OFF_BAR + al256(3456 * 4);
#if BATCH == 8 && SEQ == 4096 && CTX == 256
static_assert(WS_TOTAL <= 536870912ull, "workspace too large");
#endif
constexpr int SMEM_BYTES = 64512;

struct Params {
  const float *x, *c, *ctx, *c_ctx, *ada_w, *ada_b, *norm_pre, *norm_post, *w_in, *w_out;
  const float *rw_mu, *rw_w0, *rw_w2, *rw_a0, *rw_a2, *rw_kk, *rw_ka, *rw_rk, *rw_ln_w, *rw_ln_b;
  const float *s5_a_re, *s5_a_im, *s5_log_dt, *s5_b_re, *s5_b_im, *s5_c_re, *s5_c_im, *s5_d, *s5_glu_w, *s5_glu_b;
  const float *ssd_conv_w, *ssd_conv_b, *ssd_dt_bias, *ssd_a_log, *ssd_d, *ssd_norm;
  const float *gla_g2, *gla_gb, *gla_norm;
  float* out;
  unsigned char* ws;
};

#ifdef CPU_EMU
#define OPAQUE(x)
#else
#define OPAQUE(x) asm volatile("" : "+v"(x))
#endif
__device__ __forceinline__ float bf2f(bf16 v) { return __uint_as_float(((uint32_t)v) << 16); }
__device__ __forceinline__ bf16 f2bf(float f) {
  uint32_t u = __float_as_uint(f);
  u += 0x7fffu + ((u >> 16) & 1u);
  return (bf16)(u >> 16);
}
__device__ __forceinline__ uint32_t pack2(float lo, float hi) { return (uint32_t)f2bf(lo) | ((uint32_t)f2bf(hi) << 16); }
__device__ __forceinline__ float lo2f(uint32_t u) { return __uint_as_float(u << 16); }
__device__ __forceinline__ float hi2f(uint32_t u) { return __uint_as_float(u & 0xffff0000u); }
__device__ __forceinline__ float sigmoid_f(float x) { return 1.f / (1.f + __expf(-x)); }
__device__ __forceinline__ float silu_f(float x) { return x / (1.f + __expf(-x)); }
__device__ __forceinline__ float softplus_f(float x) { return fmaxf(x, 0.f) + __logf(1.f + __expf(-fabsf(x))); }
__device__ __forceinline__ float tanh_f(float x) { return 1.f - 2.f / (1.f + __expf(2.f * x)); }
__device__ __forceinline__ float gelu_f(float x) {
  return 0.5f * x * (1.f + tanh_f(0.7978845608028654f * (x + 0.044715f * x * x * x)));
}
__device__ __forceinline__ U4 zero4() { U4 r; r.a[0] = r.a[1] = r.a[2] = r.a[3] = 0; return r; }
__device__ __forceinline__ f32x16 mfma32(bf16x8 a, bf16x8 b, f32x16 c) {
#ifdef CPU_EMU
  return emu_mfma32(a, b, c);
#else
  return __builtin_amdgcn_mfma_f32_32x32x16_bf16(a, b, c, 0, 0, 0);
#endif
}
__device__ __forceinline__ f32x16 zero16() { f32x16 z; for (int i = 0; i < 16; i++) z[i] = 0.f; return z; }
__device__ __forceinline__ int acc_row(int reg, int lane) { return (reg & 3) + 8 * (reg >> 2) + 4 * (lane >> 5); }
template <int CTRL> __device__ __forceinline__ float dpp_mov(float v) {
#ifdef CPU_EMU
  int l = threadIdx.x & 63, src;
  if (CTRL == 0xB1) src = l ^ 1; else if (CTRL == 0x4E) src = l ^ 2;
  else if (CTRL == 0x141) src = (l & ~7) | (7 - (l & 7)); else src = (l & ~15) | (15 - (l & 15));
  return emu_lane_read(v, src);
#else
  return __int_as_float(__builtin_amdgcn_update_dpp(0, __float_as_int(v), CTRL, 0xF, 0xF, true));
#endif
}
__device__ __forceinline__ float sum16(float v) {
  v += dpp_mov<0xB1>(v); v += dpp_mov<0x4E>(v); v += dpp_mov<0x141>(v); v += dpp_mov<0x140>(v); return v;
}
__device__ __forceinline__ float sum32(float v) {
  v = sum16(v);
#ifdef CPU_EMU
  int l = threadIdx.x & 63; float o = emu_lane_read(v, ((l >> 4) > 0 ? ((l >> 4) - 1) * 16 + 15 : 0));
  if ((l >> 4) & 1) v += o;
#else
  v += __int_as_float(__builtin_amdgcn_update_dpp(0, __float_as_int(v), 0x142, 0xA, 0xF, false));
#endif
  return v;
}
__device__ __forceinline__ float sum64(float v) {
  v = sum16(v);
#ifdef CPU_EMU
  return emu_lane_read(v, 0) + emu_lane_read(v, 16) + emu_lane_read(v, 32) + emu_lane_read(v, 48);
#else
  int iv = __float_as_int(v);
  return __int_as_float(__builtin_amdgcn_readlane(iv, 0)) + __int_as_float(__builtin_amdgcn_readlane(iv, 16)) +
         __int_as_float(__builtin_amdgcn_readlane(iv, 32)) + __int_as_float(__builtin_amdgcn_readlane(iv, 48));
#endif
}

__device__ __forceinline__ const bf16x8& ldsfrag(const bf16* p) { return *(const bf16x8*)p; }

__device__ __forceinline__ int chunk_row0(int b, int pc, int T, int nC) {
  return pc < nC ? b * CTX + pc * T : ROWS_C + b * SEQ + (pc - nC) * T;
}
__device__ __forceinline__ int ord_chunk(int d, int vc, int nC, int nAll) {
  return d == 0 ? vc : (vc < nC ? nC - 1 - vc : nAll - 1 - (vc - nC));
}
struct RowInfo { int isctx, b, t, seq0, len; };
__device__ __forceinline__ RowInfo row_info(int m) {
  RowInfo r;
  if (m < ROWS_C) { r.isctx = 1; r.b = m / CTX; r.t = m - r.b * CTX; r.seq0 = r.b * CTX; r.len = CTX; }
  else { int q = m - ROWS_C; r.isctx = 0; r.b = q / SEQ; r.t = q - r.b * SEQ; r.seq0 = ROWS_C + r.b * SEQ; r.len = SEQ; }
  return r;
}

template <class AL, class BL, class EP>
__device__ __forceinline__ void gemm_tile(unsigned char* sm, int m0, int n0, int K, AL al, BL bl, EP ep) {
  bf16* sA0 = (bf16*)sm;
  int tid_ = threadIdx.x; OPAQUE(tid_);
  const int tid = tid_, lane = tid & 63, w = tid >> 6, wm = w >> 1, wn = w & 1;
  f32x16 acc[2][2];
#pragma unroll
  for (int i = 0; i < 2; i++)
#pragma unroll
    for (int j = 0; j < 2; j++) acc[i][j] = zero16();
  const int lr = tid >> 2, lk = (tid & 3) * 8;
  U4 ra0 = al(m0 + lr, lk), ra1 = al(m0 + lr + 64, lk), rb0 = bl(n0 + lr, lk), rb1 = bl(n0 + lr + 64, lk);
  {
    bf16* sA = sA0; bf16* sB = sA + 128 * 40;
    *(U4*)&sA[lr * 40 + lk] = ra0; *(U4*)&sA[(lr + 64) * 40 + lk] = ra1;
    *(U4*)&sB[lr * 40 + lk] = rb0; *(U4*)&sB[(lr + 64) * 40 + lk] = rb1;
  }
  if (32 < K) { ra0 = al(m0 + lr, 32 + lk); ra1 = al(m0 + lr + 64, 32 + lk); rb0 = bl(n0 + lr, 32 + lk); rb1 = bl(n0 + lr + 64, 32 + lk); }
  __syncthreads();
  int cur = 0;
#pragma unroll 1
  for (int k0 = 0; k0 < K; k0 += 32) {
    bf16* sA = sA0 + cur * (256 * 40); bf16* sB = sA + 128 * 40;
    if (k0 + 32 < K) {
      bf16* nA = sA0 + (cur ^ 1) * (256 * 40); bf16* nB = nA + 128 * 40;
      *(U4*)&nA[lr * 40 + lk] = ra0; *(U4*)&nA[(lr + 64) * 40 + lk] = ra1;
      *(U4*)&nB[lr * 40 + lk] = rb0; *(U4*)&nB[(lr + 64) * 40 + lk] = rb1;
      if (k0 + 64 < K) {
        ra0 = al(m0 + lr, k0 + 64 + lk); ra1 = al(m0 + lr + 64, k0 + 64 + lk);
        rb0 = bl(n0 + lr, k0 + 64 + lk); rb1 = bl(n0 + lr + 64, k0 + 64 + lk);
      }
    }
#pragma unroll
    for (int ks = 0; ks < 32; ks += 16) {
      bf16x8 fa[2], fb[2];
#pragma unroll
      for (int i = 0; i < 2; i++) fa[i] = ldsfrag(&sA[(wm * 64 + i * 32 + (lane & 31)) * 40 + ks + 8 * (lane >> 5)]);
#pragma unroll
      for (int j = 0; j < 2; j++) fb[j] = ldsfrag(&sB[(wn * 64 + j * 32 + (lane & 31)) * 40 + ks + 8 * (lane >> 5)]);
#pragma unroll
      for (int i = 0; i < 2; i++)
#pragma unroll
        for (int j = 0; j < 2; j++) acc[i][j] = mfma32(fa[i], fb[j], acc[i][j]);
    }
    __syncthreads();
    cur ^= 1;
  }
#pragma unroll
  for (int i = 0; i < 2; i++)
#pragma unroll
   for (int j = 0; j < 2; j++)
#pragma unroll
    for (int r = 0; r < 16; r++)
      ep(m0 + wm * 64 + i * 32 + acc_row(r, lane), n0 + wn * 64 + j * 32 + (lane & 31), acc[i][j][r]);
}

template <class AL, class BL, class EP>
__device__ __forceinline__ void gemm_tile_big(unsigned char* sm, int m0, int n0, int K, AL al, BL bl, EP ep) {
  bf16* sA0 = (bf16*)sm;
  int tid_ = threadIdx.x; OPAQUE(tid_);
  const int tid = tid_, lane = tid & 63, w = tid >> 6, wm = w >> 1, wn = w & 1;
  f32x16 acc[4][2];
#pragma unroll
  for (int i = 0; i < 4; i++)
#pragma unroll
    for (int j = 0; j < 2; j++) acc[i][j] = zero16();
  const int lr = tid >> 2, lk = (tid & 3) * 8;
  U4 ra[4], rb[2];
#pragma unroll
  for (int i = 0; i < 4; i++) ra[i] = al(m0 + lr + 64 * i, lk);
#pragma unroll
  for (int i = 0; i < 2; i++) rb[i] = bl(n0 + lr + 64 * i, lk);
  {
    bf16* sA = sA0; bf16* sB = sA + 256 * 40;
#pragma unroll
    for (int i = 0; i < 4; i++) *(U4*)&sA[(lr + 64 * i) * 40 + lk] = ra[i];
#pragma unroll
    for (int i = 0; i < 2; i++) *(U4*)&sB[(lr + 64 * i) * 40 + lk] = rb[i];
  }
  if (32 < K) {
#pragma unroll
    for (int i = 0; i < 4; i++) ra[i] = al(m0 + lr + 64 * i, 32 + lk);
#pragma unroll
    for (int i = 0; i < 2; i++) rb[i] = bl(n0 + lr + 64 * i, 32 + lk);
  }
  __syncthreads();
  int cur = 0;
#pragma unroll 2
  for (int k0 = 0; k0 < K; k0 += 32) {
    bf16* sA = sA0 + cur * (384 * 40); bf16* sB = sA + 256 * 40;
    if (k0 + 32 < K) {
      bf16* nA = sA0 + (cur ^ 1) * (384 * 40); bf16* nB = nA + 256 * 40;
#pragma unroll
      for (int i = 0; i < 4; i++) *(U4*)&nA[(lr + 64 * i) * 40 + lk] = ra[i];
#pragma unroll
      for (int i = 0; i < 2; i++) *(U4*)&nB[(lr + 64 * i) * 40 + lk] = rb[i];
      if (k0 + 64 < K) {
#pragma unroll
        for (int i = 0; i < 4; i++) ra[i] = al(m0 + lr + 64 * i, k0 + 64 + lk);
#pragma unroll
        for (int i = 0; i < 2; i++) rb[i] = bl(n0 + lr + 64 * i, k0 + 64 + lk);
      }
    }
#pragma unroll
    for (int ks = 0; ks < 32; ks += 16) {
      bf16x8 fa[4], fb[2];
#pragma unroll
      for (int i = 0; i < 4; i++) fa[i] = ldsfrag(&sA[(wm * 128 + i * 32 + (lane & 31)) * 40 + ks + 8 * (lane >> 5)]);
#pragma unroll
      for (int j = 0; j < 2; j++) fb[j] = ldsfrag(&sB[(wn * 64 + j * 32 + (lane & 31)) * 40 + ks + 8 * (lane >> 5)]);
#pragma unroll
      for (int i = 0; i < 4; i++)
#pragma unroll
        for (int j = 0; j < 2; j++) acc[i][j] = mfma32(fa[i], fb[j], acc[i][j]);
    }
    __syncthreads();
    cur ^= 1;
  }
#pragma unroll
  for (int i = 0; i < 4; i++)
#pragma unroll
    for (int j = 0; j < 2; j++)
#pragma unroll
      for (int r = 0; r < 16; r++)
        ep(m0 + wm * 128 + i * 32 + acc_row(r, lane), n0 + wn * 64 + j * 32 + (lane & 31), acc[i][j][r]);
}

#define ITEM_LOOP(var, count, base) _Pragma("unroll 1") for (int var = (int)((blockIdx.x + gridDim.x - ((unsigned)(base) % gridDim.x)) % gridDim.x); var < (count); var += gridDim.x)
#define WS(T, off) ((T*)(P.ws + (off)))

__device__ __forceinline__ void transpose_tile(const float* src, int ld, int Ksz, int Nsz, bf16* dst, int kt, int nt, unsigned char* sm, bool perm = false) {
  float* s = (float*)sm;
  const int tid = threadIdx.x;
#pragma unroll 8
  for (int i = tid; i < 4096; i += 256) {
    int kk = i >> 6, nn = i & 63;
    int k = kt * 64 + kk, n = nt * 64 + nn;
    s[kk * 65 + nn] = (n < Nsz && k < Ksz) ? src[(size_t)k * ld + n] : 0.f;
  }
  __syncthreads();
#pragma unroll 8
  for (int i = tid; i < 4096; i += 256) {
    int nn = i >> 6, kk = i & 63;
    int ktd = perm ? (kt < 4 ? kt + 8 : (kt >= 8 && kt < 12) ? kt - 8 : kt) : kt;
    dst[(size_t)(nt * 64 + nn) * Ksz + ktd * 64 + kk] = f2bf(s[kk * 65 + nn]);
  }
  __syncthreads();
}

struct S5c { float lr, li, dt; };
__device__ __forceinline__ void s5_pow(const Params& P, int l, int d, int g, int p, float e, float& re, float& im) {
  int idx = ((l * 2 + d) * 16 + g) * 64 + p;
  float dt = __expf(P.s5_log_dt[(l * 2 + d) * 16 + g]);
  float ar = P.s5_a_re[idx] * dt * e, ai = P.s5_a_im[idx] * dt * e;
  float m = expf(ar);
  re = m * cosf(ai); im = m * sinf(ai);
}
__device__ __forceinline__ void s5_bbar_coef(const Params& P, int l, int d, int g, int p, float& re, float& im) {
  int idx = ((l * 2 + d) * 16 + g) * 64 + p;
  float lr = P.s5_a_re[idx], li = P.s5_a_im[idx];
  float br, bi; s5_pow(P, l, d, g, p, 1.f, br, bi);
  br -= 1.f;
  float den = lr * lr + li * li;
  re = (br * lr + bi * li) / den;
  im = (bi * lr - br * li) / den;
}

__device__ __forceinline__ void phase_prologue(const Params& P, unsigned char* sm) {
  const int tid = threadIdx.x;
  const int N_TIN = 2 * 16 * (NINP / 64);
  const int N_TOUT = 2 * 16 * 16;
  const int N_TL = 2 * 2 * 4;
  const int N_TA = 2 * 2 * 4;
  const int N_TG = 2 * 16;
  const int N_MOD = 2 * 48;
  const int N_S5K = 2 * 16 * 2 * 32;
  const int N_S5W1 = 2 * 16 * 32;
  const int N_S5B2 = 2 * 16 * 32;
  const int total = N_TIN + N_TOUT + N_TL + N_TA + N_TG + N_MOD + N_S5K + N_S5W1 + N_S5B2;
#pragma unroll 1
  for (int it = blockIdx.x; it < total; it += gridDim.x) {
    int i = it;
    if (i < N_TIN) {
      int l = i / (16 * (NINP / 64)), r = i % (16 * (NINP / 64));
      transpose_tile(P.w_in + (size_t)l * D * NIN, NIN, D, NIN, WS(bf16, OFF_WTIN) + (size_t)l * NINP * D, r % 16, r / 16, sm);
      continue;
    }
    i -= N_TIN;
    if (i < N_TOUT) {
      int l = i / 256, r = i % 256;
      transpose_tile(P.w_out + (size_t)l * D * D, D, D, D, WS(bf16, OFF_WTOUT) + (size_t)l * D * D, r % 16, r / 16, sm, true);
      continue;
    }
    i -= N_TOUT;
    if (i < N_TL) {
      int ld = i / 4, nt = i % 4;
      transpose_tile(P.rw_w2 + (size_t)ld * 64 * 256, 256, 64, 256, WS(bf16, OFF_W2T) + (size_t)ld * 256 * 64, 0, nt, sm);
      continue;
    }
    i -= N_TL;
    if (i < N_TA) {
      int ld = i / 4, nt = i % 4;
      transpose_tile(P.rw_a2 + (size_t)ld * 64 * 256, 256, 64, 256, WS(bf16, OFF_A2T) + (size_t)ld * 256 * 64, 0, nt, sm);
      continue;
    }
    i -= N_TA;
    if (i < N_TG) {
      int l = i / 16, r = i % 16;
      transpose_tile(P.s5_glu_w + (size_t)l * 256 * 256, 256, 256, 256, WS(bf16, OFF_GLUT) + (size_t)l * 256 * 256, r % 4, r / 4, sm);
      continue;
    }
    i -= N_TG;
    if (i < N_MOD) {
      int l = i / 48, ct = i % 48;
      float* ssil = (float*)sm;
      float* red = ssil + NMOD * 1024;
#pragma unroll 8
      for (int e = tid; e < NMOD * 1024; e += 256) {
        int r = e >> 10, k = e & 1023;
        float v = r < BATCH ? P.c[r * 1024 + k] : P.c_ctx[k];
        ssil[e] = silu_f(v);
      }
      __syncthreads();
      int kq = tid >> 6, jj = tid & 63, j = ct * 64 + jj;
      float acc[NMOD];
      for (int r = 0; r < NMOD; r++) acc[r] = 0.f;
      const float* wp = P.ada_w + (size_t)l * D * 3072 + j;
#pragma unroll 16
      for (int k = kq * 256; k < kq * 256 + 256; k++) {
        float wv = wp[(size_t)k * 3072];
#pragma unroll
        for (int r = 0; r < NMOD; r++) acc[r] += ssil[r * 1024 + k] * wv;
      }
#pragma unroll
      for (int r = 0; r < NMOD; r++) red[(kq * NMOD + r) * 64 + jj] = acc[r];
      __syncthreads();
#pragma unroll 8
      for (int e = tid; e < NMOD * 64; e += 256) {
        int r = e >> 6, j2 = e & 63;
        float s = red[(0 * NMOD + r) * 64 + j2] + red[(1 * NMOD + r) * 64 + j2] + red[(2 * NMOD + r) * 64 + j2] + red[(3 * NMOD + r) * 64 + j2];
        WS(float, OFF_MOD)[((size_t)l * NMOD + r) * 3072 + ct * 64 + j2] = s + P.ada_b[l * 3072 + ct * 64 + j2];
      }
      __syncthreads();
      continue;
    }
    i -= N_MOD;
    if (i < N_S5K) {
      int m = i & 31, d = (i >> 5) & 1, g = (i >> 6) & 15, l = i >> 10;
      float* spw = (float*)sm;
      if (tid < 64) {
        float pr, pi, cr, ci;
        s5_pow(P, l, d, g, tid, (float)m, pr, pi);
        s5_bbar_coef(P, l, d, g, tid, cr, ci);
        spw[tid * 2] = pr * cr - pi * ci; spw[tid * 2 + 1] = pr * ci + pi * cr;
      }
      __syncthreads();
      int c = tid >> 4, cp = tid & 15;
      size_t bb = ((size_t)((l * 2 + d) * 16 + g) * 64) * 16;
      size_t cb = ((size_t)((l * 2 + d) * 16 + g) * 16 + c) * 64;
      float s = 0.f;
#pragma unroll 8
      for (int p = 0; p < 64; p++) {
        float wr = spw[p * 2], wi = spw[p * 2 + 1];
        float br = P.s5_b_re[bb + p * 16 + cp], bi = P.s5_b_im[bb + p * 16 + cp];
        float zr = wr * br - wi * bi, zi = wr * bi + wi * br;
        float cr = P.s5_c_re[cb + p], ci = P.s5_c_im[cb + p];
        s += cr * zr - ci * zi;
      }
      WS(float, OFF_S5K)[((size_t)(((l * 16 + g) * 2 + d) * 32 + m)) * 256 + tid] = s;
      __syncthreads();
      continue;
    }
    i -= N_S5K;
    if (i < N_S5W1) {
      int j = i & 31, g = (i >> 5) & 15, l = i >> 9;
      int pp = tid, d = pp >> 7, ri = (pp >> 6) & 1, p = pp & 63;
      float e = d == 0 ? (float)(T5 - 1 - j) : (float)j;
      float pr, pi, cr, ci;
      s5_pow(P, l, d, g, p, e, pr, pi);
      s5_bbar_coef(P, l, d, g, p, cr, ci);
      float wr = pr * cr - pi * ci, wi = pr * ci + pi * cr;
      size_t bb = ((size_t)((l * 2 + d) * 16 + g) * 64 + p) * 16;
      bf16* dst = WS(bf16, OFF_W1T) + ((size_t)(l * 16 + g) * 256 + pp) * 512 + j * 16;
      for (int cp = 0; cp < 16; cp++) {
        float br = P.s5_b_re[bb + cp], bi = P.s5_b_im[bb + cp];
        float zr = wr * br - wi * bi, zi = wr * bi + wi * br;
        dst[cp] = f2bf(ri == 0 ? zr : zi);
      }
      if (j == 0 && ri == 0) {
        float tr, ti; s5_pow(P, l, d, g, p, (float)T5, tr, ti);
        float* lt = WS(float, OFF_S5LT) + ((size_t)((l * 16 + g) * 2 + d) * 64 + p) * 2;
        lt[0] = tr; lt[1] = ti;
      }
      continue;
    }
    i -= N_S5W1;
    {
      int t = i & 31, g = (i >> 5) & 15, l = i >> 9;
      int kk = tid, d = kk >> 7, ri = (kk >> 6) & 1, p = kk & 63;
      float e = d == 0 ? (float)(t + 1) : (float)(T5 - t);
      float pr, pi; s5_pow(P, l, d, g, p, e, pr, pi);
      for (int c = 0; c < 16; c++) {
        size_t cb = ((size_t)((l * 2 + d) * 16 + g) * 16 + c) * 64 + p;
        float cr = P.s5_c_re[cb], ci = P.s5_c_im[cb];
        float zr = cr * pr - ci * pi, zi = cr * pi + ci * pr;
        WS(bf16, OFF_BT2)[((size_t)(l * 16 + g) * 512 + t * 16 + c) * 768 + 512 + kk] = f2bf(ri == 0 ? zr : -zi);
      }
    }
  }
}

__device__ __forceinline__ void s5_toeplitz_items(const Params& P, int item) {
  int t = item & 31, g = (item >> 5) & 15, l = item >> 9;
  const float* K = WS(float, OFF_S5K) + (size_t)((l * 16 + g) * 2) * 32 * 256;
  bf16* dst = WS(bf16, OFF_BT2) + ((size_t)(l * 16 + g) * 512 + t * 16) * 768;
#pragma unroll 8
  for (int e = threadIdx.x; e < 16 * 512; e += 256) {
    int c = e >> 9, k = e & 511, j = k >> 4, cp = k & 15;
    float v;
    if (j < t) v = K[((0 * 32) + (t - j)) * 256 + c * 16 + cp];
    else if (j > t) v = K[((1 * 32) + (j - t)) * 256 + c * 16 + cp];
    else v = K[(0 * 32) * 256 + c * 16 + cp] + K[(1 * 32) * 256 + c * 16 + cp];
    dst[(size_t)c * 768 + k] = f2bf(v);
  }
}

__device__ __forceinline__ void phase_normmod(const Params& P, int l) {
  const int lane = threadIdx.x & 63, w = threadIdx.x >> 6;
  const int nrow_items = ROWS / 4;
  const int n_toe = (l == 0) ? 2 * 16 * 32 : 0;
#pragma unroll 1
  for (int it = blockIdx.x; it < nrow_items + n_toe; it += gridDim.x) {
    if (it >= nrow_items) { s5_toeplitz_items(P, it - nrow_items); continue; }
    int m = it * 4 + w;
    RowInfo ri = row_info(m);
    const float* src;
    if (ri.isctx) src = (l == 0 ? P.ctx : WS(float, OFF_HC)) + (size_t)m * D;
    else src = (l == 0 ? P.x : P.out) + (size_t)(m - ROWS_C) * D;
    const float* mod = WS(float, OFF_MOD) + ((size_t)l * NMOD + (ri.isctx ? BATCH : ri.b)) * 3072;
    F4 v[4]; float ss = 0.f;
    for (int q = 0; q < 4; q++) {
      v[q] = *(const F4*)(src + q * 256 + lane * 4);
      for (int e = 0; e < 4; e++) ss += v[q].a[e] * v[q].a[e];
    }
    ss = sum64(ss);
    float rstd = rsqrtf(ss * (1.f / 1024.f) + 1e-6f);
    bf16* dst = WS(bf16, OFF_R) + (size_t)m * D;
    for (int q = 0; q < 4; q++) {
      int c0 = q * 256 + lane * 4;
      float o[4];
      for (int e = 0; e < 4; e++) {
        int c = c0 + e;
        o[e] = v[q].a[e] * rstd * P.norm_pre[l * D + c] * (1.f + mod[1024 + c]) + mod[c];
      }
      U2 pk; pk.a[0] = pack2(o[0], o[1]); pk.a[1] = pack2(o[2], o[3]);
      *(U2*)(dst + c0) = pk;
    }
  }
}

__device__ __forceinline__ void phase_inproj(const Params& P, int l, unsigned char* sm) {
  const bf16* A = WS(bf16, OFF_R);
  const bf16* Bt = WS(bf16, OFF_WTIN) + (size_t)l * NINP * D;
  bf16* C = WS(bf16, OFF_PROJ);
  const int NT = NINP / 128, MT = ROWS / 256;
  const int total = MT * NT, per = total / 8;
  const int nfull = (total / (int)gridDim.x) * (int)gridDim.x;
#pragma unroll 1
  for (int it0 = blockIdx.x; it0 < nfull; it0 += gridDim.x) {
    int it = total % 8 == 0 ? (it0 & 7) * per + (it0 >> 3) : it0;
    int mt = it / NT, nt = it % NT;
    gemm_tile_big(sm, mt * 256, nt * 128, D,
      [&](int m, int k) { return *(const U4*)(A + (size_t)m * D + k); },
      [&](int n, int k) { return *(const U4*)(Bt + (size_t)n * D + k); },
      [&](int m, int n, float v) { if (n < NIN) C[(size_t)m * NIN + n] = f2bf(v); });
  }
#pragma unroll 1
  for (int q = blockIdx.x; q < 2 * (total - nfull); q += gridDim.x) {
    int it0 = nfull + (q >> 1), half = q & 1;
    int it = total % 8 == 0 ? (it0 & 7) * per + (it0 >> 3) : it0;
    int mt = it / NT, nt = it % NT;
    gemm_tile(sm, mt * 256 + half * 128, nt * 128, D,
      [&](int m, int k) { return *(const U4*)(A + (size_t)m * D + k); },
      [&](int n, int k) { return *(const U4*)(Bt + (size_t)n * D + k); },
      [&](int m, int n, float v) { if (n < NIN) C[(size_t)m * NIN + n] = f2bf(v); });
  }
}

__device__ __forceinline__ void rw_lerp4(const Params& P, int l, int m, int ms, int col, float* o) {
  const bf16* pr = WS(bf16, OFF_PROJ);
  U2 z = *(const U2*)(pr + (size_t)m * NIN + col);
  U2 zs; zs.a[0] = zs.a[1] = 0;
  if (ms >= 0) zs = *(const U2*)(pr + (size_t)ms * NIN + col);
  const float* mu = P.rw_mu + l * 1024 + col;
#pragma unroll
  for (int e = 0; e < 2; e++) {
    float a0 = lo2f(z.a[e]), a1 = hi2f(z.a[e]), s0 = lo2f(zs.a[e]), s1 = hi2f(zs.a[e]);
    o[2 * e] = a0 + mu[2 * e] * (s0 - a0);
    o[2 * e + 1] = a1 + mu[2 * e + 1] * (s1 - a1);
  }
}
__device__ __forceinline__ void phase_rwprep(const Params& P, int l, unsigned char* sm) {
  const int lane = threadIdx.x & 63, w = threadIdx.x >> 6;
  const int MT = ROWS / 128;
  const int n_gemm = MT * 2 * 4;
  const int n_rows = ROWS / 4;
  bf16* XA = WS(bf16, OFF_XA);
#pragma unroll 1
  for (int it = blockIdx.x; it < n_gemm + n_rows; it += gridDim.x) {
    if (it < n_gemm) {
      int kind = it & 3, nt = (it >> 2) & 1, mt = it >> 3;
      int isA = kind >> 1, d = kind & 1;
      const bf16* Bt = (isA ? WS(bf16, OFF_A2T) : WS(bf16, OFF_W2T)) + (size_t)(l * 2 + d) * 256 * 64;
      const float* bias = (isA ? P.rw_a0 : P.rw_w0) + (l * 2 + d) * 256;
      gemm_tile(sm, mt * 128, nt * 128, 64,
        [&](int m, int k) {
          RowInfo ri = row_info(m);
          int ms;
          if (ri.isctx) ms = ri.t < CTX - 1 ? m + 1 : -1; else ms = ri.t < SEQ - 64 ? m + 64 : -1;
          int col = 768 + isA * 128 + d * 64 + k;
          const bf16* prj = WS(bf16, OFF_PROJ);
          U4 z = *(const U4*)(prj + (size_t)m * NIN + col);
          U4 zs = ms >= 0 ? *(const U4*)(prj + (size_t)ms * NIN + col) : zero4();
          const float* mu = P.rw_mu + l * 1024 + col;
          U4 r;
#pragma unroll
          for (int e = 0; e < 4; e++) {
            float a0 = lo2f(z.a[e]), a1 = hi2f(z.a[e]), s0 = lo2f(zs.a[e]), s1 = hi2f(zs.a[e]);
            float o0 = a0 + mu[2 * e] * (s0 - a0), o1 = a1 + mu[2 * e + 1] * (s1 - a1);
            if (!isA) { o0 = tanh_f(o0); o1 = tanh_f(o1); }
            r.a[e] = pack2(o0, o1);
          }
          return r;
        },
        [&](int n, int k) { return *(const U4*)(Bt + (size_t)n * 64 + k); },
        [&](int m, int n, float v) {
          v += bias[n];
          float o;
          if (!isA) { o = -__expf(-softplus_f(-v) - 0.5f); }
          else o = sigmoid_f(v);
          XA[(size_t)m * 1024 + isA * 512 + d * 256 + n] = f2bf(o);
        });
      continue;
    }
    int m = (it - n_gemm) * 4 + w;
    RowInfo ri = row_info(m);
    int ms_r, ms_k, ms_v;
    if (ri.isctx) { ms_r = ms_k = ri.t > 0 ? m - 1 : -1; ms_v = ri.t < CTX - 1 ? m + 1 : -1; }
    else {
      int gx = ri.t & 63;
      ms_r = gx > 0 ? m - 1 : -1; ms_k = gx < 63 ? m + 1 : -1; ms_v = ri.t >= 64 ? m - 64 : -1;
    }
    bf16* R = WS(bf16, OFF_R) + (size_t)m * 1024;
    float rr[4], kk[4], vv[4], kap[4];
    rw_lerp4(P, l, m, ms_r, lane * 4, rr);
    rw_lerp4(P, l, m, ms_k, 256 + lane * 4, kk);
    rw_lerp4(P, l, m, ms_v, 512 + lane * 4, vv);
    float ss = 0.f;
    for (int e = 0; e < 4; e++) { kap[e] = kk[e] * P.rw_kk[l * 256 + lane * 4 + e]; ss += kap[e] * kap[e]; }
    ss = sum16(ss);
    float rs = rsqrtf(ss + 1e-6f);
    U2 o;
    o.a[0] = pack2(rr[0], rr[1]); o.a[1] = pack2(rr[2], rr[3]); *(U2*)(R + lane * 4) = o;
    o.a[0] = pack2(kk[0], kk[1]); o.a[1] = pack2(kk[2], kk[3]); *(U2*)(R + 256 + lane * 4) = o;
    o.a[0] = pack2(vv[0], vv[1]); o.a[1] = pack2(vv[2], vv[3]); *(U2*)(R + 512 + lane * 4) = o;
    o.a[0] = pack2(kap[0] * rs, kap[1] * rs); o.a[1] = pack2(kap[2] * rs, kap[3] * rs); *(U2*)(R + 768 + lane * 4) = o;
  }
}

__device__ __forceinline__ bf16x8 gfrag(const bf16* base, int ld, int row, int k) {
  return *(const bf16x8*)(base + (size_t)row * ld + k);
}
__device__ __forceinline__ void wave_sync() {
#ifdef CPU_EMU
  pthread_barrier_wait(&g_wavebar[threadIdx.x >> 6]);
#else
  __builtin_amdgcn_wave_barrier();
#endif
}
__device__ __forceinline__ void store_acc_T(bf16* dst, int ld, int row_base, int col, const f32x16& acc, int lane) {
#pragma unroll
  for (int g = 0; g < 4; g++) {
    U2 o; o.a[0] = pack2(acc[4 * g], acc[4 * g + 1]); o.a[1] = pack2(acc[4 * g + 2], acc[4 * g + 3]);
    *(U2*)&dst[col * ld + row_base + 8 * g + 4 * (lane >> 5)] = o;
  }
}
__device__ __forceinline__ void rwkv_chunk_item(const Params& P, int l, int item, unsigned char* sm, long long& pacc) {
  long long tp0_ = 0; if (PROBE_PHASE >= 33 && PROBE_PHASE <= 36) tp0_ = wall_clock64();
  int tid_ = threadIdx.x; OPAQUE(tid_);
  const int tid = tid_, lane = tid & 63, w = tid >> 6, ti = w >> 1, tj = w & 1;
  const int lr = lane & 31, lh = lane >> 5;
  const int d = item & 1, h = (item >> 1) & 3, rest = item >> 3;
  const int pc = rest % NCH, b = rest / NCH;
  const int row0 = chunk_row0(b, pc, TC, NCH_C);
  float* sL = (float*)sm;
  bf16* sG1t = (bf16*)sm;
  bf16* sKT = (bf16*)(sm + 16640);
  bf16* sBT = sKT + 64 * 72;
  bf16* sKD = sBT + 64 * 72;
  bf16* sRT = sKD + 64 * 72;
  bf16* sVt = sRT + 64 * 72;
  float* sGT = (float*)(sVt + 64 * 72);
  bf16* X0 = WS(bf16, OFF_XA) + (size_t)row0 * 1024 + d * 256 + h * 64;
  bf16* X1 = X0 + 512;
  bf16* P0 = WS(bf16, OFF_PROJ) + (size_t)row0 * NIN + (h * 2 + d) * 128;
  bf16* P1 = P0 + 64;
  const bf16* Rb = WS(bf16, OFF_R) + (size_t)row0 * 1024 + h * 64;
  float rq[16], kq[16], pq[16], vq[16];
#pragma unroll
  for (int i = 0; i < 16; i++) {
    const bf16* rp = Rb + (size_t)(w + 4 * i) * 1024 + lane;
    rq[i] = bf2f(rp[0]); kq[i] = bf2f(rp[256]); vq[i] = bf2f(rp[512]); pq[i] = bf2f(rp[768]);
  }
#pragma unroll 8
  for (int idx = tid; idx < 4096; idx += 256) {
    int p = idx >> 6, k = idx & 63;
    sL[p * 65 + k] = bf2f(X0[(size_t)p * 1024 + k]);
    sVt[idx] = X1[(size_t)p * 1024 + k];
  }
  __syncthreads();
  {
    const int k = tid & 63, qq = tid >> 6;
    float* qt = sGT + 64 + 128;
    float run = 0.f;
    if (d == 0) { for (int p = qq * 16; p < qq * 16 + 16; p++) { run += sL[p * 65 + k]; sL[p * 65 + k] = run; } }
    else { for (int p = qq * 16 + 15; p >= qq * 16; p--) { run += sL[p * 65 + k]; sL[p * 65 + k] = run; } }
    qt[qq * 64 + k] = run;
    __syncthreads();
    float off = 0.f;
    if (d == 0) { for (int j = 0; j < qq; j++) off += qt[j * 64 + k]; }
    else { for (int j = 3; j > qq; j--) off += qt[j * 64 + k]; }
    for (int p = qq * 16; p < qq * 16 + 16; p++) sL[p * 65 + k] += off;
    if (qq == 0) sGT[k] = qt[k] + qt[64 + k] + qt[128 + k] + qt[192 + k];
  }
  __syncthreads();
  if (PROBE_PHASE == 35) pacc += wall_clock64() - tp0_;
  {
    const int k = lane;
    const float ka = P.rw_ka[l * 256 + h * 64 + k], rk = P.rw_rk[l * 256 + h * 64 + k];
#pragma unroll
    for (int i = 0; i < 16; i++) {
      const int p = w + 4 * i;
      float incl = sL[p * 65 + k];
      int pp = d == 0 ? p - 1 : p + 1;
      float excl = (pp < 0 || pp > 63) ? 0.f : sL[pp * 65 + k];
      float rr = rq[i], kk = kq[i], kap = pq[i];
      float a = bf2f(sVt[p * 64 + k]);
      float kd = kk * (1.f + (a - 1.f) * ka), beta = kap * a;
      float ei = __expf(incl), eni = __expf(-incl), ee = __expf(excl);
      sKT[p * 72 + k] = f2bf(kap * ee);
      sBT[p * 72 + k] = f2bf(beta * eni);
      sKD[p * 72 + k] = f2bf(kd * eni);
      sRT[p * 72 + k] = f2bf(rr * ei);
      float bs = sum64(rr * kd * rk);
      if (lane == 0) WS(float, OFF_BON)[(size_t)(row0 + p) * 8 + h * 2 + d] = bs;
    }
  }
  __syncthreads();
#pragma unroll 8
  for (int idx = tid; idx < 4096; idx += 256) {
    int kk = idx >> 6, p = idx & 63;
    P0[(size_t)kk * NIN + p] = sKT[p * 72 + kk];
    P1[(size_t)kk * NIN + p] = sBT[p * 72 + kk];
    X1[(size_t)kk * 1024 + p] = sKD[p * 72 + kk];
    X0[(size_t)kk * 1024 + p] = sRT[kk * 72 + p];
  }
  if (PROBE_PHASE == 36) pacc += wall_clock64() - tp0_;
  f32x16 aA = zero16(), aB = zero16(), aC = zero16(), aD = zero16();
#pragma unroll
  for (int ks = 0; ks < 64; ks += 16) {
    bf16x8 fK = ldsfrag(&sKT[(ti * 32 + lr) * 72 + ks + 8 * lh]);
    bf16x8 fR = ldsfrag(&sRT[(ti * 32 + lr) * 72 + ks + 8 * lh]);
    bf16x8 fB = ldsfrag(&sBT[(tj * 32 + lr) * 72 + ks + 8 * lh]);
    bf16x8 fD = ldsfrag(&sKD[(tj * 32 + lr) * 72 + ks + 8 * lh]);
    aA = mfma32(fK, fB, aA); aB = mfma32(fK, fD, aB); aC = mfma32(fR, fB, aC); aD = mfma32(fR, fD, aD);
  }
  __syncthreads();
  {
    int s_ = tj * 32 + lr;
#pragma unroll
    for (int r = 0; r < 16; r++) {
      int p = ti * 32 + acc_row(r, lane);
      bool earlier = d == 0 ? s_ < p : s_ > p;
      bool eq = s_ == p;
      sL[p * 65 + s_] = earlier ? aA[r] : 0.f;
      sKT[p * 72 + s_] = f2bf(earlier ? aB[r] : 0.f);
      sBT[p * 72 + s_] = f2bf((earlier || eq) ? aC[r] : 0.f);
      sKD[p * 72 + s_] = f2bf((earlier || eq) ? aD[r] : 0.f);
    }
  }
#pragma unroll
  for (int i = 0; i < 16; i++) sVt[lane * 72 + w + 4 * i] = f2bf(vq[i]);
  __syncthreads();
  if (PROBE_PHASE == 33) pacc += wall_clock64() - tp0_;
  bf16x8 fKt[4];
#pragma unroll
  for (int q4 = 0; q4 < 4; q4++) fKt[q4] = gfrag(P0, NIN, tj * 32 + lr, q4 * 16 + 8 * lh);
  bf16* sTinv = sRT;
  {
    const int q = tid >> 2, seg = tid & 3;
    float x[16];
#pragma unroll
    for (int i = 0; i < 16; i++) x[i] = (q == seg * 16 + i) ? 1.f : 0.f;
    float* rowbuf = (float*)sRT;
#pragma unroll 1
    for (int Bi = 0; Bi < 4; Bi++) {
      const int B = d == 0 ? Bi : 3 - Bi;
      float* rb = rowbuf + (Bi & 1) * 1024;
      if (w == B) {
#pragma unroll 1
        for (int s_ = 0; s_ < 16; s_++) {
          const int pl = d == 0 ? s_ : 15 - s_, p = B * 16 + pl;
          if (q == p) {
#pragma unroll
            for (int i = 0; i < 4; i++) { F4 o; o.a[0] = x[4 * i]; o.a[1] = x[4 * i + 1]; o.a[2] = x[4 * i + 2]; o.a[3] = x[4 * i + 3]; *(F4*)&rb[pl * 64 + seg * 16 + 4 * i] = o; }
          }
          wave_sync();
          const bool later = d == 0 ? q > p : q < p;
          if (later) {
            const float m = sL[q * 65 + p];
#pragma unroll
            for (int i = 0; i < 4; i++) {
              F4 o = *(const F4*)&rb[pl * 64 + seg * 16 + 4 * i];
              x[4 * i] -= m * o.a[0]; x[4 * i + 1] -= m * o.a[1]; x[4 * i + 2] -= m * o.a[2]; x[4 * i + 3] -= m * o.a[3];
            }
          }
        }
      }
      __syncthreads();
      const bool laterblock = d == 0 ? w > B : w < B;
      if (laterblock) {
#pragma unroll 4
        for (int pl = 0; pl < 16; pl++) {
          const float m = sL[q * 65 + B * 16 + pl];
#pragma unroll
          for (int i = 0; i < 4; i++) {
            F4 o = *(const F4*)&rb[pl * 64 + seg * 16 + 4 * i];
            x[4 * i] -= m * o.a[0]; x[4 * i + 1] -= m * o.a[1]; x[4 * i + 2] -= m * o.a[2]; x[4 * i + 3] -= m * o.a[3];
          }
        }
      }
    }
    __syncthreads();
#pragma unroll
    for (int i = 0; i < 8; i++) *(uint32_t*)&sTinv[q * 72 + seg * 16 + 2 * i] = pack2(x[2 * i], x[2 * i + 1]);
  }
  __syncthreads();
  if (PROBE_PHASE == 34) pacc += wall_clock64() - tp0_;
  {
    f32x16 aBV = zero16(), aG1 = zero16();
#pragma unroll
    for (int ks = 0; ks < 64; ks += 16) {
      aBV = mfma32(ldsfrag(&sKT[(ti * 32 + lr) * 72 + ks + 8 * lh]), ldsfrag(&sVt[(tj * 32 + lr) * 72 + ks + 8 * lh]), aBV);
      aG1 = mfma32(ldsfrag(&sTinv[(ti * 32 + lr) * 72 + ks + 8 * lh]), fKt[ks >> 4], aG1);
    }
    __syncthreads();
    store_acc_T(sKT, 72, ti * 32, tj * 32 + lr, aBV, lane);
    store_acc_T(sG1t, 72, ti * 32, tj * 32 + lr, aG1, lane);
  }
  __syncthreads();
  bf16x8 fKd4[4], fBt4[4]; float rtc[16];
#pragma unroll
  for (int q4 = 0; q4 < 4; q4++) { fKd4[q4] = gfrag(X1, 1024, ti * 32 + lr, q4 * 16 + 8 * lh); fBt4[q4] = gfrag(P1, NIN, ti * 32 + lr, q4 * 16 + 8 * lh); }
#pragma unroll
  for (int r = 0; r < 16; r++) rtc[r] = bf2f(X0[(size_t)(ti * 32 + acc_row(r, lane)) * 1024 + tj * 32 + lr]);
  {
    f32x16 aG2 = zero16();
#pragma unroll
    for (int ks = 0; ks < 64; ks += 16)
      aG2 = mfma32(ldsfrag(&sTinv[(ti * 32 + lr) * 72 + ks + 8 * lh]), ldsfrag(&sKT[(tj * 32 + lr) * 72 + ks + 8 * lh]), aG2);
    __syncthreads();
    store_acc_T(sRT, 72, ti * 32, tj * 32 + lr, aG2, lane);
  }
  __syncthreads();
  bf16* sG2t = sRT;
  {
    f32x16 a1 = zero16(), a2 = zero16(), a3 = zero16();
#pragma unroll
    for (int ks = 0; ks < 64; ks += 16) {
      bf16x8 fC = ldsfrag(&sBT[(ti * 32 + lr) * 72 + ks + 8 * lh]);
      bf16x8 fDy = ldsfrag(&sKD[(ti * 32 + lr) * 72 + ks + 8 * lh]);
      a1 = mfma32(fC, ldsfrag(&sG1t[(tj * 32 + lr) * 72 + ks + 8 * lh]), a1);
      a2 = mfma32(fDy, ldsfrag(&sVt[(tj * 32 + lr) * 72 + ks + 8 * lh]), a2);
      a3 = mfma32(fC, ldsfrag(&sG2t[(tj * 32 + lr) * 72 + ks + 8 * lh]), a3);
    }
    int c = tj * 32 + lr;
#pragma unroll
    for (int r = 0; r < 16; r++) {
      int p = ti * 32 + acc_row(r, lane);
      X0[(size_t)p * 1024 + c] = f2bf(rtc[r] - a1[r]);
      P0[(size_t)p * NIN + c] = f2bf(a2[r] - a3[r]);
    }
  }
  {
    f32x16 a1 = zero16(), a2 = zero16(), a3 = zero16();
#pragma unroll
    for (int ks = 0; ks < 64; ks += 16) {
      bf16x8 fKd = fKd4[ks >> 4];
      bf16x8 fBt = fBt4[ks >> 4];
      a1 = mfma32(fKd, ldsfrag(&sVt[(tj * 32 + lr) * 72 + ks + 8 * lh]), a1);
      a2 = mfma32(fBt, ldsfrag(&sG2t[(tj * 32 + lr) * 72 + ks + 8 * lh]), a2);
      a3 = mfma32(fBt, ldsfrag(&sG1t[(tj * 32 + lr) * 72 + ks + 8 * lh]), a3);
    }
    __syncthreads();
    int c = tj * 32 + lr;
#pragma unroll
    for (int r = 0; r < 16; r++) {
      int kp = ti * 32 + acc_row(r, lane);
      float gt = __expf(sGT[kp]);
      a1[r] = gt * (a1[r] - a2[r]);
      X1[(size_t)kp * 1024 + c] = f2bf(gt * ((kp == c ? 1.f : 0.f) - a3[r]));
    }
    U4 o0, o1;
#pragma unroll
    for (int e = 0; e < 4; e++) { o0.a[e] = pack2(a1[2 * e], a1[2 * e + 1]); o1.a[e] = pack2(a1[8 + 2 * e], a1[8 + 2 * e + 1]); }
    bf16* lp = P1 + (size_t)(tid >> 2) * NIN + (tid & 3) * 16;
    *(U4*)lp = o0; *(U4*)(lp + 8) = o1;
  }
  __syncthreads();
}

struct RwStage { bf16x8 pm[4]; U4 l0, l1; };
__device__ __forceinline__ void rwkv_scan2_item(const Params& P, int l, int item, unsigned char* sm) {
  int tid_ = threadIdx.x; OPAQUE(tid_);
  const int tid = tid_, lane = tid & 63, w = tid >> 6, ti = w >> 1, tj = w & 1;
  const int lr = lane & 31, lh = lane >> 5;
  const int d = item & 1, h = (item >> 1) & 3, b = item >> 3;
  bf16* sS = (bf16*)sm;
  f32x16 acc = zero16();
  RwStage st[4];
  auto load = [&](RwStage& s_, int vc) {
    int pc = ord_chunk(d, vc < NCH ? vc : NCH - 1, NCH_C, NCH);
    int row0 = chunk_row0(b, pc, TC, NCH_C);
    const bf16* X1 = WS(bf16, OFF_XA) + (size_t)row0 * 1024 + 512 + d * 256 + h * 64;
    const bf16* P1 = WS(bf16, OFF_PROJ) + (size_t)row0 * NIN + (h * 2 + d) * 128 + 64;
#pragma unroll
    for (int q = 0; q < 4; q++) s_.pm[q] = gfrag(X1, 1024, ti * 32 + lr, q * 16 + 8 * lh);
    const bf16* lp = P1 + (size_t)(tid >> 2) * NIN + (tid & 3) * 16;
    s_.l0 = *(const U4*)lp; s_.l1 = *(const U4*)(lp + 8);
  };
#pragma unroll
  for (int j = 0; j < 4; j++) load(st[j], j);
#pragma unroll 1
  for (int v0 = 0; v0 < NCH; v0 += 4) {
#pragma unroll
    for (int j = 0; j < 4; j++) {
      const int vc = v0 + j;
      if (vc < NCH) {
        int pc = ord_chunk(d, vc, NCH_C, NCH);
        int row0 = chunk_row0(b, pc, TC, NCH_C);
        bf16* X1 = WS(bf16, OFF_XA) + (size_t)row0 * 1024 + 512 + d * 256 + h * 64;
        store_acc_T(sS, 72, ti * 32, tj * 32 + lr, acc, lane);
        RwStage cur = st[j];
        __syncthreads();
        load(st[j], vc + 4);
        for (int idx = tid; idx < 512; idx += 256) {
          int v = idx >> 3, c8 = idx & 7;
          *(U4*)(X1 + (size_t)v * 1024 + c8 * 8) = *(const U4*)(sS + v * 72 + c8 * 8);
        }
        f32x16 nw;
#pragma unroll
        for (int e = 0; e < 4; e++) {
          nw[2 * e] = lo2f(cur.l0.a[e]); nw[2 * e + 1] = hi2f(cur.l0.a[e]);
          nw[8 + 2 * e] = lo2f(cur.l1.a[e]); nw[8 + 2 * e + 1] = hi2f(cur.l1.a[e]);
        }
#pragma unroll
        for (int q = 0; q < 4; q++) nw = mfma32(cur.pm[q], ldsfrag(&sS[(tj * 32 + lr) * 72 + q * 16 + 8 * lh]), nw);
        acc = nw;
        __syncthreads();
      }
    }
  }
}

__device__ __forceinline__ void rwkv_out_item(const Params& P, int l, int item, unsigned char* sm) {
  int tid_ = threadIdx.x; OPAQUE(tid_);
  const int tid = tid_, lane = tid & 63, w = tid >> 6, ti = w >> 1, tj = w & 1;
  const int lr = lane & 31, lh = lane >> 5;
  const int h = item & 3, rest = item >> 2, pc = rest % NCH, b = rest / NCH;
  if (l == 1 && pc < NCH_C) return;
  const int row0 = chunk_row0(b, pc, TC, NCH_C);
  float* spart = (float*)sm;
  float vvh[16], ggh[16], bnh[16];
#pragma unroll
  for (int r = 0; r < 16; r++) {
    const int row = row0 + ti * 32 + acc_row(r, lane), c = h * 64 + tj * 32 + lr;
    vvh[r] = bf2f(WS(bf16, OFF_R)[(size_t)row * 1024 + 512 + c]);
    ggh[r] = bf2f(WS(bf16, OFF_PROJ)[(size_t)row * NIN + C_RWG + c]);
    const float* bon = WS(float, OFF_BON) + (size_t)row * 8 + h * 2;
    bnh[r] = bon[0] + bon[1];
  }
  f32x16 acc = zero16();
#pragma unroll
  for (int d = 0; d < 2; d++) {
    const bf16* X0 = WS(bf16, OFF_XA) + (size_t)row0 * 1024 + d * 256 + h * 64;
    const bf16* X1 = X0 + 512;
    const bf16* P0 = WS(bf16, OFF_PROJ) + (size_t)row0 * NIN + (h * 2 + d) * 128;
#pragma unroll
    for (int ks = 0; ks < 64; ks += 16)
      acc = mfma32(gfrag(X0, 1024, ti * 32 + lr, ks + 8 * lh), gfrag(X1, 1024, tj * 32 + lr, ks + 8 * lh), acc);
#pragma unroll
    for (int r = 0; r < 16; r++) acc[r] += bf2f(P0[(size_t)(ti * 32 + acc_row(r, lane)) * NIN + tj * 32 + lr]);
  }
#pragma unroll
  for (int r = 0; r < 16; r++) {
    int p = ti * 32 + acc_row(r, lane);
    float s1 = sum32(acc[r]), s2 = sum32(acc[r] * acc[r]);
    if (lr == 31) { spart[(p * 2 + tj) * 2] = s1; spart[(p * 2 + tj) * 2 + 1] = s2; }
  }
  __syncthreads();
  {
    int c = h * 64 + tj * 32 + lr;
    float lw_ = P.rw_ln_w[l * 256 + c], lb_ = P.rw_ln_b[l * 256 + c];
    bf16* yc = WS(bf16, OFF_R);
    const bf16* pr = WS(bf16, OFF_PROJ);
#pragma unroll
    for (int r = 0; r < 16; r++) {
      int p = ti * 32 + acc_row(r, lane);
      int row = row0 + p;
      float mu = (spart[(p * 2) * 2] + spart[(p * 2 + 1) * 2]) * (1.f / 64.f);
      float ex2 = (spart[(p * 2) * 2 + 1] + spart[(p * 2 + 1) * 2 + 1]) * (1.f / 64.f);
      float var = fmaxf(ex2 - mu * mu, 0.f);
      float yn = (acc[r] - mu) * rsqrtf(var + 64e-5f) * lw_ + lb_;
      yc[(size_t)row * 1024 + 512 + c] = f2bf((yn + bnh[r] * vvh[r]) * silu_f(ggh[r]));
    }
  }
  __syncthreads();
}

__device__ __forceinline__ float wave_scan64(float v, float* tmp, int lane, bool reverse) {
  const int idx = reverse ? 63 - lane : lane;
#pragma unroll
  for (int off = 1; off < 64; off <<= 1) {
    tmp[idx] = v; wave_sync();
    float o = idx >= off ? tmp[idx - off] : 0.f; wave_sync();
    v += o;
  }
  return v;
}
__device__ __forceinline__ float ssd_aneg(const Params& P, int l, int d, int h) { return -__expf(P.ssd_a_log[(l * 2 + d) * 4 + h]); }
__device__ __forceinline__ void ssd_state_item(const Params& P, int l, int item, unsigned char* sm) {
  int tid_ = threadIdx.x; OPAQUE(tid_);
  const int tid = tid_, lane = tid & 63, w = tid >> 6;
  const int d = item & 1, h = (item >> 1) & 3, rest = item >> 3;
  const int pc = rest % NCH, b = rest / NCH;
  const int isctx = pc < NCH_C, len = isctx ? CTX : SEQ, t0 = (isctx ? pc : pc - NCH_C) * TC;
  const int seq0 = isctx ? b * CTX : ROWS_C + b * SEQ;
  bf16* sRaw = (bf16*)sm;
  bf16* sVt = sRaw + 2 * 68 * 64;
  bf16* sBt = sVt + 64 * 72;
  float* sdt = (float*)(sBt + 64 * 72);
  float* sdw = sdt + 64;
  const bf16* pr = WS(bf16, OFF_PROJ);
#pragma unroll 8
  for (int idx = tid; idx < 2 * 68 * 8; idx += 256) {
    int which = idx / (68 * 8), rem = idx % (68 * 8), tr = rem >> 3, c8 = rem & 7;
    int t = t0 - 2 + tr;
    int col = C_SSD + (which == 0 ? h * 64 : 256 + (h >> 1) * 64) + c8 * 8;
    U4 v = (t >= 0 && t < len) ? *(const U4*)(pr + (size_t)(seq0 + t) * NIN + col) : zero4();
    *(U4*)&sRaw[(which * 68 + tr) * 64 + c8 * 8] = v;
  }
  if (tid < 64) {
    float raw = bf2f(pr[(size_t)(seq0 + t0 + tid) * NIN + C_SSDDT + d * 4 + h]);
    sdt[tid] = softplus_f(raw + P.ssd_dt_bias[(l * 2 + d) * 4 + h]);
  }
  __syncthreads();
  if (w == 0) {
    float la = sdt[lane] * ssd_aneg(P, l, d, h);
    float incl = wave_scan64(la, sdw, lane, d == 0);
    wave_sync();
    sdw[lane] = __expf(incl - la);
    if (lane == (d == 0 ? 0 : 63)) WS(float, OFF_SSDDEC)[((size_t)(d * BATCH + b) * NCH + pc) * 4 + h] = __expf(incl);
  }
  __syncthreads();
#pragma unroll
  for (int which = 0; which < 2; which++) {
    const int c = tid & 63;
    const int ch = which == 0 ? h * 64 + c : 256 + (h >> 1) * 64 + c;
    float cw[5], cb = P.ssd_conv_b[l * 512 + ch];
#pragma unroll
    for (int i = 0; i < 5; i++) cw[i] = P.ssd_conv_w[(l * 5 + i) * 512 + ch];
    const int tb = (tid >> 6) * 16;
    float w0 = bf2f(sRaw[(which * 68 + tb) * 64 + c]), w1 = bf2f(sRaw[(which * 68 + tb + 1) * 64 + c]);
    float w2 = bf2f(sRaw[(which * 68 + tb + 2) * 64 + c]), w3 = bf2f(sRaw[(which * 68 + tb + 3) * 64 + c]);
#pragma unroll 4
    for (int t = tb; t < tb + 16; t++) {
      float w4 = bf2f(sRaw[(which * 68 + t + 4) * 64 + c]);
      float acc = cb + w0 * cw[0] + w1 * cw[1] + w2 * cw[2] + w3 * cw[3] + w4 * cw[4];
      w0 = w1; w1 = w2; w2 = w3; w3 = w4;
      float v = silu_f(acc);
      if (which == 0) sVt[c * 72 + t] = f2bf(v * sdt[t] * sdw[t]);
      else sBt[c * 72 + t] = f2bf(v);
    }
  }
  __syncthreads();
  {
    int ti = w >> 1, tj = w & 1;
    f32x16 acc = zero16();
    for (int ks = 0; ks < 64; ks += 16)
      acc = mfma32(ldsfrag(&sVt[(ti * 32 + (lane & 31)) * 72 + ks + 8 * (lane >> 5)]),
                   ldsfrag(&sBt[(tj * 32 + (lane & 31)) * 72 + ks + 8 * (lane >> 5)]), acc);
    bf16* st = WS(bf16, OFF_SSDST) + ((size_t)((d * BATCH + b) * NCH + pc) * 4 + h) * 4096;
    for (int r = 0; r < 16; r++) st[(ti * 32 + acc_row(r, lane)) * 64 + tj * 32 + (lane & 31)] = f2bf(acc[r]);
  }
  __syncthreads();
}

__device__ __forceinline__ void gla_la(const Params& P, int l, int d, int h, const float* sGl, float* dst) {
  const int k = threadIdx.x & 31;
  float gw[16], gb = P.gla_gb[(l * 2 + d) * 128 + h * 32 + k];
  const float* g2 = P.gla_g2 + (size_t)(l * 2 + d) * 16 * 128 + h * 32 + k;
#pragma unroll
  for (int r = 0; r < 16; r++) gw[r] = g2[r * 128];
#pragma unroll 2
  for (int t = threadIdx.x >> 5; t < 64; t += 8) {
    float acc = gb;
#pragma unroll
    for (int r = 0; r < 16; r++) acc += sGl[t * 32 + d * 16 + r] * gw[r];
    dst[t * 32 + k] = -softplus_f(-acc) * (1.f / 16.f);
  }
}
__device__ __forceinline__ void gla_state_item(const Params& P, int l, int item, unsigned char* sm) {
  int tid_ = threadIdx.x; OPAQUE(tid_);
  const int tid = tid_, lane = tid & 63, w = tid >> 6;
  const int d = item & 1, h = (item >> 1) & 3, rest = item >> 3;
  const int pc = rest % NCH, b = rest / NCH;
  const int row0 = chunk_row0(b, pc, TC, NCH_C);
  float* sGl = (float*)sm;
  float* sLa = sGl + 2048;
  bf16* sVt = (bf16*)(sLa + 2048);
  bf16* sKt = sVt + 64 * 72;
  const bf16* pr = WS(bf16, OFF_PROJ);
  float kh[8], vh[16];
#pragma unroll
  for (int i = 0; i < 8; i++) kh[i] = bf2f(pr[(size_t)(row0 + (tid >> 5) + 8 * i) * NIN + C_GLAK + h * 32 + (tid & 31)]);
#pragma unroll
  for (int i = 0; i < 16; i++) vh[i] = bf2f(pr[(size_t)(row0 + (tid >> 6) + 4 * i) * NIN + C_GLAV + h * 64 + (tid & 63)]);
#pragma unroll 8
  for (int idx = tid; idx < 64 * 32; idx += 256) {
    int t = idx >> 5, c = idx & 31;
    sGl[idx] = bf2f(pr[(size_t)(row0 + t) * NIN + C_GLAGL + c]);
  }
  __syncthreads();
  gla_la(P, l, d, h, sGl, sLa);
  __syncthreads();
  {
    float* segtot = (float*)(sKt + 32 * 72);
    const int k = tid & 31, sg = tid >> 5;
    float run = 0.f, loc[8];
#pragma unroll
    for (int j = 0; j < 8; j++) {
      int tau = sg * 8 + j, t = d == 0 ? 63 - tau : tau;
      float la = sLa[t * 32 + k]; loc[j] = run; run += la;
    }
    segtot[sg * 32 + k] = run;
    __syncthreads();
    float off = 0.f, tot = 0.f;
#pragma unroll
    for (int j = 0; j < 8; j++) { float v = segtot[j * 32 + k]; tot += v; if (j < sg) off += v; }
#pragma unroll
    for (int j = 0; j < 8; j++) {
      int tau = sg * 8 + j, t = d == 0 ? 63 - tau : tau;
      sLa[t * 32 + k] = loc[j] + off;
    }
    if (sg == 0) WS(float, OFF_GLADEC)[(((size_t)(d * BATCH + b) * NCH + pc) * 4 + h) * 32 + k] = __expf(tot);
  }
  __syncthreads();
#pragma unroll
  for (int i = 0; i < 16; i++) sVt[(tid & 63) * 72 + (tid >> 6) + 4 * i] = f2bf(vh[i]);
#pragma unroll
  for (int i = 0; i < 8; i++) {
    const int t = (tid >> 5) + 8 * i, k = tid & 31;
    sKt[k * 72 + t] = f2bf(kh[i] * __expf(sLa[t * 32 + k]));
  }
  __syncthreads();
  if (w < 2) {
    f32x16 acc = zero16();
    for (int ks = 0; ks < 64; ks += 16)
      acc = mfma32(ldsfrag(&sVt[(w * 32 + (lane & 31)) * 72 + ks + 8 * (lane >> 5)]),
                   ldsfrag(&sKt[(lane & 31) * 72 + ks + 8 * (lane >> 5)]), acc);
    bf16* st = WS(bf16, OFF_GLAST) + ((size_t)((d * BATCH + b) * NCH + pc) * 4 + h) * 2048;
    for (int r = 0; r < 16; r++) st[(w * 32 + acc_row(r, lane)) * 32 + (lane & 31)] = f2bf(acc[r]);
  }
  __syncthreads();
}

__device__ __forceinline__ U4 s5_u_load(const Params& P, int g, int n, int k8) {
  if (n >= M5) return zero4();
  int b = n / NCH5, pc = n - b * NCH5;
  int row = chunk_row0(b, pc, T5, NC5) + (k8 >> 4);
  return *(const U4*)(WS(bf16, OFF_PROJ) + (size_t)row * NIN + C_S5 + g * 16 + (k8 & 15));
}
__device__ __forceinline__ void s5_state_tile(const Params& P, int l, int item, unsigned char* sm) {
  const int MT5 = (M5 + 127) / 128;
  int nt = item & 1, mt = (item >> 1) % MT5, g = (item >> 1) / MT5;
  const bf16* Bt = WS(bf16, OFF_W1T) + (size_t)(l * 16 + g) * 256 * 512;
  float* S = WS(float, OFF_S5ST) + (size_t)g * M5 * 256;
  gemm_tile(sm, mt * 128, nt * 128, 512,
    [&](int m, int k) { return s5_u_load(P, g, m, k); },
    [&](int n, int k) { return *(const U4*)(Bt + (size_t)n * 512 + k); },
    [&](int m, int n, float v) { if (m < M5) S[(size_t)m * 256 + n] = v; });
}

__device__ __forceinline__ void phase_D(const Params& P, int l, unsigned char* sm, long long& pacc) {
  const int n_rw = BATCH * NCH * 8, n_ssd = BATCH * NCH * 8, n_gla = BATCH * NCH * 8;
  const int n_s5 = 16 * ((M5 + 127) / 128) * 2;
  { long long t0_ = 0; if (PROBE_PHASE == 30) t0_ = wall_clock64();
  ITEM_LOOP(i, n_rw, 0) rwkv_chunk_item(P, l, i, sm, pacc);
  if (PROBE_PHASE == 30) pacc += wall_clock64() - t0_; }
  { long long t0_ = 0; if (PROBE_PHASE == 31) t0_ = wall_clock64();
  ITEM_LOOP(i, n_ssd, n_rw) ssd_state_item(P, l, i, sm);
  if (PROBE_PHASE == 31) pacc += wall_clock64() - t0_; }
  { long long t0_ = 0; if (PROBE_PHASE == 32) t0_ = wall_clock64();
  ITEM_LOOP(i, n_gla, n_rw + n_ssd) gla_state_item(P, l, i, sm);
  if (PROBE_PHASE == 32) pacc += wall_clock64() - t0_; }
  ITEM_LOOP(i, n_s5, n_rw + n_ssd + n_gla) s5_state_tile(P, l, i, sm);
}

__device__ __forceinline__ void phase_E(const Params& P, int l, unsigned char* sm) {
  const int tid = threadIdx.x, w = tid >> 6;
  const int n_rw = BATCH * 8;
  ITEM_LOOP(i, n_rw, 0) rwkv_scan2_item(P, l, i, sm);
  const int n_ssd = 2 * BATCH * 4 * 4, n_gla = 2 * BATCH * 4 * 2, n_s5 = 16 * BATCH;
#pragma unroll 1
  for (int it = (int)((blockIdx.x + gridDim.x - ((unsigned)n_rw % gridDim.x)) % gridDim.x); it < n_ssd + n_gla + n_s5; it += gridDim.x) {
    int i = it;
    if (i < n_ssd) {
      int q = i & 3, h = (i >> 2) & 3, rest = i >> 4, b = rest % BATCH, d = rest / BATCH;
      float S[4] = {0.f, 0.f, 0.f, 0.f};
#pragma unroll 1
      for (int v0 = 0; v0 < NCH; v0 += 8) {
        U2 cv[8]; float dec[8];
#pragma unroll
        for (int j = 0; j < 8; j++) {
          int vc = v0 + j < NCH ? v0 + j : NCH - 1;
          size_t ci = ((size_t)(d * BATCH + b) * NCH + ord_chunk(d, vc, NCH_C, NCH)) * 4 + h;
          cv[j] = *(const U2*)(WS(bf16, OFF_SSDST) + ci * 4096 + q * 1024 + tid * 4);
          dec[j] = WS(float, OFF_SSDDEC)[ci];
        }
#pragma unroll
        for (int j = 0; j < 8; j++) {
          if (v0 + j < NCH) {
            size_t ci = ((size_t)(d * BATCH + b) * NCH + ord_chunk(d, v0 + j, NCH_C, NCH)) * 4 + h;
            U2 o; o.a[0] = pack2(S[0], S[1]); o.a[1] = pack2(S[2], S[3]);
            *(U2*)(WS(bf16, OFF_SSDST) + ci * 4096 + q * 1024 + tid * 4) = o;
            S[0] = dec[j] * S[0] + lo2f(cv[j].a[0]); S[1] = dec[j] * S[1] + hi2f(cv[j].a[0]);
            S[2] = dec[j] * S[2] + lo2f(cv[j].a[1]); S[3] = dec[j] * S[3] + hi2f(cv[j].a[1]);
          }
        }
      }
      continue;
    }
    i -= n_ssd;
    if (i < n_gla) {
      int q = i & 1, h = (i >> 1) & 3, rest = i >> 3, b = rest % BATCH, d = rest / BATCH;
      float S[4] = {0.f, 0.f, 0.f, 0.f};
      int e0 = q * 1024 + tid * 4, k0 = e0 & 31;
#pragma unroll 1
      for (int v0 = 0; v0 < NCH; v0 += 8) {
        U2 cv[8]; F4 dec[8];
#pragma unroll
        for (int j = 0; j < 8; j++) {
          int vc = v0 + j < NCH ? v0 + j : NCH - 1;
          size_t ci = ((size_t)(d * BATCH + b) * NCH + ord_chunk(d, vc, NCH_C, NCH)) * 4 + h;
          cv[j] = *(const U2*)(WS(bf16, OFF_GLAST) + ci * 2048 + e0);
          dec[j] = *(const F4*)(WS(float, OFF_GLADEC) + ci * 32 + k0);
        }
#pragma unroll
        for (int j = 0; j < 8; j++) {
          if (v0 + j < NCH) {
            size_t ci = ((size_t)(d * BATCH + b) * NCH + ord_chunk(d, v0 + j, NCH_C, NCH)) * 4 + h;
            U2 o; o.a[0] = pack2(S[0], S[1]); o.a[1] = pack2(S[2], S[3]);
            *(U2*)(WS(bf16, OFF_GLAST) + ci * 2048 + e0) = o;
            S[0] = dec[j].a[0] * S[0] + lo2f(cv[j].a[0]); S[1] = dec[j].a[1] * S[1] + hi2f(cv[j].a[0]);
            S[2] = dec[j].a[2] * S[2] + lo2f(cv[j].a[1]); S[3] = dec[j].a[3] * S[3] + hi2f(cv[j].a[1]);
          }
        }
      }
      continue;
    }
    i -= n_gla;
    if (i < n_s5) {
      int b = i % BATCH, g = i / BATCH;
      if (tid < 128) {
        int d = tid >> 6, p = tid & 63;
        const float* lt = WS(float, OFF_S5LT) + ((size_t)((l * 16 + g) * 2 + d) * 64 + p) * 2;
        float lr = lt[0], li = lt[1], xr = 0.f, xi = 0.f;
#pragma unroll 1
        for (int v0 = 0; v0 < NCH5; v0 += 8) {
          float sr[8], si[8];
#pragma unroll
          for (int j = 0; j < 8; j++) {
            int vc = v0 + j < NCH5 ? v0 + j : NCH5 - 1;
            const float* sp = WS(float, OFF_S5ST) + ((size_t)g * M5 + b * NCH5 + ord_chunk(d, vc, NC5, NCH5)) * 256 + d * 128 + p;
            sr[j] = sp[0]; si[j] = sp[64];
          }
#pragma unroll
          for (int j = 0; j < 8; j++) {
            if (v0 + j < NCH5) {
              float* sp = WS(float, OFF_S5ST) + ((size_t)g * M5 + b * NCH5 + ord_chunk(d, v0 + j, NC5, NCH5)) * 256 + d * 128 + p;
              sp[0] = xr; sp[64] = xi;
              float nr = lr * xr - li * xi + sr[j], ni = lr * xi + li * xr + si[j];
              xr = nr; xi = ni;
            }
          }
        }
      }
      continue;
    }
  }
}

__device__ __forceinline__ void ssd_out_item(const Params& P, int l, int item, unsigned char* sm, long long& pacc) {
  long long tp0_ = 0; if (PROBE_PHASE == 55 || PROBE_PHASE == 56) tp0_ = wall_clock64();
  int tid_ = threadIdx.x; OPAQUE(tid_);
  const int tid = tid_, lane = tid & 63, w = tid >> 6;
  const int h = item & 3, rest = item >> 2, pc = rest % NCH, b = rest / NCH;
  if (l == 1 && pc < NCH_C) return;
  const int isctx = pc < NCH_C, len = isctx ? CTX : SEQ, t0 = (isctx ? pc : pc - NCH_C) * TC;
  const int seq0 = isctx ? b * CTX : ROWS_C + b * SEQ;
  bf16* sRaw = (bf16*)sm;
  bf16* sA2 = (bf16*)sm;
  bf16* sB2 = (bf16*)(sm + 26112);
  bf16* sC = (bf16*)(sm + 26112 + 25600);
  float* sdt = (float*)(sm + 26112 + 25600 + 9216);
  float* scf = sdt + 128; float* scr = scf + 64; float* spart = scr + 64;
  const bf16* pr = WS(bf16, OFF_PROJ);
#pragma unroll 8
  for (int idx = tid; idx < 3 * 68 * 8; idx += 256) {
    int which = idx / (68 * 8), rem = idx % (68 * 8), tr = rem >> 3, c8 = rem & 7;
    int t = t0 - 2 + tr;
    int col = C_SSD + (which == 0 ? h * 64 : which == 1 ? 256 + (h >> 1) * 64 : 384 + (h >> 1) * 64) + c8 * 8;
    U4 v = (t >= 0 && t < len) ? *(const U4*)(pr + (size_t)(seq0 + t) * NIN + col) : zero4();
    *(U4*)&sRaw[(which * 68 + tr) * 64 + c8 * 8] = v;
  }
  u32x4 stv0, stv1, stv2, stv3;
  {
    const bf16* stb = WS(bf16, OFF_SSDST);
    const size_t o0 = ((size_t)((0 * BATCH + b) * NCH + pc) * 4 + h) * 4096, o1 = ((size_t)((1 * BATCH + b) * NCH + pc) * 4 + h) * 4096;
    const int p_ = (tid >> 3) & 31, c8_ = tid & 7;
    stv0 = *(const u32x4*)(stb + o0 + p_ * 64 + c8_ * 8);
    stv1 = *(const u32x4*)(stb + o0 + (p_ + 32) * 64 + c8_ * 8);
    stv2 = *(const u32x4*)(stb + o1 + p_ * 64 + c8_ * 8);
    stv3 = *(const u32x4*)(stb + o1 + (p_ + 32) * 64 + c8_ * 8);
  }
  float zv[16];
#pragma unroll
  for (int r = 0; r < 16; r++)
    zv[r] = bf2f(pr[(size_t)(seq0 + t0 + (w >> 1) * 32 + acc_row(r, lane)) * NIN + C_SSDZ + h * 64 + (w & 1) * 32 + (lane & 31)]);
  if (tid < 128) {
    int d = tid >> 6, t = tid & 63;
    float raw = bf2f(pr[(size_t)(seq0 + t0 + t) * NIN + C_SSDDT + d * 4 + h]);
    sdt[tid] = softplus_f(raw + P.ssd_dt_bias[(l * 2 + d) * 4 + h]);
  }
  __syncthreads();
  if (w == 0) { float v = wave_scan64(sdt[lane] * ssd_aneg(P, l, 0, h), scf, lane, false); wave_sync(); scf[lane] = v; }
  if (w == 1) { float v = wave_scan64(sdt[64 + lane] * ssd_aneg(P, l, 1, h), scr, lane, true); wave_sync(); scr[lane] = v; }
#pragma unroll
  for (int which = 0; which < 3; which++) {
    const int c = tid & 63;
    const int ch = which == 0 ? h * 64 + c : which == 1 ? 256 + (h >> 1) * 64 + c : 384 + (h >> 1) * 64 + c;
    float cw[5], cb = P.ssd_conv_b[l * 512 + ch];
#pragma unroll
    for (int i = 0; i < 5; i++) cw[i] = P.ssd_conv_w[(l * 5 + i) * 512 + ch];
    const int tb = (tid >> 6) * 16;
    float w0 = bf2f(sRaw[(which * 68 + tb) * 64 + c]), w1 = bf2f(sRaw[(which * 68 + tb + 1) * 64 + c]);
    float w2 = bf2f(sRaw[(which * 68 + tb + 2) * 64 + c]), w3 = bf2f(sRaw[(which * 68 + tb + 3) * 64 + c]);
#pragma unroll 4
    for (int t = tb; t < tb + 16; t++) {
      float w4 = bf2f(sRaw[(which * 68 + t + 4) * 64 + c]);
      float acc = cb + w0 * cw[0] + w1 * cw[1] + w2 * cw[2] + w3 * cw[3] + w4 * cw[4];
      w0 = w1; w1 = w2; w2 = w3; w3 = w4;
      bf16 v = f2bf(silu_f(acc));
      if (which == 0) sB2[c * 200 + t] = v;
      else if (which == 1) sB2[t * 200 + 64 + c] = v;
      else sC[t * 72 + c] = v;
    }
  }
  __syncthreads();
  const int ti = w >> 1, tj = w & 1;
  {
    f32x16 g = zero16();
    for (int ks = 0; ks < 64; ks += 16)
      g = mfma32(ldsfrag(&sC[(ti * 32 + (lane & 31)) * 72 + ks + 8 * (lane >> 5)]),
                 ldsfrag(&sB2[(tj * 32 + (lane & 31)) * 200 + 64 + ks + 8 * (lane >> 5)]), g);
    int j = tj * 32 + (lane & 31);
    float cfj = scf[j], crj = scr[j], d0j = sdt[j], d1j = sdt[64 + j];
    for (int r = 0; r < 16; r++) {
      int i = ti * 32 + acc_row(r, lane);
      float mlt = 0.f;
      if (j <= i) mlt += __expf(scf[i] - cfj) * d0j;
      if (j >= i) mlt += __expf(scr[i] - crj) * d1j;
      sA2[i * 200 + j] = f2bf(g[r] * mlt);
    }
  }
#pragma unroll 8
  for (int idx = tid; idx < 64 * 64; idx += 256) {
    int i = idx >> 6, n = idx & 63;
    float cv = bf2f(sC[i * 72 + n]);
    sA2[i * 200 + 64 + n] = f2bf(cv * __expf(scf[i]));
    sA2[i * 200 + 128 + n] = f2bf(cv * __expf(scr[i]));
  }
  __syncthreads();
  {
    const int p_ = (tid >> 3) & 31, c8_ = tid & 7;
    *(u32x4*)&sB2[p_ * 200 + 64 + c8_ * 8] = stv0;
    *(u32x4*)&sB2[(p_ + 32) * 200 + 64 + c8_ * 8] = stv1;
    *(u32x4*)&sB2[p_ * 200 + 128 + c8_ * 8] = stv2;
    *(u32x4*)&sB2[(p_ + 32) * 200 + 128 + c8_ * 8] = stv3;
  }
  __syncthreads();
  {
    f32x16 acc = zero16();
    for (int ks = 0; ks < 192; ks += 16)
      acc = mfma32(ldsfrag(&sA2[(ti * 32 + (lane & 31)) * 200 + ks + 8 * (lane >> 5)]),
                   ldsfrag(&sB2[(tj * 32 + (lane & 31)) * 200 + ks + 8 * (lane >> 5)]), acc);
    int p = tj * 32 + (lane & 31);
    float dd = P.ssd_d[l * 4 + h];
    bf16* yc = WS(bf16, OFF_R);
    for (int r = 0; r < 16; r++) {
      int i = ti * 32 + acc_row(r, lane);
      int row = seq0 + t0 + i;
      float xv = bf2f(sB2[p * 200 + i]);
      float y = acc[r] + dd * xv;
      float z = zv[r];
      y *= silu_f(z);
      yc[(size_t)row * 1024 + h * 64 + p] = f2bf(y);
      float s2 = sum32(y * y);
      if ((lane & 31) == 31) spart[i * 2 + tj] = s2;
    }
  }
  __syncthreads();
  if (tid < 64) WS(float, OFF_SSQ)[(size_t)(seq0 + t0 + tid) * 4 + h] = spart[tid * 2] + spart[tid * 2 + 1];
  __syncthreads();
}

__device__ __forceinline__ void gla_out_item(const Params& P, int l, int item, unsigned char* sm) {
  int tid_ = threadIdx.x; OPAQUE(tid_);
  const int tid = tid_, lane = tid & 63, w = tid >> 6;
  const int h = item & 3, rest = item >> 2, pc = rest % NCH, b = rest / NCH;
  if (l == 1 && pc < NCH_C) return;
  const int row0 = chunk_row0(b, pc, TC, NCH_C);
  bf16* sA2 = (bf16*)sm;
  bf16* sB2 = sA2 + 64 * 136;
  bf16* sKf = sB2 + 64 * 136;
  bf16* sKr = sKf + 64 * 40;
  float* sbf = (float*)(sKr + 64 * 40);
  float* sbr = sbf + 2048;
  float* spart = sbr + 2048;
  float* sGl = (float*)sB2;
  const bf16* pr = WS(bf16, OFF_PROJ);
  float qh[8], kh[8], vh[16], gh[16];
  u32x4 sth0, sth1;
#pragma unroll
  for (int i = 0; i < 8; i++) {
    const bf16* rp = pr + (size_t)(row0 + (tid >> 5) + 8 * i) * NIN + h * 32 + (tid & 31);
    qh[i] = bf2f(rp[C_GLA]); kh[i] = bf2f(rp[C_GLAK]);
  }
#pragma unroll
  for (int i = 0; i < 16; i++) vh[i] = bf2f(pr[(size_t)(row0 + (tid >> 6) + 4 * i) * NIN + C_GLAV + h * 64 + (tid & 63)]);
#pragma unroll
  for (int r = 0; r < 16; r++)
    gh[r] = bf2f(pr[(size_t)(row0 + (w >> 1) * 32 + acc_row(r, lane)) * NIN + C_GLAG + h * 64 + (w & 1) * 32 + (lane & 31)]);
  {
    const bf16* st0 = WS(bf16, OFF_GLAST) + ((size_t)((0 * BATCH + b) * NCH + pc) * 4 + h) * 2048;
    const bf16* st1 = WS(bf16, OFF_GLAST) + ((size_t)((1 * BATCH + b) * NCH + pc) * 4 + h) * 2048;
    sth0 = *(const u32x4*)(st0 + (tid >> 2) * 32 + (tid & 3) * 8);
    sth1 = *(const u32x4*)(st1 + (tid >> 2) * 32 + (tid & 3) * 8);
  }
#pragma unroll 8
  for (int idx = tid; idx < 64 * 32; idx += 256) {
    int t = idx >> 5, c = idx & 31;
    sGl[idx] = bf2f(pr[(size_t)(row0 + t) * NIN + C_GLAGL + c]);
  }
  __syncthreads();
  gla_la(P, l, 0, h, sGl, sbf);
  gla_la(P, l, 1, h, sGl, sbr);
  __syncthreads();
  {
    float* segtot = spart + 128;
    const int k = tid & 31, sg = tid >> 5;
    float rf = 0.f, rr_ = 0.f, lf[8], lr_[8];
#pragma unroll
    for (int j = 0; j < 8; j++) {
      int tf = sg * 8 + j, tr = 63 - tf;
      rf += sbf[tf * 32 + k]; lf[j] = rf;
      rr_ += sbr[tr * 32 + k]; lr_[j] = rr_;
    }
    segtot[sg * 32 + k] = rf; segtot[256 + sg * 32 + k] = rr_;
    __syncthreads();
    float of = 0.f, orr = 0.f;
#pragma unroll
    for (int j = 0; j < 8; j++) { if (j < sg) { of += segtot[j * 32 + k]; orr += segtot[256 + j * 32 + k]; } }
#pragma unroll
    for (int j = 0; j < 8; j++) {
      int tf = sg * 8 + j, tr = 63 - tf;
      sbf[tf * 32 + k] = lf[j] + of;
      sbr[tr * 32 + k] = lr_[j] + orr;
    }
  }
  __syncthreads();
#pragma unroll
  for (int i = 0; i < 8; i++) {
    const int idx = tid + 256 * i, t = idx >> 5, k = idx & 31;
    float q = qh[i] * 0.17677669529663687f;
    float kv = kh[i];
    float bf_ = sbf[idx], br_ = sbr[idx];
    sA2[t * 136 + 64 + k] = f2bf(q * __expf(bf_));
    sA2[t * 136 + 96 + k] = f2bf(q * __expf(br_));
    sKf[t * 40 + k] = f2bf(kv * __expf(-bf_));
    sKr[t * 40 + k] = f2bf(kv * __expf(-br_));
  }
#pragma unroll
  for (int i = 0; i < 16; i++) sB2[(tid & 63) * 136 + (tid >> 6) + 4 * i] = f2bf(vh[i]);
  *(u32x4*)&sB2[(tid >> 2) * 136 + 64 + (tid & 3) * 8] = sth0;
  *(u32x4*)&sB2[(tid >> 2) * 136 + 96 + (tid & 3) * 8] = sth1;
  __syncthreads();
  const int ti = w >> 1, tj = w & 1;
  {
    f32x16 pf = zero16(), pv = zero16();
    for (int ks = 0; ks < 32; ks += 16) {
      pf = mfma32(ldsfrag(&sA2[(ti * 32 + (lane & 31)) * 136 + 64 + ks + 8 * (lane >> 5)]),
                  ldsfrag(&sKf[(tj * 32 + (lane & 31)) * 40 + ks + 8 * (lane >> 5)]), pf);
      pv = mfma32(ldsfrag(&sA2[(ti * 32 + (lane & 31)) * 136 + 96 + ks + 8 * (lane >> 5)]),
                  ldsfrag(&sKr[(tj * 32 + (lane & 31)) * 40 + ks + 8 * (lane >> 5)]), pv);
    }
    int j = tj * 32 + (lane & 31);
    for (int r = 0; r < 16; r++) {
      int i = ti * 32 + acc_row(r, lane);
      float v = (j < i) ? pf[r] : (j > i) ? pv[r] : pf[r] + pv[r];
      sA2[i * 136 + j] = f2bf(v);
    }
  }
  __syncthreads();
  {
    f32x16 acc = zero16();
    for (int ks = 0; ks < 128; ks += 16)
      acc = mfma32(ldsfrag(&sA2[(ti * 32 + (lane & 31)) * 136 + ks + 8 * (lane >> 5)]),
                   ldsfrag(&sB2[(tj * 32 + (lane & 31)) * 136 + ks + 8 * (lane >> 5)]), acc);
    for (int r = 0; r < 16; r++) {
      int i = ti * 32 + acc_row(r, lane);
      float s2 = sum32(acc[r] * acc[r]);
      if ((lane & 31) == 31) spart[i * 2 + tj] = s2;
    }
    __syncthreads();
    int v = tj * 32 + (lane & 31);
    float gn = P.gla_norm[l * 256 + h * 64 + v];
    bf16* yc = WS(bf16, OFF_R);
    for (int r = 0; r < 16; r++) {
      int i = ti * 32 + acc_row(r, lane);
      int row = row0 + i;
      float rstd = rsqrtf((spart[i * 2] + spart[i * 2 + 1]) * (1.f / 64.f) + 1e-6f);
      float g = gh[r];
      yc[(size_t)row * 1024 + 768 + h * 64 + v] = f2bf(acc[r] * rstd * gn * silu_f(g));
    }
  }
  __syncthreads();
}

__device__ __forceinline__ void s5_out_tile(const Params& P, int l, int item, unsigned char* sm) {
  const int MT5 = (M5 + 127) / 128;
  int nt = item & 3, mt = (item >> 2) % MT5, g = (item >> 2) / MT5;
  const bf16* Bt = WS(bf16, OFF_BT2) + (size_t)(l * 16 + g) * 512 * 768;
  const float* X = WS(float, OFF_S5ST) + (size_t)g * M5 * 256;
  const bf16* pr = WS(bf16, OFF_PROJ);
  bf16* ys = WS(bf16, OFF_PROJ);
  gemm_tile(sm, mt * 128, nt * 128, 768,
    [&](int m, int k) {
      if (k < 512) return s5_u_load(P, g, m, k);
      if (m >= M5) return zero4();
      const float* xp = X + (size_t)m * 256 + (k - 512);
      F4 a = *(const F4*)xp, b2 = *(const F4*)(xp + 4);
      U4 r; r.a[0] = pack2(a.a[0], a.a[1]); r.a[1] = pack2(a.a[2], a.a[3]); r.a[2] = pack2(b2.a[0], b2.a[1]); r.a[3] = pack2(b2.a[2], b2.a[3]);
      return r;
    },
    [&](int n, int k) { return *(const U4*)(Bt + (size_t)n * 768 + k); },
    [&](int m, int n, float v) {
      if (m >= M5) return;
      int b = m / NCH5, pc = m - b * NCH5;
      int row = chunk_row0(b, pc, T5, NC5) + (n >> 4);
      int ch = g * 16 + (n & 15);
      float u = bf2f(pr[(size_t)row * NIN + C_S5 + ch]);
      ys[(size_t)row * NIN + (ch >> 6) * 128 + 64 + (ch & 63)] = f2bf(gelu_f(v + P.s5_d[l * 256 + ch] * u));
    });
}

__device__ __forceinline__ void phase_F(const Params& P, int l, unsigned char* sm, long long& pacc) {
  const int n_ssd = BATCH * NCH * 4, n_gla = BATCH * NCH * 4, n_s5 = 16 * ((M5 + 127) / 128) * 4, n_rw = BATCH * NCH * 4;
#define SUBP(id, stmt) { long long t0_ = 0; if (PROBE_PHASE == (id)) t0_ = wall_clock64(); stmt; if (PROBE_PHASE == (id)) pacc += wall_clock64() - t0_; }
  SUBP(51, ITEM_LOOP(i, n_ssd, 0) ssd_out_item(P, l, i, sm, pacc))
  SUBP(52, ITEM_LOOP(i, n_gla, n_ssd) gla_out_item(P, l, i, sm))
  SUBP(53, ITEM_LOOP(i, n_s5, n_ssd + n_gla) s5_out_tile(P, l, i, sm))
  SUBP(54, ITEM_LOOP(i, n_rw, n_ssd + n_gla + n_s5) rwkv_out_item(P, l, i, sm))
}

__device__ __forceinline__ void phase_G(const Params& P, int l, unsigned char* sm) {
  const int lane = threadIdx.x & 63, w = threadIdx.x >> 6;
  const int n_glu = (ROWS / 128) * 2, n_rows = ROWS / 4;
  const bf16* Bt = WS(bf16, OFF_GLUT) + (size_t)l * 256 * 256;
  const bf16* pr = WS(bf16, OFF_PROJ);
  bf16* yc = WS(bf16, OFF_R);
#pragma unroll 1
  for (int it = blockIdx.x; it < n_glu + n_rows; it += gridDim.x) {
    if (it < n_glu) {
      int nt = it & 1, mt = it >> 1;
      if (l == 1 && mt < ROWS_C / 128) continue;
      gemm_tile(sm, mt * 128, nt * 128, 256,
        [&](int m, int k) { return *(const U4*)(pr + (size_t)m * NIN + (k >> 6) * 128 + 64 + (k & 63)); },
        [&](int n, int k) { return *(const U4*)(Bt + (size_t)n * 256 + k); },
        [&](int m, int n, float v) {
          float y = bf2f(pr[(size_t)m * NIN + (n >> 6) * 128 + 64 + (n & 63)]);
          float g = bf2f(pr[(size_t)m * NIN + C_S5G + n]);
          yc[(size_t)m * 1024 + 256 + n] = f2bf(y * sigmoid_f(v + P.s5_glu_b[l * 256 + n]) * silu_f(g));
        });
      continue;
    }
    int m = (it - n_glu) * 4 + w;
    const float* sq = WS(float, OFF_SSQ) + (size_t)m * 4;
    float rstd = rsqrtf((sq[0] + sq[1] + sq[2] + sq[3]) * (1.f / 256.f) + 1e-6f);
    bf16* p = yc + (size_t)m * 1024 + lane * 4;
    U2 v = *(U2*)p;
    const float* gn = P.ssd_norm + l * 256 + lane * 4;
    U2 o;
    o.a[0] = pack2(lo2f(v.a[0]) * rstd * gn[0], hi2f(v.a[0]) * rstd * gn[1]);
    o.a[1] = pack2(lo2f(v.a[1]) * rstd * gn[2], hi2f(v.a[1]) * rstd * gn[3]);
    *(U2*)p = o;
  }
}

__device__ __forceinline__ void phase_outproj(const Params& P, int l, unsigned char* sm) {
  const bf16* A = WS(bf16, OFF_R);
  const bf16* Bt = WS(bf16, OFF_WTOUT) + (size_t)l * D * D;
  bf16* Y = WS(bf16, OFF_PROJ);
  const int NT = D / 128, MT = ROWS / 128;
#pragma unroll 1
  for (int it0 = blockIdx.x; it0 < MT * NT; it0 += gridDim.x) {
    const int per = (MT * NT) / 8;
    int it = (MT * NT) % 8 == 0 ? (it0 & 7) * per + (it0 >> 3) : it0;
    int mt = it / NT, nt = it % NT;
    if (l == 1 && mt < ROWS_C / 128) continue;
    gemm_tile(sm, mt * 128, nt * 128, D,
      [&](int m, int k) { return *(const U4*)(A + (size_t)m * D + k); },
      [&](int n, int k) { return *(const U4*)(Bt + (size_t)n * D + k); },
      [&](int m, int n, float v) { Y[(size_t)m * D + n] = f2bf(v); });
  }
}

__device__ __forceinline__ void phase_post(const Params& P, int l) {
  const int lane = threadIdx.x & 63, w = threadIdx.x >> 6;
  const int first = (l == 1) ? ROWS_C / 4 : 0;
#pragma unroll 1
  for (int it = first + blockIdx.x; it < ROWS / 4; it += gridDim.x) {
    int m = it * 4 + w;
    RowInfo ri = row_info(m);
    const bf16* y = WS(bf16, OFF_PROJ) + (size_t)m * D + lane * 16;
    const float* hres; float* dst;
    if (ri.isctx) { hres = P.ctx + (size_t)m * D; dst = WS(float, OFF_HC) + (size_t)m * D; }
    else { hres = (l == 0 ? P.x : P.out) + (size_t)(m - ROWS_C) * D; dst = P.out + (size_t)(m - ROWS_C) * D; }
    const int mrow = ri.isctx ? BATCH : ri.b;
    const float* mod = WS(float, OFF_MOD) + ((size_t)l * NMOD + mrow) * 3072 + 2048;
    const int c0 = lane * 16;
    U4 y0 = *(const U4*)y, y1 = *(const U4*)(y + 8);
    float v[16]; float ss = 0.f;
#pragma unroll
    for (int e = 0; e < 4; e++) { v[2 * e] = lo2f(y0.a[e]); v[2 * e + 1] = hi2f(y0.a[e]); v[8 + 2 * e] = lo2f(y1.a[e]); v[8 + 2 * e + 1] = hi2f(y1.a[e]); }
#pragma unroll
    for (int e = 0; e < 16; e++) ss += v[e] * v[e];
    ss = sum64(ss);
    float rstd = rsqrtf(ss * (1.f / 1024.f) + 1e-6f);
    float hn[16]; float ss2 = 0.f;
#pragma unroll
    for (int q = 0; q < 4; q++) {
      F4 hr = *(const F4*)(hres + c0 + 4 * q), gm = *(const F4*)(mod + c0 + 4 * q), np = *(const F4*)(P.norm_post + l * D + c0 + 4 * q), o;
#pragma unroll
      for (int e = 0; e < 4; e++) { o.a[e] = hr.a[e] + gm.a[e] * (v[4 * q + e] * rstd * np.a[e]); hn[4 * q + e] = o.a[e]; ss2 += o.a[e] * o.a[e]; }
      *(F4*)(dst + c0 + 4 * q) = o;
    }
    if (l == 0) {
      ss2 = sum64(ss2);
      float rstd2 = rsqrtf(ss2 * (1.f / 1024.f) + 1e-6f);
      const float* mod1 = WS(float, OFF_MOD) + ((size_t)1 * NMOD + mrow) * 3072;
      bf16* hd = WS(bf16, OFF_R) + (size_t)m * D + c0;
      U4 o0, o1;
#pragma unroll
      for (int q = 0; q < 4; q++) {
        F4 np = *(const F4*)(P.norm_pre + 1 * D + c0 + 4 * q), sc = *(const F4*)(mod1 + 1024 + c0 + 4 * q), sh = *(const F4*)(mod1 + c0 + 4 * q);
        float t0 = hn[4 * q] * rstd2 * np.a[0] * (1.f + sc.a[0]) + sh.a[0], t1 = hn[4 * q + 1] * rstd2 * np.a[1] * (1.f + sc.a[1]) + sh.a[1];
        float t2 = hn[4 * q + 2] * rstd2 * np.a[2] * (1.f + sc.a[2]) + sh.a[2], t3 = hn[4 * q + 3] * rstd2 * np.a[3] * (1.f + sc.a[3]) + sh.a[3];
        if (q < 2) { o0.a[2 * q] = pack2(t0, t1); o0.a[2 * q + 1] = pack2(t2, t3); }
        else { o1.a[2 * (q - 2)] = pack2(t0, t1); o1.a[2 * (q - 2) + 1] = pack2(t2, t3); }
      }
      *(U4*)hd = o0; *(U4*)(hd + 8) = o1;
    }
  }
}

constexpr int NPHASE = 19;
__device__ __forceinline__ void run_phase(const Params& P, int ph, unsigned char* sm) {
  if (ph == 0) { phase_prologue(P, sm); return; }
  int l = (ph - 1) / 9, s = (ph - 1) % 9;
  switch (s) {
    case 0: if (l == 0) phase_normmod(P, l); break;
    case 1: phase_inproj(P, l, sm); break;
    case 2: phase_rwprep(P, l, sm); break;
    case 3: { long long dummy = 0; phase_D(P, l, sm, dummy); } break;
    case 4: phase_E(P, l, sm); break;
    case 5: { long long dummy = 0; phase_F(P, l, sm, dummy); } break;
    case 6: phase_G(P, l, sm); break;
    case 7: phase_outproj(P, l, sm); break;
    default: phase_post(P, l); break;
  }
}

#ifndef CPU_EMU
#define XB_TMO      128
#define XB_XCNT(j)  (256  + 64 * (j))
#define XB_XSUB(j)  (1280 + 64 * (j))
#define XB_XGEN(j)  (2304 + 64 * (j))
#define XB_TOP      3328
#define XB_TOPGEN   3392
#define XCD_BAR_WORDS 3456
#define XB_SPIN_CAP (1u << 18)
#define LAS __attribute__((address_space(3)))

__device__ __forceinline__ unsigned xb_ld(unsigned* p)              { return __hip_atomic_load(p, __ATOMIC_RELAXED, __HIP_MEMORY_SCOPE_AGENT); }
__device__ __forceinline__ unsigned xb_add(unsigned* p, unsigned v) { return __hip_atomic_fetch_add(p, v, __ATOMIC_RELAXED, __HIP_MEMORY_SCOPE_AGENT); }
__device__ __forceinline__ unsigned xb_xcc_id() { return (unsigned)__builtin_amdgcn_s_getreg((3 << 11) | 20) & 0xFu; }
#define XB_SPIN(cond, bar) do { unsigned _sp = 0; while (cond) { __builtin_amdgcn_s_sleep(1); \
    if ((++_sp & 255u) == 0u) { if (xb_ld(&(bar)[XB_TMO])) break; if (_sp > XB_SPIN_CAP) { atomicAdd(&(bar)[XB_TMO], 1u); break; } } } } while (0)

struct XcdBarrier {
    unsigned* bar; unsigned x;
    volatile LAS unsigned* st;
};

__device__ __forceinline__ XcdBarrier xcd_barrier_post(unsigned* bar, volatile LAS unsigned* st) {
    XcdBarrier b; b.bar = bar; b.x = xb_xcc_id(); b.st = st;
    if (threadIdx.x == 0) (void)xb_add(&bar[XB_XCNT(b.x)], 1u);
    return b;
}
__device__ __forceinline__ void xcd_barrier_complete(unsigned* bar, unsigned x, unsigned& nloc, unsigned& nx) {
    const unsigned G = gridDim.x * gridDim.y * gridDim.z;
    unsigned sum, cnt, mine, sp = 0u;
    for (;;) {
        sum = 0u; cnt = 0u; mine = 0u;
#pragma unroll
        for (unsigned j = 0; j < 16; ++j) { const unsigned c = xb_ld(&bar[XB_XCNT(j)]); sum += c; cnt += (c > 0u) ? 1u : 0u; mine = (j == x) ? c : mine; }
        if (sum == G) break;
        __builtin_amdgcn_s_sleep(1);
        if ((++sp & 255u) == 0u) { if (xb_ld(&bar[XB_TMO])) break; if (sp > XB_SPIN_CAP) { atomicAdd(&bar[XB_TMO], 1u); break; } }
    }
    nloc = mine > 0u ? mine : 1u; nx = cnt > 0u ? cnt : 1u;
}

__device__ __forceinline__ void xcd_barrier(const XcdBarrier& b) {
    asm volatile("s_waitcnt vmcnt(0)" ::: "memory");
    __syncthreads();
    if (threadIdx.x == 0) {
        unsigned* bar = b.bar;
        __builtin_amdgcn_s_waitcnt(0);
        unsigned nloc = b.st[0], nx = b.st[1];
        if (nloc == 0u) { xcd_barrier_complete(bar, b.x, nloc, nx); b.st[0] = nloc; b.st[1] = nx; }
        const unsigned old = xb_add(&bar[XB_XSUB(b.x)], 1u);
        const unsigned gen = old / nloc;
        if (old + 1u == (gen + 1u) * nloc) {
            __builtin_amdgcn_fence(__ATOMIC_RELEASE, "agent");
            asm volatile("s_waitcnt vmcnt(0)" ::: "memory");
            const unsigned og = xb_add(&bar[XB_TOP], 1u);
            const unsigned tg = og / nx;
            if (og + 1u == (tg + 1u) * nx) xb_add(&bar[XB_TOPGEN], 1u);
            else XB_SPIN(xb_ld(&bar[XB_TOPGEN]) == tg, bar);
            __builtin_amdgcn_fence(__ATOMIC_ACQUIRE, "agent");
            xb_add(&bar[XB_XGEN(b.x)], 1u);
            asm volatile("s_waitcnt vmcnt(0)" ::: "memory");
        } else {
            XB_SPIN(xb_ld(&bar[XB_XGEN(b.x)]) == gen, bar);
            __builtin_amdgcn_fence(__ATOMIC_ACQUIRE, "agent");
            asm volatile("s_waitcnt vmcnt(0)" ::: "memory");
        }
    }
    __syncthreads();
}


#define PH(bit, call) { long long t0_ = 0; if (PROBE_PHASE == (bit)) t0_ = wall_clock64(); call; xcd_barrier(xb); if (PROBE_PHASE == (bit)) pacc += wall_clock64() - t0_; }
template <int L> __device__ __forceinline__ void run_layer(const Params& P, unsigned char* sm, const XcdBarrier& xb, long long& pacc) {
  if (L == 0) PH(0, phase_normmod(P, L))
  PH(1, phase_inproj(P, L, sm))
  PH(2, phase_rwprep(P, L, sm))
  PH(3, phase_D(P, L, sm, pacc))
  PH(4, phase_E(P, L, sm))
  PH(5, phase_F(P, L, sm, pacc))
  PH(6, phase_G(P, L, sm))
  PH(7, phase_outproj(P, L, sm))
  if (L == 0) PH(8, phase_post(P, L))
  else phase_post(P, L);
}
__global__ void __launch_bounds__(256, 2) mega_kernel(Params P) {
  __shared__ __attribute__((aligned(16))) unsigned char sm[SMEM_BYTES];
  __shared__ uint4 xb_words;
  cg::grid_group grid = cg::this_grid();
  long long pacc = 0;
  if (threadIdx.x == 0) xb_words = make_uint4(0u, 0u, 0u, 0u);
  __syncthreads();
  XcdBarrier xb = xcd_barrier_post((unsigned*)(P.ws + OFF_BAR), (volatile LAS unsigned*)&xb_words);
  if (P.ws == nullptr) grid.sync();
  PH(9, phase_prologue(P, sm))
  run_layer<0>(P, sm, xb, pacc);
  run_layer<1>(P, sm, xb, pacc);
  if (PROBE_PHASE >= 0 && blockIdx.x == 0 && threadIdx.x == 0) {
    long long t1 = wall_clock64();
    while (wall_clock64() - t1 < pacc) { __builtin_amdgcn_s_sleep(10); }
  }
}
__global__ void __launch_bounds__(256, 2) phase_kernel(Params P, int ph) {
  __shared__ __attribute__((aligned(16))) unsigned char sm[SMEM_BYTES];
  run_phase(P, ph, sm);
}

extern "C" void kernel_launch(void* const* d_in, const int* in_sizes, int n_in, void* d_out, int out_size,
                              void* d_ws, size_t ws_size, hipStream_t stream) {
  Params P{};
  const float** pp = (const float**)&P;
  for (int i = 0; i < 39; i++) pp[i] = (const float*)d_in[i];
  P.out = (float*)d_out;
  P.ws = (unsigned char*)d_ws;
  if (ws_size < WS_TOTAL) fprintf(stderr, "workspace too small: %zu < %zu\n", ws_size, (size_t)WS_TOTAL);
#if USE_COOP
  static int grid_blocks = 0;
  if (!grid_blocks) {
    int dev = 0, cus = 0, per_cu = 0;
    hipGetDevice(&dev);
    hipDeviceGetAttribute(&cus, hipDeviceAttributeMultiprocessorCount, dev);
    hipOccupancyMaxActiveBlocksPerMultiprocessor(&per_cu, mega_kernel, 256, 0);
    if (per_cu > 2) per_cu = 2;
    grid_blocks = cus * per_cu;
  }
  hipMemsetAsync((unsigned char*)d_ws + OFF_BAR, 0, 3456 * 4, stream);
  void* args[] = {&P};
  hipError_t e = hipLaunchCooperativeKernel((void*)mega_kernel, dim3(grid_blocks), dim3(256), args, 0, stream);
  if (e != hipSuccess) fprintf(stderr, "cooperative launch failed: %s (grid %d)\n", hipGetErrorString(e), grid_blocks);
#else
  for (int ph = 0; ph < NPHASE; ph++) phase_kernel<<<1024, 256, 0, stream>>>(P, ph);
#endif
}
#endif
```

```cpp
#ifdef CPU_EMU
#include "hip_emu.h"
#else
#include <hip/hip_runtime.h>
#include <hip/hip_cooperative_groups.h>
#include <stdint.h>
#include <stdio.h>
namespace cg = cooperative_groups;
#endif

#ifndef BATCH
#define BATCH 8
#endif
#ifndef SEQ
#define SEQ 4096
#endif
#ifndef CTX
#define CTX 256
#endif
#ifndef USE_COOP
#define USE_COOP 1
#endif
#ifndef PROBE_PHASE
#define PROBE_PHASE -1
#endif

typedef unsigned short bf16;
typedef __attribute__((ext_vector_type(8))) short bf16x8;
typedef __attribute__((ext_vector_type(16))) float f32x16;
struct alignas(16) U4 { uint32_t a[4]; };
typedef uint32_t u32x4 __attribute__((ext_vector_type(4)));
struct alignas(8) U2 { uint32_t a[2]; };
struct alignas(16) F4 { float a[4]; };

constexpr int D = 1024, NIN = 3368, NINP = 3456;
constexpr int ROWS_C = BATCH * CTX, ROWS_L = BATCH * SEQ, ROWS = ROWS_C + ROWS_L;
constexpr int VL = CTX + SEQ;
constexpr int TC = 64;
constexpr int NCH_C = CTX / TC, NCH_L = SEQ / TC, NCH = NCH_C + NCH_L;
constexpr int T5 = 32;
constexpr int NC5 = CTX / T5, NL5 = SEQ / T5, NCH5 = NC5 + NL5;
constexpr int M5 = BATCH * NCH5;
constexpr int NMOD = BATCH + 1;
constexpr int C_RW = 0, C_RWG = 1024, C_S5 = 1280, C_S5G = 1536, C_SSD = 1792, C_SSDDT = 2304, C_SSDZ = 2312;
constexpr int C_GLA = 2568, C_GLAK = 2696, C_GLAV = 2824, C_GLAGL = 3080, C_GLAG = 3112;

constexpr size_t al256(size_t x) { return (x + 255) & ~size_t(255); }
constexpr size_t OFF_WTIN = 0;
constexpr size_t OFF_WTOUT = OFF_WTIN + al256(2ull * NINP * D * 2);
constexpr size_t OFF_W2T = OFF_WTOUT + al256(2ull * D * D * 2);
constexpr size_t OFF_A2T = OFF_W2T + al256(2ull * 2 * 256 * 64 * 2);
constexpr size_t OFF_GLUT = OFF_A2T + al256(2ull * 2 * 256 * 64 * 2);
constexpr size_t OFF_MOD = OFF_GLUT + al256(2ull * 256 * 256 * 2);
constexpr size_t OFF_S5K = OFF_MOD + al256(2ull * NMOD * 3072 * 4);
constexpr size_t OFF_S5LT = OFF_S5K + al256(2ull * 16 * 2 * 32 * 256 * 4);
constexpr size_t OFF_W1T = OFF_S5LT + al256(2ull * 16 * 2 * 64 * 2 * 4);
constexpr size_t OFF_BT2 = OFF_W1T + al256(2ull * 16 * 256 * 512 * 2);
constexpr size_t OFF_PROJ = OFF_BT2 + al256(2ull * 16 * 512 * 768 * 2);
constexpr size_t OFF_R = OFF_PROJ + al256((size_t)ROWS * NIN * 2);
constexpr size_t OFF_XA = OFF_R + al256((size_t)ROWS * 1024 * 2);
constexpr size_t OFF_HC = OFF_XA + al256((size_t)ROWS * 1024 * 2);
constexpr size_t OFF_SSDST = OFF_HC + al256((size_t)ROWS_C * 1024 * 4);
constexpr size_t OFF_SSDDEC = OFF_SSDST + al256(2ull * BATCH * NCH * 4 * 4096 * 2);
constexpr size_t OFF_GLAST = OFF_SSDDEC + al256(2ull * BATCH * NCH * 4 * 4);
constexpr size_t OFF_GLADEC = OFF_GLAST + al256(2ull * BATCH * NCH * 4 * 2048 * 2);
constexpr size_t OFF_S5ST = OFF_GLADEC + al256(2ull * BATCH * NCH * 4 * 32 * 4);
constexpr size_t OFF_SSQ = OFF_S5ST + al256(16ull * M5 * 256 * 4);
constexpr size_t OFF_BON = OFF_SSQ + al256((size_t)ROWS * 4 * 4);
constexpr size_t OFF_BAR = OFF_BON + al256((size_t)ROWS * 8 * 4);
constexpr size_t OFF_YS5 = OFF_BAR + al256(3456 * 4);
constexpr size_t WS_TOTAL = OFF_YS5 + al256((size_t)ROWS * 256 * 2);
#if BATCH == 8 && SEQ == 4096 && CTX == 256
static_assert(WS_TOTAL <= 536870912ull, "workspace too large");
#endif
constexpr int SMEM_BYTES = 64512;

struct Params {
  const float *x, *c, *ctx, *c_ctx, *ada_w, *ada_b, *norm_pre, *norm_post, *w_in, *w_out;
  const float *rw_mu, *rw_w0, *rw_w2, *rw_a0, *rw_a2, *rw_kk, *rw_ka, *rw_rk, *rw_ln_w, *rw_ln_b;
  const float *s5_a_re, *s5_a_im, *s5_log_dt, *s5_b_re, *s5_b_im, *s5_c_re, *s5_c_im, *s5_d, *s5_glu_w, *s5_glu_b;
  const float *ssd_conv_w, *ssd_conv_b, *ssd_dt_bias, *ssd_a_log, *ssd_d, *ssd_norm;
  const float *gla_g2, *gla_gb, *gla_norm;
  float* out;
  unsigned char* ws;
};

#ifdef CPU_EMU
#define OPAQUE(x)
#else
#define OPAQUE(x) asm volatile("" : "+v"(x))
#endif
struct Params;
__device__ __forceinline__ void ssd_state_item(const Params& P, int l, int item, unsigned char* sm);
__device__ __forceinline__ void gla_state_item(const Params& P, int l, int item, unsigned char* sm);
__device__ __forceinline__ void s5_state_tile(const Params& P, int l, int item, unsigned char* sm);
__device__ __forceinline__ void chunk_scans(const Params& P, int l, int base);
__device__ __forceinline__ float bf2f(bf16 v) { return __uint_as_float(((uint32_t)v) << 16); }
__device__ __forceinline__ bf16 f2bf(float f) {
  uint32_t u = __float_as_uint(f);
  u += 0x7fffu + ((u >> 16) & 1u);
  return (bf16)(u >> 16);
}
__device__ __forceinline__ uint32_t pack2(float lo, float hi) { return (uint32_t)f2bf(lo) | ((uint32_t)f2bf(hi) << 16); }
__device__ __forceinline__ float lo2f(uint32_t u) { return __uint_as_float(u << 16); }
__device__ __forceinline__ float hi2f(uint32_t u) { return __uint_as_float(u & 0xffff0000u); }
__device__ __forceinline__ float sigmoid_f(float x) { return 1.f / (1.f + __expf(-x)); }
__device__ __forceinline__ float silu_f(float x) { return x / (1.f + __expf(-x)); }
__device__ __forceinline__ float softplus_f(float x) { return fmaxf(x, 0.f) + __logf(1.f + __expf(-fabsf(x))); }
__device__ __forceinline__ float tanh_f(float x) { return 1.f - 2.f / (1.f + __expf(2.f * x)); }
__device__ __forceinline__ float gelu_f(float x) {
  return 0.5f * x * (1.f + tanh_f(0.7978845608028654f * (x + 0.044715f * x * x * x)));
}
__device__ __forceinline__ U4 zero4() { U4 r; r.a[0] = r.a[1] = r.a[2] = r.a[3] = 0; return r; }
__device__ __forceinline__ f32x16 mfma32(bf16x8 a, bf16x8 b, f32x16 c) {
#ifdef CPU_EMU
  return emu_mfma32(a, b, c);
#else
  return __builtin_amdgcn_mfma_f32_32x32x16_bf16(a, b, c, 0, 0, 0);
#endif
}
__device__ __forceinline__ f32x16 zero16() { f32x16 z; for (int i = 0; i < 16; i++) z[i] = 0.f; return z; }
__device__ __forceinline__ int acc_row(int reg, int lane) { return (reg & 3) + 8 * (reg >> 2) + 4 * (lane >> 5); }
template <int CTRL> __device__ __forceinline__ float dpp_mov(float v) {
#ifdef CPU_EMU
  int l = threadIdx.x & 63, src;
  if (CTRL == 0xB1) src = l ^ 1; else if (CTRL == 0x4E) src = l ^ 2;
  else if (CTRL == 0x141) src = (l & ~7) | (7 - (l & 7)); else src = (l & ~15) | (15 - (l & 15));
  return emu_lane_read(v, src);
#else
  return __int_as_float(__builtin_amdgcn_update_dpp(0, __float_as_int(v), CTRL, 0xF, 0xF, true));
#endif
}
__device__ __forceinline__ float sum16(float v) {
  v += dpp_mov<0xB1>(v); v += dpp_mov<0x4E>(v); v += dpp_mov<0x141>(v); v += dpp_mov<0x140>(v); return v;
}
__device__ __forceinline__ float sum32(float v) {
  v = sum16(v);
#ifdef CPU_EMU
  int l = threadIdx.x & 63; float o = emu_lane_read(v, ((l >> 4) > 0 ? ((l >> 4) - 1) * 16 + 15 : 0));
  if ((l >> 4) & 1) v += o;
#else
  v += __int_as_float(__builtin_amdgcn_update_dpp(0, __float_as_int(v), 0x142, 0xA, 0xF, false));
#endif
  return v;
}
__device__ __forceinline__ float sum64(float v) {
  v = sum16(v);
#ifdef CPU_EMU
  return emu_lane_read(v, 0) + emu_lane_read(v, 16) + emu_lane_read(v, 32) + emu_lane_read(v, 48);
#else
  int iv = __float_as_int(v);
  return __int_as_float(__builtin_amdgcn_readlane(iv, 0)) + __int_as_float(__builtin_amdgcn_readlane(iv, 16)) +
         __int_as_float(__builtin_amdgcn_readlane(iv, 32)) + __int_as_float(__builtin_amdgcn_readlane(iv, 48));
#endif
}

__device__ __forceinline__ const bf16x8& ldsfrag(const bf16* p) { return *(const bf16x8*)p; }

__device__ __forceinline__ int chunk_row0(int b, int pc, int T, int nC) {
  return pc < nC ? b * CTX + pc * T : ROWS_C + b * SEQ + (pc - nC) * T;
}
__device__ __forceinline__ int ord_chunk(int d, int vc, int nC, int nAll) {
  return d == 0 ? vc : (vc < nC ? nC - 1 - vc : nAll - 1 - (vc - nC));
}
struct RowInfo { int isctx, b, t, seq0, len; };
__device__ __forceinline__ RowInfo row_info(int m) {
  RowInfo r;
  if (m < ROWS_C) { r.isctx = 1; r.b = m / CTX; r.t = m - r.b * CTX; r.seq0 = r.b * CTX; r.len = CTX; }
  else { int q = m - ROWS_C; r.isctx = 0; r.b = q / SEQ; r.t = q - r.b * SEQ; r.seq0 = ROWS_C + r.b * SEQ; r.len = SEQ; }
  return r;
}

template <class AL, class BL, class EP>
__device__ __forceinline__ void gemm_tile(unsigned char* sm, int m0, int n0, int K, AL al, BL bl, EP ep) {
  bf16* sA0 = (bf16*)sm;
  int tid_ = threadIdx.x; OPAQUE(tid_);
  const int tid = tid_, lane = tid & 63, w = tid >> 6, wm = w >> 1, wn = w & 1;
  f32x16 acc[2][2];
#pragma unroll
  for (int i = 0; i < 2; i++)
#pragma unroll
    for (int j = 0; j < 2; j++) acc[i][j] = zero16();
  const int lr = tid >> 2, lk = (tid & 3) * 8;
  U4 ra0 = al(m0 + lr, lk), ra1 = al(m0 + lr + 64, lk), rb0 = bl(n0 + lr, lk), rb1 = bl(n0 + lr + 64, lk);
  {
    bf16* sA = sA0; bf16* sB = sA + 128 * 40;
    *(U4*)&sA[lr * 40 + lk] = ra0; *(U4*)&sA[(lr + 64) * 40 + lk] = ra1;
    *(U4*)&sB[lr * 40 + lk] = rb0; *(U4*)&sB[(lr + 64) * 40 + lk] = rb1;
  }
  if (32 < K) { ra0 = al(m0 + lr, 32 + lk); ra1 = al(m0 + lr + 64, 32 + lk); rb0 = bl(n0 + lr, 32 + lk); rb1 = bl(n0 + lr + 64, 32 + lk); }
  __syncthreads();
  int cur = 0;
#pragma unroll 1
  for (int k0 = 0; k0 < K; k0 += 32) {
    bf16* sA = sA0 + cur * (256 * 40); bf16* sB = sA + 128 * 40;
    if (k0 + 32 < K) {
      bf16* nA = sA0 + (cur ^ 1) * (256 * 40); bf16* nB = nA + 128 * 40;
      *(U4*)&nA[lr * 40 + lk] = ra0; *(U4*)&nA[(lr + 64) * 40 + lk] = ra1;
      *(U4*)&nB[lr * 40 + lk] = rb0; *(U4*)&nB[(lr + 64) * 40 + lk] = rb1;
      if (k0 + 64 < K) {
        ra0 = al(m0 + lr, k0 + 64 + lk); ra1 = al(m0 + lr + 64, k0 + 64 + lk);
        rb0 = bl(n0 + lr, k0 + 64 + lk); rb1 = bl(n0 + lr + 64, k0 + 64 + lk);
      }
    }
#pragma unroll
    for (int ks = 0; ks < 32; ks += 16) {
      bf16x8 fa[2], fb[2];
#pragma unroll
      for (int i = 0; i < 2; i++) fa[i] = ldsfrag(&sA[(wm * 64 + i * 32 + (lane & 31)) * 40 + ks + 8 * (lane >> 5)]);
#pragma unroll
      for (int j = 0; j < 2; j++) fb[j] = ldsfrag(&sB[(wn * 64 + j * 32 + (lane & 31)) * 40 + ks + 8 * (lane >> 5)]);
#pragma unroll
      for (int i = 0; i < 2; i++)
#pragma unroll
        for (int j = 0; j < 2; j++) acc[i][j] = mfma32(fa[i], fb[j], acc[i][j]);
    }
    __syncthreads();
    cur ^= 1;
  }
#pragma unroll
  for (int i = 0; i < 2; i++)
#pragma unroll
   for (int j = 0; j < 2; j++)
#pragma unroll
    for (int r = 0; r < 16; r++)
      ep(m0 + wm * 64 + i * 32 + acc_row(r, lane), n0 + wn * 64 + j * 32 + (lane & 31), acc[i][j][r]);
}

template <class AL, class BL, class EP>
__device__ __forceinline__ void gemm_tile_big(unsigned char* sm, int m0, int n0, int K, AL al, BL bl, EP ep) {
  bf16* sA0 = (bf16*)sm;
  int tid_ = threadIdx.x; OPAQUE(tid_);
  const int tid = tid_, lane = tid & 63, w = tid >> 6, wm = w >> 1, wn = w & 1;
  f32x16 acc[4][2];
#pragma unroll
  for (int i = 0; i < 4; i++)
#pragma unroll
    for (int j = 0; j < 2; j++) acc[i][j] = zero16();
  const int lr = tid >> 2, lk = (tid & 3) * 8;
  U4 ra[4], rb[2];
#pragma unroll
  for (int i = 0; i < 4; i++) ra[i] = al(m0 + lr + 64 * i, lk);
#pragma unroll
  for (int i = 0; i < 2; i++) rb[i] = bl(n0 + lr + 64 * i, lk);
  {
    bf16* sA = sA0; bf16* sB = sA + 256 * 40;
#pragma unroll
    for (int i = 0; i < 4; i++) *(U4*)&sA[(lr + 64 * i) * 40 + lk] = ra[i];
#pragma unroll
    for (int i = 0; i < 2; i++) *(U4*)&sB[(lr + 64 * i) * 40 + lk] = rb[i];
  }
  if (32 < K) {
#pragma unroll
    for (int i = 0; i < 4; i++) ra[i] = al(m0 + lr + 64 * i, 32 + lk);
#pragma unroll
    for (int i = 0; i < 2; i++) rb[i] = bl(n0 + lr + 64 * i, 32 + lk);
  }
  __syncthreads();
  int cur = 0;
#pragma unroll 2
  for (int k0 = 0; k0 < K; k0 += 32) {
    bf16* sA = sA0 + cur * (384 * 40); bf16* sB = sA + 256 * 40;
    if (k0 + 32 < K) {
      bf16* nA = sA0 + (cur ^ 1) * (384 * 40); bf16* nB = nA + 256 * 40;
#pragma unroll
      for (int i = 0; i < 4; i++) *(U4*)&nA[(lr + 64 * i) * 40 + lk] = ra[i];
#pragma unroll
      for (int i = 0; i < 2; i++) *(U4*)&nB[(lr + 64 * i) * 40 + lk] = rb[i];
      if (k0 + 64 < K) {
#pragma unroll
        for (int i = 0; i < 4; i++) ra[i] = al(m0 + lr + 64 * i, k0 + 64 + lk);
#pragma unroll
        for (int i = 0; i < 2; i++) rb[i] = bl(n0 + lr + 64 * i, k0 + 64 + lk);
      }
    }
#pragma unroll
    for (int ks = 0; ks < 32; ks += 16) {
      bf16x8 fa[4], fb[2];
#pragma unroll
      for (int i = 0; i < 4; i++) fa[i] = ldsfrag(&sA[(wm * 128 + i * 32 + (lane & 31)) * 40 + ks + 8 * (lane >> 5)]);
#pragma unroll
      for (int j = 0; j < 2; j++) fb[j] = ldsfrag(&sB[(wn * 64 + j * 32 + (lane & 31)) * 40 + ks + 8 * (lane >> 5)]);
#pragma unroll
      for (int i = 0; i < 4; i++)
#pragma unroll
        for (int j = 0; j < 2; j++) acc[i][j] = mfma32(fa[i], fb[j], acc[i][j]);
    }
    __syncthreads();
    cur ^= 1;
  }
#pragma unroll
  for (int i = 0; i < 4; i++)
#pragma unroll
    for (int j = 0; j < 2; j++)
#pragma unroll
      for (int r = 0; r < 16; r++)
        ep(m0 + wm * 128 + i * 32 + acc_row(r, lane), n0 + wn * 64 + j * 32 + (lane & 31), acc[i][j][r]);
}

#define ITEM_LOOP(var, count, base) _Pragma("unroll 1") for (int var = (int)((blockIdx.x + gridDim.x - ((unsigned)(base) % gridDim.x)) % gridDim.x); var < (count); var += gridDim.x)
#define WS(T, off) ((T*)(P.ws + (off)))

__device__ __forceinline__ void transpose_tile(const float* src, int ld, int Ksz, int Nsz, bf16* dst, int kt, int nt, unsigned char* sm, bool perm = false) {
  float* s = (float*)sm;
  const int tid = threadIdx.x;
#pragma unroll 8
  for (int i = tid; i < 4096; i += 256) {
    int kk = i >> 6, nn = i & 63;
    int k = kt * 64 + kk, n = nt * 64 + nn;
    s[kk * 65 + nn] = (n < Nsz && k < Ksz) ? src[(size_t)k * ld + n] : 0.f;
  }
  __syncthreads();
#pragma unroll 8
  for (int i = tid; i < 4096; i += 256) {
    int nn = i >> 6, kk = i & 63;
    int ktd = perm ? (kt < 4 ? kt + 8 : (kt >= 8 && kt < 12) ? kt - 8 : kt) : kt;
    dst[(size_t)(nt * 64 + nn) * Ksz + ktd * 64 + kk] = f2bf(s[kk * 65 + nn]);
  }
  __syncthreads();
}

struct S5c { float lr, li, dt; };
__device__ __forceinline__ void s5_pow(const Params& P, int l, int d, int g, int p, float e, float& re, float& im) {
  int idx = ((l * 2 + d) * 16 + g) * 64 + p;
  float dt = __expf(P.s5_log_dt[(l * 2 + d) * 16 + g]);
  float ar = P.s5_a_re[idx] * dt * e, ai = P.s5_a_im[idx] * dt * e;
  float m = expf(ar);
  re = m * cosf(ai); im = m * sinf(ai);
}
__device__ __forceinline__ void s5_bbar_coef(const Params& P, int l, int d, int g, int p, float& re, float& im) {
  int idx = ((l * 2 + d) * 16 + g) * 64 + p;
  float lr = P.s5_a_re[idx], li = P.s5_a_im[idx];
  float br, bi; s5_pow(P, l, d, g, p, 1.f, br, bi);
  br -= 1.f;
  float den = lr * lr + li * li;
  re = (br * lr + bi * li) / den;
  im = (bi * lr - br * li) / den;
}

__device__ __forceinline__ void phase_prologue(const Params& P, unsigned char* sm) {
  const int tid = threadIdx.x;
  const int N_TIN = 2 * 16 * (NINP / 64);
  const int N_TOUT = 2 * 16 * 16;
  const int N_TL = 2 * 2 * 4;
  const int N_TA = 2 * 2 * 4;
  const int N_TG = 2 * 16;
  const int N_MOD = 2 * 48;
  const int N_S5K = 2 * 16 * 2 * 32;
  const int N_S5W1 = 2 * 16 * 32;
  const int N_S5B2 = 2 * 16 * 32;
  const int total = N_TIN + N_TOUT + N_TL + N_TA + N_TG + N_MOD + N_S5K + N_S5W1 + N_S5B2;
#pragma unroll 1
  for (int it = blockIdx.x; it < total; it += gridDim.x) {
    int i = it;
    if (i < N_TIN) {
      int l = i / (16 * (NINP / 64)), r = i % (16 * (NINP / 64));
      transpose_tile(P.w_in + (size_t)l * D * NIN, NIN, D, NIN, WS(bf16, OFF_WTIN) + (size_t)l * NINP * D, r % 16, r / 16, sm);
      continue;
    }
    i -= N_TIN;
    if (i < N_TOUT) {
      int l = i / 256, r = i % 256;
      transpose_tile(P.w_out + (size_t)l * D * D, D, D, D, WS(bf16, OFF_WTOUT) + (size_t)l * D * D, r % 16, r / 16, sm, true);
      continue;
    }
    i -= N_TOUT;
    if (i < N_TL) {
      int ld = i / 4, nt = i % 4;
      transpose_tile(P.rw_w2 + (size_t)ld * 64 * 256, 256, 64, 256, WS(bf16, OFF_W2T) + (size_t)ld * 256 * 64, 0, nt, sm);
      continue;
    }
    i -= N_TL;
    if (i < N_TA) {
      int ld = i / 4, nt = i % 4;
      transpose_tile(P.rw_a2 + (size_t)ld * 64 * 256, 256, 64, 256, WS(bf16, OFF_A2T) + (size_t)ld * 256 * 64, 0, nt, sm);
      continue;
    }
    i -= N_TA;
    if (i < N_TG) {
      int l = i / 16, r = i % 16;
      transpose_tile(P.s5_glu_w + (size_t)l * 256 * 256, 256, 256, 256, WS(bf16, OFF_GLUT) + (size_t)l * 256 * 256, r % 4, r / 4, sm);
      continue;
    }
    i -= N_TG;
    if (i < N_MOD) {
      int l = i / 48, ct = i % 48;
      float* ssil = (float*)sm;
      float* red = ssil + NMOD * 1024;
#pragma unroll 8
      for (int e = tid; e < NMOD * 1024; e += 256) {
        int r = e >> 10, k = e & 1023;
        float v = r < BATCH ? P.c[r * 1024 + k] : P.c_ctx[k];
        ssil[e] = silu_f(v);
      }
      __syncthreads();
      int kq = tid >> 6, jj = tid & 63, j = ct * 64 + jj;
      float acc[NMOD];
      for (int r = 0; r < NMOD; r++) acc[r] = 0.f;
      const float* wp = P.ada_w + (size_t)l * D * 3072 + j;
#pragma unroll 16
      for (int k = kq * 256; k < kq * 256 + 256; k++) {
        float wv = wp[(size_t)k * 3072];
#pragma unroll
        for (int r = 0; r < NMOD; r++) acc[r] += ssil[r * 1024 + k] * wv;
      }
#pragma unroll
      for (int r = 0; r < NMOD; r++) red[(kq * NMOD + r) * 64 + jj] = acc[r];
      __syncthreads();
#pragma unroll 8
      for (int e = tid; e < NMOD * 64; e += 256) {
        int r = e >> 6, j2 = e & 63;
        float s = red[(0 * NMOD + r) * 64 + j2] + red[(1 * NMOD + r) * 64 + j2] + red[(2 * NMOD + r) * 64 + j2] + red[(3 * NMOD + r) * 64 + j2];
        WS(float, OFF_MOD)[((size_t)l * NMOD + r) * 3072 + ct * 64 + j2] = s + P.ada_b[l * 3072 + ct * 64 + j2];
      }
      __syncthreads();
      continue;
    }
    i -= N_MOD;
    if (i < N_S5K) {
      int m = i & 31, d = (i >> 5) & 1, g = (i >> 6) & 15, l = i >> 10;
      float* spw = (float*)sm;
      if (tid < 64) {
        float pr, pi, cr, ci;
        s5_pow(P, l, d, g, tid, (float)m, pr, pi);
        s5_bbar_coef(P, l, d, g, tid, cr, ci);
        spw[tid * 2] = pr * cr - pi * ci; spw[tid * 2 + 1] = pr * ci + pi * cr;
      }
      __syncthreads();
      int c = tid >> 4, cp = tid & 15;
      size_t bb = ((size_t)((l * 2 + d) * 16 + g) * 64) * 16;
      size_t cb = ((size_t)((l * 2 + d) * 16 + g) * 16 + c) * 64;
      float s = 0.f;
#pragma unroll 8
      for (int p = 0; p < 64; p++) {
        float wr = spw[p * 2], wi = spw[p * 2 + 1];
        float br = P.s5_b_re[bb + p * 16 + cp], bi = P.s5_b_im[bb + p * 16 + cp];
        float zr = wr * br - wi * bi, zi = wr * bi + wi * br;
        float cr = P.s5_c_re[cb + p], ci = P.s5_c_im[cb + p];
        s += cr * zr - ci * zi;
      }
      WS(float, OFF_S5K)[((size_t)(((l * 16 + g) * 2 + d) * 32 + m)) * 256 + tid] = s;
      __syncthreads();
      continue;
    }
    i -= N_S5K;
    if (i < N_S5W1) {
      int j = i & 31, g = (i >> 5) & 15, l = i >> 9;
      int pp = tid, d = pp >> 7, ri = (pp >> 6) & 1, p = pp & 63;
      float e = d == 0 ? (float)(T5 - 1 - j) : (float)j;
      float pr, pi, cr, ci;
      s5_pow(P, l, d, g, p, e, pr, pi);
      s5_bbar_coef(P, l, d, g, p, cr, ci);
      float wr = pr * cr - pi * ci, wi = pr * ci + pi * cr;
      size_t bb = ((size_t)((l * 2 + d) * 16 + g) * 64 + p) * 16;
      bf16* dst = WS(bf16, OFF_W1T) + ((size_t)(l * 16 + g) * 256 + pp) * 512 + j * 16;
      for (int cp = 0; cp < 16; cp++) {
        float br = P.s5_b_re[bb + cp], bi = P.s5_b_im[bb + cp];
        float zr = wr * br - wi * bi, zi = wr * bi + wi * br;
        dst[cp] = f2bf(ri == 0 ? zr : zi);
      }
      if (j == 0 && ri == 0) {
        float tr, ti; s5_pow(P, l, d, g, p, (float)T5, tr, ti);
        float* lt = WS(float, OFF_S5LT) + ((size_t)((l * 16 + g) * 2 + d) * 64 + p) * 2;
        lt[0] = tr; lt[1] = ti;
      }
      continue;
    }
    i -= N_S5W1;
    {
      int t = i & 31, g = (i >> 5) & 15, l = i >> 9;
      int kk = tid, d = kk >> 7, ri = (kk >> 6) & 1, p = kk & 63;
      float e = d == 0 ? (float)(t + 1) : (float)(T5 - t);
      float pr, pi; s5_pow(P, l, d, g, p, e, pr, pi);
      for (int c = 0; c < 16; c++) {
        size_t cb = ((size_t)((l * 2 + d) * 16 + g) * 16 + c) * 64 + p;
        float cr = P.s5_c_re[cb], ci = P.s5_c_im[cb];
        float zr = cr * pr - ci * pi, zi = cr * pi + ci * pr;
        WS(bf16, OFF_BT2)[((size_t)(l * 16 + g) * 512 + t * 16 + c) * 768 + 512 + kk] = f2bf(ri == 0 ? zr : -zi);
      }
    }
  }
}

__device__ __forceinline__ void s5_toeplitz_items(const Params& P, int item) {
  int t = item & 31, g = (item >> 5) & 15, l = item >> 9;
  const float* K = WS(float, OFF_S5K) + (size_t)((l * 16 + g) * 2) * 32 * 256;
  bf16* dst = WS(bf16, OFF_BT2) + ((size_t)(l * 16 + g) * 512 + t * 16) * 768;
#pragma unroll 8
  for (int e = threadIdx.x; e < 16 * 512; e += 256) {
    int c = e >> 9, k = e & 511, j = k >> 4, cp = k & 15;
    float v;
    if (j < t) v = K[((0 * 32) + (t - j)) * 256 + c * 16 + cp];
    else if (j > t) v = K[((1 * 32) + (j - t)) * 256 + c * 16 + cp];
    else v = K[(0 * 32) * 256 + c * 16 + cp] + K[(1 * 32) * 256 + c * 16 + cp];
    dst[(size_t)c * 768 + k] = f2bf(v);
  }
}

__device__ __forceinline__ void phase_normmod(const Params& P, int l) {
  const int lane = threadIdx.x & 63, w = threadIdx.x >> 6;
  const int nrow_items = ROWS / 4;
  const int n_toe = (l == 0) ? 2 * 16 * 32 : 0;
#pragma unroll 1
  for (int it = blockIdx.x; it < nrow_items + n_toe; it += gridDim.x) {
    if (it >= nrow_items) { s5_toeplitz_items(P, it - nrow_items); continue; }
    int m = it * 4 + w;
    RowInfo ri = row_info(m);
    const float* src;
    if (ri.isctx) src = (l == 0 ? P.ctx : WS(float, OFF_HC)) + (size_t)m * D;
    else src = (l == 0 ? P.x : P.out) + (size_t)(m - ROWS_C) * D;
    const float* mod = WS(float, OFF_MOD) + ((size_t)l * NMOD + (ri.isctx ? BATCH : ri.b)) * 3072;
    F4 v[4]; float ss = 0.f;
    for (int q = 0; q < 4; q++) {
      v[q] = *(const F4*)(src + q * 256 + lane * 4);
      for (int e = 0; e < 4; e++) ss += v[q].a[e] * v[q].a[e];
    }
    ss = sum64(ss);
    float rstd = rsqrtf(ss * (1.f / 1024.f) + 1e-6f);
    bf16* dst = WS(bf16, OFF_R) + (size_t)m * D;
    for (int q = 0; q < 4; q++) {
      int c0 = q * 256 + lane * 4;
      float o[4];
      for (int e = 0; e < 4; e++) {
        int c = c0 + e;
        o[e] = v[q].a[e] * rstd * P.norm_pre[l * D + c] * (1.f + mod[1024 + c]) + mod[c];
      }
      U2 pk; pk.a[0] = pack2(o[0], o[1]); pk.a[1] = pack2(o[2], o[3]);
      *(U2*)(dst + c0) = pk;
    }
  }
}

__device__ __forceinline__ void phase_inproj(const Params& P, int l, unsigned char* sm) {
  const bf16* A = WS(bf16, OFF_R);
  const bf16* Bt = WS(bf16, OFF_WTIN) + (size_t)l * NINP * D;
  bf16* C = WS(bf16, OFF_PROJ);
  const int NT = NINP / 128, MT = ROWS / 256;
  const int total = MT * NT, per = total / 8;
  const int nfull = (total / (int)gridDim.x) * (int)gridDim.x;
#pragma unroll 1
  for (int it0 = blockIdx.x; it0 < nfull; it0 += gridDim.x) {
    int it = total % 8 == 0 ? (it0 & 7) * per + (it0 >> 3) : it0;
    int mt = it / NT, nt = it % NT;
    gemm_tile_big(sm, mt * 256, nt * 128, D,
      [&](int m, int k) { return *(const U4*)(A + (size_t)m * D + k); },
      [&](int n, int k) { return *(const U4*)(Bt + (size_t)n * D + k); },
      [&](int m, int n, float v) { if (n < NIN) C[(size_t)m * NIN + n] = f2bf(v); });
  }
#pragma unroll 1
  for (int q = blockIdx.x; q < 2 * (total - nfull); q += gridDim.x) {
    int it0 = nfull + (q >> 1), half = q & 1;
    int it = total % 8 == 0 ? (it0 & 7) * per + (it0 >> 3) : it0;
    int mt = it / NT, nt = it % NT;
    gemm_tile(sm, mt * 256 + half * 128, nt * 128, D,
      [&](int m, int k) { return *(const U4*)(A + (size_t)m * D + k); },
      [&](int n, int k) { return *(const U4*)(Bt + (size_t)n * D + k); },
      [&](int m, int n, float v) { if (n < NIN) C[(size_t)m * NIN + n] = f2bf(v); });
  }
}

__device__ __forceinline__ void rw_lerp4(const Params& P, int l, int m, int ms, int col, float* o) {
  const bf16* pr = WS(bf16, OFF_PROJ);
  U2 z = *(const U2*)(pr + (size_t)m * NIN + col);
  U2 zs; zs.a[0] = zs.a[1] = 0;
  if (ms >= 0) zs = *(const U2*)(pr + (size_t)ms * NIN + col);
  const float* mu = P.rw_mu + l * 1024 + col;
#pragma unroll
  for (int e = 0; e < 2; e++) {
    float a0 = lo2f(z.a[e]), a1 = hi2f(z.a[e]), s0 = lo2f(zs.a[e]), s1 = hi2f(zs.a[e]);
    o[2 * e] = a0 + mu[2 * e] * (s0 - a0);
    o[2 * e + 1] = a1 + mu[2 * e + 1] * (s1 - a1);
  }
}
__device__ __forceinline__ void phase_rwprep(const Params& P, int l, unsigned char* sm) {
  const int lane = threadIdx.x & 63, w = threadIdx.x >> 6;
  const int MT = ROWS / 128;
  const int n_gemm = MT * 2 * 4;
  const int n_rows = ROWS / 4;
  bf16* XA = WS(bf16, OFF_XA);
#pragma unroll 1
  for (int it = blockIdx.x; it < n_gemm + n_rows; it += gridDim.x) {
    if (it < n_gemm) {
      int kind = it & 3, nt = (it >> 2) & 1, mt = it >> 3;
      int isA = kind >> 1, d = kind & 1;
      const bf16* Bt = (isA ? WS(bf16, OFF_A2T) : WS(bf16, OFF_W2T)) + (size_t)(l * 2 + d) * 256 * 64;
      const float* bias = (isA ? P.rw_a0 : P.rw_w0) + (l * 2 + d) * 256;
      gemm_tile(sm, mt * 128, nt * 128, 64,
        [&](int m, int k) {
          RowInfo ri = row_info(m);
          int ms;
          if (ri.isctx) ms = ri.t < CTX - 1 ? m + 1 : -1; else ms = ri.t < SEQ - 64 ? m + 64 : -1;
          int col = 768 + isA * 128 + d * 64 + k;
          const bf16* prj = WS(bf16, OFF_PROJ);
          U4 z = *(const U4*)(prj + (size_t)m * NIN + col);
          U4 zs = ms >= 0 ? *(const U4*)(prj + (size_t)ms * NIN + col) : zero4();
          const float* mu = P.rw_mu + l * 1024 + col;
          U4 r;
#pragma unroll
          for (int e = 0; e < 4; e++) {
            float a0 = lo2f(z.a[e]), a1 = hi2f(z.a[e]), s0 = lo2f(zs.a[e]), s1 = hi2f(zs.a[e]);
            float o0 = a0 + mu[2 * e] * (s0 - a0), o1 = a1 + mu[2 * e + 1] * (s1 - a1);
            if (!isA) { o0 = tanh_f(o0); o1 = tanh_f(o1); }
            r.a[e] = pack2(o0, o1);
          }
          return r;
        },
        [&](int n, int k) { return *(const U4*)(Bt + (size_t)n * 64 + k); },
        [&](int m, int n, float v) {
          v += bias[n];
          float o;
          if (!isA) { o = -__expf(-softplus_f(-v) - 0.5f); }
          else o = sigmoid_f(v);
          XA[(size_t)m * 1024 + isA * 512 + d * 256 + n] = f2bf(o);
        });
      continue;
    }
    int m = (it - n_gemm) * 4 + w;
    RowInfo ri = row_info(m);
    int ms_r, ms_k, ms_v;
    if (ri.isctx) { ms_r = ms_k = ri.t > 0 ? m - 1 : -1; ms_v = ri.t < CTX - 1 ? m + 1 : -1; }
    else {
      int gx = ri.t & 63;
      ms_r = gx > 0 ? m - 1 : -1; ms_k = gx < 63 ? m + 1 : -1; ms_v = ri.t >= 64 ? m - 64 : -1;
    }
    bf16* R = WS(bf16, OFF_R) + (size_t)m * 1024;
    float rr[4], kk[4], vv[4], kap[4];
    rw_lerp4(P, l, m, ms_r, lane * 4, rr);
    rw_lerp4(P, l, m, ms_k, 256 + lane * 4, kk);
    rw_lerp4(P, l, m, ms_v, 512 + lane * 4, vv);
    float ss = 0.f;
    for (int e = 0; e < 4; e++) { kap[e] = kk[e] * P.rw_kk[l * 256 + lane * 4 + e]; ss += kap[e] * kap[e]; }
    ss = sum16(ss);
    float rs = rsqrtf(ss + 1e-6f);
    U2 o;
    o.a[0] = pack2(rr[0], rr[1]); o.a[1] = pack2(rr[2], rr[3]); *(U2*)(R + lane * 4) = o;
    o.a[0] = pack2(kk[0], kk[1]); o.a[1] = pack2(kk[2], kk[3]); *(U2*)(R + 256 + lane * 4) = o;
    o.a[0] = pack2(vv[0], vv[1]); o.a[1] = pack2(vv[2], vv[3]); *(U2*)(R + 512 + lane * 4) = o;
    o.a[0] = pack2(kap[0] * rs, kap[1] * rs); o.a[1] = pack2(kap[2] * rs, kap[3] * rs); *(U2*)(R + 768 + lane * 4) = o;
  }
  {
    const int n_ssd = BATCH * NCH * 8, n_gla = BATCH * NCH * 8, n_s5 = 16 * ((M5 + 127) / 128) * 2, base0 = n_gemm + n_rows;
    ITEM_LOOP(i, n_ssd, base0) ssd_state_item(P, l, i, sm);
    ITEM_LOOP(i, n_gla, base0 + n_ssd) gla_state_item(P, l, i, sm);
    ITEM_LOOP(i, n_s5, base0 + n_ssd + n_gla) s5_state_tile(P, l, i, sm);
  }
}

__device__ __forceinline__ bf16x8 gfrag(const bf16* base, int ld, int row, int k) {
  return *(const bf16x8*)(base + (size_t)row * ld + k);
}
__device__ __forceinline__ void wave_sync() {
#ifdef CPU_EMU
  pthread_barrier_wait(&g_wavebar[threadIdx.x >> 6]);
#else
  __builtin_amdgcn_wave_barrier();
#endif
}
__device__ __forceinline__ void store_acc_T(bf16* dst, int ld, int row_base, int col, const f32x16& acc, int lane) {
#pragma unroll
  for (int g = 0; g < 4; g++) {
    U2 o; o.a[0] = pack2(acc[4 * g], acc[4 * g + 1]); o.a[1] = pack2(acc[4 * g + 2], acc[4 * g + 3]);
    *(U2*)&dst[col * ld + row_base + 8 * g + 4 * (lane >> 5)] = o;
  }
}
__device__ __forceinline__ void rwkv_chunk_item(const Params& P, int l, int item, unsigned char* sm, long long& pacc) {
  long long tp0_ = 0; if (PROBE_PHASE >= 33 && PROBE_PHASE <= 36) tp0_ = wall_clock64();
  int tid_ = threadIdx.x; OPAQUE(tid_);
  const int tid = tid_, lane = tid & 63, w = tid >> 6, ti = w >> 1, tj = w & 1;
  const int lr = lane & 31, lh = lane >> 5;
  const int d = item & 1, h = (item >> 1) & 3, rest = item >> 3;
  const int pc = rest % NCH, b = rest / NCH;
  const int row0 = chunk_row0(b, pc, TC, NCH_C);
  float* sL = (float*)sm;
  bf16* sG1t = (bf16*)sm;
  bf16* sKT = (bf16*)(sm + 16640);
  bf16* sBT = sKT + 64 * 72;
  bf16* sKD = sBT + 64 * 72;
  bf16* sRT = sKD + 64 * 72;
  bf16* sVt = sRT + 64 * 72;
  float* sGT = (float*)(sVt + 64 * 72);
  bf16* X0 = WS(bf16, OFF_XA) + (size_t)row0 * 1024 + d * 256 + h * 64;
  bf16* X1 = X0 + 512;
  bf16* P0 = WS(bf16, OFF_PROJ) + (size_t)row0 * NIN + (h * 2 + d) * 128;
  bf16* P1 = P0 + 64;
  const bf16* Rb = WS(bf16, OFF_R) + (size_t)row0 * 1024 + h * 64;
  float rq[16], kq[16], pq[16], vq[16];
#pragma unroll
  for (int i = 0; i < 16; i++) {
    const bf16* rp = Rb + (size_t)(w + 4 * i) * 1024 + lane;
    rq[i] = bf2f(rp[0]); kq[i] = bf2f(rp[256]); vq[i] = bf2f(rp[512]); pq[i] = bf2f(rp[768]);
  }
#pragma unroll 8
  for (int idx = tid; idx < 4096; idx += 256) {
    int p = idx >> 6, k = idx & 63;
    sL[p * 65 + k] = bf2f(X0[(size_t)p * 1024 + k]);
    sVt[idx] = X1[(size_t)p * 1024 + k];
  }
  __syncthreads();
  {
    const int k = tid & 63, qq = tid >> 6;
    float* qt = sGT + 64 + 128;
    float run = 0.f;
    if (d == 0) { for (int p = qq * 16; p < qq * 16 + 16; p++) { run += sL[p * 65 + k]; sL[p * 65 + k] = run; } }
    else { for (int p = qq * 16 + 15; p >= qq * 16; p--) { run += sL[p * 65 + k]; sL[p * 65 + k] = run; } }
    qt[qq * 64 + k] = run;
    __syncthreads();
    float off = 0.f;
    if (d == 0) { for (int j = 0; j < qq; j++) off += qt[j * 64 + k]; }
    else { for (int j = 3; j > qq; j--) off += qt[j * 64 + k]; }
    for (int p = qq * 16; p < qq * 16 + 16; p++) sL[p * 65 + k] += off;
    if (qq == 0) sGT[k] = qt[k] + qt[64 + k] + qt[128 + k] + qt[192 + k];
  }
  __syncthreads();
  if (PROBE_PHASE == 35) pacc += wall_clock64() - tp0_;
  {
    const int k = lane;
    const float ka = P.rw_ka[l * 256 + h * 64 + k], rk = P.rw_rk[l * 256 + h * 64 + k];
#pragma unroll
    for (int i = 0; i < 16; i++) {
      const int p = w + 4 * i;
      float incl = sL[p * 65 + k];
      int pp = d == 0 ? p - 1 : p + 1;
      float excl = (pp < 0 || pp > 63) ? 0.f : sL[pp * 65 + k];
      float rr = rq[i], kk = kq[i], kap = pq[i];
      float a = bf2f(sVt[p * 64 + k]);
      float kd = kk * (1.f + (a - 1.f) * ka), beta = kap * a;
      float ei = __expf(incl), eni = __expf(-incl), ee = __expf(excl);
      sKT[p * 72 + k] = f2bf(kap * ee);
      sBT[p * 72 + k] = f2bf(beta * eni);
      sKD[p * 72 + k] = f2bf(kd * eni);
      sRT[p * 72 + k] = f2bf(rr * ei);
      float bs = sum64(rr * kd * rk);
      if (lane == 0) WS(float, OFF_BON)[(size_t)(row0 + p) * 8 + h * 2 + d] = bs;
    }
  }
  __syncthreads();
#pragma unroll 8
  for (int idx = tid; idx < 4096; idx += 256) {
    int kk = idx >> 6, p = idx & 63;
    P0[(size_t)kk * NIN + p] = sKT[p * 72 + kk];
    P1[(size_t)kk * NIN + p] = sBT[p * 72 + kk];
    X1[(size_t)kk * 1024 + p] = sKD[p * 72 + kk];
    X0[(size_t)kk * 1024 + p] = sRT[kk * 72 + p];
  }
  if (PROBE_PHASE == 36) pacc += wall_clock64() - tp0_;
  f32x16 aA = zero16(), aB = zero16(), aC = zero16(), aD = zero16();
#pragma unroll
  for (int ks = 0; ks < 64; ks += 16) {
    bf16x8 fK = ldsfrag(&sKT[(ti * 32 + lr) * 72 + ks + 8 * lh]);
    bf16x8 fR = ldsfrag(&sRT[(ti * 32 + lr) * 72 + ks + 8 * lh]);
    bf16x8 fB = ldsfrag(&sBT[(tj * 32 + lr) * 72 + ks + 8 * lh]);
    bf16x8 fD = ldsfrag(&sKD[(tj * 32 + lr) * 72 + ks + 8 * lh]);
    aA = mfma32(fK, fB, aA); aB = mfma32(fK, fD, aB); aC = mfma32(fR, fB, aC); aD = mfma32(fR, fD, aD);
  }
  __syncthreads();
  {
    int s_ = tj * 32 + lr;
#pragma unroll
    for (int r = 0; r < 16; r++) {
      int p = ti * 32 + acc_row(r, lane);
      bool earlier = d == 0 ? s_ < p : s_ > p;
      bool eq = s_ == p;
      sL[p * 65 + s_] = earlier ? aA[r] : 0.f;
      sKT[p * 72 + s_] = f2bf(earlier ? aB[r] : 0.f);
      sBT[p * 72 + s_] = f2bf((earlier || eq) ? aC[r] : 0.f);
      sKD[p * 72 + s_] = f2bf((earlier || eq) ? aD[r] : 0.f);
    }
  }
#pragma unroll
  for (int i = 0; i < 16; i++) sVt[lane * 72 + w + 4 * i] = f2bf(vq[i]);
  __syncthreads();
  if (PROBE_PHASE == 33) pacc += wall_clock64() - tp0_;
  bf16x8 fKt[4];
#pragma unroll
  for (int q4 = 0; q4 < 4; q4++) fKt[q4] = gfrag(P0, NIN, tj * 32 + lr, q4 * 16 + 8 * lh);
  bf16* sTinv = sRT;
  {
    const int q = tid >> 2, seg = tid & 3;
    float x[16];
#pragma unroll
    for (int i = 0; i < 16; i++) x[i] = (q == seg * 16 + i) ? 1.f : 0.f;
    float* rowbuf = (float*)sRT;
#pragma unroll 1
    for (int Bi = 0; Bi < 4; Bi++) {
      const int B = d == 0 ? Bi : 3 - Bi;
      float* rb = rowbuf + (Bi & 1) * 1024;
      if (w == B) {
#pragma unroll 1
        for (int s_ = 0; s_ < 16; s_++) {
          const int pl = d == 0 ? s_ : 15 - s_, p = B * 16 + pl;
          if (q == p) {
#pragma unroll
            for (int i = 0; i < 4; i++) { F4 o; o.a[0] = x[4 * i]; o.a[1] = x[4 * i + 1]; o.a[2] = x[4 * i + 2]; o.a[3] = x[4 * i + 3]; *(F4*)&rb[pl * 64 + seg * 16 + 4 * i] = o; }
          }
          wave_sync();
          const bool later = d == 0 ? q > p : q < p;
          if (later) {
            const float m = sL[q * 65 + p];
#pragma unroll
            for (int i = 0; i < 4; i++) {
              F4 o = *(const F4*)&rb[pl * 64 + seg * 16 + 4 * i];
              x[4 * i] -= m * o.a[0]; x[4 * i + 1] -= m * o.a[1]; x[4 * i + 2] -= m * o.a[2]; x[4 * i + 3] -= m * o.a[3];
            }
          }
        }
      }
      __syncthreads();
      const bool laterblock = d == 0 ? w > B : w < B;
      if (laterblock) {
#pragma unroll 4
        for (int pl = 0; pl < 16; pl++) {
          const float m = sL[q * 65 + B * 16 + pl];
#pragma unroll
          for (int i = 0; i < 4; i++) {
            F4 o = *(const F4*)&rb[pl * 64 + seg * 16 + 4 * i];
            x[4 * i] -= m * o.a[0]; x[4 * i + 1] -= m * o.a[1]; x[4 * i + 2] -= m * o.a[2]; x[4 * i + 3] -= m * o.a[3];
          }
        }
      }
    }
    __syncthreads();
#pragma unroll
    for (int i = 0; i < 8; i++) *(uint32_t*)&sTinv[q * 72 + seg * 16 + 2 * i] = pack2(x[2 * i], x[2 * i + 1]);
  }
  __syncthreads();
  if (PROBE_PHASE == 34) pacc += wall_clock64() - tp0_;
  {
    f32x16 aBV = zero16(), aG1 = zero16();
#pragma unroll
    for (int ks = 0; ks < 64; ks += 16) {
      aBV = mfma32(ldsfrag(&sKT[(ti * 32 + lr) * 72 + ks + 8 * lh]), ldsfrag(&sVt[(tj * 32 + lr) * 72 + ks + 8 * lh]), aBV);
      aG1 = mfma32(ldsfrag(&sTinv[(ti * 32 + lr) * 72 + ks + 8 * lh]), fKt[ks >> 4], aG1);
    }
    __syncthreads();
    store_acc_T(sKT, 72, ti * 32, tj * 32 + lr, aBV, lane);
    store_acc_T(sG1t, 72, ti * 32, tj * 32 + lr, aG1, lane);
  }
  __syncthreads();
  bf16x8 fKd4[4], fBt4[4]; float rtc[16];
#pragma unroll
  for (int q4 = 0; q4 < 4; q4++) { fKd4[q4] = gfrag(X1, 1024, ti * 32 + lr, q4 * 16 + 8 * lh); fBt4[q4] = gfrag(P1, NIN, ti * 32 + lr, q4 * 16 + 8 * lh); }
#pragma unroll
  for (int r = 0; r < 16; r++) rtc[r] = bf2f(X0[(size_t)(ti * 32 + acc_row(r, lane)) * 1024 + tj * 32 + lr]);
  {
    f32x16 aG2 = zero16();
#pragma unroll
    for (int ks = 0; ks < 64; ks += 16)
      aG2 = mfma32(ldsfrag(&sTinv[(ti * 32 + lr) * 72 + ks + 8 * lh]), ldsfrag(&sKT[(tj * 32 + lr) * 72 + ks + 8 * lh]), aG2);
    __syncthreads();
    store_acc_T(sRT, 72, ti * 32, tj * 32 + lr, aG2, lane);
  }
  __syncthreads();
  bf16* sG2t = sRT;
  {
    f32x16 a1 = zero16(), a2 = zero16(), a3 = zero16();
#pragma unroll
    for (int ks = 0; ks < 64; ks += 16) {
      bf16x8 fC = ldsfrag(&sBT[(ti * 32 + lr) * 72 + ks + 8 * lh]);
      bf16x8 fDy = ldsfrag(&sKD[(ti * 32 + lr) * 72 + ks + 8 * lh]);
      a1 = mfma32(fC, ldsfrag(&sG1t[(tj * 32 + lr) * 72 + ks + 8 * lh]), a1);
      a2 = mfma32(fDy, ldsfrag(&sVt[(tj * 32 + lr) * 72 + ks + 8 * lh]), a2);
      a3 = mfma32(fC, ldsfrag(&sG2t[(tj * 32 + lr) * 72 + ks + 8 * lh]), a3);
    }
    int c = tj * 32 + lr;
#pragma unroll
    for (int r = 0; r < 16; r++) {
      int p = ti * 32 + acc_row(r, lane);
      X0[(size_t)p * 1024 + c] = f2bf(rtc[r] - a1[r]);
      P0[(size_t)p * NIN + c] = f2bf(a2[r] - a3[r]);
    }
  }
  {
    f32x16 a1 = zero16(), a2 = zero16(), a3 = zero16();
#pragma unroll
    for (int ks = 0; ks < 64; ks += 16) {
      bf16x8 fKd = fKd4[ks >> 4];
      bf16x8 fBt = fBt4[ks >> 4];
      a1 = mfma32(fKd, ldsfrag(&sVt[(tj * 32 + lr) * 72 + ks + 8 * lh]), a1);
      a2 = mfma32(fBt, ldsfrag(&sG2t[(tj * 32 + lr) * 72 + ks + 8 * lh]), a2);
      a3 = mfma32(fBt, ldsfrag(&sG1t[(tj * 32 + lr) * 72 + ks + 8 * lh]), a3);
    }
    __syncthreads();
    int c = tj * 32 + lr;
#pragma unroll
    for (int r = 0; r < 16; r++) {
      int kp = ti * 32 + acc_row(r, lane);
      float gt = __expf(sGT[kp]);
      a1[r] = gt * (a1[r] - a2[r]);
      X1[(size_t)kp * 1024 + c] = f2bf(gt * ((kp == c ? 1.f : 0.f) - a3[r]));
    }
    U4 o0, o1;
#pragma unroll
    for (int e = 0; e < 4; e++) { o0.a[e] = pack2(a1[2 * e], a1[2 * e + 1]); o1.a[e] = pack2(a1[8 + 2 * e], a1[8 + 2 * e + 1]); }
    bf16* lp = P1 + (size_t)(tid >> 2) * NIN + (tid & 3) * 16;
    *(U4*)lp = o0; *(U4*)(lp + 8) = o1;
  }
  __syncthreads();
}

struct RwStage { bf16x8 pm[4]; U4 l0, l1; };
__device__ __forceinline__ void rwkv_scan2_item(const Params& P, int l, int item, unsigned char* sm) {
  int tid_ = threadIdx.x; OPAQUE(tid_);
  const int tid = tid_, lane = tid & 63, w = tid >> 6, ti = w >> 1, tj = w & 1;
  const int lr = lane & 31, lh = lane >> 5;
  const int d = item & 1, h = (item >> 1) & 3, b = item >> 3;
  bf16* sS = (bf16*)sm;
  f32x16 acc = zero16();
  RwStage st[4];
  auto load = [&](RwStage& s_, int vc) {
    int pc = ord_chunk(d, vc < NCH ? vc : NCH - 1, NCH_C, NCH);
    int row0 = chunk_row0(b, pc, TC, NCH_C);
    const bf16* X1 = WS(bf16, OFF_XA) + (size_t)row0 * 1024 + 512 + d * 256 + h * 64;
    const bf16* P1 = WS(bf16, OFF_PROJ) + (size_t)row0 * NIN + (h * 2 + d) * 128 + 64;
#pragma unroll
    for (int q = 0; q < 4; q++) s_.pm[q] = gfrag(X1, 1024, ti * 32 + lr, q * 16 + 8 * lh);
    const bf16* lp = P1 + (size_t)(tid >> 2) * NIN + (tid & 3) * 16;
    s_.l0 = *(const U4*)lp; s_.l1 = *(const U4*)(lp + 8);
  };
#pragma unroll
  for (int j = 0; j < 4; j++) load(st[j], j);
#pragma unroll 1
  for (int v0 = 0; v0 < NCH; v0 += 4) {
#pragma unroll
    for (int j = 0; j < 4; j++) {
      const int vc = v0 + j;
      if (vc < NCH) {
        int pc = ord_chunk(d, vc, NCH_C, NCH);
        int row0 = chunk_row0(b, pc, TC, NCH_C);
        bf16* X1 = WS(bf16, OFF_XA) + (size_t)row0 * 1024 + 512 + d * 256 + h * 64;
        store_acc_T(sS, 72, ti * 32, tj * 32 + lr, acc, lane);
        RwStage cur = st[j];
        __syncthreads();
        load(st[j], vc + 4);
        for (int idx = tid; idx < 512; idx += 256) {
          int v = idx >> 3, c8 = idx & 7;
          *(U4*)(X1 + (size_t)v * 1024 + c8 * 8) = *(const U4*)(sS + v * 72 + c8 * 8);
        }
        f32x16 nw;
#pragma unroll
        for (int e = 0; e < 4; e++) {
          nw[2 * e] = lo2f(cur.l0.a[e]); nw[2 * e + 1] = hi2f(cur.l0.a[e]);
          nw[8 + 2 * e] = lo2f(cur.l1.a[e]); nw[8 + 2 * e + 1] = hi2f(cur.l1.a[e]);
        }
#pragma unroll
        for (int q = 0; q < 4; q++) nw = mfma32(cur.pm[q], ldsfrag(&sS[(tj * 32 + lr) * 72 + q * 16 + 8 * lh]), nw);
        acc = nw;
        __syncthreads();
      }
    }
  }
}

__device__ __forceinline__ void rwkv_out_item(const Params& P, int l, int item, unsigned char* sm) {
  int tid_ = threadIdx.x; OPAQUE(tid_);
  const int tid = tid_, lane = tid & 63, w = tid >> 6, ti = w >> 1, tj = w & 1;
  const int lr = lane & 31, lh = lane >> 5;
  const int h = item & 3, rest = item >> 2, pc = rest % NCH, b = rest / NCH;
  if (l == 1 && pc < NCH_C) return;
  const int row0 = chunk_row0(b, pc, TC, NCH_C);
  float* spart = (float*)sm;
  float vvh[16], ggh[16], bnh[16];
#pragma unroll
  for (int r = 0; r < 16; r++) {
    const int row = row0 + ti * 32 + acc_row(r, lane), c = h * 64 + tj * 32 + lr;
    vvh[r] = bf2f(WS(bf16, OFF_R)[(size_t)row * 1024 + 512 + c]);
    ggh[r] = bf2f(WS(bf16, OFF_PROJ)[(size_t)row * NIN + C_RWG + c]);
    const float* bon = WS(float, OFF_BON) + (size_t)row * 8 + h * 2;
    bnh[r] = bon[0] + bon[1];
  }
  f32x16 acc = zero16();
#pragma unroll
  for (int d = 0; d < 2; d++) {
    const bf16* X0 = WS(bf16, OFF_XA) + (size_t)row0 * 1024 + d * 256 + h * 64;
    const bf16* X1 = X0 + 512;
    const bf16* P0 = WS(bf16, OFF_PROJ) + (size_t)row0 * NIN + (h * 2 + d) * 128;
#pragma unroll
    for (int ks = 0; ks < 64; ks += 16)
      acc = mfma32(gfrag(X0, 1024, ti * 32 + lr, ks + 8 * lh), gfrag(X1, 1024, tj * 32 + lr, ks + 8 * lh), acc);
#pragma unroll
    for (int r = 0; r < 16; r++) acc[r] += bf2f(P0[(size_t)(ti * 32 + acc_row(r, lane)) * NIN + tj * 32 + lr]);
  }
#pragma unroll
  for (int r = 0; r < 16; r++) {
    int p = ti * 32 + acc_row(r, lane);
    float s1 = sum32(acc[r]), s2 = sum32(acc[r] * acc[r]);
    if (lr == 31) { spart[(p * 2 + tj) * 2] = s1; spart[(p * 2 + tj) * 2 + 1] = s2; }
  }
  __syncthreads();
  {
    int c = h * 64 + tj * 32 + lr;
    float lw_ = P.rw_ln_w[l * 256 + c], lb_ = P.rw_ln_b[l * 256 + c];
    bf16* yc = WS(bf16, OFF_R);
    const bf16* pr = WS(bf16, OFF_PROJ);
#pragma unroll
    for (int r = 0; r < 16; r++) {
      int p = ti * 32 + acc_row(r, lane);
      int row = row0 + p;
      float mu = (spart[(p * 2) * 2] + spart[(p * 2 + 1) * 2]) * (1.f / 64.f);
      float ex2 = (spart[(p * 2) * 2 + 1] + spart[(p * 2 + 1) * 2 + 1]) * (1.f / 64.f);
      float var = fmaxf(ex2 - mu * mu, 0.f);
      float yn = (acc[r] - mu) * rsqrtf(var + 64e-5f) * lw_ + lb_;
      yc[(size_t)row * 1024 + 512 + c] = f2bf((yn + bnh[r] * vvh[r]) * silu_f(ggh[r]));
    }
  }
  __syncthreads();
}

__device__ __forceinline__ float wave_scan64(float v, float* tmp, int lane, bool reverse) {
  const int idx = reverse ? 63 - lane : lane;
#pragma unroll
  for (int off = 1; off < 64; off <<= 1) {
    tmp[idx] = v; wave_sync();
    float o = idx >= off ? tmp[idx - off] : 0.f; wave_sync();
    v += o;
  }
  return v;
}
__device__ __forceinline__ float ssd_aneg(const Params& P, int l, int d, int h) { return -__expf(P.ssd_a_log[(l * 2 + d) * 4 + h]); }
__device__ __forceinline__ void ssd_state_item(const Params& P, int l, int item, unsigned char* sm) {
  int tid_ = threadIdx.x; OPAQUE(tid_);
  const int tid = tid_, lane = tid & 63, w = tid >> 6;
  const int d = item & 1, h = (item >> 1) & 3, rest = item >> 3;
  const int pc = rest % NCH, b = rest / NCH;
  const int isctx = pc < NCH_C, len = isctx ? CTX : SEQ, t0 = (isctx ? pc : pc - NCH_C) * TC;
  const int seq0 = isctx ? b * CTX : ROWS_C + b * SEQ;
  bf16* sRaw = (bf16*)sm;
  bf16* sVt = sRaw + 2 * 68 * 64;
  bf16* sBt = sVt + 64 * 72;
  float* sdt = (float*)(sBt + 64 * 72);
  float* sdw = sdt + 64;
  const bf16* pr = WS(bf16, OFF_PROJ);
#pragma unroll 8
  for (int idx = tid; idx < 2 * 68 * 8; idx += 256) {
    int which = idx / (68 * 8), rem = idx % (68 * 8), tr = rem >> 3, c8 = rem & 7;
    int t = t0 - 2 + tr;
    int col = C_SSD + (which == 0 ? h * 64 : 256 + (h >> 1) * 64) + c8 * 8;
    U4 v = (t >= 0 && t < len) ? *(const U4*)(pr + (size_t)(seq0 + t) * NIN + col) : zero4();
    *(U4*)&sRaw[(which * 68 + tr) * 64 + c8 * 8] = v;
  }
  if (tid < 64) {
    float raw = bf2f(pr[(size_t)(seq0 + t0 + tid) * NIN + C_SSDDT + d * 4 + h]);
    sdt[tid] = softplus_f(raw + P.ssd_dt_bias[(l * 2 + d) * 4 + h]);
  }
  __syncthreads();
  if (w == 0) {
    float la = sdt[lane] * ssd_aneg(P, l, d, h);
    float incl = wave_scan64(la, sdw, lane, d == 0);
    wave_sync();
    sdw[lane] = __expf(incl - la);
    if (lane == (d == 0 ? 0 : 63)) WS(float, OFF_SSDDEC)[((size_t)(d * BATCH + b) * NCH + pc) * 4 + h] = __expf(incl);
  }
  __syncthreads();
#pragma unroll
  for (int which = 0; which < 2; which++) {
    const int c = tid & 63;
    const int ch = which == 0 ? h * 64 + c : 256 + (h >> 1) * 64 + c;
    float cw[5], cb = P.ssd_conv_b[l * 512 + ch];
#pragma unroll
    for (int i = 0; i < 5; i++) cw[i] = P.ssd_conv_w[(l * 5 + i) * 512 + ch];
    const int tb = (tid >> 6) * 16;
    float w0 = bf2f(sRaw[(which * 68 + tb) * 64 + c]), w1 = bf2f(sRaw[(which * 68 + tb + 1) * 64 + c]);
    float w2 = bf2f(sRaw[(which * 68 + tb + 2) * 64 + c]), w3 = bf2f(sRaw[(which * 68 + tb + 3) * 64 + c]);
#pragma unroll 4
    for (int t = tb; t < tb + 16; t++) {
      float w4 = bf2f(sRaw[(which * 68 + t + 4) * 64 + c]);
      float acc = cb + w0 * cw[0] + w1 * cw[1] + w2 * cw[2] + w3 * cw[3] + w4 * cw[4];
      w0 = w1; w1 = w2; w2 = w3; w3 = w4;
      float v = silu_f(acc);
      if (which == 0) sVt[c * 72 + t] = f2bf(v * sdt[t] * sdw[t]);
      else sBt[c * 72 + t] = f2bf(v);
    }
  }
  __syncthreads();
  {
    int ti = w >> 1, tj = w & 1;
    f32x16 acc = zero16();
    for (int ks = 0; ks < 64; ks += 16)
      acc = mfma32(ldsfrag(&sVt[(ti * 32 + (lane & 31)) * 72 + ks + 8 * (lane >> 5)]),
                   ldsfrag(&sBt[(tj * 32 + (lane & 31)) * 72 + ks + 8 * (lane >> 5)]), acc);
    bf16* st = WS(bf16, OFF_SSDST) + ((size_t)((d * BATCH + b) * NCH + pc) * 4 + h) * 4096;
    for (int r = 0; r < 16; r++) st[(ti * 32 + acc_row(r, lane)) * 64 + tj * 32 + (lane & 31)] = f2bf(acc[r]);
  }
  __syncthreads();
}

__device__ __forceinline__ void gla_la(const Params& P, int l, int d, int h, const float* sGl, float* dst) {
  const int k = threadIdx.x & 31;
  float gw[16], gb = P.gla_gb[(l * 2 + d) * 128 + h * 32 + k];
  const float* g2 = P.gla_g2 + (size_t)(l * 2 + d) * 16 * 128 + h * 32 + k;
#pragma unroll
  for (int r = 0; r < 16; r++) gw[r] = g2[r * 128];
#pragma unroll 2
  for (int t = threadIdx.x >> 5; t < 64; t += 8) {
    float acc = gb;
#pragma unroll
    for (int r = 0; r < 16; r++) acc += sGl[t * 32 + d * 16 + r] * gw[r];
    dst[t * 32 + k] = -softplus_f(-acc) * (1.f / 16.f);
  }
}
__device__ __forceinline__ void gla_state_item(const Params& P, int l, int item, unsigned char* sm) {
  int tid_ = threadIdx.x; OPAQUE(tid_);
  const int tid = tid_, lane = tid & 63, w = tid >> 6;
  const int d = item & 1, h = (item >> 1) & 3, rest = item >> 3;
  const int pc = rest % NCH, b = rest / NCH;
  const int row0 = chunk_row0(b, pc, TC, NCH_C);
  float* sGl = (float*)sm;
  float* sLa = sGl + 2048;
  bf16* sVt = (bf16*)(sLa + 2048);
  bf16* sKt = sVt + 64 * 72;
  const bf16* pr = WS(bf16, OFF_PROJ);
  float kh[8], vh[16];
#pragma unroll
  for (int i = 0; i < 8; i++) kh[i] = bf2f(pr[(size_t)(row0 + (tid >> 5) + 8 * i) * NIN + C_GLAK + h * 32 + (tid & 31)]);
#pragma unroll
  for (int i = 0; i < 16; i++) vh[i] = bf2f(pr[(size_t)(row0 + (tid >> 6) + 4 * i) * NIN + C_GLAV + h * 64 + (tid & 63)]);
#pragma unroll 8
  for (int idx = tid; idx < 64 * 32; idx += 256) {
    int t = idx >> 5, c = idx & 31;
    sGl[idx] = bf2f(pr[(size_t)(row0 + t) * NIN + C_GLAGL + c]);
  }
  __syncthreads();
  gla_la(P, l, d, h, sGl, sLa);
  __syncthreads();
  {
    float* segtot = (float*)(sKt + 32 * 72);
    const int k = tid & 31, sg = tid >> 5;
    float run = 0.f, loc[8];
#pragma unroll
    for (int j = 0; j < 8; j++) {
      int tau = sg * 8 + j, t = d == 0 ? 63 - tau : tau;
      float la = sLa[t * 32 + k]; loc[j] = run; run += la;
    }
    segtot[sg * 32 + k] = run;
    __syncthreads();
    float off = 0.f, tot = 0.f;
#pragma unroll
    for (int j = 0; j < 8; j++) { float v = segtot[j * 32 + k]; tot += v; if (j < sg) off += v; }
#pragma unroll
    for (int j = 0; j < 8; j++) {
      int tau = sg * 8 + j, t = d == 0 ? 63 - tau : tau;
      sLa[t * 32 + k] = loc[j] + off;
    }
    if (sg == 0) WS(float, OFF_GLADEC)[(((size_t)(d * BATCH + b) * NCH + pc) * 4 + h) * 32 + k] = __expf(tot);
  }
  __syncthreads();
#pragma unroll
  for (int i = 0; i < 16; i++) sVt[(tid & 63) * 72 + (tid >> 6) + 4 * i] = f2bf(vh[i]);
#pragma unroll
  for (int i = 0; i < 8; i++) {
    const int t = (tid >> 5) + 8 * i, k = tid & 31;
    sKt[k * 72 + t] = f2bf(kh[i] * __expf(sLa[t * 32 + k]));
  }
  __syncthreads();
  if (w < 2) {
    f32x16 acc = zero16();
    for (int ks = 0; ks < 64; ks += 16)
      acc = mfma32(ldsfrag(&sVt[(w * 32 + (lane & 31)) * 72 + ks + 8 * (lane >> 5)]),
                   ldsfrag(&sKt[(lane & 31) * 72 + ks + 8 * (lane >> 5)]), acc);
    bf16* st = WS(bf16, OFF_GLAST) + ((size_t)((d * BATCH + b) * NCH + pc) * 4 + h) * 2048;
    for (int r = 0; r < 16; r++) st[(w * 32 + acc_row(r, lane)) * 32 + (lane & 31)] = f2bf(acc[r]);
  }
  __syncthreads();
}

__device__ __forceinline__ U4 s5_u_load(const Params& P, int g, int n, int k8) {
  if (n >= M5) return zero4();
  int b = n / NCH5, pc = n - b * NCH5;
  int row = chunk_row0(b, pc, T5, NC5) + (k8 >> 4);
  return *(const U4*)(WS(bf16, OFF_PROJ) + (size_t)row * NIN + C_S5 + g * 16 + (k8 & 15));
}
__device__ __forceinline__ void s5_state_tile(const Params& P, int l, int item, unsigned char* sm) {
  const int MT5 = (M5 + 127) / 128;
  int nt = item & 1, mt = (item >> 1) % MT5, g = (item >> 1) / MT5;
  const bf16* Bt = WS(bf16, OFF_W1T) + (size_t)(l * 16 + g) * 256 * 512;
  float* S = WS(float, OFF_S5ST) + (size_t)g * M5 * 256;
  gemm_tile(sm, mt * 128, nt * 128, 512,
    [&](int m, int k) { return s5_u_load(P, g, m, k); },
    [&](int n, int k) { return *(const U4*)(Bt + (size_t)n * 512 + k); },
    [&](int m, int n, float v) { if (m < M5) S[(size_t)m * 256 + n] = v; });
}

__device__ __forceinline__ void phase_D(const Params& P, int l, unsigned char* sm, long long& pacc) {
  const int n_rw = BATCH * NCH * 8, n_ssd = BATCH * NCH * 8, n_gla = BATCH * NCH * 8;
  const int n_s5 = 16 * ((M5 + 127) / 128) * 2;
  { long long t0_ = 0; if (PROBE_PHASE == 30) t0_ = wall_clock64();
  ITEM_LOOP(i, n_rw, 0) rwkv_chunk_item(P, l, i, sm, pacc);
  if (PROBE_PHASE == 30) pacc += wall_clock64() - t0_; }
  chunk_scans(P, l, n_rw);
}

__device__ __forceinline__ void chunk_scans(const Params& P, int l, int base) {
  const int tid = threadIdx.x;
  const int n_ssd = 2 * BATCH * 4 * 4, n_gla = 2 * BATCH * 4 * 2, n_s5 = 16 * BATCH;
#pragma unroll 1
  for (int it = (int)((blockIdx.x + gridDim.x - ((unsigned)base % gridDim.x)) % gridDim.x); it < n_ssd + n_gla + n_s5; it += gridDim.x) {
    int i = it;
    if (i < n_ssd) {
      int q = i & 3, h = (i >> 2) & 3, rest = i >> 4, b = rest % BATCH, d = rest / BATCH;
      float S[4] = {0.f, 0.f, 0.f, 0.f};
#pragma unroll 1
      for (int v0 = 0; v0 < NCH; v0 += 8) {
        U2 cv[8]; float dec[8];
#pragma unroll
        for (int j = 0; j < 8; j++) {
          int vc = v0 + j < NCH ? v0 + j : NCH - 1;
          size_t ci = ((size_t)(d * BATCH + b) * NCH + ord_chunk(d, vc, NCH_C, NCH)) * 4 + h;
          cv[j] = *(const U2*)(WS(bf16, OFF_SSDST) + ci * 4096 + q * 1024 + tid * 4);
          dec[j] = WS(float, OFF_SSDDEC)[ci];
        }
#pragma unroll
        for (int j = 0; j < 8; j++) {
          if (v0 + j < NCH) {
            size_t ci = ((size_t)(d * BATCH + b) * NCH + ord_chunk(d, v0 + j, NCH_C, NCH)) * 4 + h;
            U2 o; o.a[0] = pack2(S[0], S[1]); o.a[1] = pack2(S[2], S[3]);
            *(U2*)(WS(bf16, OFF_SSDST) + ci * 4096 + q * 1024 + tid * 4) = o;
            S[0] = dec[j] * S[0] + lo2f(cv[j].a[0]); S[1] = dec[j] * S[1] + hi2f(cv[j].a[0]);
            S[2] = dec[j] * S[2] + lo2f(cv[j].a[1]); S[3] = dec[j] * S[3] + hi2f(cv[j].a[1]);
          }
        }
      }
      continue;
    }
    i -= n_ssd;
    if (i < n_gla) {
      int q = i & 1, h = (i >> 1) & 3, rest = i >> 3, b = rest % BATCH, d = rest / BATCH;
      float S[4] = {0.f, 0.f, 0.f, 0.f};
      int e0 = q * 1024 + tid * 4, k0 = e0 & 31;
#pragma unroll 1
      for (int v0 = 0; v0 < NCH; v0 += 8) {
        U2 cv[8]; F4 dec[8];
#pragma unroll
        for (int j = 0; j < 8; j++) {
          int vc = v0 + j < NCH ? v0 + j : NCH - 1;
          size_t ci = ((size_t)(d * BATCH + b) * NCH + ord_chunk(d, vc, NCH_C, NCH)) * 4 + h;
          cv[j] = *(const U2*)(WS(bf16, OFF_GLAST) + ci * 2048 + e0);
          dec[j] = *(const F4*)(WS(float, OFF_GLADEC) + ci * 32 + k0);
        }
#pragma unroll
        for (int j = 0; j < 8; j++) {
          if (v0 + j < NCH) {
            size_t ci = ((size_t)(d * BATCH + b) * NCH + ord_chunk(d, v0 + j, NCH_C, NCH)) * 4 + h;
            U2 o; o.a[0] = pack2(S[0], S[1]); o.a[1] = pack2(S[2], S[3]);
            *(U2*)(WS(bf16, OFF_GLAST) + ci * 2048 + e0) = o;
            S[0] = dec[j].a[0] * S[0] + lo2f(cv[j].a[0]); S[1] = dec[j].a[1] * S[1] + hi2f(cv[j].a[0]);
            S[2] = dec[j].a[2] * S[2] + lo2f(cv[j].a[1]); S[3] = dec[j].a[3] * S[3] + hi2f(cv[j].a[1]);
          }
        }
      }
      continue;
    }
    i -= n_gla;
    if (i < n_s5) {
      int b = i % BATCH, g = i / BATCH;
      if (tid < 128) {
        int d = tid >> 6, p = tid & 63;
        const float* lt = WS(float, OFF_S5LT) + ((size_t)((l * 16 + g) * 2 + d) * 64 + p) * 2;
        float lr = lt[0], li = lt[1], xr = 0.f, xi = 0.f;
#pragma unroll 1
        for (int v0 = 0; v0 < NCH5; v0 += 8) {
          float sr[8], si[8];
#pragma unroll
          for (int j = 0; j < 8; j++) {
            int vc = v0 + j < NCH5 ? v0 + j : NCH5 - 1;
            const float* sp = WS(float, OFF_S5ST) + ((size_t)g * M5 + b * NCH5 + ord_chunk(d, vc, NC5, NCH5)) * 256 + d * 128 + p;
            sr[j] = sp[0]; si[j] = sp[64];
          }
#pragma unroll
          for (int j = 0; j < 8; j++) {
            if (v0 + j < NCH5) {
              float* sp = WS(float, OFF_S5ST) + ((size_t)g * M5 + b * NCH5 + ord_chunk(d, v0 + j, NC5, NCH5)) * 256 + d * 128 + p;
              sp[0] = xr; sp[64] = xi;
              float nr = lr * xr - li * xi + sr[j], ni = lr * xi + li * xr + si[j];
              xr = nr; xi = ni;
            }
          }
        }
      }
      continue;
    }
  }
}

__device__ __forceinline__ void ssd_out_item(const Params& P, int l, int item, unsigned char* sm, long long& pacc) {
  long long tp0_ = 0; if (PROBE_PHASE == 55 || PROBE_PHASE == 56) tp0_ = wall_clock64();
  int tid_ = threadIdx.x; OPAQUE(tid_);
  const int tid = tid_, lane = tid & 63, w = tid >> 6;
  const int h = item & 3, rest = item >> 2, pc = rest % NCH, b = rest / NCH;
  if (l == 1 && pc < NCH_C) return;
  const int isctx = pc < NCH_C, len = isctx ? CTX : SEQ, t0 = (isctx ? pc : pc - NCH_C) * TC;
  const int seq0 = isctx ? b * CTX : ROWS_C + b * SEQ;
  bf16* sRaw = (bf16*)sm;
  bf16* sA2 = (bf16*)sm;
  bf16* sB2 = (bf16*)(sm + 26112);
  bf16* sC = (bf16*)(sm + 26112 + 25600);
  float* sdt = (float*)(sm + 26112 + 25600 + 9216);
  float* scf = sdt + 128; float* scr = scf + 64; float* spart = scr + 64;
  const bf16* pr = WS(bf16, OFF_PROJ);
#pragma unroll 8
  for (int idx = tid; idx < 3 * 68 * 8; idx += 256) {
    int which = idx / (68 * 8), rem = idx % (68 * 8), tr = rem >> 3, c8 = rem & 7;
    int t = t0 - 2 + tr;
    int col = C_SSD + (which == 0 ? h * 64 : which == 1 ? 256 + (h >> 1) * 64 : 384 + (h >> 1) * 64) + c8 * 8;
    U4 v = (t >= 0 && t < len) ? *(const U4*)(pr + (size_t)(seq0 + t) * NIN + col) : zero4();
    *(U4*)&sRaw[(which * 68 + tr) * 64 + c8 * 8] = v;
  }
  u32x4 stv0, stv1, stv2, stv3;
  {
    const bf16* stb = WS(bf16, OFF_SSDST);
    const size_t o0 = ((size_t)((0 * BATCH + b) * NCH + pc) * 4 + h) * 4096, o1 = ((size_t)((1 * BATCH + b) * NCH + pc) * 4 + h) * 4096;
    const int p_ = (tid >> 3) & 31, c8_ = tid & 7;
    stv0 = *(const u32x4*)(stb + o0 + p_ * 64 + c8_ * 8);
    stv1 = *(const u32x4*)(stb + o0 + (p_ + 32) * 64 + c8_ * 8);
    stv2 = *(const u32x4*)(stb + o1 + p_ * 64 + c8_ * 8);
    stv3 = *(const u32x4*)(stb + o1 + (p_ + 32) * 64 + c8_ * 8);
  }
  float zv[16];
#pragma unroll
  for (int r = 0; r < 16; r++)
    zv[r] = bf2f(pr[(size_t)(seq0 + t0 + (w >> 1) * 32 + acc_row(r, lane)) * NIN + C_SSDZ + h * 64 + (w & 1) * 32 + (lane & 31)]);
  if (tid < 128) {
    int d = tid >> 6, t = tid & 63;
    float raw = bf2f(pr[(size_t)(seq0 + t0 + t) * NIN + C_SSDDT + d * 4 + h]);
    sdt[tid] = softplus_f(raw + P.ssd_dt_bias[(l * 2 + d) * 4 + h]);
  }
  __syncthreads();
  if (w == 0) { float v = wave_scan64(sdt[lane] * ssd_aneg(P, l, 0, h), scf, lane, false); wave_sync(); scf[lane] = v; }
  if (w == 1) { float v = wave_scan64(sdt[64 + lane] * ssd_aneg(P, l, 1, h), scr, lane, true); wave_sync(); scr[lane] = v; }
#pragma unroll
  for (int which = 0; which < 3; which++) {
    const int c = tid & 63;
    const int ch = which == 0 ? h * 64 + c : which == 1 ? 256 + (h >> 1) * 64 + c : 384 + (h >> 1) * 64 + c;
    float cw[5], cb = P.ssd_conv_b[l * 512 + ch];
#pragma unroll
    for (int i = 0; i < 5; i++) cw[i] = P.ssd_conv_w[(l * 5 + i) * 512 + ch];
    const int tb = (tid >> 6) * 16;
    float w0 = bf2f(sRaw[(which * 68 + tb) * 64 + c]), w1 = bf2f(sRaw[(which * 68 + tb + 1) * 64 + c]);
    float w2 = bf2f(sRaw[(which * 68 + tb + 2) * 64 + c]), w3 = bf2f(sRaw[(which * 68 + tb + 3) * 64 + c]);
#pragma unroll 4
    for (int t = tb; t < tb + 16; t++) {
      float w4 = bf2f(sRaw[(which * 68 + t + 4) * 64 + c]);
      float acc = cb + w0 * cw[0] + w1 * cw[1] + w2 * cw[2] + w3 * cw[3] + w4 * cw[4];
      w0 = w1; w1 = w2; w2 = w3; w3 = w4;
      bf16 v = f2bf(silu_f(acc));
      if (which == 0) sB2[c * 200 + t] = v;
      else if (which == 1) sB2[t * 200 + 64 + c] = v;
      else sC[t * 72 + c] = v;
    }
  }
  __syncthreads();
  const int ti = w >> 1, tj = w & 1;
  {
    f32x16 g = zero16();
    for (int ks = 0; ks < 64; ks += 16)
      g = mfma32(ldsfrag(&sC[(ti * 32 + (lane & 31)) * 72 + ks + 8 * (lane >> 5)]),
                 ldsfrag(&sB2[(tj * 32 + (lane & 31)) * 200 + 64 + ks + 8 * (lane >> 5)]), g);
    int j = tj * 32 + (lane & 31);
    float cfj = scf[j], crj = scr[j], d0j = sdt[j], d1j = sdt[64 + j];
    for (int r = 0; r < 16; r++) {
      int i = ti * 32 + acc_row(r, lane);
      float mlt = 0.f;
      if (j <= i) mlt += __expf(scf[i] - cfj) * d0j;
      if (j >= i) mlt += __expf(scr[i] - crj) * d1j;
      sA2[i * 200 + j] = f2bf(g[r] * mlt);
    }
  }
#pragma unroll 8
  for (int idx = tid; idx < 64 * 64; idx += 256) {
    int i = idx >> 6, n = idx & 63;
    float cv = bf2f(sC[i * 72 + n]);
    sA2[i * 200 + 64 + n] = f2bf(cv * __expf(scf[i]));
    sA2[i * 200 + 128 + n] = f2bf(cv * __expf(scr[i]));
  }
  __syncthreads();
  {
    const int p_ = (tid >> 3) & 31, c8_ = tid & 7;
    *(u32x4*)&sB2[p_ * 200 + 64 + c8_ * 8] = stv0;
    *(u32x4*)&sB2[(p_ + 32) * 200 + 64 + c8_ * 8] = stv1;
    *(u32x4*)&sB2[p_ * 200 + 128 + c8_ * 8] = stv2;
    *(u32x4*)&sB2[(p_ + 32) * 200 + 128 + c8_ * 8] = stv3;
  }
  __syncthreads();
  {
    f32x16 acc = zero16();
    for (int ks = 0; ks < 192; ks += 16)
      acc = mfma32(ldsfrag(&sA2[(ti * 32 + (lane & 31)) * 200 + ks + 8 * (lane >> 5)]),
                   ldsfrag(&sB2[(tj * 32 + (lane & 31)) * 200 + ks + 8 * (lane >> 5)]), acc);
    int p = tj * 32 + (lane & 31);
    float dd = P.ssd_d[l * 4 + h];
    bf16* yc = WS(bf16, OFF_R);
    for (int r = 0; r < 16; r++) {
      int i = ti * 32 + acc_row(r, lane);
      int row = seq0 + t0 + i;
      float xv = bf2f(sB2[p * 200 + i]);
      float y = acc[r] + dd * xv;
      float z = zv[r];
      y *= silu_f(z);
      yc[(size_t)row * 1024 + h * 64 + p] = f2bf(y);
      float s2 = sum32(y * y);
      if ((lane & 31) == 31) spart[i * 2 + tj] = s2;
    }
  }
  __syncthreads();
  if (tid < 64) WS(float, OFF_SSQ)[(size_t)(seq0 + t0 + tid) * 4 + h] = spart[tid * 2] + spart[tid * 2 + 1];
  __syncthreads();
}

__device__ __forceinline__ void gla_out_item(const Params& P, int l, int item, unsigned char* sm) {
  int tid_ = threadIdx.x; OPAQUE(tid_);
  const int tid = tid_, lane = tid & 63, w = tid >> 6;
  const int h = item & 3, rest = item >> 2, pc = rest % NCH, b = rest / NCH;
  if (l == 1 && pc < NCH_C) return;
  const int row0 = chunk_row0(b, pc, TC, NCH_C);
  bf16* sA2 = (bf16*)sm;
  bf16* sB2 = sA2 + 64 * 136;
  bf16* sKf = sB2 + 64 * 136;
  bf16* sKr = sKf + 64 * 40;
  float* sbf = (float*)(sKr + 64 * 40);
  float* sbr = sbf + 2048;
  float* spart = sbr + 2048;
  float* sGl = (float*)sB2;
  const bf16* pr = WS(bf16, OFF_PROJ);
  float qh[8], kh[8], vh[16], gh[16];
  u32x4 sth0, sth1;
#pragma unroll
  for (int i = 0; i < 8; i++) {
    const bf16* rp = pr + (size_t)(row0 + (tid >> 5) + 8 * i) * NIN + h * 32 + (tid & 31);
    qh[i] = bf2f(rp[C_GLA]); kh[i] = bf2f(rp[C_GLAK]);
  }
#pragma unroll
  for (int i = 0; i < 16; i++) vh[i] = bf2f(pr[(size_t)(row0 + (tid >> 6) + 4 * i) * NIN + C_GLAV + h * 64 + (tid & 63)]);
#pragma unroll
  for (int r = 0; r < 16; r++)
    gh[r] = bf2f(pr[(size_t)(row0 + (w >> 1) * 32 + acc_row(r, lane)) * NIN + C_GLAG + h * 64 + (w & 1) * 32 + (lane & 31)]);
  {
    const bf16* st0 = WS(bf16, OFF_GLAST) + ((size_t)((0 * BATCH + b) * NCH + pc) * 4 + h) * 2048;
    const bf16* st1 = WS(bf16, OFF_GLAST) + ((size_t)((1 * BATCH + b) * NCH + pc) * 4 + h) * 2048;
    sth0 = *(const u32x4*)(st0 + (tid >> 2) * 32 + (tid & 3) * 8);
    sth1 = *(const u32x4*)(st1 + (tid >> 2) * 32 + (tid & 3) * 8);
  }
#pragma unroll 8
  for (int idx = tid; idx < 64 * 32; idx += 256) {
    int t = idx >> 5, c = idx & 31;
    sGl[idx] = bf2f(pr[(size_t)(row0 + t) * NIN + C_GLAGL + c]);
  }
  __syncthreads();
  gla_la(P, l, 0, h, sGl, sbf);
  gla_la(P, l, 1, h, sGl, sbr);
  __syncthreads();
  {
    float* segtot = spart + 128;
    const int k = tid & 31, sg = tid >> 5;
    float rf = 0.f, rr_ = 0.f, lf[8], lr_[8];
#pragma unroll
    for (int j = 0; j < 8; j++) {
      int tf = sg * 8 + j, tr = 63 - tf;
      rf += sbf[tf * 32 + k]; lf[j] = rf;
      rr_ += sbr[tr * 32 + k]; lr_[j] = rr_;
    }
    segtot[sg * 32 + k] = rf; segtot[256 + sg * 32 + k] = rr_;
    __syncthreads();
    float of = 0.f, orr = 0.f;
#pragma unroll
    for (int j = 0; j < 8; j++) { if (j < sg) { of += segtot[j * 32 + k]; orr += segtot[256 + j * 32 + k]; } }
#pragma unroll
    for (int j = 0; j < 8; j++) {
      int tf = sg * 8 + j, tr = 63 - tf;
      sbf[tf * 32 + k] = lf[j] + of;
      sbr[tr * 32 + k] = lr_[j] + orr;
    }
  }
  __syncthreads();
#pragma unroll
  for (int i = 0; i < 8; i++) {
    const int idx = tid + 256 * i, t = idx >> 5, k = idx & 31;
    float q = qh[i] * 0.17677669529663687f;
    float kv = kh[i];
    float bf_ = sbf[idx], br_ = sbr[idx];
    sA2[t * 136 + 64 + k] = f2bf(q * __expf(bf_));
    sA2[t * 136 + 96 + k] = f2bf(q * __expf(br_));
    sKf[t * 40 + k] = f2bf(kv * __expf(-bf_));
    sKr[t * 40 + k] = f2bf(kv * __expf(-br_));
  }
#pragma unroll
  for (int i = 0; i < 16; i++) sB2[(tid & 63) * 136 + (tid >> 6) + 4 * i] = f2bf(vh[i]);
  *(u32x4*)&sB2[(tid >> 2) * 136 + 64 + (tid & 3) * 8] = sth0;
  *(u32x4*)&sB2[(tid >> 2) * 136 + 96 + (tid & 3) * 8] = sth1;
  __syncthreads();
  const int ti = w >> 1, tj = w & 1;
  {
    f32x16 pf = zero16(), pv = zero16();
    for (int ks = 0; ks < 32; ks += 16) {
      pf = mfma32(ldsfrag(&sA2[(ti * 32 + (lane & 31)) * 136 + 64 + ks + 8 * (lane >> 5)]),
                  ldsfrag(&sKf[(tj * 32 + (lane & 31)) * 40 + ks + 8 * (lane >> 5)]), pf);
      pv = mfma32(ldsfrag(&sA2[(ti * 32 + (lane & 31)) * 136 + 96 + ks + 8 * (lane >> 5)]),
                  ldsfrag(&sKr[(tj * 32 + (lane & 31)) * 40 + ks + 8 * (lane >> 5)]), pv);
    }
    int j = tj * 32 + (lane & 31);
    for (int r = 0; r < 16; r++) {
      int i = ti * 32 + acc_row(r, lane);
      float v = (j < i) ? pf[r] : (j > i) ? pv[r] : pf[r] + pv[r];
      sA2[i * 136 + j] = f2bf(v);
    }
  }
  __syncthreads();
  {
    f32x16 acc = zero16();
    for (int ks = 0; ks < 128; ks += 16)
      acc = mfma32(ldsfrag(&sA2[(ti * 32 + (lane & 31)) * 136 + ks + 8 * (lane >> 5)]),
                   ldsfrag(&sB2[(tj * 32 + (lane & 31)) * 136 + ks + 8 * (lane >> 5)]), acc);
    for (int r = 0; r < 16; r++) {
      int i = ti * 32 + acc_row(r, lane);
      float s2 = sum32(acc[r] * acc[r]);
      if ((lane & 31) == 31) spart[i * 2 + tj] = s2;
    }
    __syncthreads();
    int v = tj * 32 + (lane & 31);
    float gn = P.gla_norm[l * 256 + h * 64 + v];
    bf16* yc = WS(bf16, OFF_R);
    for (int r = 0; r < 16; r++) {
      int i = ti * 32 + acc_row(r, lane);
      int row = row0 + i;
      float rstd = rsqrtf((spart[i * 2] + spart[i * 2 + 1]) * (1.f / 64.f) + 1e-6f);
      float g = gh[r];
      yc[(size_t)row * 1024 + 768 + h * 64 + v] = f2bf(acc[r] * rstd * gn * silu_f(g));
    }
  }
  __syncthreads();
}

__device__ __forceinline__ void s5_out_tile(const Params& P, int l, int item, unsigned char* sm) {
  const int MT5 = (M5 + 127) / 128;
  int nt = item & 3, mt = (item >> 2) % MT5, g = (item >> 2) / MT5;
  const bf16* Bt = WS(bf16, OFF_BT2) + (size_t)(l * 16 + g) * 512 * 768;
  const float* X = WS(float, OFF_S5ST) + (size_t)g * M5 * 256;
  const bf16* pr = WS(bf16, OFF_PROJ);
  bf16* ys = WS(bf16, OFF_YS5);
  gemm_tile(sm, mt * 128, nt * 128, 768,
    [&](int m, int k) {
      if (k < 512) return s5_u_load(P, g, m, k);
      if (m >= M5) return zero4();
      const float* xp = X + (size_t)m * 256 + (k - 512);
      F4 a = *(const F4*)xp, b2 = *(const F4*)(xp + 4);
      U4 r; r.a[0] = pack2(a.a[0], a.a[1]); r.a[1] = pack2(a.a[2], a.a[3]); r.a[2] = pack2(b2.a[0], b2.a[1]); r.a[3] = pack2(b2.a[2], b2.a[3]);
      return r;
    },
    [&](int n, int k) { return *(const U4*)(Bt + (size_t)n * 768 + k); },
    [&](int m, int n, float v) {
      if (m >= M5) return;
      int b = m / NCH5, pc = m - b * NCH5;
      int row = chunk_row0(b, pc, T5, NC5) + (n >> 4);
      int ch = g * 16 + (n & 15);
      float u = bf2f(pr[(size_t)row * NIN + C_S5 + ch]);
      ys[(size_t)row * 256 + ch] = f2bf(gelu_f(v + P.s5_d[l * 256 + ch] * u));
    });
}

__device__ __forceinline__ void phase_E(const Params& P, int l, unsigned char* sm, long long& pacc) {
  const int n_rw = BATCH * 8;
  ITEM_LOOP(i, n_rw, 0) rwkv_scan2_item(P, l, i, sm);
  const int n_ssd = BATCH * NCH * 4, n_gla = BATCH * NCH * 4, n_s5 = 16 * ((M5 + 127) / 128) * 4;
  ITEM_LOOP(i, n_ssd, n_rw) ssd_out_item(P, l, i, sm, pacc);
  ITEM_LOOP(i, n_gla, n_rw + n_ssd) gla_out_item(P, l, i, sm);
  ITEM_LOOP(i, n_s5, n_rw + n_ssd + n_gla) s5_out_tile(P, l, i, sm);
}
__device__ __forceinline__ void phase_F(const Params& P, int l, unsigned char* sm, long long& pacc) {
  const int n_rw = BATCH * NCH * 4;
  ITEM_LOOP(i, n_rw, 0) rwkv_out_item(P, l, i, sm);
}

__device__ __forceinline__ void phase_G(const Params& P, int l, unsigned char* sm) {
  const int lane = threadIdx.x & 63, w = threadIdx.x >> 6;
  const int n_glu = (ROWS / 128) * 2, n_rows = ROWS / 4;
  const bf16* Bt = WS(bf16, OFF_GLUT) + (size_t)l * 256 * 256;
  const bf16* pr = WS(bf16, OFF_PROJ);
  bf16* yc = WS(bf16, OFF_R);
#pragma unroll 1
  for (int it = blockIdx.x; it < n_glu + n_rows; it += gridDim.x) {
    if (it < n_glu) {
      int nt = it & 1, mt = it >> 1;
      if (l == 1 && mt < ROWS_C / 128) continue;
      gemm_tile(sm, mt * 128, nt * 128, 256,
        [&](int m, int k) { return *(const U4*)(WS(bf16, OFF_YS5) + (size_t)m * 256 + k); },
        [&](int n, int k) { return *(const U4*)(Bt + (size_t)n * 256 + k); },
        [&](int m, int n, float v) {
          float y = bf2f(WS(bf16, OFF_YS5)[(size_t)m * 256 + n]);
          float g = bf2f(pr[(size_t)m * NIN + C_S5G + n]);
          yc[(size_t)m * 1024 + 256 + n] = f2bf(y * sigmoid_f(v + P.s5_glu_b[l * 256 + n]) * silu_f(g));
        });
      continue;
    }
    int m = (it - n_glu) * 4 + w;
    const float* sq = WS(float, OFF_SSQ) + (size_t)m * 4;
    float rstd = rsqrtf((sq[0] + sq[1] + sq[2] + sq[3]) * (1.f / 256.f) + 1e-6f);
    bf16* p = yc + (size_t)m * 1024 + lane * 4;
    U2 v = *(U2*)p;
    const float* gn = P.ssd_norm + l * 256 + lane * 4;
    U2 o;
    o.a[0] = pack2(lo2f(v.a[0]) * rstd * gn[0], hi2f(v.a[0]) * rstd * gn[1]);
    o.a[1] = pack2(lo2f(v.a[1]) * rstd * gn[2], hi2f(v.a[1]) * rstd * gn[3]);
    *(U2*)p = o;
  }
}

__device__ __forceinline__ void phase_outproj(const Params& P, int l, unsigned char* sm) {
  const bf16* A = WS(bf16, OFF_R);
  const bf16* Bt = WS(bf16, OFF_WTOUT) + (size_t)l * D * D;
  bf16* Y = WS(bf16, OFF_PROJ);
  const int NT = D / 128, MT = ROWS / 128;
#pragma unroll 1
  for (int it0 = blockIdx.x; it0 < MT * NT; it0 += gridDim.x) {
    const int per = (MT * NT) / 8;
    int it = (MT * NT) % 8 == 0 ? (it0 & 7) * per + (it0 >> 3) : it0;
    int mt = it / NT, nt = it % NT;
    if (l == 1 && mt < ROWS_C / 128) continue;
    gemm_tile(sm, mt * 128, nt * 128, D,
      [&](int m, int k) { return *(const U4*)(A + (size_t)m * D + k); },
      [&](int n, int k) { return *(const U4*)(Bt + (size_t)n * D + k); },
      [&](int m, int n, float v) { Y[(size_t)m * D + n] = f2bf(v); });
  }
}

__device__ __forceinline__ void phase_post(const Params& P, int l) {
  const int lane = threadIdx.x & 63, w = threadIdx.x >> 6;
  const int first = (l == 1) ? ROWS_C / 4 : 0;
#pragma unroll 1
  for (int it = first + blockIdx.x; it < ROWS / 4; it += gridDim.x) {
    int m = it * 4 + w;
    RowInfo ri = row_info(m);
    const bf16* y = WS(bf16, OFF_PROJ) + (size_t)m * D + lane * 16;
    const float* hres; float* dst;
    if (ri.isctx) { hres = P.ctx + (size_t)m * D; dst = WS(float, OFF_HC) + (size_t)m * D; }
    else { hres = (l == 0 ? P.x : P.out) + (size_t)(m - ROWS_C) * D; dst = P.out + (size_t)(m - ROWS_C) * D; }
    const int mrow = ri.isctx ? BATCH : ri.b;
    const float* mod = WS(float, OFF_MOD) + ((size_t)l * NMOD + mrow) * 3072 + 2048;
    const int c0 = lane * 16;
    U4 y0 = *(const U4*)y, y1 = *(const U4*)(y + 8);
    float v[16]; float ss = 0.f;
#pragma unroll
    for (int e = 0; e < 4; e++) { v[2 * e] = lo2f(y0.a[e]); v[2 * e + 1] = hi2f(y0.a[e]); v[8 + 2 * e] = lo2f(y1.a[e]); v[8 + 2 * e + 1] = hi2f(y1.a[e]); }
#pragma unroll
    for (int e = 0; e < 16; e++) ss += v[e] * v[e];
    ss = sum64(ss);
    float rstd = rsqrtf(ss * (1.f / 1024.f) + 1e-6f);
    float hn[16]; float ss2 = 0.f;
#pragma unroll
    for (int q = 0; q < 4; q++) {
      F4 hr = *(const F4*)(hres + c0 + 4 * q), gm = *(const F4*)(mod + c0 + 4 * q), np = *(const F4*)(P.norm_post + l * D + c0 + 4 * q), o;
#pragma unroll
      for (int e = 0; e < 4; e++) { o.a[e] = hr.a[e] + gm.a[e] * (v[4 * q + e] * rstd * np.a[e]); hn[4 * q + e] = o.a[e]; ss2 += o.a[e] * o.a[e]; }
      *(F4*)(dst + c0 + 4 * q) = o;
    }
    if (l == 0) {
      ss2 = sum64(ss2);
      float rstd2 = rsqrtf(ss2 * (1.f / 1024.f) + 1e-6f);
      const float* mod1 = WS(float, OFF_MOD) + ((size_t)1 * NMOD + mrow) * 3072;
      bf16* hd = WS(bf16, OFF_R) + (size_t)m * D + c0;
      U4 o0, o1;
#pragma unroll
      for (int q = 0; q < 4; q++) {
        F4 np = *(const F4*)(P.norm_pre + 1 * D + c0 + 4 * q), sc = *(const F4*)(mod1 + 1024 + c0 + 4 * q), sh = *(const F4*)(mod1 + c0 + 4 * q);
        float t0 = hn[4 * q] * rstd2 * np.a[0] * (1.f + sc.a[0]) + sh.a[0], t1 = hn[4 * q + 1] * rstd2 * np.a[1] * (1.f + sc.a[1]) + sh.a[1];
        float t2 = hn[4 * q + 2] * rstd2 * np.a[2] * (1.f + sc.a[2]) + sh.a[2], t3 = hn[4 * q + 3] * rstd2 * np.a[3] * (1.f + sc.a[3]) + sh.a[3];
        if (q < 2) { o0.a[2 * q] = pack2(t0, t1); o0.a[2 * q + 1] = pack2(t2, t3); }
        else { o1.a[2 * (q - 2)] = pack2(t0, t1); o1.a[2 * (q - 2) + 1] = pack2(t2, t3); }
      }
      *(U4*)hd = o0; *(U4*)(hd + 8) = o1;
    }
  }
}

constexpr int NPHASE = 19;
__device__ __forceinline__ void run_phase(const Params& P, int ph, unsigned char* sm) {
  if (ph == 0) { phase_prologue(P, sm); return; }
  int l = (ph - 1) / 9, s = (ph - 1) % 9;
  switch (s) {
    case 0: if (l == 0) phase_normmod(P, l); break;
    case 1: phase_inproj(P, l, sm); break;
    case 2: phase_rwprep(P, l, sm); break;
    case 3: { long long dummy = 0; phase_D(P, l, sm, dummy); } break;
    case 4: { long long dummy = 0; phase_E(P, l, sm, dummy); } break;
    case 5: { long long dummy = 0; phase_F(P, l, sm, dummy); } break;
    case 6: phase_G(P, l, sm); break;
    case 7: phase_outproj(P, l, sm); break;
    default: phase_post(P, l); break;
  }
}

#ifndef CPU_EMU
#define XB_TMO      128
#define XB_XCNT(j)  (256  + 64 * (j))
#define XB_XSUB(j)  (1280 + 64 * (j))
#define XB_XGEN(j)  (2304 + 64 * (j))
#define XB_TOP      3328
#define XB_TOPGEN   3392
#define XCD_BAR_WORDS 3456
#define XB_SPIN_CAP (1u << 18)
#define LAS __attribute__((address_space(3)))

__device__ __forceinline__ unsigned xb_ld(unsigned* p)              { return __hip_atomic_load(p, __ATOMIC_RELAXED, __HIP_MEMORY_SCOPE_AGENT); }
__device__ __forceinline__ unsigned xb_add(unsigned* p, unsigned v) { return __hip_atomic_fetch_add(p, v, __ATOMIC_RELAXED, __HIP_MEMORY_SCOPE_AGENT); }
__device__ __forceinline__ unsigned xb_xcc_id() { return (unsigned)__builtin_amdgcn_s_getreg((3 << 11) | 20) & 0xFu; }
#define XB_SPIN(cond, bar) do { unsigned _sp = 0; while (cond) { __builtin_amdgcn_s_sleep(1); \
    if ((++_sp & 255u) == 0u) { if (xb_ld(&(bar)[XB_TMO])) break; if (_sp > XB_SPIN_CAP) { atomicAdd(&(bar)[XB_TMO], 1u); break; } } } } while (0)

struct XcdBarrier {
    unsigned* bar; unsigned x;
    volatile LAS unsigned* st;
};

__device__ __forceinline__ XcdBarrier xcd_barrier_post(unsigned* bar, volatile LAS unsigned* st) {
    XcdBarrier b; b.bar = bar; b.x = xb_xcc_id(); b.st = st;
    if (threadIdx.x == 0) (void)xb_add(&bar[XB_XCNT(b.x)], 1u);
    return b;
}
__device__ __forceinline__ void xcd_barrier_complete(unsigned* bar, unsigned x, unsigned& nloc, unsigned& nx) {
    const unsigned G = gridDim.x * gridDim.y * gridDim.z;
    unsigned sum, cnt, mine, sp = 0u;
    for (;;) {
        sum = 0u; cnt = 0u; mine = 0u;
#pragma unroll
        for (unsigned j = 0; j < 16; ++j) { const unsigned c = xb_ld(&bar[XB_XCNT(j)]); sum += c; cnt += (c > 0u) ? 1u : 0u; mine = (j == x) ? c : mine; }
        if (sum == G) break;
        __builtin_amdgcn_s_sleep(1);
        if ((++sp & 255u) == 0u) { if (xb_ld(&bar[XB_TMO])) break; if (sp > XB_SPIN_CAP) { atomicAdd(&bar[XB_TMO], 1u); break; } }
    }
    nloc = mine > 0u ? mine : 1u; nx = cnt > 0u ? cnt : 1u;
}

__device__ __forceinline__ void xcd_barrier(const XcdBarrier& b) {
    asm volatile("s_waitcnt vmcnt(0)" ::: "memory");
    __syncthreads();
    if (threadIdx.x == 0) {
        unsigned* bar = b.bar;
        __builtin_amdgcn_s_waitcnt(0);
        unsigned nloc = b.st[0], nx = b.st[1];
        if (nloc == 0u) { xcd_barrier_complete(bar, b.x, nloc, nx); b.st[0] = nloc; b.st[1] = nx; }
        const unsigned old = xb_add(&bar[XB_XSUB(b.x)], 1u);
        const unsigned gen = old / nloc;
        if (old + 1u == (gen + 1u) * nloc) {
            __builtin_amdgcn_fence(__ATOMIC_RELEASE, "agent");
            asm volatile("s_waitcnt vmcnt(0)" ::: "memory");
            const unsigned og = xb_add(&bar[XB_TOP], 1u);
            const unsigned tg = og / nx;
            if (og + 1u == (tg + 1u) * nx) xb_add(&bar[XB_TOPGEN], 1u);
            else XB_SPIN(xb_ld(&bar[XB_TOPGEN]) == tg, bar);
            __builtin_amdgcn_fence(__ATOMIC_ACQUIRE, "agent");
            xb_add(&bar[XB_XGEN(b.x)], 1u);
            asm volatile("s_waitcnt vmcnt(0)" ::: "memory");
        } else {
            XB_SPIN(xb_ld(&bar[XB_XGEN(b.x)]) == gen, bar);
            __builtin_amdgcn_fence(__ATOMIC_ACQUIRE, "agent");
            asm volatile("s_waitcnt vmcnt(0)" ::: "memory");
        }
    }
    __syncthreads();
}


#define PH(bit, call) { long long t0_ = 0; if (PROBE_PHASE == (bit)) t0_ = wall_clock64(); call; xcd_barrier(xb); if (PROBE_PHASE == (bit)) pacc += wall_clock64() - t0_; }
template <int L> __device__ __forceinline__ void run_layer(const Params& P, unsigned char* sm, const XcdBarrier& xb, long long& pacc) {
  if (L == 0) PH(0, phase_normmod(P, L))
  PH(1, phase_inproj(P, L, sm))
  PH(2, phase_rwprep(P, L, sm))
  PH(3, phase_D(P, L, sm, pacc))
  PH(4, phase_E(P, L, sm, pacc))
  PH(5, phase_F(P, L, sm, pacc))
  PH(6, phase_G(P, L, sm))
  PH(7, phase_outproj(P, L, sm))
  if (L == 0) PH(8, phase_post(P, L))
  else phase_post(P, L);
}
__global__ void __launch_bounds__(256, 2) mega_kernel(Params P) {
  __shared__ __attribute__((aligned(16))) unsigned char sm[SMEM_BYTES];
  __shared__ uint4 xb_words;
  cg::grid_group grid = cg::this_grid();
  long long pacc = 0;
  if (threadIdx.x == 0) xb_words = make_uint4(0u, 0u, 0u, 0u);
  __syncthreads();
  XcdBarrier xb = xcd_barrier_post((unsigned*)(P.ws + OFF_BAR), (volatile LAS unsigned*)&xb_words);
  if (P.ws == nullptr) grid.sync();
  PH(9, phase_prologue(P, sm))
  run_layer<0>(P, sm, xb, pacc);
  run_layer<1>(P, sm, xb, pacc);
  if (PROBE_PHASE >= 0 && blockIdx.x == 0 && threadIdx.x == 0) {
    long long t1 = wall_clock64();
    while (wall_clock64() - t1 < pacc) { __builtin_amdgcn_s_sleep(10); }
  }
}
__global__ void __launch_bounds__(256, 2) phase_kernel(Params P, int ph) {
  __shared__ __attribute__((aligned(16))) unsigned char sm[SMEM_BYTES];
  run_phase(P, ph, sm);
}

extern "C" void kernel_launch(void* const* d_in, const int* in_sizes, int n_in, void* d_out, int out_size,
                              void* d_ws, size_t ws_size, hipStream_t stream) {
  Params P{};
  const float** pp = (const float**)&P;
  for (int i = 0; i < 39; i++) pp[i] = (const float*)d_in[i];
  P.out = (float*)d_out;
  P.ws = (unsigned char*)d_ws;
  if (ws_size < WS_TOTAL) fprintf(stderr, "workspace too small: %zu < %zu\n", ws_size, (size_t)WS_TOTAL);
#if USE_COOP
  static int grid_blocks = 0;
  if (!grid_blocks) {
    int dev = 0, cus = 0, per_cu = 0;
    hipGetDevice(&dev);
    hipDeviceGetAttribute(&cus, hipDeviceAttributeMultiprocessorCount, dev);
    hipOccupancyMaxActiveBlocksPerMultiprocessor(&per_cu, mega_kernel, 256, 0);
    if (per_cu > 2) per_cu = 2;
    grid_blocks = cus * per_cu;
  }
  hipMemsetAsync((unsigned char*)d_ws + OFF_BAR, 0, 3456 * 4, stream);
  void* args[] = {&P};
  hipError_t e = hipLaunchCooperativeKernel((void*)mega_kernel, dim3(grid_blocks), dim3(256), args, 0, stream);
  if (e != hipSuccess) fprintf(stderr, "cooperative launch failed: %s (grid %d)\n", hipGetErrorString(e), grid_blocks);
#else
  for (int ph = 0; ph < NPHASE; ph++) phase_kernel<<<1024, 256, 0, stream>>>(P, ph);
#endif
}
#endif
```

```cpp
#ifdef CPU_EMU
#include "hip_emu.h"
#else
#include <hip/hip_runtime.h>
#include <hip/hip_cooperative_groups.h>
#include <stdint.h>
#include <stdio.h>
namespace cg = cooperative_groups;
#endif

#ifndef BATCH
#define BATCH 8
#endif
#ifndef SEQ
#define SEQ 4096
#endif
#ifndef CTX
#define CTX 256
#endif
#ifndef USE_COOP
#define USE_COOP 1
#endif
#ifndef PROBE_PHASE
#define PROBE_PHASE -1
#endif

typedef unsigned short bf16;
typedef __attribute__((ext_vector_type(8))) short bf16x8;
typedef __attribute__((ext_vector_type(16))) float f32x16;
struct alignas(16) U4 { uint32_t a[4]; };
typedef uint32_t u32x4 __attribute__((ext_vector_type(4)));
struct alignas(8) U2 { uint32_t a[2]; };
struct alignas(16) F4 { float a[4]; };

constexpr int D = 1024, NIN = 3368, NINP = 3456;
constexpr int ROWS_C = BATCH * CTX, ROWS_L = BATCH * SEQ, ROWS = ROWS_C + ROWS_L;
constexpr int VL = CTX + SEQ;
constexpr int TC = 64;
constexpr int NCH_C = CTX / TC, NCH_L = SEQ / TC, NCH = NCH_C + NCH_L;
constexpr int T5 = 32;
constexpr int NC5 = CTX / T5, NL5 = SEQ / T5, NCH5 = NC5 + NL5;
constexpr int M5 = BATCH * NCH5;
constexpr int NMOD = BATCH + 1;
constexpr int C_RW = 0, C_RWG = 1024, C_S5 = 1280, C_S5G = 1536, C_SSD = 1792, C_SSDDT = 2304, C_SSDZ = 2312;
constexpr int C_GLA = 2568, C_GLAK = 2696, C_GLAV = 2824, C_GLAGL = 3080, C_GLAG = 3112;

constexpr size_t al256(size_t x) { return (x + 255) & ~size_t(255); }
constexpr size_t OFF_WTIN = 0;
constexpr size_t OFF_WTOUT = OFF_WTIN + al256(2ull * NINP * D * 2);
constexpr size_t OFF_W2T = OFF_WTOUT + al256(2ull * D * D * 2);
constexpr size_t OFF_A2T = OFF_W2T + al256(2ull * 2 * 256 * 64 * 2);
constexpr size_t OFF_GLUT = OFF_A2T + al256(2ull * 2 * 256 * 64 * 2);
constexpr size_t OFF_MOD = OFF_GLUT + al256(2ull * 256 * 256 * 2);
constexpr size_t OFF_S5K = OFF_MOD + al256(2ull * NMOD * 3072 * 4);
constexpr size_t OFF_S5LT = OFF_S5K + al256(2ull * 16 * 2 * 32 * 256 * 4);
constexpr size_t OFF_W1T = OFF_S5LT + al256(2ull * 16 * 2 * 64 * 2 * 4);
constexpr size_t OFF_BT2 = OFF_W1T + al256(2ull * 16 * 256 * 512 * 2);
constexpr size_t OFF_PROJ = OFF_BT2 + al256(2ull * 16 * 512 * 768 * 2);
constexpr size_t OFF_R = OFF_PROJ + al256((size_t)ROWS * NIN * 2);
constexpr size_t OFF_XA = OFF_R + al256((size_t)ROWS * 1024 * 2);
constexpr size_t OFF_HC = OFF_XA + al256((size_t)ROWS * 1024 * 2);
constexpr size_t OFF_SSDST = OFF_HC + al256((size_t)ROWS_C * 1024 * 4);
constexpr size_t OFF_SSDDEC = OFF_SSDST + al256(2ull * BATCH * NCH * 4 * 4096 * 2);
constexpr size_t OFF_GLAST = OFF_SSDDEC + al256(2ull * BATCH * NCH * 4 * 4);
constexpr size_t OFF_GLADEC = OFF_GLAST + al256(2ull * BATCH * NCH * 4 * 2048 * 2);
constexpr size_t OFF_S5ST = OFF_GLADEC + al256(2ull * BATCH * NCH * 4 * 32 * 4);
constexpr size_t OFF_SSQ = OFF_S5ST + al256(16ull * M5 * 256 * 4);
constexpr size_t OFF_BON = OFF_SSQ + al256((size_t)ROWS * 4 * 4);
constexpr size_t OFF_BAR = OFF_BON + al256((size_t)ROWS * 8 * 4);
constexpr size_t OFF_YS5 = OFF_BAR + al256(3456 * 4);
constexpr size_t WS_TOTAL = OFF_YS5 + al256((size_t)ROWS * 256 * 2);
#if BATCH == 8 && SEQ == 4096 && CTX == 256
static_assert(WS_TOTAL <= 536870912ull, "workspace too large");
#endif
constexpr int SMEM_BYTES = 64512;

struct Params {
  const float *x, *c, *ctx, *c_ctx, *ada_w, *ada_b, *norm_pre, *norm_post, *w_in, *w_out;
  const float *rw_mu, *rw_w0, *rw_w2, *rw_a0, *rw_a2, *rw_kk, *rw_ka, *rw_rk, *rw_ln_w, *rw_ln_b;
  const float *s5_a_re, *s5_a_im, *s5_log_dt, *s5_b_re, *s5_b_im, *s5_c_re, *s5_c_im, *s5_d, *s5_glu_w, *s5_glu_b;
  const float *ssd_conv_w, *ssd_conv_b, *ssd_dt_bias, *ssd_a_log, *ssd_d, *ssd_norm;
  const float *gla_g2, *gla_gb, *gla_norm;
  float* out;
  unsigned char* ws;
};

#ifdef CPU_EMU
#define OPAQUE(x)
#else
#define OPAQUE(x) asm volatile("" : "+v"(x))
#endif
struct Params;
__device__ __forceinline__ void ssd_state_item(const Params& P, int l, int item, unsigned char* sm);
__device__ __forceinline__ void gla_state_item(const Params& P, int l, int item, unsigned char* sm);
__device__ __forceinline__ void s5_state_tile(const Params& P, int l, int item, unsigned char* sm);
__device__ __forceinline__ void chunk_scans(const Params& P, int l, int base);
__device__ __forceinline__ float bf2f(bf16 v) { return __uint_as_float(((uint32_t)v) << 16); }
__device__ __forceinline__ bf16 f2bf(float f) {
  uint32_t u = __float_as_uint(f);
  u += 0x7fffu + ((u >> 16) & 1u);
  return (bf16)(u >> 16);
}
__device__ __forceinline__ uint32_t pack2(float lo, float hi) { return (uint32_t)f2bf(lo) | ((uint32_t)f2bf(hi) << 16); }
__device__ __forceinline__ float lo2f(uint32_t u) { return __uint_as_float(u << 16); }
__device__ __forceinline__ float hi2f(uint32_t u) { return __uint_as_float(u & 0xffff0000u); }
__device__ __forceinline__ float sigmoid_f(float x) { return 1.f / (1.f + __expf(-x)); }
__device__ __forceinline__ float silu_f(float x) { return x / (1.f + __expf(-x)); }
__device__ __forceinline__ float softplus_f(float x) { return fmaxf(x, 0.f) + __logf(1.f + __expf(-fabsf(x))); }
__device__ __forceinline__ float tanh_f(float x) { return 1.f - 2.f / (1.f + __expf(2.f * x)); }
__device__ __forceinline__ float gelu_f(float x) {
  return 0.5f * x * (1.f + tanh_f(0.7978845608028654f * (x + 0.044715f * x * x * x)));
}
__device__ __forceinline__ U4 zero4() { U4 r; r.a[0] = r.a[1] = r.a[2] = r.a[3] = 0; return r; }
__device__ __forceinline__ f32x16 mfma32(bf16x8 a, bf16x8 b, f32x16 c) {
#ifdef CPU_EMU
  return emu_mfma32(a, b, c);
#else
  return __builtin_amdgcn_mfma_f32_32x32x16_bf16(a, b, c, 0, 0, 0);
#endif
}
__device__ __forceinline__ f32x16 zero16() { f32x16 z; for (int i = 0; i < 16; i++) z[i] = 0.f; return z; }
__device__ __forceinline__ int acc_row(int reg, int lane) { return (reg & 3) + 8 * (reg >> 2) + 4 * (lane >> 5); }
template <int CTRL> __device__ __forceinline__ float dpp_mov(float v) {
#ifdef CPU_EMU
  int l = threadIdx.x & 63, src;
  if (CTRL == 0xB1) src = l ^ 1; else if (CTRL == 0x4E) src = l ^ 2;
  else if (CTRL == 0x141) src = (l & ~7) | (7 - (l & 7)); else src = (l & ~15) | (15 - (l & 15));
  return emu_lane_read(v, src);
#else
  return __int_as_float(__builtin_amdgcn_update_dpp(0, __float_as_int(v), CTRL, 0xF, 0xF, true));
#endif
}
__device__ __forceinline__ float sum16(float v) {
  v += dpp_mov<0xB1>(v); v += dpp_mov<0x4E>(v); v += dpp_mov<0x141>(v); v += dpp_mov<0x140>(v); return v;
}
__device__ __forceinline__ float sum32(float v) {
  v = sum16(v);
#ifdef CPU_EMU
  int l = threadIdx.x & 63; float o = emu_lane_read(v, ((l >> 4) > 0 ? ((l >> 4) - 1) * 16 + 15 : 0));
  if ((l >> 4) & 1) v += o;
#else
  v += __int_as_float(__builtin_amdgcn_update_dpp(0, __float_as_int(v), 0x142, 0xA, 0xF, false));
#endif
  return v;
}
__device__ __forceinline__ float sum64(float v) {
  v = sum16(v);
#ifdef CPU_EMU
  return emu_lane_read(v, 0) + emu_lane_read(v, 16) + emu_lane_read(v, 32) + emu_lane_read(v, 48);
#else
  int iv = __float_as_int(v);
  return __int_as_float(__builtin_amdgcn_readlane(iv, 0)) + __int_as_float(__builtin_amdgcn_readlane(iv, 16)) +
         __int_as_float(__builtin_amdgcn_readlane(iv, 32)) + __int_as_float(__builtin_amdgcn_readlane(iv, 48));
#endif
}

__device__ __forceinline__ const bf16x8& ldsfrag(const bf16* p) { return *(const bf16x8*)p; }

__device__ __forceinline__ int chunk_row0(int b, int pc, int T, int nC) {
  return pc < nC ? b * CTX + pc * T : ROWS_C + b * SEQ + (pc - nC) * T;
}
__device__ __forceinline__ int ord_chunk(int d, int vc, int nC, int nAll) {
  return d == 0 ? vc : (vc < nC ? nC - 1 - vc : nAll - 1 - (vc - nC));
}
struct RowInfo { int isctx, b, t, seq0, len; };
__device__ __forceinline__ RowInfo row_info(int m) {
  RowInfo r;
  if (m < ROWS_C) { r.isctx = 1; r.b = m / CTX; r.t = m - r.b * CTX; r.seq0 = r.b * CTX; r.len = CTX; }
  else { int q = m - ROWS_C; r.isctx = 0; r.b = q / SEQ; r.t = q - r.b * SEQ; r.seq0 = ROWS_C + r.b * SEQ; r.len = SEQ; }
  return r;
}

template <class AL, class BL, class EP>
__device__ __forceinline__ void gemm_tile(unsigned char* sm, int m0, int n0, int K, AL al, BL bl, EP ep) {
  bf16* sA0 = (bf16*)sm;
  int tid_ = threadIdx.x; OPAQUE(tid_);
  const int tid = tid_, lane = tid & 63, w = tid >> 6, wm = w >> 1, wn = w & 1;
  f32x16 acc[2][2];
#pragma unroll
  for (int i = 0; i < 2; i++)
#pragma unroll
    for (int j = 0; j < 2; j++) acc[i][j] = zero16();
  const int lr = tid >> 2, lk = (tid & 3) * 8;
  U4 ra0 = al(m0 + lr, lk), ra1 = al(m0 + lr + 64, lk), rb0 = bl(n0 + lr, lk), rb1 = bl(n0 + lr + 64, lk);
  {
    bf16* sA = sA0; bf16* sB = sA + 128 * 40;
    *(U4*)&sA[lr * 40 + lk] = ra0; *(U4*)&sA[(lr + 64) * 40 + lk] = ra1;
    *(U4*)&sB[lr * 40 + lk] = rb0; *(U4*)&sB[(lr + 64) * 40 + lk] = rb1;
  }
  if (32 < K) { ra0 = al(m0 + lr, 32 + lk); ra1 = al(m0 + lr + 64, 32 + lk); rb0 = bl(n0 + lr, 32 + lk); rb1 = bl(n0 + lr + 64, 32 + lk); }
  __syncthreads();
  int cur = 0;
#pragma unroll 1
  for (int k0 = 0; k0 < K; k0 += 32) {
    bf16* sA = sA0 + cur * (256 * 40); bf16* sB = sA + 128 * 40;
    if (k0 + 32 < K) {
      bf16* nA = sA0 + (cur ^ 1) * (256 * 40); bf16* nB = nA + 128 * 40;
      *(U4*)&nA[lr * 40 + lk] = ra0; *(U4*)&nA[(lr + 64) * 40 + lk] = ra1;
      *(U4*)&nB[lr * 40 + lk] = rb0; *(U4*)&nB[(lr + 64) * 40 + lk] = rb1;
      if (k0 + 64 < K) {
        ra0 = al(m0 + lr, k0 + 64 + lk); ra1 = al(m0 + lr + 64, k0 + 64 + lk);
        rb0 = bl(n0 + lr, k0 + 64 + lk); rb1 = bl(n0 + lr + 64, k0 + 64 + lk);
      }
    }
#pragma unroll
    for (int ks = 0; ks < 32; ks += 16) {
      bf16x8 fa[2], fb[2];
#pragma unroll
      for (int i = 0; i < 2; i++) fa[i] = ldsfrag(&sA[(wm * 64 + i * 32 + (lane & 31)) * 40 + ks + 8 * (lane >> 5)]);
#pragma unroll
      for (int j = 0; j < 2; j++) fb[j] = ldsfrag(&sB[(wn * 64 + j * 32 + (lane & 31)) * 40 + ks + 8 * (lane >> 5)]);
#pragma unroll
      for (int i = 0; i < 2; i++)
#pragma unroll
        for (int j = 0; j < 2; j++) acc[i][j] = mfma32(fa[i], fb[j], acc[i][j]);
    }
    __syncthreads();
    cur ^= 1;
  }
#pragma unroll
  for (int i = 0; i < 2; i++)
#pragma unroll
   for (int j = 0; j < 2; j++)
#pragma unroll
    for (int r = 0; r < 16; r++)
      ep(m0 + wm * 64 + i * 32 + acc_row(r, lane), n0 + wn * 64 + j * 32 + (lane & 31), acc[i][j][r]);
}

template <class AL, class BL, class EP>
__device__ __forceinline__ void gemm_tile_big(unsigned char* sm, int m0, int n0, int K, AL al, BL bl, EP ep) {
  bf16* sA0 = (bf16*)sm;
  int tid_ = threadIdx.x; OPAQUE(tid_);
  const int tid = tid_, lane = tid & 63, w = tid >> 6, wm = w >> 1, wn = w & 1;
  f32x16 acc[4][2];
#pragma unroll
  for (int i = 0; i < 4; i++)
#pragma unroll
    for (int j = 0; j < 2; j++) acc[i][j] = zero16();
  const int lr = tid >> 2, lk = (tid & 3) * 8;
  U4 ra[4], rb[2];
#pragma unroll
  for (int i = 0; i < 4; i++) ra[i] = al(m0 + lr + 64 * i, lk);
#pragma unroll
  for (int i = 0; i < 2; i++) rb[i] = bl(n0 + lr + 64 * i, lk);
  {
    bf16* sA = sA0; bf16* sB = sA + 256 * 40;
#pragma unroll
    for (int i = 0; i < 4; i++) *(U4*)&sA[(lr + 64 * i) * 40 + lk] = ra[i];
#pragma unroll
    for (int i = 0; i < 2; i++) *(U4*)&sB[(lr + 64 * i) * 40 + lk] = rb[i];
  }
  if (32 < K) {
#pragma unroll
    for (int i = 0; i < 4; i++) ra[i] = al(m0 + lr + 64 * i, 32 + lk);
#pragma unroll
    for (int i = 0; i < 2; i++) rb[i] = bl(n0 + lr + 64 * i, 32 + lk);
  }
  __syncthreads();
  int cur = 0;
#pragma unroll 2
  for (int k0 = 0; k0 < K; k0 += 32) {
    bf16* sA = sA0 + cur * (384 * 40); bf16* sB = sA + 256 * 40;
    if (k0 + 32 < K) {
      bf16* nA = sA0 + (cur ^ 1) * (384 * 40); bf16* nB = nA + 256 * 40;
#pragma unroll
      for (int i = 0; i < 4; i++) *(U4*)&nA[(lr + 64 * i) * 40 + lk] = ra[i];
#pragma unroll
      for (int i = 0; i < 2; i++) *(U4*)&nB[(lr + 64 * i) * 40 + lk] = rb[i];
      if (k0 + 64 < K) {
#pragma unroll
        for (int i = 0; i < 4; i++) ra[i] = al(m0 + lr + 64 * i, k0 + 64 + lk);
#pragma unroll
        for (int i = 0; i < 2; i++) rb[i] = bl(n0 + lr + 64 * i, k0 + 64 + lk);
      }
    }
#pragma unroll
    for (int ks = 0; ks < 32; ks += 16) {
      bf16x8 fa[4], fb[2];
#pragma unroll
      for (int i = 0; i < 4; i++) fa[i] = ldsfrag(&sA[(wm * 128 + i * 32 + (lane & 31)) * 40 + ks + 8 * (lane >> 5)]);
#pragma unroll
      for (int j = 0; j < 2; j++) fb[j] = ldsfrag(&sB[(wn * 64 + j * 32 + (lane & 31)) * 40 + ks + 8 * (lane >> 5)]);
#pragma unroll
      for (int i = 0; i < 4; i++)
#pragma unroll
        for (int j = 0; j < 2; j++) acc[i][j] = mfma32(fa[i], fb[j], acc[i][j]);
    }
    __syncthreads();
    cur ^= 1;
  }
#pragma unroll
  for (int i = 0; i < 4; i++)
#pragma unroll
    for (int j = 0; j < 2; j++)
#pragma unroll
      for (int r = 0; r < 16; r++)
        ep(m0 + wm * 128 + i * 32 + acc_row(r, lane), n0 + wn * 64 + j * 32 + (lane & 31), acc[i][j][r]);
}

#define ITEM_LOOP(var, count, base) _Pragma("unroll 1") for (int var = (int)((blockIdx.x + gridDim.x - ((unsigned)(base) % gridDim.x)) % gridDim.x); var < (count); var += gridDim.x)
#define WS(T, off) ((T*)(P.ws + (off)))

__device__ __forceinline__ void transpose_tile(const float* src, int ld, int Ksz, int Nsz, bf16* dst, int kt, int nt, unsigned char* sm, bool perm = false) {
  float* s = (float*)sm;
  const int tid = threadIdx.x;
#pragma unroll 8
  for (int i = tid; i < 4096; i += 256) {
    int kk = i >> 6, nn = i & 63;
    int k = kt * 64 + kk, n = nt * 64 + nn;
    s[kk * 65 + nn] = (n < Nsz && k < Ksz) ? src[(size_t)k * ld + n] : 0.f;
  }
  __syncthreads();
#pragma unroll 8
  for (int i = tid; i < 4096; i += 256) {
    int nn = i >> 6, kk = i & 63;
    int ktd = perm ? (kt < 4 ? kt + 8 : (kt >= 8 && kt < 12) ? kt - 8 : kt) : kt;
    dst[(size_t)(nt * 64 + nn) * Ksz + ktd * 64 + kk] = f2bf(s[kk * 65 + nn]);
  }
  __syncthreads();
}

struct S5c { float lr, li, dt; };
__device__ __forceinline__ void s5_pow(const Params& P, int l, int d, int g, int p, float e, float& re, float& im) {
  int idx = ((l * 2 + d) * 16 + g) * 64 + p;
  float dt = __expf(P.s5_log_dt[(l * 2 + d) * 16 + g]);
  float ar = P.s5_a_re[idx] * dt * e, ai = P.s5_a_im[idx] * dt * e;
  float m = expf(ar);
  re = m * cosf(ai); im = m * sinf(ai);
}
__device__ __forceinline__ void s5_bbar_coef(const Params& P, int l, int d, int g, int p, float& re, float& im) {
  int idx = ((l * 2 + d) * 16 + g) * 64 + p;
  float lr = P.s5_a_re[idx], li = P.s5_a_im[idx];
  float br, bi; s5_pow(P, l, d, g, p, 1.f, br, bi);
  br -= 1.f;
  float den = lr * lr + li * li;
  re = (br * lr + bi * li) / den;
  im = (bi * lr - br * li) / den;
}

__device__ __forceinline__ void phase_prologue(const Params& P, unsigned char* sm) {
  const int tid = threadIdx.x;
  const int N_TIN = 2 * 16 * (NINP / 64);
  const int N_TOUT = 2 * 16 * 16;
  const int N_TL = 2 * 2 * 4;
  const int N_TA = 2 * 2 * 4;
  const int N_TG = 2 * 16;
  const int N_MOD = 2 * 48;
  const int N_S5K = 2 * 16 * 2 * 32;
  const int N_S5W1 = 2 * 16 * 32;
  const int N_S5B2 = 2 * 16 * 32;
  const int total = N_TIN + N_TOUT + N_TL + N_TA + N_TG + N_MOD + N_S5K + N_S5W1 + N_S5B2;
#pragma unroll 1
  for (int it = blockIdx.x; it < total; it += gridDim.x) {
    int i = it;
    if (i < N_TIN) {
      int l = i / (16 * (NINP / 64)), r = i % (16 * (NINP / 64));
      transpose_tile(P.w_in + (size_t)l * D * NIN, NIN, D, NIN, WS(bf16, OFF_WTIN) + (size_t)l * NINP * D, r % 16, r / 16, sm);
      continue;
    }
    i -= N_TIN;
    if (i < N_TOUT) {
      int l = i / 256, r = i % 256;
      transpose_tile(P.w_out + (size_t)l * D * D, D, D, D, WS(bf16, OFF_WTOUT) + (size_t)l * D * D, r % 16, r / 16, sm, true);
      continue;
    }
    i -= N_TOUT;
    if (i < N_TL) {
      int ld = i / 4, nt = i % 4;
      transpose_tile(P.rw_w2 + (size_t)ld * 64 * 256, 256, 64, 256, WS(bf16, OFF_W2T) + (size_t)ld * 256 * 64, 0, nt, sm);
      continue;
    }
    i -= N_TL;
    if (i < N_TA) {
      int ld = i / 4, nt = i % 4;
      transpose_tile(P.rw_a2 + (size_t)ld * 64 * 256, 256, 64, 256, WS(bf16, OFF_A2T) + (size_t)ld * 256 * 64, 0, nt, sm);
      continue;
    }
    i -= N_TA;
    if (i < N_TG) {
      int l = i / 16, r = i % 16;
      transpose_tile(P.s5_glu_w + (size_t)l * 256 * 256, 256, 256, 256, WS(bf16, OFF_GLUT) + (size_t)l * 256 * 256, r % 4, r / 4, sm);
      continue;
    }
    i -= N_TG;
    if (i < N_MOD) {
      int l = i / 48, ct = i % 48;
      float* ssil = (float*)sm;
      float* red = ssil + NMOD * 1024;
#pragma unroll 8
      for (int e = tid; e < NMOD * 1024; e += 256) {
        int r = e >> 10, k = e & 1023;
        float v = r < BATCH ? P.c[r * 1024 + k] : P.c_ctx[k];
        ssil[e] = silu_f(v);
      }
      __syncthreads();
      int kq = tid >> 6, jj = tid & 63, j = ct * 64 + jj;
      float acc[NMOD];
      for (int r = 0; r < NMOD; r++) acc[r] = 0.f;
      const float* wp = P.ada_w + (size_t)l * D * 3072 + j;
#pragma unroll 16
      for (int k = kq * 256; k < kq * 256 + 256; k++) {
        float wv = wp[(size_t)k * 3072];
#pragma unroll
        for (int r = 0; r < NMOD; r++) acc[r] += ssil[r * 1024 + k] * wv;
      }
#pragma unroll
      for (int r = 0; r < NMOD; r++) red[(kq * NMOD + r) * 64 + jj] = acc[r];
      __syncthreads();
#pragma unroll 8
      for (int e = tid; e < NMOD * 64; e += 256) {
        int r = e >> 6, j2 = e & 63;
        float s = red[(0 * NMOD + r) * 64 + j2] + red[(1 * NMOD + r) * 64 + j2] + red[(2 * NMOD + r) * 64 + j2] + red[(3 * NMOD + r) * 64 + j2];
        WS(float, OFF_MOD)[((size_t)l * NMOD + r) * 3072 + ct * 64 + j2] = s + P.ada_b[l * 3072 + ct * 64 + j2];
      }
      __syncthreads();
      continue;
    }
    i -= N_MOD;
    if (i < N_S5K) {
      int m = i & 31, d = (i >> 5) & 1, g = (i >> 6) & 15, l = i >> 10;
      float* spw = (float*)sm;
      if (tid < 64) {
        float pr, pi, cr, ci;
        s5_pow(P, l, d, g, tid, (float)m, pr, pi);
        s5_bbar_coef(P, l, d, g, tid, cr, ci);
        spw[tid * 2] = pr * cr - pi * ci; spw[tid * 2 + 1] = pr * ci + pi * cr;
      }
      __syncthreads();
      int c = tid >> 4, cp = tid & 15;
      size_t bb = ((size_t)((l * 2 + d) * 16 + g) * 64) * 16;
      size_t cb = ((size_t)((l * 2 + d) * 16 + g) * 16 + c) * 64;
      float s = 0.f;
#pragma unroll 8
      for (int p = 0; p < 64; p++) {
        float wr = spw[p * 2], wi = spw[p * 2 + 1];
        float br = P.s5_b_re[bb + p * 16 + cp], bi = P.s5_b_im[bb + p * 16 + cp];
        float zr = wr * br - wi * bi, zi = wr * bi + wi * br;
        float cr = P.s5_c_re[cb + p], ci = P.s5_c_im[cb + p];
        s += cr * zr - ci * zi;
      }
      WS(float, OFF_S5K)[((size_t)(((l * 16 + g) * 2 + d) * 32 + m)) * 256 + tid] = s;
      __syncthreads();
      continue;
    }
    i -= N_S5K;
    if (i < N_S5W1) {
      int j = i & 31, g = (i >> 5) & 15, l = i >> 9;
      int pp = tid, d = pp >> 7, ri = (pp >> 6) & 1, p = pp & 63;
      float e = d == 0 ? (float)(T5 - 1 - j) : (float)j;
      float pr, pi, cr, ci;
      s5_pow(P, l, d, g, p, e, pr, pi);
      s5_bbar_coef(P, l, d, g, p, cr, ci);
      float wr = pr * cr - pi * ci, wi = pr * ci + pi * cr;
      size_t bb = ((size_t)((l * 2 + d) * 16 + g) * 64 + p) * 16;
      bf16* dst = WS(bf16, OFF_W1T) + ((size_t)(l * 16 + g) * 256 + pp) * 512 + j * 16;
      for (int cp = 0; cp < 16; cp++) {
        float br = P.s5_b_re[bb + cp], bi = P.s5_b_im[bb + cp];
        float zr = wr * br - wi * bi, zi = wr * bi + wi * br;
        dst[cp] = f2bf(ri == 0 ? zr : zi);
      }
      if (j == 0 && ri == 0) {
        float tr, ti; s5_pow(P, l, d, g, p, (float)T5, tr, ti);
        float* lt = WS(float, OFF_S5LT) + ((size_t)((l * 16 + g) * 2 + d) * 64 + p) * 2;
        lt[0] = tr; lt[1] = ti;
      }
      continue;
    }
    i -= N_S5W1;
    {
      int t = i & 31, g = (i >> 5) & 15, l = i >> 9;
      int kk = tid, d = kk >> 7, ri = (kk >> 6) & 1, p = kk & 63;
      float e = d == 0 ? (float)(t + 1) : (float)(T5 - t);
      float pr, pi; s5_pow(P, l, d, g, p, e, pr, pi);
      for (int c = 0; c < 16; c++) {
        size_t cb = ((size_t)((l * 2 + d) * 16 + g) * 16 + c) * 64 + p;
        float cr = P.s5_c_re[cb], ci = P.s5_c_im[cb];
        float zr = cr * pr - ci * pi, zi = cr * pi + ci * pr;
        WS(bf16, OFF_BT2)[((size_t)(l * 16 + g) * 512 + t * 16 + c) * 768 + 512 + kk] = f2bf(ri == 0 ? zr : -zi);
      }
    }
  }
}

__device__ __forceinline__ void s5_toeplitz_items(const Params& P, int item) {
  int t = item & 31, g = (item >> 5) & 15, l = item >> 9;
  const float* K = WS(float, OFF_S5K) + (size_t)((l * 16 + g) * 2) * 32 * 256;
  bf16* dst = WS(bf16, OFF_BT2) + ((size_t)(l * 16 + g) * 512 + t * 16) * 768;
#pragma unroll 8
  for (int e = threadIdx.x; e < 16 * 512; e += 256) {
    int c = e >> 9, k = e & 511, j = k >> 4, cp = k & 15;
    float v;
    if (j < t) v = K[((0 * 32) + (t - j)) * 256 + c * 16 + cp];
    else if (j > t) v = K[((1 * 32) + (j - t)) * 256 + c * 16 + cp];
    else v = K[(0 * 32) * 256 + c * 16 + cp] + K[(1 * 32) * 256 + c * 16 + cp];
    dst[(size_t)c * 768 + k] = f2bf(v);
  }
}

__device__ __forceinline__ void phase_normmod(const Params& P, int l) {
  const int lane = threadIdx.x & 63, w = threadIdx.x >> 6;
  const int nrow_items = ROWS / 4;
  const int n_toe = (l == 0) ? 2 * 16 * 32 : 0;
#pragma unroll 1
  for (int it = blockIdx.x; it < nrow_items + n_toe; it += gridDim.x) {
    if (it >= nrow_items) { s5_toeplitz_items(P, it - nrow_items); continue; }
    int m = it * 4 + w;
    RowInfo ri = row_info(m);
    const float* src;
    if (ri.isctx) src = (l == 0 ? P.ctx : WS(float, OFF_HC)) + (size_t)m * D;
    else src = (l == 0 ? P.x : P.out) + (size_t)(m - ROWS_C) * D;
    const float* mod = WS(float, OFF_MOD) + ((size_t)l * NMOD + (ri.isctx ? BATCH : ri.b)) * 3072;
    F4 v[4]; float ss = 0.f;
    for (int q = 0; q < 4; q++) {
      v[q] = *(const F4*)(src + q * 256 + lane * 4);
      for (int e = 0; e < 4; e++) ss += v[q].a[e] * v[q].a[e];
    }
    ss = sum64(ss);
    float rstd = rsqrtf(ss * (1.f / 1024.f) + 1e-6f);
    bf16* dst = WS(bf16, OFF_R) + (size_t)m * D;
    for (int q = 0; q < 4; q++) {
      int c0 = q * 256 + lane * 4;
      float o[4];
      for (int e = 0; e < 4; e++) {
        int c = c0 + e;
        o[e] = v[q].a[e] * rstd * P.norm_pre[l * D + c] * (1.f + mod[1024 + c]) + mod[c];
      }
      U2 pk; pk.a[0] = pack2(o[0], o[1]); pk.a[1] = pack2(o[2], o[3]);
      *(U2*)(dst + c0) = pk;
    }
  }
}

__device__ __forceinline__ void phase_inproj(const Params& P, int l, unsigned char* sm) {
  const bf16* A = WS(bf16, OFF_R);
  const bf16* Bt = WS(bf16, OFF_WTIN) + (size_t)l * NINP * D;
  bf16* C = WS(bf16, OFF_PROJ);
  const int NT = NINP / 128, MT = ROWS / 256;
  const int total = MT * NT, per = total / 8;
  const int nfull = (total / (int)gridDim.x) * (int)gridDim.x;
#pragma unroll 1
  for (int it0 = blockIdx.x; it0 < nfull; it0 += gridDim.x) {
    int it = total % 8 == 0 ? (it0 & 7) * per + (it0 >> 3) : it0;
    int mt = it / NT, nt = it % NT;
    gemm_tile_big(sm, mt * 256, nt * 128, D,
      [&](int m, int k) { return *(const U4*)(A + (size_t)m * D + k); },
      [&](int n, int k) { return *(const U4*)(Bt + (size_t)n * D + k); },
      [&](int m, int n, float v) { if (n < NIN) C[(size_t)m * NIN + n] = f2bf(v); });
  }
#pragma unroll 1
  for (int q = blockIdx.x; q < 2 * (total - nfull); q += gridDim.x) {
    int it0 = nfull + (q >> 1), half = q & 1;
    int it = total % 8 == 0 ? (it0 & 7) * per + (it0 >> 3) : it0;
    int mt = it / NT, nt = it % NT;
    gemm_tile(sm, mt * 256 + half * 128, nt * 128, D,
      [&](int m, int k) { return *(const U4*)(A + (size_t)m * D + k); },
      [&](int n, int k) { return *(const U4*)(Bt + (size_t)n * D + k); },
      [&](int m, int n, float v) { if (n < NIN) C[(size_t)m * NIN + n] = f2bf(v); });
  }
}

__device__ __forceinline__ void rw_lerp4(const Params& P, int l, int m, int ms, int col, float* o) {
  const bf16* pr = WS(bf16, OFF_PROJ);
  U2 z = *(const U2*)(pr + (size_t)m * NIN + col);
  U2 zs; zs.a[0] = zs.a[1] = 0;
  if (ms >= 0) zs = *(const U2*)(pr + (size_t)ms * NIN + col);
  const float* mu = P.rw_mu + l * 1024 + col;
#pragma unroll
  for (int e = 0; e < 2; e++) {
    float a0 = lo2f(z.a[e]), a1 = hi2f(z.a[e]), s0 = lo2f(zs.a[e]), s1 = hi2f(zs.a[e]);
    o[2 * e] = a0 + mu[2 * e] * (s0 - a0);
    o[2 * e + 1] = a1 + mu[2 * e + 1] * (s1 - a1);
  }
}
__device__ __forceinline__ void phase_rwprep(const Params& P, int l, unsigned char* sm) {
  const int lane = threadIdx.x & 63, w = threadIdx.x >> 6;
  const int MT = ROWS / 128;
  const int n_gemm = MT * 2 * 4;
  const int n_rows = ROWS / 4;
  bf16* XA = WS(bf16, OFF_XA);
#pragma unroll 1
  for (int it = blockIdx.x; it < n_gemm + n_rows; it += gridDim.x) {
    if (it < n_gemm) {
      int kind = it & 3, nt = (it >> 2) & 1, mt = it >> 3;
      int isA = kind >> 1, d = kind & 1;
      const bf16* Bt = (isA ? WS(bf16, OFF_A2T) : WS(bf16, OFF_W2T)) + (size_t)(l * 2 + d) * 256 * 64;
      const float* bias = (isA ? P.rw_a0 : P.rw_w0) + (l * 2 + d) * 256;
      gemm_tile(sm, mt * 128, nt * 128, 64,
        [&](int m, int k) {
          RowInfo ri = row_info(m);
          int ms;
          if (ri.isctx) ms = ri.t < CTX - 1 ? m + 1 : -1; else ms = ri.t < SEQ - 64 ? m + 64 : -1;
          int col = 768 + isA * 128 + d * 64 + k;
          const bf16* prj = WS(bf16, OFF_PROJ);
          U4 z = *(const U4*)(prj + (size_t)m * NIN + col);
          U4 zs = ms >= 0 ? *(const U4*)(prj + (size_t)ms * NIN + col) : zero4();
          const float* mu = P.rw_mu + l * 1024 + col;
          U4 r;
#pragma unroll
          for (int e = 0; e < 4; e++) {
            float a0 = lo2f(z.a[e]), a1 = hi2f(z.a[e]), s0 = lo2f(zs.a[e]), s1 = hi2f(zs.a[e]);
            float o0 = a0 + mu[2 * e] * (s0 - a0), o1 = a1 + mu[2 * e + 1] * (s1 - a1);
            if (!isA) { o0 = tanh_f(o0); o1 = tanh_f(o1); }
            r.a[e] = pack2(o0, o1);
          }
          return r;
        },
        [&](int n, int k) { return *(const U4*)(Bt + (size_t)n * 64 + k); },
        [&](int m, int n, float v) {
          v += bias[n];
          float o;
          if (!isA) { o = -__expf(-softplus_f(-v) - 0.5f); }
          else o = sigmoid_f(v);
          XA[(size_t)m * 1024 + isA * 512 + d * 256 + n] = f2bf(o);
        });
      continue;
    }
    int m = (it - n_gemm) * 4 + w;
    RowInfo ri = row_info(m);
    int ms_r, ms_k, ms_v;
    if (ri.isctx) { ms_r = ms_k = ri.t > 0 ? m - 1 : -1; ms_v = ri.t < CTX - 1 ? m + 1 : -1; }
    else {
      int gx = ri.t & 63;
      ms_r = gx > 0 ? m - 1 : -1; ms_k = gx < 63 ? m + 1 : -1; ms_v = ri.t >= 64 ? m - 64 : -1;
    }
    bf16* R = WS(bf16, OFF_R) + (size_t)m * 1024;
    float rr[4], kk[4], vv[4], kap[4];
    rw_lerp4(P, l, m, ms_r, lane * 4, rr);
    rw_lerp4(P, l, m, ms_k, 256 + lane * 4, kk);
    rw_lerp4(P, l, m, ms_v, 512 + lane * 4, vv);
    float ss = 0.f;
    for (int e = 0; e < 4; e++) { kap[e] = kk[e] * P.rw_kk[l * 256 + lane * 4 + e]; ss += kap[e] * kap[e]; }
    ss = sum16(ss);
    float rs = rsqrtf(ss + 1e-6f);
    U2 o;
    o.a[0] = pack2(rr[0], rr[1]); o.a[1] = pack2(rr[2], rr[3]); *(U2*)(R + lane * 4) = o;
    o.a[0] = pack2(kk[0], kk[1]); o.a[1] = pack2(kk[2], kk[3]); *(U2*)(R + 256 + lane * 4) = o;
    o.a[0] = pack2(vv[0], vv[1]); o.a[1] = pack2(vv[2], vv[3]); *(U2*)(R + 512 + lane * 4) = o;
    o.a[0] = pack2(kap[0] * rs, kap[1] * rs); o.a[1] = pack2(kap[2] * rs, kap[3] * rs); *(U2*)(R + 768 + lane * 4) = o;
  }
  {
    const int n_ssd = BATCH * NCH * 8, n_gla = BATCH * NCH * 8, n_s5 = 16 * ((M5 + 127) / 128) * 2, base0 = n_gemm + n_rows;
    ITEM_LOOP(i, n_ssd, base0) ssd_state_item(P, l, i, sm);
    ITEM_LOOP(i, n_gla, base0 + n_ssd) gla_state_item(P, l, i, sm);
    ITEM_LOOP(i, n_s5, base0 + n_ssd + n_gla) s5_state_tile(P, l, i, sm);
  }
}

__device__ __forceinline__ bf16x8 gfrag(const bf16* base, int ld, int row, int k) {
  return *(const bf16x8*)(base + (size_t)row * ld + k);
}
__device__ __forceinline__ void wave_sync() {
#ifdef CPU_EMU
  pthread_barrier_wait(&g_wavebar[threadIdx.x >> 6]);
#else
  __builtin_amdgcn_wave_barrier();
#endif
}
__device__ __forceinline__ void store_acc_T(bf16* dst, int ld, int row_base, int col, const f32x16& acc, int lane) {
#pragma unroll
  for (int g = 0; g < 4; g++) {
    U2 o; o.a[0] = pack2(acc[4 * g], acc[4 * g + 1]); o.a[1] = pack2(acc[4 * g + 2], acc[4 * g + 3]);
    *(U2*)&dst[col * ld + row_base + 8 * g + 4 * (lane >> 5)] = o;
  }
}
__device__ __forceinline__ void rwkv_chunk_item(const Params& P, int l, int item, unsigned char* sm, long long& pacc) {
  long long tp0_ = 0; if (PROBE_PHASE >= 33 && PROBE_PHASE <= 36) tp0_ = wall_clock64();
  int tid_ = threadIdx.x; OPAQUE(tid_);
  const int tid = tid_, lane = tid & 63, w = tid >> 6, ti = w >> 1, tj = w & 1;
  const int lr = lane & 31, lh = lane >> 5;
  const int d = item & 1, h = (item >> 1) & 3, rest = item >> 3;
  const int pc = rest % NCH, b = rest / NCH;
  const int row0 = chunk_row0(b, pc, TC, NCH_C);
  float* sL = (float*)sm;
  bf16* sG1t = (bf16*)sm;
  bf16* sKT = (bf16*)(sm + 16640);
  bf16* sBT = sKT + 64 * 72;
  bf16* sKD = sBT + 64 * 72;
  bf16* sRT = sKD + 64 * 72;
  bf16* sVt = sRT + 64 * 72;
  float* sGT = (float*)(sVt + 64 * 72);
  bf16* X0 = WS(bf16, OFF_XA) + (size_t)row0 * 1024 + d * 256 + h * 64;
  bf16* X1 = X0 + 512;
  bf16* P0 = WS(bf16, OFF_PROJ) + (size_t)row0 * NIN + (h * 2 + d) * 128;
  bf16* P1 = P0 + 64;
  const bf16* Rb = WS(bf16, OFF_R) + (size_t)row0 * 1024 + h * 64;
  float rq[16], kq[16], pq[16], vq[16];
#pragma unroll
  for (int i = 0; i < 16; i++) {
    const bf16* rp = Rb + (size_t)(w + 4 * i) * 1024 + lane;
    rq[i] = bf2f(rp[0]); kq[i] = bf2f(rp[256]); vq[i] = bf2f(rp[512]); pq[i] = bf2f(rp[768]);
  }
#pragma unroll 8
  for (int idx = tid; idx < 4096; idx += 256) {
    int p = idx >> 6, k = idx & 63;
    sL[p * 65 + k] = bf2f(X0[(size_t)p * 1024 + k]);
    sVt[idx] = X1[(size_t)p * 1024 + k];
  }
  __syncthreads();
  {
    const int k = tid & 63, qq = tid >> 6;
    float* qt = sGT + 64 + 128;
    float run = 0.f;
    if (d == 0) { for (int p = qq * 16; p < qq * 16 + 16; p++) { run += sL[p * 65 + k]; sL[p * 65 + k] = run; } }
    else { for (int p = qq * 16 + 15; p >= qq * 16; p--) { run += sL[p * 65 + k]; sL[p * 65 + k] = run; } }
    qt[qq * 64 + k] = run;
    __syncthreads();
    float off = 0.f;
    if (d == 0) { for (int j = 0; j < qq; j++) off += qt[j * 64 + k]; }
    else { for (int j = 3; j > qq; j--) off += qt[j * 64 + k]; }
    for (int p = qq * 16; p < qq * 16 + 16; p++) sL[p * 65 + k] += off;
    if (qq == 0) sGT[k] = qt[k] + qt[64 + k] + qt[128 + k] + qt[192 + k];
  }
  __syncthreads();
  if (PROBE_PHASE == 35) pacc += wall_clock64() - tp0_;
  {
    const int k = lane;
    const float ka = P.rw_ka[l * 256 + h * 64 + k], rk = P.rw_rk[l * 256 + h * 64 + k];
#pragma unroll
    for (int i = 0; i < 16; i++) {
      const int p = w + 4 * i;
      float incl = sL[p * 65 + k];
      int pp = d == 0 ? p - 1 : p + 1;
      float excl = (pp < 0 || pp > 63) ? 0.f : sL[pp * 65 + k];
      float rr = rq[i], kk = kq[i], kap = pq[i];
      float a = bf2f(sVt[p * 64 + k]);
      float kd = kk * (1.f + (a - 1.f) * ka), beta = kap * a;
      float ei = __expf(incl), eni = __expf(-incl), ee = __expf(excl);
      sKT[p * 72 + k] = f2bf(kap * ee);
      sBT[p * 72 + k] = f2bf(beta * eni);
      sKD[p * 72 + k] = f2bf(kd * eni);
      sRT[p * 72 + k] = f2bf(rr * ei);
      float bs = sum64(rr * kd * rk);
      if (lane == 0) WS(float, OFF_BON)[(size_t)(row0 + p) * 8 + h * 2 + d] = bs;
    }
  }
  __syncthreads();
#pragma unroll 8
  for (int idx = tid; idx < 4096; idx += 256) {
    int kk = idx >> 6, p = idx & 63;
    P0[(size_t)kk * NIN + p] = sKT[p * 72 + kk];
    P1[(size_t)kk * NIN + p] = sBT[p * 72 + kk];
    X1[(size_t)kk * 1024 + p] = sKD[p * 72 + kk];
    X0[(size_t)kk * 1024 + p] = sRT[kk * 72 + p];
  }
  if (PROBE_PHASE == 36) pacc += wall_clock64() - tp0_;
  f32x16 aA = zero16(), aB = zero16(), aC = zero16(), aD = zero16();
#pragma unroll
  for (int ks = 0; ks < 64; ks += 16) {
    bf16x8 fK = ldsfrag(&sKT[(ti * 32 + lr) * 72 + ks + 8 * lh]);
    bf16x8 fR = ldsfrag(&sRT[(ti * 32 + lr) * 72 + ks + 8 * lh]);
    bf16x8 fB = ldsfrag(&sBT[(tj * 32 + lr) * 72 + ks + 8 * lh]);
    bf16x8 fD = ldsfrag(&sKD[(tj * 32 + lr) * 72 + ks + 8 * lh]);
    aA = mfma32(fK, fB, aA); aB = mfma32(fK, fD, aB); aC = mfma32(fR, fB, aC); aD = mfma32(fR, fD, aD);
  }
  __syncthreads();
  {
    int s_ = tj * 32 + lr;
#pragma unroll
    for (int r = 0; r < 16; r++) {
      int p = ti * 32 + acc_row(r, lane);
      bool earlier = d == 0 ? s_ < p : s_ > p;
      bool eq = s_ == p;
      sL[p * 65 + s_] = earlier ? aA[r] : 0.f;
      sKT[p * 72 + s_] = f2bf(earlier ? aB[r] : 0.f);
      sBT[p * 72 + s_] = f2bf((earlier || eq) ? aC[r] : 0.f);
      sKD[p * 72 + s_] = f2bf((earlier || eq) ? aD[r] : 0.f);
    }
  }
#pragma unroll
  for (int i = 0; i < 16; i++) sVt[lane * 72 + w + 4 * i] = f2bf(vq[i]);
  __syncthreads();
  if (PROBE_PHASE == 33) pacc += wall_clock64() - tp0_;
  bf16x8 fKt[4];
#pragma unroll
  for (int q4 = 0; q4 < 4; q4++) fKt[q4] = gfrag(P0, NIN, tj * 32 + lr, q4 * 16 + 8 * lh);
  bf16* sTinv = sRT;
  {
    const int q = tid >> 2, seg = tid & 3;
    float x[16];
#pragma unroll
    for (int i = 0; i < 16; i++) x[i] = (q == seg * 16 + i) ? 1.f : 0.f;
    float* rowbuf = (float*)sRT;
#pragma unroll 1
    for (int Bi = 0; Bi < 4; Bi++) {
      const int B = d == 0 ? Bi : 3 - Bi;
      float* rb = rowbuf + (Bi & 1) * 1024;
      if (w == B) {
#pragma unroll 1
        for (int s_ = 0; s_ < 16; s_++) {
          const int pl = d == 0 ? s_ : 15 - s_, p = B * 16 + pl;
          if (q == p) {
#pragma unroll
            for (int i = 0; i < 4; i++) { F4 o; o.a[0] = x[4 * i]; o.a[1] = x[4 * i + 1]; o.a[2] = x[4 * i + 2]; o.a[3] = x[4 * i + 3]; *(F4*)&rb[pl * 64 + seg * 16 + 4 * i] = o; }
          }
          wave_sync();
          const bool later = d == 0 ? q > p : q < p;
          if (later) {
            const float m = sL[q * 65 + p];
#pragma unroll
            for (int i = 0; i < 4; i++) {
              F4 o = *(const F4*)&rb[pl * 64 + seg * 16 + 4 * i];
              x[4 * i] -= m * o.a[0]; x[4 * i + 1] -= m * o.a[1]; x[4 * i + 2] -= m * o.a[2]; x[4 * i + 3] -= m * o.a[3];
            }
          }
        }
      }
      __syncthreads();
      const bool laterblock = d == 0 ? w > B : w < B;
      if (laterblock) {
#pragma unroll 4
        for (int pl = 0; pl < 16; pl++) {
          const float m = sL[q * 65 + B * 16 + pl];
#pragma unroll
          for (int i = 0; i < 4; i++) {
            F4 o = *(const F4*)&rb[pl * 64 + seg * 16 + 4 * i];
            x[4 * i] -= m * o.a[0]; x[4 * i + 1] -= m * o.a[1]; x[4 * i + 2] -= m * o.a[2]; x[4 * i + 3] -= m * o.a[3];
          }
        }
      }
    }
    __syncthreads();
#pragma unroll
    for (int i = 0; i < 8; i++) *(uint32_t*)&sTinv[q * 72 + seg * 16 + 2 * i] = pack2(x[2 * i], x[2 * i + 1]);
  }
  __syncthreads();
  if (PROBE_PHASE == 34) pacc += wall_clock64() - tp0_;
  {
    f32x16 aBV = zero16(), aG1 = zero16();
#pragma unroll
    for (int ks = 0; ks < 64; ks += 16) {
      aBV = mfma32(ldsfrag(&sKT[(ti * 32 + lr) * 72 + ks + 8 * lh]), ldsfrag(&sVt[(tj * 32 + lr) * 72 + ks + 8 * lh]), aBV);
      aG1 = mfma32(ldsfrag(&sTinv[(ti * 32 + lr) * 72 + ks + 8 * lh]), fKt[ks >> 4], aG1);
    }
    __syncthreads();
    store_acc_T(sKT, 72, ti * 32, tj * 32 + lr, aBV, lane);
    store_acc_T(sG1t, 72, ti * 32, tj * 32 + lr, aG1, lane);
  }
  __syncthreads();
  bf16x8 fKd4[4], fBt4[4]; float rtc[16];
#pragma unroll
  for (int q4 = 0; q4 < 4; q4++) { fKd4[q4] = gfrag(X1, 1024, ti * 32 + lr, q4 * 16 + 8 * lh); fBt4[q4] = gfrag(P1, NIN, ti * 32 + lr, q4 * 16 + 8 * lh); }
#pragma unroll
  for (int r = 0; r < 16; r++) rtc[r] = bf2f(X0[(size_t)(ti * 32 + acc_row(r, lane)) * 1024 + tj * 32 + lr]);
  {
    f32x16 aG2 = zero16();
#pragma unroll
    for (int ks = 0; ks < 64; ks += 16)
      aG2 = mfma32(ldsfrag(&sTinv[(ti * 32 + lr) * 72 + ks + 8 * lh]), ldsfrag(&sKT[(tj * 32 + lr) * 72 + ks + 8 * lh]), aG2);
    __syncthreads();
    store_acc_T(sRT, 72, ti * 32, tj * 32 + lr, aG2, lane);
  }
  __syncthreads();
  bf16* sG2t = sRT;
  {
    f32x16 a1 = zero16(), a2 = zero16(), a3 = zero16();
#pragma unroll
    for (int ks = 0; ks < 64; ks += 16) {
      bf16x8 fC = ldsfrag(&sBT[(ti * 32 + lr) * 72 + ks + 8 * lh]);
      bf16x8 fDy = ldsfrag(&sKD[(ti * 32 + lr) * 72 + ks + 8 * lh]);
      a1 = mfma32(fC, ldsfrag(&sG1t[(tj * 32 + lr) * 72 + ks + 8 * lh]), a1);
      a2 = mfma32(fDy, ldsfrag(&sVt[(tj * 32 + lr) * 72 + ks + 8 * lh]), a2);
      a3 = mfma32(fC, ldsfrag(&sG2t[(tj * 32 + lr) * 72 + ks + 8 * lh]), a3);
    }
    int c = tj * 32 + lr;
#pragma unroll
    for (int r = 0; r < 16; r++) {
      int p = ti * 32 + acc_row(r, lane);
      X0[(size_t)p * 1024 + c] = f2bf(rtc[r] - a1[r]);
      P0[(size_t)p * NIN + c] = f2bf(a2[r] - a3[r]);
    }
  }
  {
    f32x16 a1 = zero16(), a2 = zero16(), a3 = zero16();
#pragma unroll
    for (int ks = 0; ks < 64; ks += 16) {
      bf16x8 fKd = fKd4[ks >> 4];
      bf16x8 fBt = fBt4[ks >> 4];
      a1 = mfma32(fKd, ldsfrag(&sVt[(tj * 32 + lr) * 72 + ks + 8 * lh]), a1);
      a2 = mfma32(fBt, ldsfrag(&sG2t[(tj * 32 + lr) * 72 + ks + 8 * lh]), a2);
      a3 = mfma32(fBt, ldsfrag(&sG1t[(tj * 32 + lr) * 72 + ks + 8 * lh]), a3);
    }
    __syncthreads();
    int c = tj * 32 + lr;
#pragma unroll
    for (int r = 0; r < 16; r++) {
      int kp = ti * 32 + acc_row(r, lane);
      float gt = __expf(sGT[kp]);
      a1[r] = gt * (a1[r] - a2[r]);
      X1[(size_t)kp * 1024 + c] = f2bf(gt * ((kp == c ? 1.f : 0.f) - a3[r]));
    }
    U4 o0, o1;
#pragma unroll
    for (int e = 0; e < 4; e++) { o0.a[e] = pack2(a1[2 * e], a1[2 * e + 1]); o1.a[e] = pack2(a1[8 + 2 * e], a1[8 + 2 * e + 1]); }
    bf16* lp = P1 + (size_t)(tid >> 2) * NIN + (tid & 3) * 16;
    *(U4*)lp = o0; *(U4*)(lp + 8) = o1;
  }
  __syncthreads();
}

struct RwStage { bf16x8 pm[4]; U4 l0, l1; };
__device__ __forceinline__ void rwkv_scan2_item(const Params& P, int l, int item, unsigned char* sm) {
  int tid_ = threadIdx.x; OPAQUE(tid_);
  const int tid = tid_, lane = tid & 63, w = tid >> 6, ti = w >> 1, tj = w & 1;
  const int lr = lane & 31, lh = lane >> 5;
  const int d = item & 1, h = (item >> 1) & 3, b = item >> 3;
  bf16* sS = (bf16*)sm;
  f32x16 acc = zero16();
  RwStage st[4];
  auto load = [&](RwStage& s_, int vc) {
    int pc = ord_chunk(d, vc < NCH ? vc : NCH - 1, NCH_C, NCH);
    int row0 = chunk_row0(b, pc, TC, NCH_C);
    const bf16* X1 = WS(bf16, OFF_XA) + (size_t)row0 * 1024 + 512 + d * 256 + h * 64;
    const bf16* P1 = WS(bf16, OFF_PROJ) + (size_t)row0 * NIN + (h * 2 + d) * 128 + 64;
#pragma unroll
    for (int q = 0; q < 4; q++) s_.pm[q] = gfrag(X1, 1024, ti * 32 + lr, q * 16 + 8 * lh);
    const bf16* lp = P1 + (size_t)(tid >> 2) * NIN + (tid & 3) * 16;
    s_.l0 = *(const U4*)lp; s_.l1 = *(const U4*)(lp + 8);
  };
#pragma unroll
  for (int j = 0; j < 4; j++) load(st[j], j);
#pragma unroll 1
  for (int v0 = 0; v0 < NCH; v0 += 4) {
#pragma unroll
    for (int j = 0; j < 4; j++) {
      const int vc = v0 + j;
      if (vc < NCH) {
        int pc = ord_chunk(d, vc, NCH_C, NCH);
        int row0 = chunk_row0(b, pc, TC, NCH_C);
        bf16* X1 = WS(bf16, OFF_XA) + (size_t)row0 * 1024 + 512 + d * 256 + h * 64;
        store_acc_T(sS, 72, ti * 32, tj * 32 + lr, acc, lane);
        RwStage cur = st[j];
        __syncthreads();
        load(st[j], vc + 4);
        for (int idx = tid; idx < 512; idx += 256) {
          int v = idx >> 3, c8 = idx & 7;
          *(U4*)(X1 + (size_t)v * 1024 + c8 * 8) = *(const U4*)(sS + v * 72 + c8 * 8);
        }
        f32x16 nw;
#pragma unroll
        for (int e = 0; e < 4; e++) {
          nw[2 * e] = lo2f(cur.l0.a[e]); nw[2 * e + 1] = hi2f(cur.l0.a[e]);
          nw[8 + 2 * e] = lo2f(cur.l1.a[e]); nw[8 + 2 * e + 1] = hi2f(cur.l1.a[e]);
        }
#pragma unroll
        for (int q = 0; q < 4; q++) nw = mfma32(cur.pm[q], ldsfrag(&sS[(tj * 32 + lr) * 72 + q * 16 + 8 * lh]), nw);
        acc = nw;
        __syncthreads();
      }
    }
  }
}

__device__ __forceinline__ void rwkv_out_item(const Params& P, int l, int item, unsigned char* sm) {
  int tid_ = threadIdx.x; OPAQUE(tid_);
  const int tid = tid_, lane = tid & 63, w = tid >> 6, ti = w >> 1, tj = w & 1;
  const int lr = lane & 31, lh = lane >> 5;
  const int h = item & 3, rest = item >> 2, pc = rest % NCH, b = rest / NCH;
  if (l == 1 && pc < NCH_C) return;
  const int row0 = chunk_row0(b, pc, TC, NCH_C);
  float* spart = (float*)sm;
  float vvh[16], ggh[16], bnh[16];
#pragma unroll
  for (int r = 0; r < 16; r++) {
    const int row = row0 + ti * 32 + acc_row(r, lane), c = h * 64 + tj * 32 + lr;
    vvh[r] = bf2f(WS(bf16, OFF_R)[(size_t)row * 1024 + 512 + c]);
    ggh[r] = bf2f(WS(bf16, OFF_PROJ)[(size_t)row * NIN + C_RWG + c]);
    const float* bon = WS(float, OFF_BON) + (size_t)row * 8 + h * 2;
    bnh[r] = bon[0] + bon[1];
  }
  f32x16 acc = zero16();
#pragma unroll
  for (int d = 0; d < 2; d++) {
    const bf16* X0 = WS(bf16, OFF_XA) + (size_t)row0 * 1024 + d * 256 + h * 64;
    const bf16* X1 = X0 + 512;
    const bf16* P0 = WS(bf16, OFF_PROJ) + (size_t)row0 * NIN + (h * 2 + d) * 128;
#pragma unroll
    for (int ks = 0; ks < 64; ks += 16)
      acc = mfma32(gfrag(X0, 1024, ti * 32 + lr, ks + 8 * lh), gfrag(X1, 1024, tj * 32 + lr, ks + 8 * lh), acc);
#pragma unroll
    for (int r = 0; r < 16; r++) acc[r] += bf2f(P0[(size_t)(ti * 32 + acc_row(r, lane)) * NIN + tj * 32 + lr]);
  }
#pragma unroll
  for (int r = 0; r < 16; r++) {
    int p = ti * 32 + acc_row(r, lane);
    float s1 = sum32(acc[r]), s2 = sum32(acc[r] * acc[r]);
    if (lr == 31) { spart[(p * 2 + tj) * 2] = s1; spart[(p * 2 + tj) * 2 + 1] = s2; }
  }
  __syncthreads();
  {
    int c = h * 64 + tj * 32 + lr;
    float lw_ = P.rw_ln_w[l * 256 + c], lb_ = P.rw_ln_b[l * 256 + c];
    bf16* yc = WS(bf16, OFF_R);
    const bf16* pr = WS(bf16, OFF_PROJ);
#pragma unroll
    for (int r = 0; r < 16; r++) {
      int p = ti * 32 + acc_row(r, lane);
      int row = row0 + p;
      float mu = (spart[(p * 2) * 2] + spart[(p * 2 + 1) * 2]) * (1.f / 64.f);
      float ex2 = (spart[(p * 2) * 2 + 1] + spart[(p * 2 + 1) * 2 + 1]) * (1.f / 64.f);
      float var = fmaxf(ex2 - mu * mu, 0.f);
      float yn = (acc[r] - mu) * rsqrtf(var + 64e-5f) * lw_ + lb_;
      yc[(size_t)row * 1024 + 512 + c] = f2bf((yn + bnh[r] * vvh[r]) * silu_f(ggh[r]));
    }
  }
  __syncthreads();
}

__device__ __forceinline__ float wave_scan64(float v, float* tmp, int lane, bool reverse) {
  const int idx = reverse ? 63 - lane : lane;
#pragma unroll
  for (int off = 1; off < 64; off <<= 1) {
    tmp[idx] = v; wave_sync();
    float o = idx >= off ? tmp[idx - off] : 0.f; wave_sync();
    v += o;
  }
  return v;
}
__device__ __forceinline__ float ssd_aneg(const Params& P, int l, int d, int h) { return -__expf(P.ssd_a_log[(l * 2 + d) * 4 + h]); }
__device__ __forceinline__ void ssd_state_item(const Params& P, int l, int item, unsigned char* sm) {
  int tid_ = threadIdx.x; OPAQUE(tid_);
  const int tid = tid_, lane = tid & 63, w = tid >> 6;
  const int d = item & 1, h = (item >> 1) & 3, rest = item >> 3;
  const int pc = rest % NCH, b = rest / NCH;
  const int isctx = pc < NCH_C, len = isctx ? CTX : SEQ, t0 = (isctx ? pc : pc - NCH_C) * TC;
  const int seq0 = isctx ? b * CTX : ROWS_C + b * SEQ;
  bf16* sRaw = (bf16*)sm;
  bf16* sVt = sRaw + 2 * 68 * 64;
  bf16* sBt = sVt + 64 * 72;
  float* sdt = (float*)(sBt + 64 * 72);
  float* sdw = sdt + 64;
  const bf16* pr = WS(bf16, OFF_PROJ);
#pragma unroll 8
  for (int idx = tid; idx < 2 * 68 * 8; idx += 256) {
    int which = idx / (68 * 8), rem = idx % (68 * 8), tr = rem >> 3, c8 = rem & 7;
    int t = t0 - 2 + tr;
    int col = C_SSD + (which == 0 ? h * 64 : 256 + (h >> 1) * 64) + c8 * 8;
    U4 v = (t >= 0 && t < len) ? *(const U4*)(pr + (size_t)(seq0 + t) * NIN + col) : zero4();
    *(U4*)&sRaw[(which * 68 + tr) * 64 + c8 * 8] = v;
  }
  if (tid < 64) {
    float raw = bf2f(pr[(size_t)(seq0 + t0 + tid) * NIN + C_SSDDT + d * 4 + h]);
    sdt[tid] = softplus_f(raw + P.ssd_dt_bias[(l * 2 + d) * 4 + h]);
  }
  __syncthreads();
  if (w == 0) {
    float la = sdt[lane] * ssd_aneg(P, l, d, h);
    float incl = wave_scan64(la, sdw, lane, d == 0);
    wave_sync();
    sdw[lane] = __expf(incl - la);
    if (lane == (d == 0 ? 0 : 63)) WS(float, OFF_SSDDEC)[((size_t)(d * BATCH + b) * NCH + pc) * 4 + h] = __expf(incl);
  }
  __syncthreads();
#pragma unroll
  for (int which = 0; which < 2; which++) {
    const int c = tid & 63;
    const int ch = which == 0 ? h * 64 + c : 256 + (h >> 1) * 64 + c;
    float cw[5], cb = P.ssd_conv_b[l * 512 + ch];
#pragma unroll
    for (int i = 0; i < 5; i++) cw[i] = P.ssd_conv_w[(l * 5 + i) * 512 + ch];
    const int tb = (tid >> 6) * 16;
    float w0 = bf2f(sRaw[(which * 68 + tb) * 64 + c]), w1 = bf2f(sRaw[(which * 68 + tb + 1) * 64 + c]);
    float w2 = bf2f(sRaw[(which * 68 + tb + 2) * 64 + c]), w3 = bf2f(sRaw[(which * 68 + tb + 3) * 64 + c]);
#pragma unroll 4
    for (int t = tb; t < tb + 16; t++) {
      float w4 = bf2f(sRaw[(which * 68 + t + 4) * 64 + c]);
      float acc = cb + w0 * cw[0] + w1 * cw[1] + w2 * cw[2] + w3 * cw[3] + w4 * cw[4];
      w0 = w1; w1 = w2; w2 = w3; w3 = w4;
      float v = silu_f(acc);
      if (which == 0) sVt[c * 72 + t] = f2bf(v * sdt[t] * sdw[t]);
      else sBt[c * 72 + t] = f2bf(v);
    }
  }
  __syncthreads();
  {
    int ti = w >> 1, tj = w & 1;
    f32x16 acc = zero16();
    for (int ks = 0; ks < 64; ks += 16)
      acc = mfma32(ldsfrag(&sVt[(ti * 32 + (lane & 31)) * 72 + ks + 8 * (lane >> 5)]),
                   ldsfrag(&sBt[(tj * 32 + (lane & 31)) * 72 + ks + 8 * (lane >> 5)]), acc);
    bf16* st = WS(bf16, OFF_SSDST) + ((size_t)((d * BATCH + b) * NCH + pc) * 4 + h) * 4096;
    for (int r = 0; r < 16; r++) st[(ti * 32 + acc_row(r, lane)) * 64 + tj * 32 + (lane & 31)] = f2bf(acc[r]);
  }
  __syncthreads();
}

__device__ __forceinline__ void gla_la(const Params& P, int l, int d, int h, const float* sGl, float* dst) {
  const int k = threadIdx.x & 31;
  float gw[16], gb = P.gla_gb[(l * 2 + d) * 128 + h * 32 + k];
  const float* g2 = P.gla_g2 + (size_t)(l * 2 + d) * 16 * 128 + h * 32 + k;
#pragma unroll
  for (int r = 0; r < 16; r++) gw[r] = g2[r * 128];
#pragma unroll 2
  for (int t = threadIdx.x >> 5; t < 64; t += 8) {
    float acc = gb;
#pragma unroll
    for (int r = 0; r < 16; r++) acc += sGl[t * 32 + d * 16 + r] * gw[r];
    dst[t * 32 + k] = -softplus_f(-acc) * (1.f / 16.f);
  }
}
__device__ __forceinline__ void gla_state_item(const Params& P, int l, int item, unsigned char* sm) {
  int tid_ = threadIdx.x; OPAQUE(tid_);
  const int tid = tid_, lane = tid & 63, w = tid >> 6;
  const int d = item & 1, h = (item >> 1) & 3, rest = item >> 3;
  const int pc = rest % NCH, b = rest / NCH;
  const int row0 = chunk_row0(b, pc, TC, NCH_C);
  float* sGl = (float*)sm;
  float* sLa = sGl + 2048;
  bf16* sVt = (bf16*)(sLa + 2048);
  bf16* sKt = sVt + 64 * 72;
  const bf16* pr = WS(bf16, OFF_PROJ);
  float kh[8], vh[16];
#pragma unroll
  for (int i = 0; i < 8; i++) kh[i] = bf2f(pr[(size_t)(row0 + (tid >> 5) + 8 * i) * NIN + C_GLAK + h * 32 + (tid & 31)]);
#pragma unroll
  for (int i = 0; i < 16; i++) vh[i] = bf2f(pr[(size_t)(row0 + (tid >> 6) + 4 * i) * NIN + C_GLAV + h * 64 + (tid & 63)]);
#pragma unroll 8
  for (int idx = tid; idx < 64 * 32; idx += 256) {
    int t = idx >> 5, c = idx & 31;
    sGl[idx] = bf2f(pr[(size_t)(row0 + t) * NIN + C_GLAGL + c]);
  }
  __syncthreads();
  gla_la(P, l, d, h, sGl, sLa);
  __syncthreads();
  {
    float* segtot = (float*)(sKt + 32 * 72);
    const int k = tid & 31, sg = tid >> 5;
    float run = 0.f, loc[8];
#pragma unroll
    for (int j = 0; j < 8; j++) {
      int tau = sg * 8 + j, t = d == 0 ? 63 - tau : tau;
      float la = sLa[t * 32 + k]; loc[j] = run; run += la;
    }
    segtot[sg * 32 + k] = run;
    __syncthreads();
    float off = 0.f, tot = 0.f;
#pragma unroll
    for (int j = 0; j < 8; j++) { float v = segtot[j * 32 + k]; tot += v; if (j < sg) off += v; }
#pragma unroll
    for (int j = 0; j < 8; j++) {
      int tau = sg * 8 + j, t = d == 0 ? 63 - tau : tau;
      sLa[t * 32 + k] = loc[j] + off;
    }
    if (sg == 0) WS(float, OFF_GLADEC)[(((size_t)(d * BATCH + b) * NCH + pc) * 4 + h) * 32 + k] = __expf(tot);
  }
  __syncthreads();
#pragma unroll
  for (int i = 0; i < 16; i++) sVt[(tid & 63) * 72 + (tid >> 6) + 4 * i] = f2bf(vh[i]);
#pragma unroll
  for (int i = 0; i < 8; i++) {
    const int t = (tid >> 5) + 8 * i, k = tid & 31;
    sKt[k * 72 + t] = f2bf(kh[i] * __expf(sLa[t * 32 + k]));
  }
  __syncthreads();
  if (w < 2) {
    f32x16 acc = zero16();
    for (int ks = 0; ks < 64; ks += 16)
      acc = mfma32(ldsfrag(&sVt[(w * 32 + (lane & 31)) * 72 + ks + 8 * (lane >> 5)]),
                   ldsfrag(&sKt[(lane & 31) * 72 + ks + 8 * (lane >> 5)]), acc);
    bf16* st = WS(bf16, OFF_GLAST) + ((size_t)((d * BATCH + b) * NCH + pc) * 4 + h) * 2048;
    for (int r = 0; r < 16; r++) st[(w * 32 + acc_row(r, lane)) * 32 + (lane & 31)] = f2bf(acc[r]);
  }
  __syncthreads();
}

__device__ __forceinline__ U4 s5_u_load(const Params& P, int g, int n, int k8) {
  if (n >= M5) return zero4();
  int b = n / NCH5, pc = n - b * NCH5;
  int row = chunk_row0(b, pc, T5, NC5) + (k8 >> 4);
  return *(const U4*)(WS(bf16, OFF_PROJ) + (size_t)row * NIN + C_S5 + g * 16 + (k8 & 15));
}
__device__ __forceinline__ void s5_state_tile(const Params& P, int l, int item, unsigned char* sm) {
  const int MT5 = (M5 + 127) / 128;
  int nt = item & 1, mt = (item >> 1) % MT5, g = (item >> 1) / MT5;
  const bf16* Bt = WS(bf16, OFF_W1T) + (size_t)(l * 16 + g) * 256 * 512;
  float* S = WS(float, OFF_S5ST) + (size_t)g * M5 * 256;
  gemm_tile(sm, mt * 128, nt * 128, 512,
    [&](int m, int k) { return s5_u_load(P, g, m, k); },
    [&](int n, int k) { return *(const U4*)(Bt + (size_t)n * 512 + k); },
    [&](int m, int n, float v) { if (m < M5) S[(size_t)m * 256 + n] = v; });
}

__device__ __forceinline__ void phase_D(const Params& P, int l, unsigned char* sm, long long& pacc) {
  const int n_rw = BATCH * NCH * 8, n_ssd = BATCH * NCH * 8, n_gla = BATCH * NCH * 8;
  const int n_s5 = 16 * ((M5 + 127) / 128) * 2;
  { long long t0_ = 0; if (PROBE_PHASE == 30) t0_ = wall_clock64();
  ITEM_LOOP(i, n_rw, 0) rwkv_chunk_item(P, l, i, sm, pacc);
  if (PROBE_PHASE == 30) pacc += wall_clock64() - t0_; }
  chunk_scans(P, l, n_rw);
}

__device__ __forceinline__ void chunk_scans(const Params& P, int l, int base) {
  const int tid = threadIdx.x;
  const int n_ssd = 2 * BATCH * 4 * 4, n_gla = 2 * BATCH * 4 * 2, n_s5 = 16 * BATCH;
#pragma unroll 1
  for (int it = (int)((blockIdx.x + gridDim.x - ((unsigned)base % gridDim.x)) % gridDim.x); it < n_ssd + n_gla + n_s5; it += gridDim.x) {
    int i = it;
    if (i < n_ssd) {
      int q = i & 3, h = (i >> 2) & 3, rest = i >> 4, b = rest % BATCH, d = rest / BATCH;
      float S[4] = {0.f, 0.f, 0.f, 0.f};
#pragma unroll 1
      for (int v0 = 0; v0 < NCH; v0 += 8) {
        U2 cv[8]; float dec[8];
#pragma unroll
        for (int j = 0; j < 8; j++) {
          int vc = v0 + j < NCH ? v0 + j : NCH - 1;
          size_t ci = ((size_t)(d * BATCH + b) * NCH + ord_chunk(d, vc, NCH_C, NCH)) * 4 + h;
          cv[j] = *(const U2*)(WS(bf16, OFF_SSDST) + ci * 4096 + q * 1024 + tid * 4);
          dec[j] = WS(float, OFF_SSDDEC)[ci];
        }
#pragma unroll
        for (int j = 0; j < 8; j++) {
          if (v0 + j < NCH) {
            size_t ci = ((size_t)(d * BATCH + b) * NCH + ord_chunk(d, v0 + j, NCH_C, NCH)) * 4 + h;
            U2 o; o.a[0] = pack2(S[0], S[1]); o.a[1] = pack2(S[2], S[3]);
            *(U2*)(WS(bf16, OFF_SSDST) + ci * 4096 + q * 1024 + tid * 4) = o;
            S[0] = dec[j] * S[0] + lo2f(cv[j].a[0]); S[1] = dec[j] * S[1] + hi2f(cv[j].a[0]);
            S[2] = dec[j] * S[2] + lo2f(cv[j].a[1]); S[3] = dec[j] * S[3] + hi2f(cv[j].a[1]);
          }
        }
      }
      continue;
    }
    i -= n_ssd;
    if (i < n_gla) {
      int q = i & 1, h = (i >> 1) & 3, rest = i >> 3, b = rest % BATCH, d = rest / BATCH;
      float S[4] = {0.f, 0.f, 0.f, 0.f};
      int e0 = q * 1024 + tid * 4, k0 = e0 & 31;
#pragma unroll 1
      for (int v0 = 0; v0 < NCH; v0 += 8) {
        U2 cv[8]; F4 dec[8];
#pragma unroll
        for (int j = 0; j < 8; j++) {
          int vc = v0 + j < NCH ? v0 + j : NCH - 1;
          size_t ci = ((size_t)(d * BATCH + b) * NCH + ord_chunk(d, vc, NCH_C, NCH)) * 4 + h;
          cv[j] = *(const U2*)(WS(bf16, OFF_GLAST) + ci * 2048 + e0);
          dec[j] = *(const F4*)(WS(float, OFF_GLADEC) + ci * 32 + k0);
        }
#pragma unroll
        for (int j = 0; j < 8; j++) {
          if (v0 + j < NCH) {
            size_t ci = ((size_t)(d * BATCH + b) * NCH + ord_chunk(d, v0 + j, NCH_C, NCH)) * 4 + h;
            U2 o; o.a[0] = pack2(S[0], S[1]); o.a[1] = pack2(S[2], S[3]);
            *(U2*)(WS(bf16, OFF_GLAST) + ci * 2048 + e0) = o;
            S[0] = dec[j].a[0] * S[0] + lo2f(cv[j].a[0]); S[1] = dec[j].a[1] * S[1] + hi2f(cv[j].a[0]);
            S[2] = dec[j].a[2] * S[2] + lo2f(cv[j].a[1]); S[3] = dec[j].a[3] * S[3] + hi2f(cv[j].a[1]);
          }
        }
      }
      continue;
    }
    i -= n_gla;
    if (i < n_s5) {
      int b = i % BATCH, g = i / BATCH;
      if (tid < 128) {
        int d = tid >> 6, p = tid & 63;
        const float* lt = WS(float, OFF_S5LT) + ((size_t)((l * 16 + g) * 2 + d) * 64 + p) * 2;
        float lr = lt[0], li = lt[1], xr = 0.f, xi = 0.f;
#pragma unroll 1
        for (int v0 = 0; v0 < NCH5; v0 += 8) {
          float sr[8], si[8];
#pragma unroll
          for (int j = 0; j < 8; j++) {
            int vc = v0 + j < NCH5 ? v0 + j : NCH5 - 1;
            const float* sp = WS(float, OFF_S5ST) + ((size_t)g * M5 + b * NCH5 + ord_chunk(d, vc, NC5, NCH5)) * 256 + d * 128 + p;
            sr[j] = sp[0]; si[j] = sp[64];
          }
#pragma unroll
          for (int j = 0; j < 8; j++) {
            if (v0 + j < NCH5) {
              float* sp = WS(float, OFF_S5ST) + ((size_t)g * M5 + b * NCH5 + ord_chunk(d, v0 + j, NC5, NCH5)) * 256 + d * 128 + p;
              sp[0] = xr; sp[64] = xi;
              float nr = lr * xr - li * xi + sr[j], ni = lr * xi + li * xr + si[j];
              xr = nr; xi = ni;
            }
          }
        }
      }
      continue;
    }
  }
}

__device__ __forceinline__ void ssd_out_item(const Params& P, int l, int item, unsigned char* sm, long long& pacc) {
  long long tp0_ = 0; if (PROBE_PHASE == 55 || PROBE_PHASE == 56) tp0_ = wall_clock64();
  int tid_ = threadIdx.x; OPAQUE(tid_);
  const int tid = tid_, lane = tid & 63, w = tid >> 6;
  const int h = item & 3, rest = item >> 2, pc = rest % NCH, b = rest / NCH;
  if (l == 1 && pc < NCH_C) return;
  const int isctx = pc < NCH_C, len = isctx ? CTX : SEQ, t0 = (isctx ? pc : pc - NCH_C) * TC;
  const int seq0 = isctx ? b * CTX : ROWS_C + b * SEQ;
  bf16* sRaw = (bf16*)sm;
  bf16* sA2 = (bf16*)sm;
  bf16* sB2 = (bf16*)(sm + 26112);
  bf16* sC = (bf16*)(sm + 26112 + 25600);
  float* sdt = (float*)(sm + 26112 + 25600 + 9216);
  float* scf = sdt + 128; float* scr = scf + 64; float* spart = scr + 64;
  const bf16* pr = WS(bf16, OFF_PROJ);
#pragma unroll 8
  for (int idx = tid; idx < 3 * 68 * 8; idx += 256) {
    int which = idx / (68 * 8), rem = idx % (68 * 8), tr = rem >> 3, c8 = rem & 7;
    int t = t0 - 2 + tr;
    int col = C_SSD + (which == 0 ? h * 64 : which == 1 ? 256 + (h >> 1) * 64 : 384 + (h >> 1) * 64) + c8 * 8;
    U4 v = (t >= 0 && t < len) ? *(const U4*)(pr + (size_t)(seq0 + t) * NIN + col) : zero4();
    *(U4*)&sRaw[(which * 68 + tr) * 64 + c8 * 8] = v;
  }
  u32x4 stv0, stv1, stv2, stv3;
  {
    const bf16* stb = WS(bf16, OFF_SSDST);
    const size_t o0 = ((size_t)((0 * BATCH + b) * NCH + pc) * 4 + h) * 4096, o1 = ((size_t)((1 * BATCH + b) * NCH + pc) * 4 + h) * 4096;
    const int p_ = (tid >> 3) & 31, c8_ = tid & 7;
    stv0 = *(const u32x4*)(stb + o0 + p_ * 64 + c8_ * 8);
    stv1 = *(const u32x4*)(stb + o0 + (p_ + 32) * 64 + c8_ * 8);
    stv2 = *(const u32x4*)(stb + o1 + p_ * 64 + c8_ * 8);
    stv3 = *(const u32x4*)(stb + o1 + (p_ + 32) * 64 + c8_ * 8);
  }
  float zv[16];
#pragma unroll
  for (int r = 0; r < 16; r++)
    zv[r] = bf2f(pr[(size_t)(seq0 + t0 + (w >> 1) * 32 + acc_row(r, lane)) * NIN + C_SSDZ + h * 64 + (w & 1) * 32 + (lane & 31)]);
  if (tid < 128) {
    int d = tid >> 6, t = tid & 63;
    float raw = bf2f(pr[(size_t)(seq0 + t0 + t) * NIN + C_SSDDT + d * 4 + h]);
    sdt[tid] = softplus_f(raw + P.ssd_dt_bias[(l * 2 + d) * 4 + h]);
  }
  __syncthreads();
  if (w == 0) { float v = wave_scan64(sdt[lane] * ssd_aneg(P, l, 0, h), scf, lane, false); wave_sync(); scf[lane] = v; }
  if (w == 1) { float v = wave_scan64(sdt[64 + lane] * ssd_aneg(P, l, 1, h), scr, lane, true); wave_sync(); scr[lane] = v; }
#pragma unroll
  for (int which = 0; which < 3; which++) {
    const int c = tid & 63;
    const int ch = which == 0 ? h * 64 + c : which == 1 ? 256 + (h >> 1) * 64 + c : 384 + (h >> 1) * 64 + c;
    float cw[5], cb = P.ssd_conv_b[l * 512 + ch];
#pragma unroll
    for (int i = 0; i < 5; i++) cw[i] = P.ssd_conv_w[(l * 5 + i) * 512 + ch];
    const int tb = (tid >> 6) * 16;
    float w0 = bf2f(sRaw[(which * 68 + tb) * 64 + c]), w1 = bf2f(sRaw[(which * 68 + tb + 1) * 64 + c]);
    float w2 = bf2f(sRaw[(which * 68 + tb + 2) * 64 + c]), w3 = bf2f(sRaw[(which * 68 + tb + 3) * 64 + c]);
#pragma unroll 4
    for (int t = tb; t < tb + 16; t++) {
      float w4 = bf2f(sRaw[(which * 68 + t + 4) * 64 + c]);
      float acc = cb + w0 * cw[0] + w1 * cw[1] + w2 * cw[2] + w3 * cw[3] + w4 * cw[4];
      w0 = w1; w1 = w2; w2 = w3; w3 = w4;
      bf16 v = f2bf(silu_f(acc));
      if (which == 0) sB2[c * 200 + t] = v;
      else if (which == 1) sB2[t * 200 + 64 + c] = v;
      else sC[t * 72 + c] = v;
    }
  }
  __syncthreads();
  const int ti = w >> 1, tj = w & 1;
  {
    f32x16 g = zero16();
    for (int ks = 0; ks < 64; ks += 16)
      g = mfma32(ldsfrag(&sC[(ti * 32 + (lane & 31)) * 72 + ks + 8 * (lane >> 5)]),
                 ldsfrag(&sB2[(tj * 32 + (lane & 31)) * 200 + 64 + ks + 8 * (lane >> 5)]), g);
    int j = tj * 32 + (lane & 31);
    float cfj = scf[j], crj = scr[j], d0j = sdt[j], d1j = sdt[64 + j];
    for (int r = 0; r < 16; r++) {
      int i = ti * 32 + acc_row(r, lane);
      float mlt = 0.f;
      if (j <= i) mlt += __expf(scf[i] - cfj) * d0j;
      if (j >= i) mlt += __expf(scr[i] - crj) * d1j;
      sA2[i * 200 + j] = f2bf(g[r] * mlt);
    }
  }
#pragma unroll 8
  for (int idx = tid; idx < 64 * 64; idx += 256) {
    int i = idx >> 6, n = idx & 63;
    float cv = bf2f(sC[i * 72 + n]);
    sA2[i * 200 + 64 + n] = f2bf(cv * __expf(scf[i]));
    sA2[i * 200 + 128 + n] = f2bf(cv * __expf(scr[i]));
  }
  __syncthreads();
  {
    const int p_ = (tid >> 3) & 31, c8_ = tid & 7;
    *(u32x4*)&sB2[p_ * 200 + 64 + c8_ * 8] = stv0;
    *(u32x4*)&sB2[(p_ + 32) * 200 + 64 + c8_ * 8] = stv1;
    *(u32x4*)&sB2[p_ * 200 + 128 + c8_ * 8] = stv2;
    *(u32x4*)&sB2[(p_ + 32) * 200 + 128 + c8_ * 8] = stv3;
  }
  __syncthreads();
  {
    f32x16 acc = zero16();
    for (int ks = 0; ks < 192; ks += 16)
      acc = mfma32(ldsfrag(&sA2[(ti * 32 + (lane & 31)) * 200 + ks + 8 * (lane >> 5)]),
                   ldsfrag(&sB2[(tj * 32 + (lane & 31)) * 200 + ks + 8 * (lane >> 5)]), acc);
    int p = tj * 32 + (lane & 31);
    float dd = P.ssd_d[l * 4 + h];
    bf16* yc = WS(bf16, OFF_R);
    for (int r = 0; r < 16; r++) {
      int i = ti * 32 + acc_row(r, lane);
      int row = seq0 + t0 + i;
      float xv = bf2f(sB2[p * 200 + i]);
      float y = acc[r] + dd * xv;
      float z = zv[r];
      y *= silu_f(z);
      yc[(size_t)row * 1024 + h * 64 + p] = f2bf(y);
      float s2 = sum32(y * y);
      if ((lane & 31) == 31) spart[i * 2 + tj] = s2;
    }
  }
  __syncthreads();
  if (tid < 64) WS(float, OFF_SSQ)[(size_t)(seq0 + t0 + tid) * 4 + h] = spart[tid * 2] + spart[tid * 2 + 1];
  __syncthreads();
}

__device__ __forceinline__ void gla_out_item(const Params& P, int l, int item, unsigned char* sm) {
  int tid_ = threadIdx.x; OPAQUE(tid_);
  const int tid = tid_, lane = tid & 63, w = tid >> 6;
  const int h = item & 3, rest = item >> 2, pc = rest % NCH, b = rest / NCH;
  if (l == 1 && pc < NCH_C) return;
  const int row0 = chunk_row0(b, pc, TC, NCH_C);
  bf16* sA2 = (bf16*)sm;
  bf16* sB2 = sA2 + 64 * 136;
  bf16* sKf = sB2 + 64 * 136;
  bf16* sKr = sKf + 64 * 40;
  float* sbf = (float*)(sKr + 64 * 40);
  float* sbr = sbf + 2048;
  float* spart = sbr + 2048;
  float* sGl = (float*)sB2;
  const bf16* pr = WS(bf16, OFF_PROJ);
  float qh[8], kh[8], vh[16], gh[16];
  u32x4 sth0, sth1;
#pragma unroll
  for (int i = 0; i < 8; i++) {
    const bf16* rp = pr + (size_t)(row0 + (tid >> 5) + 8 * i) * NIN + h * 32 + (tid & 31);
    qh[i] = bf2f(rp[C_GLA]); kh[i] = bf2f(rp[C_GLAK]);
  }
#pragma unroll
  for (int i = 0; i < 16; i++) vh[i] = bf2f(pr[(size_t)(row0 + (tid >> 6) + 4 * i) * NIN + C_GLAV + h * 64 + (tid & 63)]);
#pragma unroll
  for (int r = 0; r < 16; r++)
    gh[r] = bf2f(pr[(size_t)(row0 + (w >> 1) * 32 + acc_row(r, lane)) * NIN + C_GLAG + h * 64 + (w & 1) * 32 + (lane & 31)]);
  {
    const bf16* st0 = WS(bf16, OFF_GLAST) + ((size_t)((0 * BATCH + b) * NCH + pc) * 4 + h) * 2048;
    const bf16* st1 = WS(bf16, OFF_GLAST) + ((size_t)((1 * BATCH + b) * NCH + pc) * 4 + h) * 2048;
    sth0 = *(const u32x4*)(st0 + (tid >> 2) * 32 + (tid & 3) * 8);
    sth1 = *(const u32x4*)(st1 + (tid >> 2) * 32 + (tid & 3) * 8);
  }
#pragma unroll 8
  for (int idx = tid; idx < 64 * 32; idx += 256) {
    int t = idx >> 5, c = idx & 31;
    sGl[idx] = bf2f(pr[(size_t)(row0 + t) * NIN + C_GLAGL + c]);
  }
  __syncthreads();
  gla_la(P, l, 0, h, sGl, sbf);
  gla_la(P, l, 1, h, sGl, sbr);
  __syncthreads();
  {
    float* segtot = spart + 128;
    const int k = tid & 31, sg = tid >> 5;
    float rf = 0.f, rr_ = 0.f, lf[8], lr_[8];
#pragma unroll
    for (int j = 0; j < 8; j++) {
      int tf = sg * 8 + j, tr = 63 - tf;
      rf += sbf[tf * 32 + k]; lf[j] = rf;
      rr_ += sbr[tr * 32 + k]; lr_[j] = rr_;
    }
    segtot[sg * 32 + k] = rf; segtot[256 + sg * 32 + k] = rr_;
    __syncthreads();
    float of = 0.f, orr = 0.f;
#pragma unroll
    for (int j = 0; j < 8; j++) { if (j < sg) { of += segtot[j * 32 + k]; orr += segtot[256 + j * 32 + k]; } }
#pragma unroll
    for (int j = 0; j < 8; j++) {
      int tf = sg * 8 + j, tr = 63 - tf;
      sbf[tf * 32 + k] = lf[j] + of;
      sbr[tr * 32 + k] = lr_[j] + orr;
    }
  }
  __syncthreads();
#pragma unroll
  for (int i = 0; i < 8; i++) {
    const int idx = tid + 256 * i, t = idx >> 5, k = idx & 31;
    float q = qh[i] * 0.17677669529663687f;
    float kv = kh[i];
    float bf_ = sbf[idx], br_ = sbr[idx];
    sA2[t * 136 + 64 + k] = f2bf(q * __expf(bf_));
    sA2[t * 136 + 96 + k] = f2bf(q * __expf(br_));
    sKf[t * 40 + k] = f2bf(kv * __expf(-bf_));
    sKr[t * 40 + k] = f2bf(kv * __expf(-br_));
  }
#pragma unroll
  for (int i = 0; i < 16; i++) sB2[(tid & 63) * 136 + (tid >> 6) + 4 * i] = f2bf(vh[i]);
  *(u32x4*)&sB2[(tid >> 2) * 136 + 64 + (tid & 3) * 8] = sth0;
  *(u32x4*)&sB2[(tid >> 2) * 136 + 96 + (tid & 3) * 8] = sth1;
  __syncthreads();
  const int ti = w >> 1, tj = w & 1;
  {
    f32x16 pf = zero16(), pv = zero16();
    for (int ks = 0; ks < 32; ks += 16) {
      pf = mfma32(ldsfrag(&sA2[(ti * 32 + (lane & 31)) * 136 + 64 + ks + 8 * (lane >> 5)]),
                  ldsfrag(&sKf[(tj * 32 + (lane & 31)) * 40 + ks + 8 * (lane >> 5)]), pf);
      pv = mfma32(ldsfrag(&sA2[(ti * 32 + (lane & 31)) * 136 + 96 + ks + 8 * (lane >> 5)]),
                  ldsfrag(&sKr[(tj * 32 + (lane & 31)) * 40 + ks + 8 * (lane >> 5)]), pv);
    }
    int j = tj * 32 + (lane & 31);
    for (int r = 0; r < 16; r++) {
      int i = ti * 32 + acc_row(r, lane);
      float v = (j < i) ? pf[r] : (j > i) ? pv[r] : pf[r] + pv[r];
      sA2[i * 136 + j] = f2bf(v);
    }
  }
  __syncthreads();
  {
    f32x16 acc = zero16();
    for (int ks = 0; ks < 128; ks += 16)
      acc = mfma32(ldsfrag(&sA2[(ti * 32 + (lane & 31)) * 136 + ks + 8 * (lane >> 5)]),
                   ldsfrag(&sB2[(tj * 32 + (lane & 31)) * 136 + ks + 8 * (lane >> 5)]), acc);
    for (int r = 0; r < 16; r++) {
      int i = ti * 32 + acc_row(r, lane);
      float s2 = sum32(acc[r] * acc[r]);
      if ((lane & 31) == 31) spart[i * 2 + tj] = s2;
    }
    __syncthreads();
    int v = tj * 32 + (lane & 31);
    float gn = P.gla_norm[l * 256 + h * 64 + v];
    bf16* yc = WS(bf16, OFF_R);
    for (int r = 0; r < 16; r++) {
      int i = ti * 32 + acc_row(r, lane);
      int row = row0 + i;
      float rstd = rsqrtf((spart[i * 2] + spart[i * 2 + 1]) * (1.f / 64.f) + 1e-6f);
      float g = gh[r];
      yc[(size_t)row * 1024 + 768 + h * 64 + v] = f2bf(acc[r] * rstd * gn * silu_f(g));
    }
  }
  __syncthreads();
}

__device__ __forceinline__ void s5_out_tile(const Params& P, int l, int item, unsigned char* sm) {
  const int MT5 = (M5 + 127) / 128;
  int nt = item & 3, mt = (item >> 2) % MT5, g = (item >> 2) / MT5;
  const bf16* Bt = WS(bf16, OFF_BT2) + (size_t)(l * 16 + g) * 512 * 768;
  const float* X = WS(float, OFF_S5ST) + (size_t)g * M5 * 256;
  const bf16* pr = WS(bf16, OFF_PROJ);
  bf16* ys = WS(bf16, OFF_YS5);
  gemm_tile(sm, mt * 128, nt * 128, 768,
    [&](int m, int k) {
      if (k < 512) return s5_u_load(P, g, m, k);
      if (m >= M5) return zero4();
      const float* xp = X + (size_t)m * 256 + (k - 512);
      F4 a = *(const F4*)xp, b2 = *(const F4*)(xp + 4);
      U4 r; r.a[0] = pack2(a.a[0], a.a[1]); r.a[1] = pack2(a.a[2], a.a[3]); r.a[2] = pack2(b2.a[0], b2.a[1]); r.a[3] = pack2(b2.a[2], b2.a[3]);
      return r;
    },
    [&](int n, int k) { return *(const U4*)(Bt + (size_t)n * 768 + k); },
    [&](int m, int n, float v) {
      if (m >= M5) return;
      int b = m / NCH5, pc = m - b * NCH5;
      int row = chunk_row0(b, pc, T5, NC5) + (n >> 4);
      int ch = g * 16 + (n & 15);
      float u = bf2f(pr[(size_t)row * NIN + C_S5 + ch]);
      ys[(size_t)row * 256 + ch] = f2bf(gelu_f(v + P.s5_d[l * 256 + ch] * u));
    });
}

__device__ __forceinline__ void phase_E(const Params& P, int l, unsigned char* sm, long long& pacc) {
  const int n_rw = BATCH * 8;
  ITEM_LOOP(i, n_rw, 0) rwkv_scan2_item(P, l, i, sm);
  const int n_ssd = BATCH * NCH * 4, n_gla = BATCH * NCH * 4, n_s5 = 16 * ((M5 + 127) / 128) * 4;
  ITEM_LOOP(i, n_ssd, n_rw) ssd_out_item(P, l, i, sm, pacc);
  ITEM_LOOP(i, n_gla, n_rw + n_ssd) gla_out_item(P, l, i, sm);
  ITEM_LOOP(i, n_s5, n_rw + n_ssd + n_gla) s5_out_tile(P, l, i, sm);
}
__device__ __forceinline__ void phase_F(const Params& P, int l, unsigned char* sm, long long& pacc) {
  const int n_rw = BATCH * NCH * 4;
  ITEM_LOOP(i, n_rw, 0) rwkv_out_item(P, l, i, sm);
}

__device__ __forceinline__ void phase_G(const Params& P, int l, unsigned char* sm) {
  const int lane = threadIdx.x & 63, w = threadIdx.x >> 6;
  const int n_glu = (ROWS / 128) * 2, n_rows = ROWS / 4;
  const bf16* Bt = WS(bf16, OFF_GLUT) + (size_t)l * 256 * 256;
  const bf16* pr = WS(bf16, OFF_PROJ);
  bf16* yc = WS(bf16, OFF_R);
#pragma unroll 1
  for (int it = blockIdx.x; it < n_glu + n_rows; it += gridDim.x) {
    if (it < n_glu) {
      int nt = it & 1, mt = it >> 1;
      if (l == 1 && mt < ROWS_C / 128) continue;
      gemm_tile(sm, mt * 128, nt * 128, 256,
        [&](int m, int k) { return *(const U4*)(WS(bf16, OFF_YS5) + (size_t)m * 256 + k); },
        [&](int n, int k) { return *(const U4*)(Bt + (size_t)n * 256 + k); },
        [&](int m, int n, float v) {
          float y = bf2f(WS(bf16, OFF_YS5)[(size_t)m * 256 + n]);
          float g = bf2f(pr[(size_t)m * NIN + C_S5G + n]);
          yc[(size_t)m * 1024 + 256 + n] = f2bf(y * sigmoid_f(v + P.s5_glu_b[l * 256 + n]) * silu_f(g));
        });
      continue;
    }
    int m = (it - n_glu) * 4 + w;
    const float* sq = WS(float, OFF_SSQ) + (size_t)m * 4;
    float rstd = rsqrtf((sq[0] + sq[1] + sq[2] + sq[3]) * (1.f / 256.f) + 1e-6f);
    bf16* p = yc + (size_t)m * 1024 + lane * 4;
    U2 v = *(U2*)p;
    const float* gn = P.ssd_norm + l * 256 + lane * 4;
    U2 o;
    o.a[0] = pack2(lo2f(v.a[0]) * rstd * gn[0], hi2f(v.a[0]) * rstd * gn[1]);
    o.a[1] = pack2(lo2f(v.a[1]) * rstd * gn[2], hi2f(v.a[1]) * rstd * gn[3]);
    *(U2*)p = o;
  }
  { const int n_rw = BATCH * NCH * 4; ITEM_LOOP(i, n_rw, n_glu + n_rows) rwkv_out_item(P, l, i, sm); }
}

__device__ __forceinline__ void phase_outproj(const Params& P, int l, unsigned char* sm) {
  const bf16* A = WS(bf16, OFF_R);
  const bf16* Bt = WS(bf16, OFF_WTOUT) + (size_t)l * D * D;
  bf16* Y = WS(bf16, OFF_PROJ);
  const int NT = D / 128, MT = ROWS / 128;
#pragma unroll 1
  for (int it0 = blockIdx.x; it0 < MT * NT; it0 += gridDim.x) {
    const int per = (MT * NT) / 8;
    int it = (MT * NT) % 8 == 0 ? (it0 & 7) * per + (it0 >> 3) : it0;
    int mt = it / NT, nt = it % NT;
    if (l == 1 && mt < ROWS_C / 128) continue;
    gemm_tile(sm, mt * 128, nt * 128, D,
      [&](int m, int k) { return *(const U4*)(A + (size_t)m * D + k); },
      [&](int n, int k) { return *(const U4*)(Bt + (size_t)n * D + k); },
      [&](int m, int n, float v) { Y[(size_t)m * D + n] = f2bf(v); });
  }
}

__device__ __forceinline__ void phase_post(const Params& P, int l) {
  const int lane = threadIdx.x & 63, w = threadIdx.x >> 6;
  const int first = (l == 1) ? ROWS_C / 4 : 0;
#pragma unroll 1
  for (int it = first + blockIdx.x; it < ROWS / 4; it += gridDim.x) {
    int m = it * 4 + w;
    RowInfo ri = row_info(m);
    const bf16* y = WS(bf16, OFF_PROJ) + (size_t)m * D + lane * 16;
    const float* hres; float* dst;
    if (ri.isctx) { hres = P.ctx + (size_t)m * D; dst = WS(float, OFF_HC) + (size_t)m * D; }
    else { hres = (l == 0 ? P.x : P.out) + (size_t)(m - ROWS_C) * D; dst = P.out + (size_t)(m - ROWS_C) * D; }
    const int mrow = ri.isctx ? BATCH : ri.b;
    const float* mod = WS(float, OFF_MOD) + ((size_t)l * NMOD + mrow) * 3072 + 2048;
    const int c0 = lane * 16;
    U4 y0 = *(const U4*)y, y1 = *(const U4*)(y + 8);
    float v[16]; float ss = 0.f;
#pragma unroll
    for (int e = 0; e < 4; e++) { v[2 * e] = lo2f(y0.a[e]); v[2 * e + 1] = hi2f(y0.a[e]); v[8 + 2 * e] = lo2f(y1.a[e]); v[8 + 2 * e + 1] = hi2f(y1.a[e]); }
#pragma unroll
    for (int e = 0; e < 16; e++) ss += v[e] * v[e];
    ss = sum64(ss);
    float rstd = rsqrtf(ss * (1.f / 1024.f) + 1e-6f);
    float hn[16]; float ss2 = 0.f;
#pragma unroll
    for (int q = 0; q < 4; q++) {
      F4 hr = *(const F4*)(hres + c0 + 4 * q), gm = *(const F4*)(mod + c0 + 4 * q), np = *(const F4*)(P.norm_post + l * D + c0 + 4 * q), o;
#pragma unroll
      for (int e = 0; e < 4; e++) { o.a[e] = hr.a[e] + gm.a[e] * (v[4 * q + e] * rstd * np.a[e]); hn[4 * q + e] = o.a[e]; ss2 += o.a[e] * o.a[e]; }
      *(F4*)(dst + c0 + 4 * q) = o;
    }
    if (l == 0) {
      ss2 = sum64(ss2);
      float rstd2 = rsqrtf(ss2 * (1.f / 1024.f) + 1e-6f);
      const float* mod1 = WS(float, OFF_MOD) + ((size_t)1 * NMOD + mrow) * 3072;
      bf16* hd = WS(bf16, OFF_R) + (size_t)m * D + c0;
      U4 o0, o1;
#pragma unroll
      for (int q = 0; q < 4; q++) {
        F4 np = *(const F4*)(P.norm_pre + 1 * D + c0 + 4 * q), sc = *(const F4*)(mod1 + 1024 + c0 + 4 * q), sh = *(const F4*)(mod1 + c0 + 4 * q);
        float t0 = hn[4 * q] * rstd2 * np.a[0] * (1.f + sc.a[0]) + sh.a[0], t1 = hn[4 * q + 1] * rstd2 * np.a[1] * (1.f + sc.a[1]) + sh.a[1];
        float t2 = hn[4 * q + 2] * rstd2 * np.a[2] * (1.f + sc.a[2]) + sh.a[2], t3 = hn[4 * q + 3] * rstd2 * np.a[3] * (1.f + sc.a[3]) + sh.a[3];
        if (q < 2) { o0.a[2 * q] = pack2(t0, t1); o0.a[2 * q + 1] = pack2(t2, t3); }
        else { o1.a[2 * (q - 2)] = pack2(t0, t1); o1.a[2 * (q - 2) + 1] = pack2(t2, t3); }
      }
      *(U4*)hd = o0; *(U4*)(hd + 8) = o1;
    }
  }
}

constexpr int NPHASE = 19;
__device__ __forceinline__ void run_phase(const Params& P, int ph, unsigned char* sm) {
  if (ph == 0) { phase_prologue(P, sm); return; }
  int l = (ph - 1) / 9, s = (ph - 1) % 9;
  switch (s) {
    case 0: if (l == 0) phase_normmod(P, l); break;
    case 1: phase_inproj(P, l, sm); break;
    case 2: phase_rwprep(P, l, sm); break;
    case 3: { long long dummy = 0; phase_D(P, l, sm, dummy); } break;
    case 4: { long long dummy = 0; phase_E(P, l, sm, dummy); } break;
    case 5: break;
    case 6: phase_G(P, l, sm); break;
    case 7: phase_outproj(P, l, sm); break;
    default: phase_post(P, l); break;
  }
}

#ifndef CPU_EMU
#define XB_TMO      128
#define XB_XCNT(j)  (256  + 64 * (j))
#define XB_XSUB(j)  (1280 + 64 * (j))
#define XB_XGEN(j)  (2304 + 64 * (j))
#define XB_TOP      3328
#define XB_TOPGEN   3392
#define XCD_BAR_WORDS 3456
#define XB_SPIN_CAP (1u << 18)
#define LAS __attribute__((address_space(3)))

__device__ __forceinline__ unsigned xb_ld(unsigned* p)              { return __hip_atomic_load(p, __ATOMIC_RELAXED, __HIP_MEMORY_SCOPE_AGENT); }
__device__ __forceinline__ unsigned xb_add(unsigned* p, unsigned v) { return __hip_atomic_fetch_add(p, v, __ATOMIC_RELAXED, __HIP_MEMORY_SCOPE_AGENT); }
__device__ __forceinline__ unsigned xb_xcc_id() { return (unsigned)__builtin_amdgcn_s_getreg((3 << 11) | 20) & 0xFu; }
#define XB_SPIN(cond, bar) do { unsigned _sp = 0; while (cond) { __builtin_amdgcn_s_sleep(1); \
    if ((++_sp & 255u) == 0u) { if (xb_ld(&(bar)[XB_TMO])) break; if (_sp > XB_SPIN_CAP) { atomicAdd(&(bar)[XB_TMO], 1u); break; } } } } while (0)

struct XcdBarrier {
    unsigned* bar; unsigned x;
    volatile LAS unsigned* st;
};

__device__ __forceinline__ XcdBarrier xcd_barrier_post(unsigned* bar, volatile LAS unsigned* st) {
    XcdBarrier b; b.bar = bar; b.x = xb_xcc_id(); b.st = st;
    if (threadIdx.x == 0) (void)xb_add(&bar[XB_XCNT(b.x)], 1u);
    return b;
}
__device__ __forceinline__ void xcd_barrier_complete(unsigned* bar, unsigned x, unsigned& nloc, unsigned& nx) {
    const unsigned G = gridDim.x * gridDim.y * gridDim.z;
    unsigned sum, cnt, mine, sp = 0u;
    for (;;) {
        sum = 0u; cnt = 0u; mine = 0u;
#pragma unroll
        for (unsigned j = 0; j < 16; ++j) { const unsigned c = xb_ld(&bar[XB_XCNT(j)]); sum += c; cnt += (c > 0u) ? 1u : 0u; mine = (j == x) ? c : mine; }
        if (sum == G) break;
        __builtin_amdgcn_s_sleep(1);
        if ((++sp & 255u) == 0u) { if (xb_ld(&bar[XB_TMO])) break; if (sp > XB_SPIN_CAP) { atomicAdd(&bar[XB_TMO], 1u); break; } }
    }
    nloc = mine > 0u ? mine : 1u; nx = cnt > 0u ? cnt : 1u;
}

__device__ __forceinline__ void xcd_barrier(const XcdBarrier& b) {
    asm volatile("s_waitcnt vmcnt(0)" ::: "memory");
    __syncthreads();
    if (threadIdx.x == 0) {
        unsigned* bar = b.bar;
        __builtin_amdgcn_s_waitcnt(0);
        unsigned nloc = b.st[0], nx = b.st[1];
        if (nloc == 0u) { xcd_barrier_complete(bar, b.x, nloc, nx); b.st[0] = nloc; b.st[1] = nx; }
        const unsigned old = xb_add(&bar[XB_XSUB(b.x)], 1u);
        const unsigned gen = old / nloc;
        if (old + 1u == (gen + 1u) * nloc) {
            __builtin_amdgcn_fence(__ATOMIC_RELEASE, "agent");
            asm volatile("s_waitcnt vmcnt(0)" ::: "memory");
            const unsigned og = xb_add(&bar[XB_TOP], 1u);
            const unsigned tg = og / nx;
            if (og + 1u == (tg + 1u) * nx) xb_add(&bar[XB_TOPGEN], 1u);
            else XB_SPIN(xb_ld(&bar[XB_TOPGEN]) == tg, bar);
            __builtin_amdgcn_fence(__ATOMIC_ACQUIRE, "agent");
            xb_add(&bar[XB_XGEN(b.x)], 1u);
            asm volatile("s_waitcnt vmcnt(0)" ::: "memory");
        } else {
            XB_SPIN(xb_ld(&bar[XB_XGEN(b.x)]) == gen, bar);
            __builtin_amdgcn_fence(__ATOMIC_ACQUIRE, "agent");
            asm volatile("s_waitcnt vmcnt(0)" ::: "memory");
        }
    }
    __syncthreads();
}


#define PH(bit, call) { long long t0_ = 0; if (PROBE_PHASE == (bit)) t0_ = wall_clock64(); call; xcd_barrier(xb); if (PROBE_PHASE == (bit)) pacc += wall_clock64() - t0_; }
template <int L> __device__ __forceinline__ void run_layer(const Params& P, unsigned char* sm, const XcdBarrier& xb, long long& pacc) {
  if (L == 0) PH(0, phase_normmod(P, L))
  PH(1, phase_inproj(P, L, sm))
  PH(2, phase_rwprep(P, L, sm))
  PH(3, phase_D(P, L, sm, pacc))
  PH(4, phase_E(P, L, sm, pacc))
  PH(6, phase_G(P, L, sm))
  PH(7, phase_outproj(P, L, sm))
  if (L == 0) PH(8, phase_post(P, L))
  else phase_post(P, L);
}
__global__ void __launch_bounds__(256, 2) mega_kernel(Params P) {
  __shared__ __attribute__((aligned(16))) unsigned char sm[SMEM_BYTES];
  __shared__ uint4 xb_words;
  cg::grid_group grid = cg::this_grid();
  long long pacc = 0;
  if (threadIdx.x == 0) xb_words = make_uint4(0u, 0u, 0u, 0u);
  __syncthreads();
  XcdBarrier xb = xcd_barrier_post((unsigned*)(P.ws + OFF_BAR), (volatile LAS unsigned*)&xb_words);
  if (P.ws == nullptr) grid.sync();
  PH(9, phase_prologue(P, sm))
  run_layer<0>(P, sm, xb, pacc);
  run_layer<1>(P, sm, xb, pacc);
  if (PROBE_PHASE >= 0 && blockIdx.x == 0 && threadIdx.x == 0) {
    long long t1 = wall_clock64();
    while (wall_clock64() - t1 < pacc) { __builtin_amdgcn_s_sleep(10); }
  }
}
__global__ void __launch_bounds__(256, 2) phase_kernel(Params P, int ph) {
  __shared__ __attribute__((aligned(16))) unsigned char sm[SMEM_BYTES];
  run_phase(P, ph, sm);
}

extern "C" void kernel_launch(void* const* d_in, const int* in_sizes, int n_in, void* d_out, int out_size,
                              void* d_ws, size_t ws_size, hipStream_t stream) {
  Params P{};
  const float** pp = (const float**)&P;
  for (int i = 0; i < 39; i++) pp[i] = (const float*)d_in[i];
  P.out = (float*)d_out;
  P.ws = (unsigned char*)d_ws;
  if (ws_size < WS_TOTAL) fprintf(stderr, "workspace too small: %zu < %zu\n", ws_size, (size_t)WS_TOTAL);
#if USE_COOP
  static int grid_blocks = 0;
  if (!grid_blocks) {
    int dev = 0, cus = 0, per_cu = 0;
    hipGetDevice(&dev);
    hipDeviceGetAttribute(&cus, hipDeviceAttributeMultiprocessorCount, dev);
    hipOccupancyMaxActiveBlocksPerMultiprocessor(&per_cu, mega_kernel, 256, 0);
    if (per_cu > 2) per_cu = 2;
    grid_blocks = cus * per_cu;
  }
  hipMemsetAsync((unsigned char*)d_ws + OFF_BAR, 0, 3456 * 4, stream);
  void* args[] = {&P};
  hipError_t e = hipLaunchCooperativeKernel((void*)mega_kernel, dim3(grid_blocks), dim3(256), args, 0, stream);
  if (e != hipSuccess) fprintf(stderr, "cooperative launch failed: %s (grid %d)\n", hipGetErrorString(e), grid_blocks);
#else
  for (int ph = 0; ph < NPHASE; ph++) phase_kernel<<<1024, 256, 0, stream>>>(P, ph);
#endif
}
#endif
```

```cpp
#ifdef CPU_EMU
#include "hip_emu.h"
#else
#include <hip/hip_runtime.h>
#include <hip/hip_cooperative_groups.h>
#include <stdint.h>
#include <stdio.h>
namespace cg = cooperative_groups;
#endif

#ifndef BATCH
#define BATCH 8
#endif
#ifndef SEQ
#define SEQ 4096
#endif
#ifndef CTX
#define CTX 256
#endif
#ifndef USE_COOP
#define USE_COOP 1
#endif
#ifndef PROBE_PHASE
#define PROBE_PHASE -1
#endif

typedef unsigned short bf16;
typedef __attribute__((ext_vector_type(8))) short bf16x8;
typedef __attribute__((ext_vector_type(16))) float f32x16;
struct alignas(16) U4 { uint32_t a[4]; };
typedef uint32_t u32x4 __attribute__((ext_vector_type(4)));
struct alignas(8) U2 { uint32_t a[2]; };
struct alignas(16) F4 { float a[4]; };

constexpr int D = 1024, NIN = 3368, NINP = 3456;
constexpr int ROWS_C = BATCH * CTX, ROWS_L = BATCH * SEQ, ROWS = ROWS_C + ROWS_L;
constexpr int VL = CTX + SEQ;
constexpr int TC = 64;
constexpr int NCH_C = CTX / TC, NCH_L = SEQ / TC, NCH = NCH_C + NCH_L;
constexpr int T5 = 32;
constexpr int NC5 = CTX / T5, NL5 = SEQ / T5, NCH5 = NC5 + NL5;
constexpr int M5 = BATCH * NCH5;
constexpr int NMOD = BATCH + 1;
constexpr int C_RW = 0, C_RWG = 1024, C_S5 = 1280, C_S5G = 1536, C_SSD = 1792, C_SSDDT = 2304, C_SSDZ = 2312;
constexpr int C_GLA = 2568, C_GLAK = 2696, C_GLAV = 2824, C_GLAGL = 3080, C_GLAG = 3112;

constexpr size_t al256(size_t x) { return (x + 255) & ~size_t(255); }
constexpr size_t OFF_WTIN = 0;
constexpr size_t OFF_WTOUT = OFF_WTIN + al256(2ull * NINP * D * 2);
constexpr size_t OFF_W2T = OFF_WTOUT + al256(2ull * D * D * 2);
constexpr size_t OFF_A2T = OFF_W2T + al256(2ull * 2 * 256 * 64 * 2);
constexpr size_t OFF_GLUT = OFF_A2T + al256(2ull * 2 * 256 * 64 * 2);
constexpr size_t OFF_MOD = OFF_GLUT + al256(2ull * 256 * 256 * 2);
constexpr size_t OFF_S5K = OFF_MOD + al256(2ull * NMOD * 3072 * 4);
constexpr size_t OFF_S5LT = OFF_S5K + al256(2ull * 16 * 2 * 32 * 256 * 4);
constexpr size_t OFF_W1T = OFF_S5LT + al256(2ull * 16 * 2 * 64 * 2 * 4);
constexpr size_t OFF_BT2 = OFF_W1T + al256(2ull * 16 * 256 * 512 * 2);
constexpr size_t OFF_PROJ = OFF_BT2 + al256(2ull * 16 * 512 * 768 * 2);
constexpr size_t OFF_R = OFF_PROJ + al256((size_t)ROWS * NIN * 2);
constexpr size_t OFF_XA = OFF_R + al256((size_t)ROWS * 1024 * 2);
constexpr size_t OFF_HC = OFF_XA + al256((size_t)ROWS * 1024 * 2);
constexpr size_t OFF_SSDST = OFF_HC + al256((size_t)ROWS_C * 1024 * 4);
constexpr size_t OFF_SSDDEC = OFF_SSDST + al256(2ull * BATCH * NCH * 4 * 4096 * 2);
constexpr size_t OFF_GLAST = OFF_SSDDEC + al256(2ull * BATCH * NCH * 4 * 4);
constexpr size_t OFF_GLADEC = OFF_GLAST + al256(2ull * BATCH * NCH * 4 * 2048 * 2);
constexpr size_t OFF_S5ST = OFF_GLADEC + al256(2ull * BATCH * NCH * 4 * 32 * 4);
constexpr size_t OFF_SSQ = OFF_S5ST + al256(16ull * M5 * 256 * 4);
constexpr size_t OFF_BON = OFF_SSQ + al256((size_t)ROWS * 4 * 4);
constexpr size_t OFF_BAR = OFF_BON + al256((size_t)ROWS * 8 * 4);
constexpr size_t OFF_YS5 = OFF_BAR + al256(3456 * 4);
constexpr size_t WS_TOTAL = OFF_YS5 + al256((size_t)ROWS * 256 * 2);
#if BATCH == 8 && SEQ == 4096 && CTX == 256
static_assert(WS_TOTAL <= 536870912ull, "workspace too large");
#endif
constexpr int SMEM_BYTES = 64512;

struct Params {
  const float *x, *c, *ctx, *c_ctx, *ada_w, *ada_b, *norm_pre, *norm_post, *w_in, *w_out;
  const float *rw_mu, *rw_w0, *rw_w2, *rw_a0, *rw_a2, *rw_kk, *rw_ka, *rw_rk, *rw_ln_w, *rw_ln_b;
  const float *s5_a_re, *s5_a_im, *s5_log_dt, *s5_b_re, *s5_b_im, *s5_c_re, *s5_c_im, *s5_d, *s5_glu_w, *s5_glu_b;
  const float *ssd_conv_w, *ssd_conv_b, *ssd_dt_bias, *ssd_a_log, *ssd_d, *ssd_norm;
  const float *gla_g2, *gla_gb, *gla_norm;
  float* out;
  unsigned char* ws;
};

#ifdef CPU_EMU
#define OPAQUE(x)
#else
#define OPAQUE(x) asm volatile("" : "+v"(x))
#endif
struct Params;
__device__ __forceinline__ void ssd_state_item(const Params& P, int l, int item, unsigned char* sm);
__device__ __forceinline__ void gla_state_item(const Params& P, int l, int item, unsigned char* sm);
__device__ __forceinline__ void s5_state_tile(const Params& P, int l, int item, unsigned char* sm);
__device__ __forceinline__ void chunk_scans(const Params& P, int l, int base);
__device__ __forceinline__ float bf2f(bf16 v) { return __uint_as_float(((uint32_t)v) << 16); }
__device__ __forceinline__ bf16 f2bf(float f) {
  uint32_t u = __float_as_uint(f);
  u += 0x7fffu + ((u >> 16) & 1u);
  return (bf16)(u >> 16);
}
__device__ __forceinline__ uint32_t pack2(float lo, float hi) { return (uint32_t)f2bf(lo) | ((uint32_t)f2bf(hi) << 16); }
__device__ __forceinline__ float lo2f(uint32_t u) { return __uint_as_float(u << 16); }
__device__ __forceinline__ float hi2f(uint32_t u) { return __uint_as_float(u & 0xffff0000u); }
__device__ __forceinline__ float sigmoid_f(float x) { return 1.f / (1.f + __expf(-x)); }
__device__ __forceinline__ float silu_f(float x) { return x / (1.f + __expf(-x)); }
__device__ __forceinline__ float softplus_f(float x) { return fmaxf(x, 0.f) + __logf(1.f + __expf(-fabsf(x))); }
__device__ __forceinline__ float tanh_f(float x) { return 1.f - 2.f / (1.f + __expf(2.f * x)); }
__device__ __forceinline__ float gelu_f(float x) {
  return 0.5f * x * (1.f + tanh_f(0.7978845608028654f * (x + 0.044715f * x * x * x)));
}
__device__ __forceinline__ U4 zero4() { U4 r; r.a[0] = r.a[1] = r.a[2] = r.a[3] = 0; return r; }
__device__ __forceinline__ f32x16 mfma32(bf16x8 a, bf16x8 b, f32x16 c) {
#ifdef CPU_EMU
  return emu_mfma32(a, b, c);
#else
  return __builtin_amdgcn_mfma_f32_32x32x16_bf16(a, b, c, 0, 0, 0);
#endif
}
__device__ __forceinline__ f32x16 zero16() { f32x16 z; for (int i = 0; i < 16; i++) z[i] = 0.f; return z; }
__device__ __forceinline__ int acc_row(int reg, int lane) { return (reg & 3) + 8 * (reg >> 2) + 4 * (lane >> 5); }
template <int CTRL> __device__ __forceinline__ float dpp_mov(float v) {
#ifdef CPU_EMU
  int l = threadIdx.x & 63, src;
  if (CTRL == 0xB1) src = l ^ 1; else if (CTRL == 0x4E) src = l ^ 2;
  else if (CTRL == 0x141) src = (l & ~7) | (7 - (l & 7)); else src = (l & ~15) | (15 - (l & 15));
  return emu_lane_read(v, src);
#else
  return __int_as_float(__builtin_amdgcn_update_dpp(0, __float_as_int(v), CTRL, 0xF, 0xF, true));
#endif
}
__device__ __forceinline__ float sum16(float v) {
  v += dpp_mov<0xB1>(v); v += dpp_mov<0x4E>(v); v += dpp_mov<0x141>(v); v += dpp_mov<0x140>(v); return v;
}
__device__ __forceinline__ float sum32(float v) {
  v = sum16(v);
#ifdef CPU_EMU
  int l = threadIdx.x & 63; float o = emu_lane_read(v, ((l >> 4) > 0 ? ((l >> 4) - 1) * 16 + 15 : 0));
  if ((l >> 4) & 1) v += o;
#else
  v += __int_as_float(__builtin_amdgcn_update_dpp(0, __float_as_int(v), 0x142, 0xA, 0xF, false));
#endif
  return v;
}
__device__ __forceinline__ float sum64(float v) {
  v = sum16(v);
#ifdef CPU_EMU
  return emu_lane_read(v, 0) + emu_lane_read(v, 16) + emu_lane_read(v, 32) + emu_lane_read(v, 48);
#else
  int iv = __float_as_int(v);
  return __int_as_float(__builtin_amdgcn_readlane(iv, 0)) + __int_as_float(__builtin_amdgcn_readlane(iv, 16)) +
         __int_as_float(__builtin_amdgcn_readlane(iv, 32)) + __int_as_float(__builtin_amdgcn_readlane(iv, 48));
#endif
}

__device__ __forceinline__ const bf16x8& ldsfrag(const bf16* p) { return *(const bf16x8*)p; }

__device__ __forceinline__ int chunk_row0(int b, int pc, int T, int nC) {
  return pc < nC ? b * CTX + pc * T : ROWS_C + b * SEQ + (pc - nC) * T;
}
__device__ __forceinline__ int ord_chunk(int d, int vc, int nC, int nAll) {
  return d == 0 ? vc : (vc < nC ? nC - 1 - vc : nAll - 1 - (vc - nC));
}
struct RowInfo { int isctx, b, t, seq0, len; };
__device__ __forceinline__ RowInfo row_info(int m) {
  RowInfo r;
  if (m < ROWS_C) { r.isctx = 1; r.b = m / CTX; r.t = m - r.b * CTX; r.seq0 = r.b * CTX; r.len = CTX; }
  else { int q = m - ROWS_C; r.isctx = 0; r.b = q / SEQ; r.t = q - r.b * SEQ; r.seq0 = ROWS_C + r.b * SEQ; r.len = SEQ; }
  return r;
}

template <class AL, class BL, class EP>
__device__ __forceinline__ void gemm_tile(unsigned char* sm, int m0, int n0, int K, AL al, BL bl, EP ep) {
  bf16* sA0 = (bf16*)sm;
  int tid_ = threadIdx.x; OPAQUE(tid_);
  const int tid = tid_, lane = tid & 63, w = tid >> 6, wm = w >> 1, wn = w & 1;
  f32x16 acc[2][2];
#pragma unroll
  for (int i = 0; i < 2; i++)
#pragma unroll
    for (int j = 0; j < 2; j++) acc[i][j] = zero16();
  const int lr = tid >> 2, lk = (tid & 3) * 8;
  U4 ra0 = al(m0 + lr, lk), ra1 = al(m0 + lr + 64, lk), rb0 = bl(n0 + lr, lk), rb1 = bl(n0 + lr + 64, lk);
  {
    bf16* sA = sA0; bf16* sB = sA + 128 * 40;
    *(U4*)&sA[lr * 40 + lk] = ra0; *(U4*)&sA[(lr + 64) * 40 + lk] = ra1;
    *(U4*)&sB[lr * 40 + lk] = rb0; *(U4*)&sB[(lr + 64) * 40 + lk] = rb1;
  }
  if (32 < K) { ra0 = al(m0 + lr, 32 + lk); ra1 = al(m0 + lr + 64, 32 + lk); rb0 = bl(n0 + lr, 32 + lk); rb1 = bl(n0 + lr + 64, 32 + lk); }
  __syncthreads();
  int cur = 0;
#pragma unroll 1
  for (int k0 = 0; k0 < K; k0 += 32) {
    bf16* sA = sA0 + cur * (256 * 40); bf16* sB = sA + 128 * 40;
    if (k0 + 32 < K) {
      bf16* nA = sA0 + (cur ^ 1) * (256 * 40); bf16* nB = nA + 128 * 40;
      *(U4*)&nA[lr * 40 + lk] = ra0; *(U4*)&nA[(lr + 64) * 40 + lk] = ra1;
      *(U4*)&nB[lr * 40 + lk] = rb0; *(U4*)&nB[(lr + 64) * 40 + lk] = rb1;
      if (k0 + 64 < K) {
        ra0 = al(m0 + lr, k0 + 64 + lk); ra1 = al(m0 + lr + 64, k0 + 64 + lk);
        rb0 = bl(n0 + lr, k0 + 64 + lk); rb1 = bl(n0 + lr + 64, k0 + 64 + lk);
      }
    }
#pragma unroll
    for (int ks = 0; ks < 32; ks += 16) {
      bf16x8 fa[2], fb[2];
#pragma unroll
      for (int i = 0; i < 2; i++) fa[i] = ldsfrag(&sA[(wm * 64 + i * 32 + (lane & 31)) * 40 + ks + 8 * (lane >> 5)]);
#pragma unroll
      for (int j = 0; j < 2; j++) fb[j] = ldsfrag(&sB[(wn * 64 + j * 32 + (lane & 31)) * 40 + ks + 8 * (lane >> 5)]);
#pragma unroll
      for (int i = 0; i < 2; i++)
#pragma unroll
        for (int j = 0; j < 2; j++) acc[i][j] = mfma32(fa[i], fb[j], acc[i][j]);
    }
    __syncthreads();
    cur ^= 1;
  }
#pragma unroll
  for (int i = 0; i < 2; i++)
#pragma unroll
   for (int j = 0; j < 2; j++)
#pragma unroll
    for (int r = 0; r < 16; r++)
      ep(m0 + wm * 64 + i * 32 + acc_row(r, lane), n0 + wn * 64 + j * 32 + (lane & 31), acc[i][j][r]);
}

template <class AL, class BL, class EP>
__device__ __forceinline__ void gemm_tile_big(unsigned char* sm, int m0, int n0, int K, AL al, BL bl, EP ep) {
  bf16* sA0 = (bf16*)sm;
  int tid_ = threadIdx.x; OPAQUE(tid_);
  const int tid = tid_, lane = tid & 63, w = tid >> 6, wm = w >> 1, wn = w & 1;
  f32x16 acc[4][2];
#pragma unroll
  for (int i = 0; i < 4; i++)
#pragma unroll
    for (int j = 0; j < 2; j++) acc[i][j] = zero16();
  const int lr = tid >> 2, lk = (tid & 3) * 8;
  U4 ra[4], rb[2];
#pragma unroll
  for (int i = 0; i < 4; i++) ra[i] = al(m0 + lr + 64 * i, lk);
#pragma unroll
  for (int i = 0; i < 2; i++) rb[i] = bl(n0 + lr + 64 * i, lk);
  {
    bf16* sA = sA0; bf16* sB = sA + 256 * 40;
#pragma unroll
    for (int i = 0; i < 4; i++) *(U4*)&sA[(lr + 64 * i) * 40 + lk] = ra[i];
#pragma unroll
    for (int i = 0; i < 2; i++) *(U4*)&sB[(lr + 64 * i) * 40 + lk] = rb[i];
  }
  if (32 < K) {
#pragma unroll
    for (int i = 0; i < 4; i++) ra[i] = al(m0 + lr + 64 * i, 32 + lk);
#pragma unroll
    for (int i = 0; i < 2; i++) rb[i] = bl(n0 + lr + 64 * i, 32 + lk);
  }
  __syncthreads();
  int cur = 0;
#pragma unroll 2
  for (int k0 = 0; k0 < K; k0 += 32) {
    bf16* sA = sA0 + cur * (384 * 40); bf16* sB = sA + 256 * 40;
    if (k0 + 32 < K) {
      bf16* nA = sA0 + (cur ^ 1) * (384 * 40); bf16* nB = nA + 256 * 40;
#pragma unroll
      for (int i = 0; i < 4; i++) *(U4*)&nA[(lr + 64 * i) * 40 + lk] = ra[i];
#pragma unroll
      for (int i = 0; i < 2; i++) *(U4*)&nB[(lr + 64 * i) * 40 + lk] = rb[i];
      if (k0 + 64 < K) {
#pragma unroll
        for (int i = 0; i < 4; i++) ra[i] = al(m0 + lr + 64 * i, k0 + 64 + lk);
#pragma unroll
        for (int i = 0; i < 2; i++) rb[i] = bl(n0 + lr + 64 * i, k0 + 64 + lk);
      }
    }
#pragma unroll
    for (int ks = 0; ks < 32; ks += 16) {
      bf16x8 fa[4], fb[2];
#pragma unroll
      for (int i = 0; i < 4; i++) fa[i] = ldsfrag(&sA[(wm * 128 + i * 32 + (lane & 31)) * 40 + ks + 8 * (lane >> 5)]);
#pragma unroll
      for (int j = 0; j < 2; j++) fb[j] = ldsfrag(&sB[(wn * 64 + j * 32 + (lane & 31)) * 40 + ks + 8 * (lane >> 5)]);
#pragma unroll
      for (int i = 0; i < 4; i++)
#pragma unroll
        for (int j = 0; j < 2; j++) acc[i][j] = mfma32(fa[i], fb[j], acc[i][j]);
    }
    __syncthreads();
    cur ^= 1;
  }
#pragma unroll
  for (int i = 0; i < 4; i++)
#pragma unroll
    for (int j = 0; j < 2; j++)
#pragma unroll
      for (int r = 0; r < 16; r++)
        ep(m0 + wm * 128 + i * 32 + acc_row(r, lane), n0 + wn * 64 + j * 32 + (lane & 31), acc[i][j][r]);
}

#define ITEM_LOOP(var, count, base) _Pragma("unroll 1") for (int var = (int)((blockIdx.x + gridDim.x - ((unsigned)(base) % gridDim.x)) % gridDim.x); var < (count); var += gridDim.x)
#define WS(T, off) ((T*)(P.ws + (off)))

__device__ __forceinline__ void transpose_tile(const float* src, int ld, int Ksz, int Nsz, bf16* dst, int kt, int nt, unsigned char* sm, bool perm = false) {
  float* s = (float*)sm;
  const int tid = threadIdx.x;
#pragma unroll 8
  for (int i = tid; i < 4096; i += 256) {
    int kk = i >> 6, nn = i & 63;
    int k = kt * 64 + kk, n = nt * 64 + nn;
    s[kk * 65 + nn] = (n < Nsz && k < Ksz) ? src[(size_t)k * ld + n] : 0.f;
  }
  __syncthreads();
#pragma unroll 8
  for (int i = tid; i < 4096; i += 256) {
    int nn = i >> 6, kk = i & 63;
    int ktd = perm ? (kt < 4 ? kt + 8 : (kt >= 8 && kt < 12) ? kt - 8 : kt) : kt;
    dst[(size_t)(nt * 64 + nn) * Ksz + ktd * 64 + kk] = f2bf(s[kk * 65 + nn]);
  }
  __syncthreads();
}

struct S5c { float lr, li, dt; };
__device__ __forceinline__ void s5_pow(const Params& P, int l, int d, int g, int p, float e, float& re, float& im) {
  int idx = ((l * 2 + d) * 16 + g) * 64 + p;
  float dt = __expf(P.s5_log_dt[(l * 2 + d) * 16 + g]);
  float ar = P.s5_a_re[idx] * dt * e, ai = P.s5_a_im[idx] * dt * e;
  float m = expf(ar);
  re = m * cosf(ai); im = m * sinf(ai);
}
__device__ __forceinline__ void s5_bbar_coef(const Params& P, int l, int d, int g, int p, float& re, float& im) {
  int idx = ((l * 2 + d) * 16 + g) * 64 + p;
  float lr = P.s5_a_re[idx], li = P.s5_a_im[idx];
  float br, bi; s5_pow(P, l, d, g, p, 1.f, br, bi);
  br -= 1.f;
  float den = lr * lr + li * li;
  re = (br * lr + bi * li) / den;
  im = (bi * lr - br * li) / den;
}

__device__ __forceinline__ void phase_prologue(const Params& P, unsigned char* sm) {
  const int tid = threadIdx.x;
  const int N_TIN = 2 * 16 * (NINP / 64);
  const int N_TOUT = 2 * 16 * 16;
  const int N_TL = 2 * 2 * 4;
  const int N_TA = 2 * 2 * 4;
  const int N_TG = 2 * 16;
  const int N_MOD = 2 * 48;
  const int N_S5K = 2 * 16 * 2 * 32;
  const int N_S5W1 = 2 * 16 * 32;
  const int N_S5B2 = 2 * 16 * 32;
  const int total = N_TIN + N_TOUT + N_TL + N_TA + N_TG + N_MOD + N_S5K + N_S5W1 + N_S5B2;
#pragma unroll 1
  for (int it = blockIdx.x; it < total; it += gridDim.x) {
    int i = it;
    if (i < N_TIN) {
      int l = i / (16 * (NINP / 64)), r = i % (16 * (NINP / 64));
      transpose_tile(P.w_in + (size_t)l * D * NIN, NIN, D, NIN, WS(bf16, OFF_WTIN) + (size_t)l * NINP * D, r % 16, r / 16, sm);
      continue;
    }
    i -= N_TIN;
    if (i < N_TOUT) {
      int l = i / 256, r = i % 256;
      transpose_tile(P.w_out + (size_t)l * D * D, D, D, D, WS(bf16, OFF_WTOUT) + (size_t)l * D * D, r % 16, r / 16, sm, true);
      continue;
    }
    i -= N_TOUT;
    if (i < N_TL) {
      int ld = i / 4, nt = i % 4;
      transpose_tile(P.rw_w2 + (size_t)ld * 64 * 256, 256, 64, 256, WS(bf16, OFF_W2T) + (size_t)ld * 256 * 64, 0, nt, sm);
      continue;
    }
    i -= N_TL;
    if (i < N_TA) {
      int ld = i / 4, nt = i % 4;
      transpose_tile(P.rw_a2 + (size_t)ld * 64 * 256, 256, 64, 256, WS(bf16, OFF_A2T) + (size_t)ld * 256 * 64, 0, nt, sm);
      continue;
    }
    i -= N_TA;
    if (i < N_TG) {
      int l = i / 16, r = i % 16;
      transpose_tile(P.s5_glu_w + (size_t)l * 256 * 256, 256, 256, 256, WS(bf16, OFF_GLUT) + (size_t)l * 256 * 256, r % 4, r / 4, sm);
      continue;
    }
    i -= N_TG;
    if (i < N_MOD) {
      int l = i / 48, ct = i % 48;
      float* ssil = (float*)sm;
      float* red = ssil + NMOD * 1024;
#pragma unroll 8
      for (int e = tid; e < NMOD * 1024; e += 256) {
        int r = e >> 10, k = e & 1023;
        float v = r < BATCH ? P.c[r * 1024 + k] : P.c_ctx[k];
        ssil[e] = silu_f(v);
      }
      __syncthreads();
      int kq = tid >> 6, jj = tid & 63, j = ct * 64 + jj;
      float acc[NMOD];
      for (int r = 0; r < NMOD; r++) acc[r] = 0.f;
      const float* wp = P.ada_w + (size_t)l * D * 3072 + j;
#pragma unroll 16
      for (int k = kq * 256; k < kq * 256 + 256; k++) {
        float wv = wp[(size_t)k * 3072];
#pragma unroll
        for (int r = 0; r < NMOD; r++) acc[r] += ssil[r * 1024 + k] * wv;
      }
#pragma unroll
      for (int r = 0; r < NMOD; r++) red[(kq * NMOD + r) * 64 + jj] = acc[r];
      __syncthreads();
#pragma unroll 8
      for (int e = tid; e < NMOD * 64; e += 256) {
        int r = e >> 6, j2 = e & 63;
        float s = red[(0 * NMOD + r) * 64 + j2] + red[(1 * NMOD + r) * 64 + j2] + red[(2 * NMOD + r) * 64 + j2] + red[(3 * NMOD + r) * 64 + j2];
        WS(float, OFF_MOD)[((size_t)l * NMOD + r) * 3072 + ct * 64 + j2] = s + P.ada_b[l * 3072 + ct * 64 + j2];
      }
      __syncthreads();
      continue;
    }
    i -= N_MOD;
    if (i < N_S5K) {
      int m = i & 31, d = (i >> 5) & 1, g = (i >> 6) & 15, l = i >> 10;
      float* spw = (float*)sm;
      if (tid < 64) {
        float pr, pi, cr, ci;
        s5_pow(P, l, d, g, tid, (float)m, pr, pi);
        s5_bbar_coef(P, l, d, g, tid, cr, ci);
        spw[tid * 2] = pr * cr - pi * ci; spw[tid * 2 + 1] = pr * ci + pi * cr;
      }
      __syncthreads();
      int c = tid >> 4, cp = tid & 15;
      size_t bb = ((size_t)((l * 2 + d) * 16 + g) * 64) * 16;
      size_t cb = ((size_t)((l * 2 + d) * 16 + g) * 16 + c) * 64;
      float s = 0.f;
#pragma unroll 8
      for (int p = 0; p < 64; p++) {
        float wr = spw[p * 2], wi = spw[p * 2 + 1];
        float br = P.s5_b_re[bb + p * 16 + cp], bi = P.s5_b_im[bb + p * 16 + cp];
        float zr = wr * br - wi * bi, zi = wr * bi + wi * br;
        float cr = P.s5_c_re[cb + p], ci = P.s5_c_im[cb + p];
        s += cr * zr - ci * zi;
      }
      WS(float, OFF_S5K)[((size_t)(((l * 16 + g) * 2 + d) * 32 + m)) * 256 + tid] = s;
      __syncthreads();
      continue;
    }
    i -= N_S5K;
    if (i < N_S5W1) {
      int j = i & 31, g = (i >> 5) & 15, l = i >> 9;
      int pp = tid, d = pp >> 7, ri = (pp >> 6) & 1, p = pp & 63;
      float e = d == 0 ? (float)(T5 - 1 - j) : (float)j;
      float pr, pi, cr, ci;
      s5_pow(P, l, d, g, p, e, pr, pi);
      s5_bbar_coef(P, l, d, g, p, cr, ci);
      float wr = pr * cr - pi * ci, wi = pr * ci + pi * cr;
      size_t bb = ((size_t)((l * 2 + d) * 16 + g) * 64 + p) * 16;
      bf16* dst = WS(bf16, OFF_W1T) + ((size_t)(l * 16 + g) * 256 + pp) * 512 + j * 16;
      for (int cp = 0; cp < 16; cp++) {
        float br = P.s5_b_re[bb + cp], bi = P.s5_b_im[bb + cp];
        float zr = wr * br - wi * bi, zi = wr * bi + wi * br;
        dst[cp] = f2bf(ri == 0 ? zr : zi);
      }
      if (j == 0 && ri == 0) {
        float tr, ti; s5_pow(P, l, d, g, p, (float)T5, tr, ti);
        float* lt = WS(float, OFF_S5LT) + ((size_t)((l * 16 + g) * 2 + d) * 64 + p) * 2;
        lt[0] = tr; lt[1] = ti;
      }
      continue;
    }
    i -= N_S5W1;
    {
      int t = i & 31, g = (i >> 5) & 15, l = i >> 9;
      int kk = tid, d = kk >> 7, ri = (kk >> 6) & 1, p = kk & 63;
      float e = d == 0 ? (float)(t + 1) : (float)(T5 - t);
      float pr, pi; s5_pow(P, l, d, g, p, e, pr, pi);
      for (int c = 0; c < 16; c++) {
        size_t cb = ((size_t)((l * 2 + d) * 16 + g) * 16 + c) * 64 + p;
        float cr = P.s5_c_re[cb], ci = P.s5_c_im[cb];
        float zr = cr * pr - ci * pi, zi = cr * pi + ci * pr;
        WS(bf16, OFF_BT2)[((size_t)(l * 16 + g) * 512 + t * 16 + c) * 768 + 512 + kk] = f2bf(ri == 0 ? zr : -zi);
      }
    }
  }
}

__device__ __forceinline__ void s5_toeplitz_items(const Params& P, int item) {
  int t = item & 31, g = (item >> 5) & 15, l = item >> 9;
  const float* K = WS(float, OFF_S5K) + (size_t)((l * 16 + g) * 2) * 32 * 256;
  bf16* dst = WS(bf16, OFF_BT2) + ((size_t)(l * 16 + g) * 512 + t * 16) * 768;
#pragma unroll 8
  for (int e = threadIdx.x; e < 16 * 512; e += 256) {
    int c = e >> 9, k = e & 511, j = k >> 4, cp = k & 15;
    float v;
    if (j < t) v = K[((0 * 32) + (t - j)) * 256 + c * 16 + cp];
    else if (j > t) v = K[((1 * 32) + (j - t)) * 256 + c * 16 + cp];
    else v = K[(0 * 32) * 256 + c * 16 + cp] + K[(1 * 32) * 256 + c * 16 + cp];
    dst[(size_t)c * 768 + k] = f2bf(v);
  }
}

__device__ __forceinline__ void phase_normmod(const Params& P, int l) {
  const int lane = threadIdx.x & 63, w = threadIdx.x >> 6;
  const int nrow_items = ROWS / 4;
  const int n_toe = (l == 0) ? 2 * 16 * 32 : 0;
#pragma unroll 1
  for (int it = blockIdx.x; it < nrow_items + n_toe; it += gridDim.x) {
    if (it >= nrow_items) { s5_toeplitz_items(P, it - nrow_items); continue; }
    int m = it * 4 + w;
    RowInfo ri = row_info(m);
    const float* src;
    if (ri.isctx) src = (l == 0 ? P.ctx : WS(float, OFF_HC)) + (size_t)m * D;
    else src = (l == 0 ? P.x : P.out) + (size_t)(m - ROWS_C) * D;
    const float* mod = WS(float, OFF_MOD) + ((size_t)l * NMOD + (ri.isctx ? BATCH : ri.b)) * 3072;
    F4 v[4]; float ss = 0.f;
    for (int q = 0; q < 4; q++) {
      v[q] = *(const F4*)(src + q * 256 + lane * 4);
      for (int e = 0; e < 4; e++) ss += v[q].a[e] * v[q].a[e];
    }
    ss = sum64(ss);
    float rstd = rsqrtf(ss * (1.f / 1024.f) + 1e-6f);
    bf16* dst = WS(bf16, OFF_R) + (size_t)m * D;
    for (int q = 0; q < 4; q++) {
      int c0 = q * 256 + lane * 4;
      float o[4];
      for (int e = 0; e < 4; e++) {
        int c = c0 + e;
        o[e] = v[q].a[e] * rstd * P.norm_pre[l * D + c] * (1.f + mod[1024 + c]) + mod[c];
      }
      U2 pk; pk.a[0] = pack2(o[0], o[1]); pk.a[1] = pack2(o[2], o[3]);
      *(U2*)(dst + c0) = pk;
    }
  }
}

__device__ __forceinline__ void phase_inproj(const Params& P, int l, unsigned char* sm) {
  const bf16* A = WS(bf16, OFF_R);
  const bf16* Bt = WS(bf16, OFF_WTIN) + (size_t)l * NINP * D;
  bf16* C = WS(bf16, OFF_PROJ);
  const int NT = NINP / 128, MT = ROWS / 256;
  const int total = MT * NT, per = total / 8;
  const int nfull = (total / (int)gridDim.x) * (int)gridDim.x;
#pragma unroll 1
  for (int it0 = blockIdx.x; it0 < nfull; it0 += gridDim.x) {
    int it = total % 8 == 0 ? (it0 & 7) * per + (it0 >> 3) : it0;
    int mt = it / NT, nt = it % NT;
    gemm_tile_big(sm, mt * 256, nt * 128, D,
      [&](int m, int k) { return *(const U4*)(A + (size_t)m * D + k); },
      [&](int n, int k) { return *(const U4*)(Bt + (size_t)n * D + k); },
      [&](int m, int n, float v) { if (n < NIN) C[(size_t)m * NIN + n] = f2bf(v); });
  }
#pragma unroll 1
  for (int q = blockIdx.x; q < 2 * (total - nfull); q += gridDim.x) {
    int it0 = nfull + (q >> 1), half = q & 1;
    int it = total % 8 == 0 ? (it0 & 7) * per + (it0 >> 3) : it0;
    int mt = it / NT, nt = it % NT;
    gemm_tile(sm, mt * 256 + half * 128, nt * 128, D,
      [&](int m, int k) { return *(const U4*)(A + (size_t)m * D + k); },
      [&](int n, int k) { return *(const U4*)(Bt + (size_t)n * D + k); },
      [&](int m, int n, float v) { if (n < NIN) C[(size_t)m * NIN + n] = f2bf(v); });
  }
}

__device__ __forceinline__ void rw_lerp4(const Params& P, int l, int m, int ms, int col, float* o) {
  const bf16* pr = WS(bf16, OFF_PROJ);
  U2 z = *(const U2*)(pr + (size_t)m * NIN + col);
  U2 zs; zs.a[0] = zs.a[1] = 0;
  if (ms >= 0) zs = *(const U2*)(pr + (size_t)ms * NIN + col);
  const float* mu = P.rw_mu + l * 1024 + col;
#pragma unroll
  for (int e = 0; e < 2; e++) {
    float a0 = lo2f(z.a[e]), a1 = hi2f(z.a[e]), s0 = lo2f(zs.a[e]), s1 = hi2f(zs.a[e]);
    o[2 * e] = a0 + mu[2 * e] * (s0 - a0);
    o[2 * e + 1] = a1 + mu[2 * e + 1] * (s1 - a1);
  }
}
__device__ __forceinline__ void phase_rwprep(const Params& P, int l, unsigned char* sm) {
  const int lane = threadIdx.x & 63, w = threadIdx.x >> 6;
  const int MT = ROWS / 128;
  const int n_gemm = MT * 2 * 4;
  const int n_rows = ROWS / 4;
  bf16* XA = WS(bf16, OFF_XA);
#pragma unroll 1
  for (int it = blockIdx.x; it < n_gemm + n_rows; it += gridDim.x) {
    if (it < n_gemm) {
      int kind = it & 3, nt = (it >> 2) & 1, mt = it >> 3;
      int isA = kind >> 1, d = kind & 1;
      const bf16* Bt = (isA ? WS(bf16, OFF_A2T) : WS(bf16, OFF_W2T)) + (size_t)(l * 2 + d) * 256 * 64;
      const float* bias = (isA ? P.rw_a0 : P.rw_w0) + (l * 2 + d) * 256;
      gemm_tile(sm, mt * 128, nt * 128, 64,
        [&](int m, int k) {
          RowInfo ri = row_info(m);
          int ms;
          if (ri.isctx) ms = ri.t < CTX - 1 ? m + 1 : -1; else ms = ri.t < SEQ - 64 ? m + 64 : -1;
          int col = 768 + isA * 128 + d * 64 + k;
          const bf16* prj = WS(bf16, OFF_PROJ);
          U4 z = *(const U4*)(prj + (size_t)m * NIN + col);
          U4 zs = ms >= 0 ? *(const U4*)(prj + (size_t)ms * NIN + col) : zero4();
          const float* mu = P.rw_mu + l * 1024 + col;
          U4 r;
#pragma unroll
          for (int e = 0; e < 4; e++) {
            float a0 = lo2f(z.a[e]), a1 = hi2f(z.a[e]), s0 = lo2f(zs.a[e]), s1 = hi2f(zs.a[e]);
            float o0 = a0 + mu[2 * e] * (s0 - a0), o1 = a1 + mu[2 * e + 1] * (s1 - a1);
            if (!isA) { o0 = tanh_f(o0); o1 = tanh_f(o1); }
            r.a[e] = pack2(o0, o1);
          }
          return r;
        },
        [&](int n, int k) { return *(const U4*)(Bt + (size_t)n * 64 + k); },
        [&](int m, int n, float v) {
          v += bias[n];
          float o;
          if (!isA) { o = -__expf(-softplus_f(-v) - 0.5f); }
          else o = sigmoid_f(v);
          XA[(size_t)m * 1024 + isA * 512 + d * 256 + n] = f2bf(o);
        });
      continue;
    }
    int m = (it - n_gemm) * 4 + w;
    RowInfo ri = row_info(m);
    int ms_r, ms_k, ms_v;
    if (ri.isctx) { ms_r = ms_k = ri.t > 0 ? m - 1 : -1; ms_v = ri.t < CTX - 1 ? m + 1 : -1; }
    else {
      int gx = ri.t & 63;
      ms_r = gx > 0 ? m - 1 : -1; ms_k = gx < 63 ? m + 1 : -1; ms_v = ri.t >= 64 ? m - 64 : -1;
    }
    bf16* R = WS(bf16, OFF_R) + (size_t)m * 1024;
    float rr[4], kk[4], vv[4], kap[4];
    rw_lerp4(P, l, m, ms_r, lane * 4, rr);
    rw_lerp4(P, l, m, ms_k, 256 + lane * 4, kk);
    rw_lerp4(P, l, m, ms_v, 512 + lane * 4, vv);
    float ss = 0.f;
    for (int e = 0; e < 4; e++) { kap[e] = kk[e] * P.rw_kk[l * 256 + lane * 4 + e]; ss += kap[e] * kap[e]; }
    ss = sum16(ss);
    float rs = rsqrtf(ss + 1e-6f);
    U2 o;
    o.a[0] = pack2(rr[0], rr[1]); o.a[1] = pack2(rr[2], rr[3]); *(U2*)(R + lane * 4) = o;
    o.a[0] = pack2(kk[0], kk[1]); o.a[1] = pack2(kk[2], kk[3]); *(U2*)(R + 256 + lane * 4) = o;
    o.a[0] = pack2(vv[0], vv[1]); o.a[1] = pack2(vv[2], vv[3]); *(U2*)(R + 512 + lane * 4) = o;
    o.a[0] = pack2(kap[0] * rs, kap[1] * rs); o.a[1] = pack2(kap[2] * rs, kap[3] * rs); *(U2*)(R + 768 + lane * 4) = o;
  }
  {
    const int n_ssd = BATCH * NCH * 8, n_gla = BATCH * NCH * 8, n_s5 = 16 * ((M5 + 127) / 128) * 2, base0 = n_gemm + n_rows;
    ITEM_LOOP(i, n_ssd, base0) ssd_state_item(P, l, i, sm);
    ITEM_LOOP(i, n_gla, base0 + n_ssd) gla_state_item(P, l, i, sm);
    ITEM_LOOP(i, n_s5, base0 + n_ssd + n_gla) s5_state_tile(P, l, i, sm);
  }
}

__device__ __forceinline__ bf16x8 gfrag(const bf16* base, int ld, int row, int k) {
  return *(const bf16x8*)(base + (size_t)row * ld + k);
}
__device__ __forceinline__ void wave_sync() {
#ifdef CPU_EMU
  pthread_barrier_wait(&g_wavebar[threadIdx.x >> 6]);
#else
  __builtin_amdgcn_wave_barrier();
#endif
}
__device__ __forceinline__ void store_acc_T(bf16* dst, int ld, int row_base, int col, const f32x16& acc, int lane) {
#pragma unroll
  for (int g = 0; g < 4; g++) {
    U2 o; o.a[0] = pack2(acc[4 * g], acc[4 * g + 1]); o.a[1] = pack2(acc[4 * g + 2], acc[4 * g + 3]);
    *(U2*)&dst[col * ld + row_base + 8 * g + 4 * (lane >> 5)] = o;
  }
}
__device__ __forceinline__ void rwkv_chunk_item(const Params& P, int l, int item, unsigned char* sm, long long& pacc) {
  long long tp0_ = 0; if (PROBE_PHASE >= 33 && PROBE_PHASE <= 36) tp0_ = wall_clock64();
  int tid_ = threadIdx.x; OPAQUE(tid_);
  const int tid = tid_, lane = tid & 63, w = tid >> 6, ti = w >> 1, tj = w & 1;
  const int lr = lane & 31, lh = lane >> 5;
  const int d = item & 1, h = (item >> 1) & 3, rest = item >> 3;
  const int pc = rest % NCH, b = rest / NCH;
  const int row0 = chunk_row0(b, pc, TC, NCH_C);
  float* sL = (float*)sm;
  bf16* sG1t = (bf16*)sm;
  bf16* sKT = (bf16*)(sm + 16640);
  bf16* sBT = sKT + 64 * 72;
  bf16* sKD = sBT + 64 * 72;
  bf16* sRT = sKD + 64 * 72;
  bf16* sVt = sRT + 64 * 72;
  float* sGT = (float*)(sVt + 64 * 72);
  bf16* X0 = WS(bf16, OFF_XA) + (size_t)row0 * 1024 + d * 256 + h * 64;
  bf16* X1 = X0 + 512;
  bf16* P0 = WS(bf16, OFF_PROJ) + (size_t)row0 * NIN + (h * 2 + d) * 128;
  bf16* P1 = P0 + 64;
  const bf16* Rb = WS(bf16, OFF_R) + (size_t)row0 * 1024 + h * 64;
  float rq[16], kq[16], pq[16], vq[16];
#pragma unroll
  for (int i = 0; i < 16; i++) {
    const bf16* rp = Rb + (size_t)(w + 4 * i) * 1024 + lane;
    rq[i] = bf2f(rp[0]); kq[i] = bf2f(rp[256]); vq[i] = bf2f(rp[512]); pq[i] = bf2f(rp[768]);
  }
#pragma unroll 8
  for (int idx = tid; idx < 4096; idx += 256) {
    int p = idx >> 6, k = idx & 63;
    sL[p * 65 + k] = bf2f(X0[(size_t)p * 1024 + k]);
    sVt[idx] = X1[(size_t)p * 1024 + k];
  }
  __syncthreads();
  {
    const int k = tid & 63, qq = tid >> 6;
    float* qt = sGT + 64 + 128;
    float run = 0.f;
    if (d == 0) { for (int p = qq * 16; p < qq * 16 + 16; p++) { run += sL[p * 65 + k]; sL[p * 65 + k] = run; } }
    else { for (int p = qq * 16 + 15; p >= qq * 16; p--) { run += sL[p * 65 + k]; sL[p * 65 + k] = run; } }
    qt[qq * 64 + k] = run;
    __syncthreads();
    float off = 0.f;
    if (d == 0) { for (int j = 0; j < qq; j++) off += qt[j * 64 + k]; }
    else { for (int j = 3; j > qq; j--) off += qt[j * 64 + k]; }
    for (int p = qq * 16; p < qq * 16 + 16; p++) sL[p * 65 + k] += off;
    if (qq == 0) sGT[k] = qt[k] + qt[64 + k] + qt[128 + k] + qt[192 + k];
  }
  __syncthreads();
  if (PROBE_PHASE == 35) pacc += wall_clock64() - tp0_;
  {
    const int k = lane;
    const float ka = P.rw_ka[l * 256 + h * 64 + k], rk = P.rw_rk[l * 256 + h * 64 + k];
#pragma unroll
    for (int i = 0; i < 16; i++) {
      const int p = w + 4 * i;
      float incl = sL[p * 65 + k];
      int pp = d == 0 ? p - 1 : p + 1;
      float excl = (pp < 0 || pp > 63) ? 0.f : sL[pp * 65 + k];
      float rr = rq[i], kk = kq[i], kap = pq[i];
      float a = bf2f(sVt[p * 64 + k]);
      float kd = kk * (1.f + (a - 1.f) * ka), beta = kap * a;
      float ei = __expf(incl), eni = __expf(-incl), ee = __expf(excl);
      sKT[p * 72 + k] = f2bf(kap * ee);
      sBT[p * 72 + k] = f2bf(beta * eni);
      sKD[p * 72 + k] = f2bf(kd * eni);
      sRT[p * 72 + k] = f2bf(rr * ei);
      float bs = sum64(rr * kd * rk);
      if (lane == 0) WS(float, OFF_BON)[(size_t)(row0 + p) * 8 + h * 2 + d] = bs;
    }
  }
  __syncthreads();
#pragma unroll 8
  for (int idx = tid; idx < 4096; idx += 256) {
    int kk = idx >> 6, p = idx & 63;
    P0[(size_t)kk * NIN + p] = sKT[p * 72 + kk];
    P1[(size_t)kk * NIN + p] = sBT[p * 72 + kk];
    X1[(size_t)kk * 1024 + p] = sKD[p * 72 + kk];
    X0[(size_t)kk * 1024 + p] = sRT[kk * 72 + p];
  }
  if (PROBE_PHASE == 36) pacc += wall_clock64() - tp0_;
  f32x16 aA = zero16(), aB = zero16(), aC = zero16(), aD = zero16();
#pragma unroll
  for (int ks = 0; ks < 64; ks += 16) {
    bf16x8 fK = ldsfrag(&sKT[(ti * 32 + lr) * 72 + ks + 8 * lh]);
    bf16x8 fR = ldsfrag(&sRT[(ti * 32 + lr) * 72 + ks + 8 * lh]);
    bf16x8 fB = ldsfrag(&sBT[(tj * 32 + lr) * 72 + ks + 8 * lh]);
    bf16x8 fD = ldsfrag(&sKD[(tj * 32 + lr) * 72 + ks + 8 * lh]);
    aA = mfma32(fK, fB, aA); aB = mfma32(fK, fD, aB); aC = mfma32(fR, fB, aC); aD = mfma32(fR, fD, aD);
  }
  __syncthreads();
  {
    int s_ = tj * 32 + lr;
#pragma unroll
    for (int r = 0; r < 16; r++) {
      int p = ti * 32 + acc_row(r, lane);
      bool earlier = d == 0 ? s_ < p : s_ > p;
      bool eq = s_ == p;
      sL[p * 65 + s_] = earlier ? aA[r] : 0.f;
      sKT[p * 72 + s_] = f2bf(earlier ? aB[r] : 0.f);
      sBT[p * 72 + s_] = f2bf((earlier || eq) ? aC[r] : 0.f);
      sKD[p * 72 + s_] = f2bf((earlier || eq) ? aD[r] : 0.f);
    }
  }
#pragma unroll
  for (int i = 0; i < 16; i++) sVt[lane * 72 + w + 4 * i] = f2bf(vq[i]);
  __syncthreads();
  if (PROBE_PHASE == 33) pacc += wall_clock64() - tp0_;
  bf16x8 fKt[4];
#pragma unroll
  for (int q4 = 0; q4 < 4; q4++) fKt[q4] = gfrag(P0, NIN, tj * 32 + lr, q4 * 16 + 8 * lh);
  bf16* sTinv = sRT;
  {
    const int q = tid >> 2, seg = tid & 3;
    float x[16];
#pragma unroll
    for (int i = 0; i < 16; i++) x[i] = (q == seg * 16 + i) ? 1.f : 0.f;
    float* rowbuf = (float*)sRT;
#pragma unroll 1
    for (int Bi = 0; Bi < 4; Bi++) {
      const int B = d == 0 ? Bi : 3 - Bi;
      float* rb = rowbuf + (Bi & 1) * 1024;
      if (w == B) {
#pragma unroll 1
        for (int s_ = 0; s_ < 16; s_++) {
          const int pl = d == 0 ? s_ : 15 - s_, p = B * 16 + pl;
          if (q == p) {
#pragma unroll
            for (int i = 0; i < 4; i++) { F4 o; o.a[0] = x[4 * i]; o.a[1] = x[4 * i + 1]; o.a[2] = x[4 * i + 2]; o.a[3] = x[4 * i + 3]; *(F4*)&rb[pl * 64 + seg * 16 + 4 * i] = o; }
          }
          wave_sync();
          const bool later = d == 0 ? q > p : q < p;
          if (later) {
            const float m = sL[q * 65 + p];
#pragma unroll
            for (int i = 0; i < 4; i++) {
              F4 o = *(const F4*)&rb[pl * 64 + seg * 16 + 4 * i];
              x[4 * i] -= m * o.a[0]; x[4 * i + 1] -= m * o.a[1]; x[4 * i + 2] -= m * o.a[2]; x[4 * i + 3] -= m * o.a[3];
            }
          }
        }
      }
      __syncthreads();
      const bool laterblock = d == 0 ? w > B : w < B;
      if (laterblock) {
#pragma unroll 4
        for (int pl = 0; pl < 16; pl++) {
          const float m = sL[q * 65 + B * 16 + pl];
#pragma unroll
          for (int i = 0; i < 4; i++) {
            F4 o = *(const F4*)&rb[pl * 64 + seg * 16 + 4 * i];
            x[4 * i] -= m * o.a[0]; x[4 * i + 1] -= m * o.a[1]; x[4 * i + 2] -= m * o.a[2]; x[4 * i + 3] -= m * o.a[3];
          }
        }
      }
    }
    __syncthreads();
#pragma unroll
    for (int i = 0; i < 8; i++) *(uint32_t*)&sTinv[q * 72 + seg * 16 + 2 * i] = pack2(x[2 * i], x[2 * i + 1]);
  }
  __syncthreads();
  if (PROBE_PHASE == 34) pacc += wall_clock64() - tp0_;
  {
    f32x16 aBV = zero16(), aG1 = zero16();
#pragma unroll
    for (int ks = 0; ks < 64; ks += 16) {
      aBV = mfma32(ldsfrag(&sKT[(ti * 32 + lr) * 72 + ks + 8 * lh]), ldsfrag(&sVt[(tj * 32 + lr) * 72 + ks + 8 * lh]), aBV);
      aG1 = mfma32(ldsfrag(&sTinv[(ti * 32 + lr) * 72 + ks + 8 * lh]), fKt[ks >> 4], aG1);
    }
    __syncthreads();
    store_acc_T(sKT, 72, ti * 32, tj * 32 + lr, aBV, lane);
    store_acc_T(sG1t, 72, ti * 32, tj * 32 + lr, aG1, lane);
  }
  __syncthreads();
  bf16x8 fKd4[4], fBt4[4]; float rtc[16];
#pragma unroll
  for (int q4 = 0; q4 < 4; q4++) { fKd4[q4] = gfrag(X1, 1024, ti * 32 + lr, q4 * 16 + 8 * lh); fBt4[q4] = gfrag(P1, NIN, ti * 32 + lr, q4 * 16 + 8 * lh); }
#pragma unroll
  for (int r = 0; r < 16; r++) rtc[r] = bf2f(X0[(size_t)(ti * 32 + acc_row(r, lane)) * 1024 + tj * 32 + lr]);
  {
    f32x16 aG2 = zero16();
#pragma unroll
    for (int ks = 0; ks < 64; ks += 16)
      aG2 = mfma32(ldsfrag(&sTinv[(ti * 32 + lr) * 72 + ks + 8 * lh]), ldsfrag(&sKT[(tj * 32 + lr) * 72 + ks + 8 * lh]), aG2);
    __syncthreads();
    store_acc_T(sRT, 72, ti * 32, tj * 32 + lr, aG2, lane);
  }
  __syncthreads();
  bf16* sG2t = sRT;
  {
    f32x16 a1 = zero16(), a2 = zero16(), a3 = zero16();
#pragma unroll
    for (int ks = 0; ks < 64; ks += 16) {
      bf16x8 fC = ldsfrag(&sBT[(ti * 32 + lr) * 72 + ks + 8 * lh]);
      bf16x8 fDy = ldsfrag(&sKD[(ti * 32 + lr) * 72 + ks + 8 * lh]);
      a1 = mfma32(fC, ldsfrag(&sG1t[(tj * 32 + lr) * 72 + ks + 8 * lh]), a1);
      a2 = mfma32(fDy, ldsfrag(&sVt[(tj * 32 + lr) * 72 + ks + 8 * lh]), a2);
      a3 = mfma32(fC, ldsfrag(&sG2t[(tj * 32 + lr) * 72 + ks + 8 * lh]), a3);
    }
    int c = tj * 32 + lr;
#pragma unroll
    for (int r = 0; r < 16; r++) {
      int p = ti * 32 + acc_row(r, lane);
      X0[(size_t)p * 1024 + c] = f2bf(rtc[r] - a1[r]);
      P0[(size_t)p * NIN + c] = f2bf(a2[r] - a3[r]);
    }
  }
  {
    f32x16 a1 = zero16(), a2 = zero16(), a3 = zero16();
#pragma unroll
    for (int ks = 0; ks < 64; ks += 16) {
      bf16x8 fKd = fKd4[ks >> 4];
      bf16x8 fBt = fBt4[ks >> 4];
      a1 = mfma32(fKd, ldsfrag(&sVt[(tj * 32 + lr) * 72 + ks + 8 * lh]), a1);
      a2 = mfma32(fBt, ldsfrag(&sG2t[(tj * 32 + lr) * 72 + ks + 8 * lh]), a2);
      a3 = mfma32(fBt, ldsfrag(&sG1t[(tj * 32 + lr) * 72 + ks + 8 * lh]), a3);
    }
    __syncthreads();
    int c = tj * 32 + lr;
#pragma unroll
    for (int r = 0; r < 16; r++) {
      int kp = ti * 32 + acc_row(r, lane);
      float gt = __expf(sGT[kp]);
      a1[r] = gt * (a1[r] - a2[r]);
      X1[(size_t)kp * 1024 + c] = f2bf(gt * ((kp == c ? 1.f : 0.f) - a3[r]));
    }
    U4 o0, o1;
#pragma unroll
    for (int e = 0; e < 4; e++) { o0.a[e] = pack2(a1[2 * e], a1[2 * e + 1]); o1.a[e] = pack2(a1[8 + 2 * e], a1[8 + 2 * e + 1]); }
    bf16* lp = P1 + (size_t)(tid >> 2) * NIN + (tid & 3) * 16;
    *(U4*)lp = o0; *(U4*)(lp + 8) = o1;
  }
  __syncthreads();
}

struct RwStage { bf16x8 pm[4]; U4 l0, l1; };
__device__ __forceinline__ void rwkv_scan2_item(const Params& P, int l, int item, unsigned char* sm) {
  int tid_ = threadIdx.x; OPAQUE(tid_);
  const int tid = tid_, lane = tid & 63, w = tid >> 6, ti = w >> 1, tj = w & 1;
  const int lr = lane & 31, lh = lane >> 5;
  const int d = item & 1, h = (item >> 1) & 3, b = item >> 3;
  bf16* sS = (bf16*)sm;
  f32x16 acc = zero16();
  RwStage st[4];
  auto load = [&](RwStage& s_, int vc) {
    int pc = ord_chunk(d, vc < NCH ? vc : NCH - 1, NCH_C, NCH);
    int row0 = chunk_row0(b, pc, TC, NCH_C);
    const bf16* X1 = WS(bf16, OFF_XA) + (size_t)row0 * 1024 + 512 + d * 256 + h * 64;
    const bf16* P1 = WS(bf16, OFF_PROJ) + (size_t)row0 * NIN + (h * 2 + d) * 128 + 64;
#pragma unroll
    for (int q = 0; q < 4; q++) s_.pm[q] = gfrag(X1, 1024, ti * 32 + lr, q * 16 + 8 * lh);
    const bf16* lp = P1 + (size_t)(tid >> 2) * NIN + (tid & 3) * 16;
    s_.l0 = *(const U4*)lp; s_.l1 = *(const U4*)(lp + 8);
  };
#pragma unroll
  for (int j = 0; j < 4; j++) load(st[j], j);
#pragma unroll 1
  for (int v0 = 0; v0 < NCH; v0 += 4) {
#pragma unroll
    for (int j = 0; j < 4; j++) {
      const int vc = v0 + j;
      if (vc < NCH) {
        int pc = ord_chunk(d, vc, NCH_C, NCH);
        int row0 = chunk_row0(b, pc, TC, NCH_C);
        bf16* X1 = WS(bf16, OFF_XA) + (size_t)row0 * 1024 + 512 + d * 256 + h * 64;
        store_acc_T(sS, 72, ti * 32, tj * 32 + lr, acc, lane);
        RwStage cur = st[j];
        __syncthreads();
        load(st[j], vc + 4);
        for (int idx = tid; idx < 512; idx += 256) {
          int v = idx >> 3, c8 = idx & 7;
          *(U4*)(X1 + (size_t)v * 1024 + c8 * 8) = *(const U4*)(sS + v * 72 + c8 * 8);
        }
        f32x16 nw;
#pragma unroll
        for (int e = 0; e < 4; e++) {
          nw[2 * e] = lo2f(cur.l0.a[e]); nw[2 * e + 1] = hi2f(cur.l0.a[e]);
          nw[8 + 2 * e] = lo2f(cur.l1.a[e]); nw[8 + 2 * e + 1] = hi2f(cur.l1.a[e]);
        }
#pragma unroll
        for (int q = 0; q < 4; q++) nw = mfma32(cur.pm[q], ldsfrag(&sS[(tj * 32 + lr) * 72 + q * 16 + 8 * lh]), nw);
        acc = nw;
        __syncthreads();
      }
    }
  }
}

__device__ __forceinline__ void rwkv_out_item(const Params& P, int l, int item, unsigned char* sm) {
  int tid_ = threadIdx.x; OPAQUE(tid_);
  const int tid = tid_, lane = tid & 63, w = tid >> 6, ti = w >> 1, tj = w & 1;
  const int lr = lane & 31, lh = lane >> 5;
  const int h = item & 3, rest = item >> 2, pc = rest % NCH, b = rest / NCH;
  if (l == 1 && pc < NCH_C) return;
  const int row0 = chunk_row0(b, pc, TC, NCH_C);
  float* spart = (float*)sm;
  float vvh[16], ggh[16], bnh[16];
#pragma unroll
  for (int r = 0; r < 16; r++) {
    const int row = row0 + ti * 32 + acc_row(r, lane), c = h * 64 + tj * 32 + lr;
    vvh[r] = bf2f(WS(bf16, OFF_R)[(size_t)row * 1024 + 512 + c]);
    ggh[r] = bf2f(WS(bf16, OFF_PROJ)[(size_t)row * NIN + C_RWG + c]);
    const float* bon = WS(float, OFF_BON) + (size_t)row * 8 + h * 2;
    bnh[r] = bon[0] + bon[1];
  }
  f32x16 acc = zero16();
#pragma unroll
  for (int d = 0; d < 2; d++) {
    const bf16* X0 = WS(bf16, OFF_XA) + (size_t)row0 * 1024 + d * 256 + h * 64;
    const bf16* X1 = X0 + 512;
    const bf16* P0 = WS(bf16, OFF_PROJ) + (size_t)row0 * NIN + (h * 2 + d) * 128;
#pragma unroll
    for (int ks = 0; ks < 64; ks += 16)
      acc = mfma32(gfrag(X0, 1024, ti * 32 + lr, ks + 8 * lh), gfrag(X1, 1024, tj * 32 + lr, ks + 8 * lh), acc);
#pragma unroll
    for (int r = 0; r < 16; r++) acc[r] += bf2f(P0[(size_t)(ti * 32 + acc_row(r, lane)) * NIN + tj * 32 + lr]);
  }
#pragma unroll
  for (int r = 0; r < 16; r++) {
    int p = ti * 32 + acc_row(r, lane);
    float s1 = sum32(acc[r]), s2 = sum32(acc[r] * acc[r]);
    if (lr == 31) { spart[(p * 2 + tj) * 2] = s1; spart[(p * 2 + tj) * 2 + 1] = s2; }
  }
  __syncthreads();
  {
    int c = h * 64 + tj * 32 + lr;
    float lw_ = P.rw_ln_w[l * 256 + c], lb_ = P.rw_ln_b[l * 256 + c];
    bf16* yc = WS(bf16, OFF_R);
    const bf16* pr = WS(bf16, OFF_PROJ);
#pragma unroll
    for (int r = 0; r < 16; r++) {
      int p = ti * 32 + acc_row(r, lane);
      int row = row0 + p;
      float mu = (spart[(p * 2) * 2] + spart[(p * 2 + 1) * 2]) * (1.f / 64.f);
      float ex2 = (spart[(p * 2) * 2 + 1] + spart[(p * 2 + 1) * 2 + 1]) * (1.f / 64.f);
      float var = fmaxf(ex2 - mu * mu, 0.f);
      float yn = (acc[r] - mu) * rsqrtf(var + 64e-5f) * lw_ + lb_;
      yc[(size_t)row * 1024 + 512 + c] = f2bf((yn + bnh[r] * vvh[r]) * silu_f(ggh[r]));
    }
  }
  __syncthreads();
}

__device__ __forceinline__ float wave_scan64(float v, float* tmp, int lane, bool reverse) {
  const int idx = reverse ? 63 - lane : lane;
#pragma unroll
  for (int off = 1; off < 64; off <<= 1) {
    tmp[idx] = v; wave_sync();
    float o = idx >= off ? tmp[idx - off] : 0.f; wave_sync();
    v += o;
  }
  return v;
}
__device__ __forceinline__ float ssd_aneg(const Params& P, int l, int d, int h) { return -__expf(P.ssd_a_log[(l * 2 + d) * 4 + h]); }
__device__ __forceinline__ void ssd_state_item(const Params& P, int l, int item, unsigned char* sm) {
  int tid_ = threadIdx.x; OPAQUE(tid_);
  const int tid = tid_, lane = tid & 63, w = tid >> 6;
  const int d = item & 1, h = (item >> 1) & 3, rest = item >> 3;
  const int pc = rest % NCH, b = rest / NCH;
  const int isctx = pc < NCH_C, len = isctx ? CTX : SEQ, t0 = (isctx ? pc : pc - NCH_C) * TC;
  const int seq0 = isctx ? b * CTX : ROWS_C + b * SEQ;
  bf16* sRaw = (bf16*)sm;
  bf16* sVt = sRaw + 2 * 68 * 64;
  bf16* sBt = sVt + 64 * 72;
  float* sdt = (float*)(sBt + 64 * 72);
  float* sdw = sdt + 64;
  const bf16* pr = WS(bf16, OFF_PROJ);
#pragma unroll 8
  for (int idx = tid; idx < 2 * 68 * 8; idx += 256) {
    int which = idx / (68 * 8), rem = idx % (68 * 8), tr = rem >> 3, c8 = rem & 7;
    int t = t0 - 2 + tr;
    int col = C_SSD + (which == 0 ? h * 64 : 256 + (h >> 1) * 64) + c8 * 8;
    U4 v = (t >= 0 && t < len) ? *(const U4*)(pr + (size_t)(seq0 + t) * NIN + col) : zero4();
    *(U4*)&sRaw[(which * 68 + tr) * 64 + c8 * 8] = v;
  }
  if (tid < 64) {
    float raw = bf2f(pr[(size_t)(seq0 + t0 + tid) * NIN + C_SSDDT + d * 4 + h]);
    sdt[tid] = softplus_f(raw + P.ssd_dt_bias[(l * 2 + d) * 4 + h]);
  }
  __syncthreads();
  if (w == 0) {
    float la = sdt[lane] * ssd_aneg(P, l, d, h);
    float incl = wave_scan64(la, sdw, lane, d == 0);
    wave_sync();
    sdw[lane] = __expf(incl - la);
    if (lane == (d == 0 ? 0 : 63)) WS(float, OFF_SSDDEC)[((size_t)(d * BATCH + b) * NCH + pc) * 4 + h] = __expf(incl);
  }
  __syncthreads();
#pragma unroll
  for (int which = 0; which < 2; which++) {
    const int c = tid & 63;
    const int ch = which == 0 ? h * 64 + c : 256 + (h >> 1) * 64 + c;
    float cw[5], cb = P.ssd_conv_b[l * 512 + ch];
#pragma unroll
    for (int i = 0; i < 5; i++) cw[i] = P.ssd_conv_w[(l * 5 + i) * 512 + ch];
    const int tb = (tid >> 6) * 16;
    float w0 = bf2f(sRaw[(which * 68 + tb) * 64 + c]), w1 = bf2f(sRaw[(which * 68 + tb + 1) * 64 + c]);
    float w2 = bf2f(sRaw[(which * 68 + tb + 2) * 64 + c]), w3 = bf2f(sRaw[(which * 68 + tb + 3) * 64 + c]);
#pragma unroll 4
    for (int t = tb; t < tb + 16; t++) {
      float w4 = bf2f(sRaw[(which * 68 + t + 4) * 64 + c]);
      float acc = cb + w0 * cw[0] + w1 * cw[1] + w2 * cw[2] + w3 * cw[3] + w4 * cw[4];
      w0 = w1; w1 = w2; w2 = w3; w3 = w4;
      float v = silu_f(acc);
      if (which == 0) sVt[c * 72 + t] = f2bf(v * sdt[t] * sdw[t]);
      else sBt[c * 72 + t] = f2bf(v);
    }
  }
  __syncthreads();
  {
    int ti = w >> 1, tj = w & 1;
    f32x16 acc = zero16();
    for (int ks = 0; ks < 64; ks += 16)
      acc = mfma32(ldsfrag(&sVt[(ti * 32 + (lane & 31)) * 72 + ks + 8 * (lane >> 5)]),
                   ldsfrag(&sBt[(tj * 32 + (lane & 31)) * 72 + ks + 8 * (lane >> 5)]), acc);
    bf16* st = WS(bf16, OFF_SSDST) + ((size_t)((d * BATCH + b) * NCH + pc) * 4 + h) * 4096;
    for (int r = 0; r < 16; r++) st[(ti * 32 + acc_row(r, lane)) * 64 + tj * 32 + (lane & 31)] = f2bf(acc[r]);
  }
  __syncthreads();
}

__device__ __forceinline__ void gla_la(const Params& P, int l, int d, int h, const float* sGl, float* dst) {
  const int k = threadIdx.x & 31;
  float gw[16], gb = P.gla_gb[(l * 2 + d) * 128 + h * 32 + k];
  const float* g2 = P.gla_g2 + (size_t)(l * 2 + d) * 16 * 128 + h * 32 + k;
#pragma unroll
  for (int r = 0; r < 16; r++) gw[r] = g2[r * 128];
#pragma unroll 2
  for (int t = threadIdx.x >> 5; t < 64; t += 8) {
    float acc = gb;
#pragma unroll
    for (int r = 0; r < 16; r++) acc += sGl[t * 32 + d * 16 + r] * gw[r];
    dst[t * 32 + k] = -softplus_f(-acc) * (1.f / 16.f);
  }
}
__device__ __forceinline__ void gla_state_item(const Params& P, int l, int item, unsigned char* sm) {
  int tid_ = threadIdx.x; OPAQUE(tid_);
  const int tid = tid_, lane = tid & 63, w = tid >> 6;
  const int d = item & 1, h = (item >> 1) & 3, rest = item >> 3;
  const int pc = rest % NCH, b = rest / NCH;
  const int row0 = chunk_row0(b, pc, TC, NCH_C);
  float* sGl = (float*)sm;
  float* sLa = sGl + 2048;
  bf16* sVt = (bf16*)(sLa + 2048);
  bf16* sKt = sVt + 64 * 72;
  const bf16* pr = WS(bf16, OFF_PROJ);
  float kh[8], vh[16];
#pragma unroll
  for (int i = 0; i < 8; i++) kh[i] = bf2f(pr[(size_t)(row0 + (tid >> 5) + 8 * i) * NIN + C_GLAK + h * 32 + (tid & 31)]);
#pragma unroll
  for (int i = 0; i < 16; i++) vh[i] = bf2f(pr[(size_t)(row0 + (tid >> 6) + 4 * i) * NIN + C_GLAV + h * 64 + (tid & 63)]);
#pragma unroll 8
  for (int idx = tid; idx < 64 * 32; idx += 256) {
    int t = idx >> 5, c = idx & 31;
    sGl[idx] = bf2f(pr[(size_t)(row0 + t) * NIN + C_GLAGL + c]);
  }
  __syncthreads();
  gla_la(P, l, d, h, sGl, sLa);
  __syncthreads();
  {
    float* segtot = (float*)(sKt + 32 * 72);
    const int k = tid & 31, sg = tid >> 5;
    float run = 0.f, loc[8];
#pragma unroll
    for (int j = 0; j < 8; j++) {
      int tau = sg * 8 + j, t = d == 0 ? 63 - tau : tau;
      float la = sLa[t * 32 + k]; loc[j] = run; run += la;
    }
    segtot[sg * 32 + k] = run;
    __syncthreads();
    float off = 0.f, tot = 0.f;
#pragma unroll
    for (int j = 0; j < 8; j++) { float v = segtot[j * 32 + k]; tot += v; if (j < sg) off += v; }
#pragma unroll
    for (int j = 0; j < 8; j++) {
      int tau = sg * 8 + j, t = d == 0 ? 63 - tau : tau;
      sLa[t * 32 + k] = loc[j] + off;
    }
    if (sg == 0) WS(float, OFF_GLADEC)[(((size_t)(d * BATCH + b) * NCH + pc) * 4 + h) * 32 + k] = __expf(tot);
  }
  __syncthreads();
#pragma unroll
  for (int i = 0; i < 16; i++) sVt[(tid & 63) * 72 + (tid >> 6) + 4 * i] = f2bf(vh[i]);
#pragma unroll
  for (int i = 0; i < 8; i++) {
    const int t = (tid >> 5) + 8 * i, k = tid & 31;
    sKt[k * 72 + t] = f2bf(kh[i] * __expf(sLa[t * 32 + k]));
  }
  __syncthreads();
  if (w < 2) {
    f32x16 acc = zero16();
    for (int ks = 0; ks < 64; ks += 16)
      acc = mfma32(ldsfrag(&sVt[(w * 32 + (lane & 31)) * 72 + ks + 8 * (lane >> 5)]),
                   ldsfrag(&sKt[(lane & 31) * 72 + ks + 8 * (lane >> 5)]), acc);
    bf16* st = WS(bf16, OFF_GLAST) + ((size_t)((d * BATCH + b) * NCH + pc) * 4 + h) * 2048;
    for (int r = 0; r < 16; r++) st[(w * 32 + acc_row(r, lane)) * 32 + (lane & 31)] = f2bf(acc[r]);
  }
  __syncthreads();
}

__device__ __forceinline__ U4 s5_u_load(const Params& P, int g, int n, int k8) {
  if (n >= M5) return zero4();
  int b = n / NCH5, pc = n - b * NCH5;
  int row = chunk_row0(b, pc, T5, NC5) + (k8 >> 4);
  return *(const U4*)(WS(bf16, OFF_PROJ) + (size_t)row * NIN + C_S5 + g * 16 + (k8 & 15));
}
__device__ __forceinline__ void s5_state_tile(const Params& P, int l, int item, unsigned char* sm) {
  const int MT5 = (M5 + 127) / 128;
  int nt = item & 1, mt = (item >> 1) % MT5, g = (item >> 1) / MT5;
  const bf16* Bt = WS(bf16, OFF_W1T) + (size_t)(l * 16 + g) * 256 * 512;
  float* S = WS(float, OFF_S5ST) + (size_t)g * M5 * 256;
  gemm_tile(sm, mt * 128, nt * 128, 512,
    [&](int m, int k) { return s5_u_load(P, g, m, k); },
    [&](int n, int k) { return *(const U4*)(Bt + (size_t)n * 512 + k); },
    [&](int m, int n, float v) { if (m < M5) S[(size_t)m * 256 + n] = v; });
}

__device__ __forceinline__ void phase_D(const Params& P, int l, unsigned char* sm, long long& pacc) {
  const int n_rw = BATCH * NCH * 8, n_ssd = BATCH * NCH * 8, n_gla = BATCH * NCH * 8;
  const int n_s5 = 16 * ((M5 + 127) / 128) * 2;
  { long long t0_ = 0; if (PROBE_PHASE == 30) t0_ = wall_clock64();
  ITEM_LOOP(i, n_rw, 0) rwkv_chunk_item(P, l, i, sm, pacc);
  if (PROBE_PHASE == 30) pacc += wall_clock64() - t0_; }
  chunk_scans(P, l, n_rw);
}

__device__ __forceinline__ void chunk_scans(const Params& P, int l, int base) {
  const int tid = threadIdx.x;
  const int n_ssd = 2 * BATCH * 4 * 4, n_gla = 2 * BATCH * 4 * 2, n_s5 = 16 * BATCH;
#pragma unroll 1
  for (int it = (int)((blockIdx.x + gridDim.x - ((unsigned)base % gridDim.x)) % gridDim.x); it < n_ssd + n_gla + n_s5; it += gridDim.x) {
    int i = it;
    if (i < n_ssd) {
      int q = i & 3, h = (i >> 2) & 3, rest = i >> 4, b = rest % BATCH, d = rest / BATCH;
      float S[4] = {0.f, 0.f, 0.f, 0.f};
#pragma unroll 1
      for (int v0 = 0; v0 < NCH; v0 += 8) {
        U2 cv[8]; float dec[8];
#pragma unroll
        for (int j = 0; j < 8; j++) {
          int vc = v0 + j < NCH ? v0 + j : NCH - 1;
          size_t ci = ((size_t)(d * BATCH + b) * NCH + ord_chunk(d, vc, NCH_C, NCH)) * 4 + h;
          cv[j] = *(const U2*)(WS(bf16, OFF_SSDST) + ci * 4096 + q * 1024 + tid * 4);
          dec[j] = WS(float, OFF_SSDDEC)[ci];
        }
#pragma unroll
        for (int j = 0; j < 8; j++) {
          if (v0 + j < NCH) {
            size_t ci = ((size_t)(d * BATCH + b) * NCH + ord_chunk(d, v0 + j, NCH_C, NCH)) * 4 + h;
            U2 o; o.a[0] = pack2(S[0], S[1]); o.a[1] = pack2(S[2], S[3]);
            *(U2*)(WS(bf16, OFF_SSDST) + ci * 4096 + q * 1024 + tid * 4) = o;
            S[0] = dec[j] * S[0] + lo2f(cv[j].a[0]); S[1] = dec[j] * S[1] + hi2f(cv[j].a[0]);
            S[2] = dec[j] * S[2] + lo2f(cv[j].a[1]); S[3] = dec[j] * S[3] + hi2f(cv[j].a[1]);
          }
        }
      }
      continue;
    }
    i -= n_ssd;
    if (i < n_gla) {
      int q = i & 1, h = (i >> 1) & 3, rest = i >> 3, b = rest % BATCH, d = rest / BATCH;
      float S[4] = {0.f, 0.f, 0.f, 0.f};
      int e0 = q * 1024 + tid * 4, k0 = e0 & 31;
#pragma unroll 1
      for (int v0 = 0; v0 < NCH; v0 += 8) {
        U2 cv[8]; F4 dec[8];
#pragma unroll
        for (int j = 0; j < 8; j++) {
          int vc = v0 + j < NCH ? v0 + j : NCH - 1;
          size_t ci = ((size_t)(d * BATCH + b) * NCH + ord_chunk(d, vc, NCH_C, NCH)) * 4 + h;
          cv[j] = *(const U2*)(WS(bf16, OFF_GLAST) + ci * 2048 + e0);
          dec[j] = *(const F4*)(WS(float, OFF_GLADEC) + ci * 32 + k0);
        }
#pragma unroll
        for (int j = 0; j < 8; j++) {
          if (v0 + j < NCH) {
            size_t ci = ((size_t)(d * BATCH + b) * NCH + ord_chunk(d, v0 + j, NCH_C, NCH)) * 4 + h;
            U2 o; o.a[0] = pack2(S[0], S[1]); o.a[1] = pack2(S[2], S[3]);
            *(U2*)(WS(bf16, OFF_GLAST) + ci * 2048 + e0) = o;
            S[0] = dec[j].a[0] * S[0] + lo2f(cv[j].a[0]); S[1] = dec[j].a[1] * S[1] + hi2f(cv[j].a[0]);
            S[2] = dec[j].a[2] * S[2] + lo2f(cv[j].a[1]); S[3] = dec[j].a[3] * S[3] + hi2f(cv[j].a[1]);
          }
        }
      }
      continue;
    }
    i -= n_gla;
    if (i < n_s5) {
      int b = i % BATCH, g = i / BATCH;
      if (tid < 128) {
        int d = tid >> 6, p = tid & 63;
        const float* lt = WS(float, OFF_S5LT) + ((size_t)((l * 16 + g) * 2 + d) * 64 + p) * 2;
        float lr = lt[0], li = lt[1], xr = 0.f, xi = 0.f;
#pragma unroll 1
        for (int v0 = 0; v0 < NCH5; v0 += 8) {
          float sr[8], si[8];
#pragma unroll
          for (int j = 0; j < 8; j++) {
            int vc = v0 + j < NCH5 ? v0 + j : NCH5 - 1;
            const float* sp = WS(float, OFF_S5ST) + ((size_t)g * M5 + b * NCH5 + ord_chunk(d, vc, NC5, NCH5)) * 256 + d * 128 + p;
            sr[j] = sp[0]; si[j] = sp[64];
          }
#pragma unroll
          for (int j = 0; j < 8; j++) {
            if (v0 + j < NCH5) {
              float* sp = WS(float, OFF_S5ST) + ((size_t)g * M5 + b * NCH5 + ord_chunk(d, v0 + j, NC5, NCH5)) * 256 + d * 128 + p;
              sp[0] = xr; sp[64] = xi;
              float nr = lr * xr - li * xi + sr[j], ni = lr * xi + li * xr + si[j];
              xr = nr; xi = ni;
            }
          }
        }
      }
      continue;
    }
  }
}

__device__ __forceinline__ void ssd_out_item(const Params& P, int l, int item, unsigned char* sm, long long& pacc) {
  long long tp0_ = 0; if (PROBE_PHASE == 55 || PROBE_PHASE == 56) tp0_ = wall_clock64();
  int tid_ = threadIdx.x; OPAQUE(tid_);
  const int tid = tid_, lane = tid & 63, w = tid >> 6;
  const int h = item & 3, rest = item >> 2, pc = rest % NCH, b = rest / NCH;
  if (l == 1 && pc < NCH_C) return;
  const int isctx = pc < NCH_C, len = isctx ? CTX : SEQ, t0 = (isctx ? pc : pc - NCH_C) * TC;
  const int seq0 = isctx ? b * CTX : ROWS_C + b * SEQ;
  bf16* sRaw = (bf16*)sm;
  bf16* sA2 = (bf16*)sm;
  bf16* sB2 = (bf16*)(sm + 26112);
  bf16* sC = (bf16*)(sm + 26112 + 25600);
  float* sdt = (float*)(sm + 26112 + 25600 + 9216);
  float* scf = sdt + 128; float* scr = scf + 64; float* spart = scr + 64;
  const bf16* pr = WS(bf16, OFF_PROJ);
#pragma unroll 8
  for (int idx = tid; idx < 3 * 68 * 8; idx += 256) {
    int which = idx / (68 * 8), rem = idx % (68 * 8), tr = rem >> 3, c8 = rem & 7;
    int t = t0 - 2 + tr;
    int col = C_SSD + (which == 0 ? h * 64 : which == 1 ? 256 + (h >> 1) * 64 : 384 + (h >> 1) * 64) + c8 * 8;
    U4 v = (t >= 0 && t < len) ? *(const U4*)(pr + (size_t)(seq0 + t) * NIN + col) : zero4();
    *(U4*)&sRaw[(which * 68 + tr) * 64 + c8 * 8] = v;
  }
  u32x4 stv0, stv1, stv2, stv3;
  {
    const bf16* stb = WS(bf16, OFF_SSDST);
    const size_t o0 = ((size_t)((0 * BATCH + b) * NCH + pc) * 4 + h) * 4096, o1 = ((size_t)((1 * BATCH + b) * NCH + pc) * 4 + h) * 4096;
    const int p_ = (tid >> 3) & 31, c8_ = tid & 7;
    stv0 = *(const u32x4*)(stb + o0 + p_ * 64 + c8_ * 8);
    stv1 = *(const u32x4*)(stb + o0 + (p_ + 32) * 64 + c8_ * 8);
    stv2 = *(const u32x4*)(stb + o1 + p_ * 64 + c8_ * 8);
    stv3 = *(const u32x4*)(stb + o1 + (p_ + 32) * 64 + c8_ * 8);
  }
  float zv[16];
#pragma unroll
  for (int r = 0; r < 16; r++)
    zv[r] = bf2f(pr[(size_t)(seq0 + t0 + (w >> 1) * 32 + acc_row(r, lane)) * NIN + C_SSDZ + h * 64 + (w & 1) * 32 + (lane & 31)]);
  if (tid < 128) {
    int d = tid >> 6, t = tid & 63;
    float raw = bf2f(pr[(size_t)(seq0 + t0 + t) * NIN + C_SSDDT + d * 4 + h]);
    sdt[tid] = softplus_f(raw + P.ssd_dt_bias[(l * 2 + d) * 4 + h]);
  }
  __syncthreads();
  if (w == 0) { float v = wave_scan64(sdt[lane] * ssd_aneg(P, l, 0, h), scf, lane, false); wave_sync(); scf[lane] = v; }
  if (w == 1) { float v = wave_scan64(sdt[64 + lane] * ssd_aneg(P, l, 1, h), scr, lane, true); wave_sync(); scr[lane] = v; }
#pragma unroll
  for (int which = 0; which < 3; which++) {
    const int c = tid & 63;
    const int ch = which == 0 ? h * 64 + c : which == 1 ? 256 + (h >> 1) * 64 + c : 384 + (h >> 1) * 64 + c;
    float cw[5], cb = P.ssd_conv_b[l * 512 + ch];
#pragma unroll
    for (int i = 0; i < 5; i++) cw[i] = P.ssd_conv_w[(l * 5 + i) * 512 + ch];
    const int tb = (tid >> 6) * 16;
    float w0 = bf2f(sRaw[(which * 68 + tb) * 64 + c]), w1 = bf2f(sRaw[(which * 68 + tb + 1) * 64 + c]);
    float w2 = bf2f(sRaw[(which * 68 + tb + 2) * 64 + c]), w3 = bf2f(sRaw[(which * 68 + tb + 3) * 64 + c]);
#pragma unroll 4
    for (int t = tb; t < tb + 16; t++) {
      float w4 = bf2f(sRaw[(which * 68 + t + 4) * 64 + c]);
      float acc = cb + w0 * cw[0] + w1 * cw[1] + w2 * cw[2] + w3 * cw[3] + w4 * cw[4];
      w0 = w1; w1 = w2; w2 = w3; w3 = w4;
      bf16 v = f2bf(silu_f(acc));
      if (which == 0) sB2[c * 200 + t] = v;
      else if (which == 1) sB2[t * 200 + 64 + c] = v;
      else sC[t * 72 + c] = v;
    }
  }
  __syncthreads();
  const int ti = w >> 1, tj = w & 1;
  {
    f32x16 g = zero16();
    for (int ks = 0; ks < 64; ks += 16)
      g = mfma32(ldsfrag(&sC[(ti * 32 + (lane & 31)) * 72 + ks + 8 * (lane >> 5)]),
                 ldsfrag(&sB2[(tj * 32 + (lane & 31)) * 200 + 64 + ks + 8 * (lane >> 5)]), g);
    int j = tj * 32 + (lane & 31);
    float cfj = scf[j], crj = scr[j], d0j = sdt[j], d1j = sdt[64 + j];
    for (int r = 0; r < 16; r++) {
      int i = ti * 32 + acc_row(r, lane);
      float mlt = 0.f;
      if (j <= i) mlt += __expf(scf[i] - cfj) * d0j;
      if (j >= i) mlt += __expf(scr[i] - crj) * d1j;
      sA2[i * 200 + j] = f2bf(g[r] * mlt);
    }
  }
#pragma unroll 8
  for (int idx = tid; idx < 64 * 64; idx += 256) {
    int i = idx >> 6, n = idx & 63;
    float cv = bf2f(sC[i * 72 + n]);
    sA2[i * 200 + 64 + n] = f2bf(cv * __expf(scf[i]));
    sA2[i * 200 + 128 + n] = f2bf(cv * __expf(scr[i]));
  }
  __syncthreads();
  {
    const int p_ = (tid >> 3) & 31, c8_ = tid & 7;
    *(u32x4*)&sB2[p_ * 200 + 64 + c8_ * 8] = stv0;
    *(u32x4*)&sB2[(p_ + 32) * 200 + 64 + c8_ * 8] = stv1;
    *(u32x4*)&sB2[p_ * 200 + 128 + c8_ * 8] = stv2;
    *(u32x4*)&sB2[(p_ + 32) * 200 + 128 + c8_ * 8] = stv3;
  }
  __syncthreads();
  {
    f32x16 acc = zero16();
    for (int ks = 0; ks < 192; ks += 16)
      acc = mfma32(ldsfrag(&sA2[(ti * 32 + (lane & 31)) * 200 + ks + 8 * (lane >> 5)]),
                   ldsfrag(&sB2[(tj * 32 + (lane & 31)) * 200 + ks + 8 * (lane >> 5)]), acc);
    int p = tj * 32 + (lane & 31);
    float dd = P.ssd_d[l * 4 + h];
    bf16* yc = WS(bf16, OFF_R);
    for (int r = 0; r < 16; r++) {
      int i = ti * 32 + acc_row(r, lane);
      int row = seq0 + t0 + i;
      float xv = bf2f(sB2[p * 200 + i]);
      float y = acc[r] + dd * xv;
      float z = zv[r];
      y *= silu_f(z);
      yc[(size_t)row * 1024 + h * 64 + p] = f2bf(y);
      float s2 = sum32(y * y);
      if ((lane & 31) == 31) spart[i * 2 + tj] = s2;
    }
  }
  __syncthreads();
  if (tid < 64) WS(float, OFF_SSQ)[(size_t)(seq0 + t0 + tid) * 4 + h] = spart[tid * 2] + spart[tid * 2 + 1];
  __syncthreads();
}

__device__ __forceinline__ void gla_out_item(const Params& P, int l, int item, unsigned char* sm) {
  int tid_ = threadIdx.x; OPAQUE(tid_);
  const int tid = tid_, lane = tid & 63, w = tid >> 6;
  const int h = item & 3, rest = item >> 2, pc = rest % NCH, b = rest / NCH;
  if (l == 1 && pc < NCH_C) return;
  const int row0 = chunk_row0(b, pc, TC, NCH_C);
  bf16* sA2 = (bf16*)sm;
  bf16* sB2 = sA2 + 64 * 136;
  bf16* sKf = sB2 + 64 * 136;
  bf16* sKr = sKf + 64 * 40;
  float* sbf = (float*)(sKr + 64 * 40);
  float* sbr = sbf + 2048;
  float* spart = sbr + 2048;
  float* sGl = (float*)sB2;
  const bf16* pr = WS(bf16, OFF_PROJ);
  float qh[8], kh[8], vh[16], gh[16];
  u32x4 sth0, sth1;
#pragma unroll
  for (int i = 0; i < 8; i++) {
    const bf16* rp = pr + (size_t)(row0 + (tid >> 5) + 8 * i) * NIN + h * 32 + (tid & 31);
    qh[i] = bf2f(rp[C_GLA]); kh[i] = bf2f(rp[C_GLAK]);
  }
#pragma unroll
  for (int i = 0; i < 16; i++) vh[i] = bf2f(pr[(size_t)(row0 + (tid >> 6) + 4 * i) * NIN + C_GLAV + h * 64 + (tid & 63)]);
#pragma unroll
  for (int r = 0; r < 16; r++)
    gh[r] = bf2f(pr[(size_t)(row0 + (w >> 1) * 32 + acc_row(r, lane)) * NIN + C_GLAG + h * 64 + (w & 1) * 32 + (lane & 31)]);
  {
    const bf16* st0 = WS(bf16, OFF_GLAST) + ((size_t)((0 * BATCH + b) * NCH + pc) * 4 + h) * 2048;
    const bf16* st1 = WS(bf16, OFF_GLAST) + ((size_t)((1 * BATCH + b) * NCH + pc) * 4 + h) * 2048;
    sth0 = *(const u32x4*)(st0 + (tid >> 2) * 32 + (tid & 3) * 8);
    sth1 = *(const u32x4*)(st1 + (tid >> 2) * 32 + (tid & 3) * 8);
  }
#pragma unroll 8
  for (int idx = tid; idx < 64 * 32; idx += 256) {
    int t = idx >> 5, c = idx & 31;
    sGl[idx] = bf2f(pr[(size_t)(row0 + t) * NIN + C_GLAGL + c]);
  }
  __syncthreads();
  gla_la(P, l, 0, h, sGl, sbf);
  gla_la(P, l, 1, h, sGl, sbr);
  __syncthreads();
  {
    float* segtot = spart + 128;
    const int k = tid & 31, sg = tid >> 5;
    float rf = 0.f, rr_ = 0.f, lf[8], lr_[8];
#pragma unroll
    for (int j = 0; j < 8; j++) {
      int tf = sg * 8 + j, tr = 63 - tf;
      rf += sbf[tf * 32 + k]; lf[j] = rf;
      rr_ += sbr[tr * 32 + k]; lr_[j] = rr_;
    }
    segtot[sg * 32 + k] = rf; segtot[256 + sg * 32 + k] = rr_;
    __syncthreads();
    float of = 0.f, orr = 0.f;
#pragma unroll
    for (int j = 0; j < 8; j++) { if (j < sg) { of += segtot[j * 32 + k]; orr += segtot[256 + j * 32 + k]; } }
#pragma unroll
    for (int j = 0; j < 8; j++) {
      int tf = sg * 8 + j, tr = 63 - tf;
      sbf[tf * 32 + k] = lf[j] + of;
      sbr[tr * 32 + k] = lr_[j] + orr;
    }
  }
  __syncthreads();
#pragma unroll
  for (int i = 0; i < 8; i++) {
    const int idx = tid + 256 * i, t = idx >> 5, k = idx & 31;
    float q = qh[i] * 0.17677669529663687f;
    float kv = kh[i];
    float bf_ = sbf[idx], br_ = sbr[idx];
    sA2[t * 136 + 64 + k] = f2bf(q * __expf(bf_));
    sA2[t * 136 + 96 + k] = f2bf(q * __expf(br_));
    sKf[t * 40 + k] = f2bf(kv * __expf(-bf_));
    sKr[t * 40 + k] = f2bf(kv * __expf(-br_));
  }
#pragma unroll
  for (int i = 0; i < 16; i++) sB2[(tid & 63) * 136 + (tid >> 6) + 4 * i] = f2bf(vh[i]);
  *(u32x4*)&sB2[(tid >> 2) * 136 + 64 + (tid & 3) * 8] = sth0;
  *(u32x4*)&sB2[(tid >> 2) * 136 + 96 + (tid & 3) * 8] = sth1;
  __syncthreads();
  const int ti = w >> 1, tj = w & 1;
  {
    f32x16 pf = zero16(), pv = zero16();
    for (int ks = 0; ks < 32; ks += 16) {
      pf = mfma32(ldsfrag(&sA2[(ti * 32 + (lane & 31)) * 136 + 64 + ks + 8 * (lane >> 5)]),
                  ldsfrag(&sKf[(tj * 32 + (lane & 31)) * 40 + ks + 8 * (lane >> 5)]), pf);
      pv = mfma32(ldsfrag(&sA2[(ti * 32 + (lane & 31)) * 136 + 96 + ks + 8 * (lane >> 5)]),
                  ldsfrag(&sKr[(tj * 32 + (lane & 31)) * 40 + ks + 8 * (lane >> 5)]), pv);
    }
    int j = tj * 32 + (lane & 31);
    for (int r = 0; r < 16; r++) {
      int i = ti * 32 + acc_row(r, lane);
      float v = (j < i) ? pf[r] : (j > i) ? pv[r] : pf[r] + pv[r];
      sA2[i * 136 + j] = f2bf(v);
    }
  }
  __syncthreads();
  {
    f32x16 acc = zero16();
    for (int ks = 0; ks < 128; ks += 16)
      acc = mfma32(ldsfrag(&sA2[(ti * 32 + (lane & 31)) * 136 + ks + 8 * (lane >> 5)]),
                   ldsfrag(&sB2[(tj * 32 + (lane & 31)) * 136 + ks + 8 * (lane >> 5)]), acc);
    for (int r = 0; r < 16; r++) {
      int i = ti * 32 + acc_row(r, lane);
      float s2 = sum32(acc[r] * acc[r]);
      if ((lane & 31) == 31) spart[i * 2 + tj] = s2;
    }
    __syncthreads();
    int v = tj * 32 + (lane & 31);
    float gn = P.gla_norm[l * 256 + h * 64 + v];
    bf16* yc = WS(bf16, OFF_R);
    for (int r = 0; r < 16; r++) {
      int i = ti * 32 + acc_row(r, lane);
      int row = row0 + i;
      float rstd = rsqrtf((spart[i * 2] + spart[i * 2 + 1]) * (1.f / 64.f) + 1e-6f);
      float g = gh[r];
      yc[(size_t)row * 1024 + 768 + h * 64 + v] = f2bf(acc[r] * rstd * gn * silu_f(g));
    }
  }
  __syncthreads();
}

__device__ __forceinline__ void s5_out_tile(const Params& P, int l, int item, unsigned char* sm) {
  const int MT5 = (M5 + 127) / 128;
  int nt = item & 3, mt = (item >> 2) % MT5, g = (item >> 2) / MT5;
  const bf16* Bt = WS(bf16, OFF_BT2) + (size_t)(l * 16 + g) * 512 * 768;
  const float* X = WS(float, OFF_S5ST) + (size_t)g * M5 * 256;
  const bf16* pr = WS(bf16, OFF_PROJ);
  bf16* ys = WS(bf16, OFF_YS5);
  gemm_tile(sm, mt * 128, nt * 128, 768,
    [&](int m, int k) {
      if (k < 512) return s5_u_load(P, g, m, k);
      if (m >= M5) return zero4();
      const float* xp = X + (size_t)m * 256 + (k - 512);
      F4 a = *(const F4*)xp, b2 = *(const F4*)(xp + 4);
      U4 r; r.a[0] = pack2(a.a[0], a.a[1]); r.a[1] = pack2(a.a[2], a.a[3]); r.a[2] = pack2(b2.a[0], b2.a[1]); r.a[3] = pack2(b2.a[2], b2.a[3]);
      return r;
    },
    [&](int n, int k) { return *(const U4*)(Bt + (size_t)n * 768 + k); },
    [&](int m, int n, float v) {
      if (m >= M5) return;
      int b = m / NCH5, pc = m - b * NCH5;
      int row = chunk_row0(b, pc, T5, NC5) + (n >> 4);
      int ch = g * 16 + (n & 15);
      float u = bf2f(pr[(size_t)row * NIN + C_S5 + ch]);
      ys[(size_t)row * 256 + ch] = f2bf(gelu_f(v + P.s5_d[l * 256 + ch] * u));
    });
}

__device__ __forceinline__ void phase_E(const Params& P, int l, unsigned char* sm, long long& pacc) {
  const int n_rw = BATCH * 8;
  ITEM_LOOP(i, n_rw, 0) rwkv_scan2_item(P, l, i, sm);
  const int n_ssd = BATCH * NCH * 4, n_gla = BATCH * NCH * 4, n_s5 = 16 * ((M5 + 127) / 128) * 4;
  ITEM_LOOP(i, n_ssd, n_rw) ssd_out_item(P, l, i, sm, pacc);
  ITEM_LOOP(i, n_gla, n_rw + n_ssd) gla_out_item(P, l, i, sm);
  ITEM_LOOP(i, n_s5, n_rw + n_ssd + n_gla) s5_out_tile(P, l, i, sm);
}
__device__ __forceinline__ void phase_F(const Params& P, int l, unsigned char* sm, long long& pacc) {
  const int n_rw = BATCH * NCH * 4;
  ITEM_LOOP(i, n_rw, 0) rwkv_out_item(P, l, i, sm);
}

__device__ __forceinline__ void phase_G(const Params& P, int l, unsigned char* sm) {
  const int lane = threadIdx.x & 63, w = threadIdx.x >> 6;
  const int n_glu = (ROWS / 128) * 2, n_rows = ROWS / 4;
  const bf16* Bt = WS(bf16, OFF_GLUT) + (size_t)l * 256 * 256;
  const bf16* pr = WS(bf16, OFF_PROJ);
  bf16* yc = WS(bf16, OFF_R);
#pragma unroll 1
  for (int it = blockIdx.x; it < n_glu + n_rows; it += gridDim.x) {
    if (it < n_glu) {
      int nt = it & 1, mt = it >> 1;
      if (l == 1 && mt < ROWS_C / 128) continue;
      gemm_tile(sm, mt * 128, nt * 128, 256,
        [&](int m, int k) { return *(const U4*)(WS(bf16, OFF_YS5) + (size_t)m * 256 + k); },
        [&](int n, int k) { return *(const U4*)(Bt + (size_t)n * 256 + k); },
        [&](int m, int n, float v) {
          float y = bf2f(WS(bf16, OFF_YS5)[(size_t)m * 256 + n]);
          float g = bf2f(pr[(size_t)m * NIN + C_S5G + n]);
          yc[(size_t)m * 1024 + 256 + n] = f2bf(y * sigmoid_f(v + P.s5_glu_b[l * 256 + n]) * silu_f(g));
        });
      continue;
    }
    int m = (it - n_glu) * 4 + w;
    const float* sq = WS(float, OFF_SSQ) + (size_t)m * 4;
    float rstd = rsqrtf((sq[0] + sq[1] + sq[2] + sq[3]) * (1.f / 256.f) + 1e-6f);
    bf16* p = yc + (size_t)m * 1024 + lane * 4;
    U2 v = *(U2*)p;
    const float* gn = P.ssd_norm + l * 256 + lane * 4;
    U2 o;
    o.a[0] = pack2(lo2f(v.a[0]) * rstd * gn[0], hi2f(v.a[0]) * rstd * gn[1]);
    o.a[1] = pack2(lo2f(v.a[1]) * rstd * gn[2], hi2f(v.a[1]) * rstd * gn[3]);
    *(U2*)p = o;
  }
  { const int n_rw = BATCH * NCH * 4; ITEM_LOOP(i, n_rw, n_glu + n_rows) rwkv_out_item(P, l, i, sm); }
}

__device__ __forceinline__ void phase_outproj(const Params& P, int l, unsigned char* sm) {
  const bf16* A = WS(bf16, OFF_R);
  const bf16* Bt = WS(bf16, OFF_WTOUT) + (size_t)l * D * D;
  bf16* Y = WS(bf16, OFF_PROJ);
  const int NT = D / 128, MT = ROWS / 256;
  const int total = MT * NT, per = total / 8;
  const int nfull = (total / (int)gridDim.x) * (int)gridDim.x;
#pragma unroll 1
  for (int it0 = blockIdx.x; it0 < nfull; it0 += gridDim.x) {
    int it = total % 8 == 0 ? (it0 & 7) * per + (it0 >> 3) : it0;
    int mt = it / NT, nt = it % NT;
    if (l == 1 && mt < ROWS_C / 256) continue;
    gemm_tile_big(sm, mt * 256, nt * 128, D,
      [&](int m, int k) { return *(const U4*)(A + (size_t)m * D + k); },
      [&](int n, int k) { return *(const U4*)(Bt + (size_t)n * D + k); },
      [&](int m, int n, float v) { Y[(size_t)m * D + n] = f2bf(v); });
  }
#pragma unroll 1
  for (int q = blockIdx.x; q < 2 * (total - nfull); q += gridDim.x) {
    int it0 = nfull + (q >> 1), half = q & 1;
    int it = total % 8 == 0 ? (it0 & 7) * per + (it0 >> 3) : it0;
    int mt = it / NT, nt = it % NT;
    if (l == 1 && mt < ROWS_C / 256) continue;
    gemm_tile(sm, mt * 256 + half * 128, nt * 128, D,
      [&](int m, int k) { return *(const U4*)(A + (size_t)m * D + k); },
      [&](int n, int k) { return *(const U4*)(Bt + (size_t)n * D + k); },
      [&](int m, int n, float v) { Y[(size_t)m * D + n] = f2bf(v); });
  }
}

__device__ __forceinline__ void phase_post(const Params& P, int l) {
  const int lane = threadIdx.x & 63, w = threadIdx.x >> 6;
  const int first = (l == 1) ? ROWS_C / 4 : 0;
#pragma unroll 1
  for (int it = first + blockIdx.x; it < ROWS / 4; it += gridDim.x) {
    int m = it * 4 + w;
    RowInfo ri = row_info(m);
    const bf16* y = WS(bf16, OFF_PROJ) + (size_t)m * D + lane * 16;
    const float* hres; float* dst;
    if (ri.isctx) { hres = P.ctx + (size_t)m * D; dst = WS(float, OFF_HC) + (size_t)m * D; }
    else { hres = (l == 0 ? P.x : P.out) + (size_t)(m - ROWS_C) * D; dst = P.out + (size_t)(m - ROWS_C) * D; }
    const int mrow = ri.isctx ? BATCH : ri.b;
    const float* mod = WS(float, OFF_MOD) + ((size_t)l * NMOD + mrow) * 3072 + 2048;
    const int c0 = lane * 16;
    U4 y0 = *(const U4*)y, y1 = *(const U4*)(y + 8);
    float v[16]; float ss = 0.f;
#pragma unroll
    for (int e = 0; e < 4; e++) { v[2 * e] = lo2f(y0.a[e]); v[2 * e + 1] = hi2f(y0.a[e]); v[8 + 2 * e] = lo2f(y1.a[e]); v[8 + 2 * e + 1] = hi2f(y1.a[e]); }
#pragma unroll
    for (int e = 0; e < 16; e++) ss += v[e] * v[e];
    ss = sum64(ss);
    float rstd = rsqrtf(ss * (1.f / 1024.f) + 1e-6f);
    float hn[16]; float ss2 = 0.f;
#pragma unroll
    for (int q = 0; q < 4; q++) {
      F4 hr = *(const F4*)(hres + c0 + 4 * q), gm = *(const F4*)(mod + c0 + 4 * q), np = *(const F4*)(P.norm_post + l * D + c0 + 4 * q), o;
#pragma unroll
      for (int e = 0; e < 4; e++) { o.a[e] = hr.a[e] + gm.a[e] * (v[4 * q + e] * rstd * np.a[e]); hn[4 * q + e] = o.a[e]; ss2 += o.a[e] * o.a[e]; }
      *(F4*)(dst + c0 + 4 * q) = o;
    }
    if (l == 0) {
      ss2 = sum64(ss2);
      float rstd2 = rsqrtf(ss2 * (1.f / 1024.f) + 1e-6f);
      const float* mod1 = WS(float, OFF_MOD) + ((size_t)1 * NMOD + mrow) * 3072;
      bf16* hd = WS(bf16, OFF_R) + (size_t)m * D + c0;
      U4 o0, o1;
#pragma unroll
      for (int q = 0; q < 4; q++) {
        F4 np = *(const F4*)(P.norm_pre + 1 * D + c0 + 4 * q), sc = *(const F4*)(mod1 + 1024 + c0 + 4 * q), sh = *(const F4*)(mod1 + c0 + 4 * q);
        float t0 = hn[4 * q] * rstd2 * np.a[0] * (1.f + sc.a[0]) + sh.a[0], t1 = hn[4 * q + 1] * rstd2 * np.a[1] * (1.f + sc.a[1]) + sh.a[1];
        float t2 = hn[4 * q + 2] * rstd2 * np.a[2] * (1.f + sc.a[2]) + sh.a[2], t3 = hn[4 * q + 3] * rstd2 * np.a[3] * (1.f + sc.a[3]) + sh.a[3];
        if (q < 2) { o0.a[2 * q] = pack2(t0, t1); o0.a[2 * q + 1] = pack2(t2, t3); }
        else { o1.a[2 * (q - 2)] = pack2(t0, t1); o1.a[2 * (q - 2) + 1] = pack2(t2, t3); }
      }
      *(U4*)hd = o0; *(U4*)(hd + 8) = o1;
    }
  }
}

constexpr int NPHASE = 19;
__device__ __forceinline__ void run_phase(const Params& P, int ph, unsigned char* sm) {
  if (ph == 0) { phase_prologue(P, sm); return; }
  int l = (ph - 1) / 9, s = (ph - 1) % 9;
  switch (s) {
    case 0: if (l == 0) phase_normmod(P, l); break;
    case 1: phase_inproj(P, l, sm); break;
    case 2: phase_rwprep(P, l, sm); break;
    case 3: { long long dummy = 0; phase_D(P, l, sm, dummy); } break;
    case 4: { long long dummy = 0; phase_E(P, l, sm, dummy); } break;
    case 5: break;
    case 6: phase_G(P, l, sm); break;
    case 7: phase_outproj(P, l, sm); break;
    default: phase_post(P, l); break;
  }
}

#ifndef CPU_EMU
#define XB_TMO      128
#define XB_XCNT(j)  (256  + 64 * (j))
#define XB_XSUB(j)  (1280 + 64 * (j))
#define XB_XGEN(j)  (2304 + 64 * (j))
#define XB_TOP      3328
#define XB_TOPGEN   3392
#define XCD_BAR_WORDS 3456
#define XB_SPIN_CAP (1u << 18)
#define LAS __attribute__((address_space(3)))

__device__ __forceinline__ unsigned xb_ld(unsigned* p)              { return __hip_atomic_load(p, __ATOMIC_RELAXED, __HIP_MEMORY_SCOPE_AGENT); }
__device__ __forceinline__ unsigned xb_add(unsigned* p, unsigned v) { return __hip_atomic_fetch_add(p, v, __ATOMIC_RELAXED, __HIP_MEMORY_SCOPE_AGENT); }
__device__ __forceinline__ unsigned xb_xcc_id() { return (unsigned)__builtin_amdgcn_s_getreg((3 << 11) | 20) & 0xFu; }
#define XB_SPIN(cond, bar) do { unsigned _sp = 0; while (cond) { __builtin_amdgcn_s_sleep(1); \
    if ((++_sp & 255u) == 0u) { if (xb_ld(&(bar)[XB_TMO])) break; if (_sp > XB_SPIN_CAP) { atomicAdd(&(bar)[XB_TMO], 1u); break; } } } } while (0)

struct XcdBarrier {
    unsigned* bar; unsigned x;
    volatile LAS unsigned* st;
};

__device__ __forceinline__ XcdBarrier xcd_barrier_post(unsigned* bar, volatile LAS unsigned* st) {
    XcdBarrier b; b.bar = bar; b.x = xb_xcc_id(); b.st = st;
    if (threadIdx.x == 0) (void)xb_add(&bar[XB_XCNT(b.x)], 1u);
    return b;
}
__device__ __forceinline__ void xcd_barrier_complete(unsigned* bar, unsigned x, unsigned& nloc, unsigned& nx) {
    const unsigned G = gridDim.x * gridDim.y * gridDim.z;
    unsigned sum, cnt, mine, sp = 0u;
    for (;;) {
        sum = 0u; cnt = 0u; mine = 0u;
#pragma unroll
        for (unsigned j = 0; j < 16; ++j) { const unsigned c = xb_ld(&bar[XB_XCNT(j)]); sum += c; cnt += (c > 0u) ? 1u : 0u; mine = (j == x) ? c : mine; }
        if (sum == G) break;
        __builtin_amdgcn_s_sleep(1);
        if ((++sp & 255u) == 0u) { if (xb_ld(&bar[XB_TMO])) break; if (sp > XB_SPIN_CAP) { atomicAdd(&bar[XB_TMO], 1u); break; } }
    }
    nloc = mine > 0u ? mine : 1u; nx = cnt > 0u ? cnt : 1u;
}

__device__ __forceinline__ void xcd_barrier(const XcdBarrier& b) {
    asm volatile("s_waitcnt vmcnt(0)" ::: "memory");
    __syncthreads();
    if (threadIdx.x == 0) {
        unsigned* bar = b.bar;
        __builtin_amdgcn_s_waitcnt(0);
        unsigned nloc = b.st[0], nx = b.st[1];
        if (nloc == 0u) { xcd_barrier_complete(bar, b.x, nloc, nx); b.st[0] = nloc; b.st[1] = nx; }
        const unsigned old = xb_add(&bar[XB_XSUB(b.x)], 1u);
        const unsigned gen = old / nloc;
        if (old + 1u == (gen + 1u) * nloc) {
            __builtin_amdgcn_fence(__ATOMIC_RELEASE, "agent");
            asm volatile("s_waitcnt vmcnt(0)" ::: "memory");
            const unsigned og = xb_add(&bar[XB_TOP], 1u);
            const unsigned tg = og / nx;
            if (og + 1u == (tg + 1u) * nx) xb_add(&bar[XB_TOPGEN], 1u);
            else XB_SPIN(xb_ld(&bar[XB_TOPGEN]) == tg, bar);
            __builtin_amdgcn_fence(__ATOMIC_ACQUIRE, "agent");
            xb_add(&bar[XB_XGEN(b.x)], 1u);
            asm volatile("s_waitcnt vmcnt(0)" ::: "memory");
        } else {
            XB_SPIN(xb_ld(&bar[XB_XGEN(b.x)]) == gen, bar);
            __builtin_amdgcn_fence(__ATOMIC_ACQUIRE, "agent");
            asm volatile("s_waitcnt vmcnt(0)" ::: "memory");
        }
    }
    __syncthreads();
}


#define PH(bit, call) { long long t0_ = 0; if (PROBE_PHASE == (bit)) t0_ = wall_clock64(); call; xcd_barrier(xb); if (PROBE_PHASE == (bit)) pacc += wall_clock64() - t0_; }
template <int L> __device__ __forceinline__ void run_layer(const Params& P, unsigned char* sm, const XcdBarrier& xb, long long& pacc) {
  if (L == 0) PH(0, phase_normmod(P, L))
  PH(1, phase_inproj(P, L, sm))
  PH(2, phase_rwprep(P, L, sm))
  PH(3, phase_D(P, L, sm, pacc))
  PH(4, phase_E(P, L, sm, pacc))
  PH(6, phase_G(P, L, sm))
  PH(7, phase_outproj(P, L, sm))
  if (L == 0) PH(8, phase_post(P, L))
  else phase_post(P, L);
}
__global__ void __launch_bounds__(256, 2) mega_kernel(Params P) {
  __shared__ __attribute__((aligned(16))) unsigned char sm[SMEM_BYTES];
  __shared__ uint4 xb_words;
  cg::grid_group grid = cg::this_grid();
  long long pacc = 0;
  if (threadIdx.x == 0) xb_words = make_uint4(0u, 0u, 0u, 0u);
  __syncthreads();
  XcdBarrier xb = xcd_barrier_post((unsigned*)(P.ws + OFF_BAR), (volatile LAS unsigned*)&xb_words);
  if (P.ws == nullptr) grid.sync();
  PH(9, phase_prologue(P, sm))
  run_layer<0>(P, sm, xb, pacc);
  run_layer<1>(P, sm, xb, pacc);
  if (PROBE_PHASE >= 0 && blockIdx.x == 0 && threadIdx.x == 0) {
    long long t1 = wall_clock64();
    while (wall_clock64() - t1 < pacc) { __builtin_amdgcn_s_sleep(10); }
  }
}
__global__ void __launch_bounds__(256, 2) phase_kernel(Params P, int ph) {
  __shared__ __attribute__((aligned(16))) unsigned char sm[SMEM_BYTES];
  run_phase(P, ph, sm);
}

extern "C" void kernel_launch(void* const* d_in, const int* in_sizes, int n_in, void* d_out, int out_size,
                              void* d_ws, size_t ws_size, hipStream_t stream) {
  Params P{};
  const float** pp = (const float**)&P;
  for (int i = 0; i < 39; i++) pp[i] = (const float*)d_in[i];
  P.out = (float*)d_out;
  P.ws = (unsigned char*)d_ws;
  if (ws_size < WS_TOTAL) fprintf(stderr, "workspace too small: %zu < %zu\n", ws_size, (size_t)WS_TOTAL);
#if USE_COOP
  static int grid_blocks = 0;
  if (!grid_blocks) {
    int dev = 0, cus = 0, per_cu = 0;
    hipGetDevice(&dev);
    hipDeviceGetAttribute(&cus, hipDeviceAttributeMultiprocessorCount, dev);
    hipOccupancyMaxActiveBlocksPerMultiprocessor(&per_cu, mega_kernel, 256, 0);
    if (per_cu > 2) per_cu = 2;
    grid_blocks = cus * per_cu;
  }
  hipMemsetAsync((unsigned char*)d_ws + OFF_BAR, 0, 3456 * 4, stream);
  void* args[] = {&P};
  hipError_t e = hipLaunchCooperativeKernel((void*)mega_kernel, dim3(grid_blocks), dim3(256), args, 0, stream);
  if (e != hipSuccess) fprintf(stderr, "cooperative launch failed: %s (grid %d)\n", hipGetErrorString(e), grid_blocks);
#else
  for (int ph = 0; ph < NPHASE; ph++) phase_kernel<<<1024, 256, 0, stream>>>(P, ph);
#endif
}
#endif
```

```cpp
#ifdef CPU_EMU
#include "hip_emu.h"
#else
#include <hip/hip_runtime.h>
#include <hip/hip_cooperative_groups.h>
#include <stdint.h>
#include <stdio.h>
namespace cg = cooperative_groups;
#endif

#ifndef BATCH
#define BATCH 8
#endif
#ifndef SEQ
#define SEQ 4096
#endif
#ifndef CTX
#define CTX 256
#endif
#ifndef USE_COOP
#define USE_COOP 1
#endif
#ifndef PROBE_PHASE
#define PROBE_PHASE -1
#endif

typedef unsigned short bf16;
typedef __attribute__((ext_vector_type(8))) short bf16x8;
typedef __attribute__((ext_vector_type(16))) float f32x16;
struct alignas(16) U4 { uint32_t a[4]; };
typedef uint32_t u32x4 __attribute__((ext_vector_type(4)));
struct alignas(8) U2 { uint32_t a[2]; };
struct alignas(16) F4 { float a[4]; };

constexpr int D = 1024, NIN = 3368, NINP = 3456;
constexpr int ROWS_C = BATCH * CTX, ROWS_L = BATCH * SEQ, ROWS = ROWS_C + ROWS_L;
constexpr int VL = CTX + SEQ;
constexpr int TC = 64;
constexpr int NCH_C = CTX / TC, NCH_L = SEQ / TC, NCH = NCH_C + NCH_L;
constexpr int T5 = 32;
constexpr int NC5 = CTX / T5, NL5 = SEQ / T5, NCH5 = NC5 + NL5;
constexpr int M5 = BATCH * NCH5;
constexpr int NMOD = BATCH + 1;
constexpr int C_RW = 0, C_RWG = 1024, C_S5 = 1280, C_S5G = 1536, C_SSD = 1792, C_SSDDT = 2304, C_SSDZ = 2312;
constexpr int C_GLA = 2568, C_GLAK = 2696, C_GLAV = 2824, C_GLAGL = 3080, C_GLAG = 3112;

constexpr size_t al256(size_t x) { return (x + 255) & ~size_t(255); }
constexpr size_t OFF_WTIN = 0;
constexpr size_t OFF_WTOUT = OFF_WTIN + al256(2ull * NINP * D * 2);
constexpr size_t OFF_W2T = OFF_WTOUT + al256(2ull * D * D * 2);
constexpr size_t OFF_A2T = OFF_W2T + al256(2ull * 2 * 256 * 64 * 2);
constexpr size_t OFF_GLUT = OFF_A2T + al256(2ull * 2 * 256 * 64 * 2);
constexpr size_t OFF_MOD = OFF_GLUT + al256(2ull * 256 * 256 * 2);
constexpr size_t OFF_S5K = OFF_MOD + al256(2ull * NMOD * 3072 * 4);
constexpr size_t OFF_S5LT = OFF_S5K + al256(2ull * 16 * 2 * 32 * 256 * 4);
constexpr size_t OFF_W1T = OFF_S5LT + al256(2ull * 16 * 2 * 64 * 2 * 4);
constexpr size_t OFF_BT2 = OFF_W1T + al256(2ull * 16 * 256 * 512 * 2);
constexpr size_t OFF_PROJ = OFF_BT2 + al256(2ull * 16 * 512 * 768 * 2);
constexpr size_t OFF_R = OFF_PROJ + al256((size_t)ROWS * NIN * 2);
constexpr size_t OFF_XA = OFF_R + al256((size_t)ROWS * 1024 * 2);
constexpr size_t OFF_HC = OFF_XA + al256((size_t)ROWS * 1024 * 2);
constexpr size_t OFF_SSDST = OFF_HC + al256((size_t)ROWS_C * 1024 * 4);
constexpr size_t OFF_SSDDEC = OFF_SSDST + al256(2ull * BATCH * NCH * 4 * 4096 * 2);
constexpr size_t OFF_GLAST = OFF_SSDDEC + al256(2ull * BATCH * NCH * 4 * 4);
constexpr size_t OFF_GLADEC = OFF_GLAST + al256(2ull * BATCH * NCH * 4 * 2048 * 2);
constexpr size_t OFF_S5ST = OFF_GLADEC + al256(2ull * BATCH * NCH * 4 * 32 * 4);
constexpr size_t OFF_SSQ = OFF_S5ST + al256(16ull * M5 * 256 * 4);
constexpr size_t OFF_BON = OFF_SSQ + al256((size_t)ROWS * 4 * 4);
constexpr size_t OFF_BAR = OFF_BON + al256((size_t)ROWS * 8 * 4);
constexpr size_t OFF_YS5 = OFF_BAR + al256(3456 * 4);
constexpr size_t WS_TOTAL = OFF_YS5 + al256((size_t)ROWS * 256 * 2);
#if BATCH == 8 && SEQ == 4096 && CTX == 256
static_assert(WS_TOTAL <= 536870912ull, "workspace too large");
#endif
constexpr int SMEM_BYTES = 64512;

struct Params {
  const float *x, *c, *ctx, *c_ctx, *ada_w, *ada_b, *norm_pre, *norm_post, *w_in, *w_out;
  const float *rw_mu, *rw_w0, *rw_w2, *rw_a0, *rw_a2, *rw_kk, *rw_ka, *rw_rk, *rw_ln_w, *rw_ln_b;
  const float *s5_a_re, *s5_a_im, *s5_log_dt, *s5_b_re, *s5_b_im, *s5_c_re, *s5_c_im, *s5_d, *s5_glu_w, *s5_glu_b;
  const float *ssd_conv_w, *ssd_conv_b, *ssd_dt_bias, *ssd_a_log, *ssd_d, *ssd_norm;
  const float *gla_g2, *gla_gb, *gla_norm;
  float* out;
  unsigned char* ws;
};

#ifdef CPU_EMU
#define OPAQUE(x)
#else
#define OPAQUE(x) asm volatile("" : "+v"(x))
#endif
struct Params;
__device__ __forceinline__ void ssd_state_item(const Params& P, int l, int item, unsigned char* sm);
__device__ __forceinline__ void gla_state_item(const Params& P, int l, int item, unsigned char* sm);
__device__ __forceinline__ void s5_state_tile(const Params& P, int l, int item, unsigned char* sm);
__device__ __forceinline__ void chunk_scans(const Params& P, int l, int base);
__device__ __forceinline__ float bf2f(bf16 v) { return __uint_as_float(((uint32_t)v) << 16); }
__device__ __forceinline__ bf16 f2bf(float f) {
  uint32_t u = __float_as_uint(f);
  u += 0x7fffu + ((u >> 16) & 1u);
  return (bf16)(u >> 16);
}
__device__ __forceinline__ uint32_t pack2(float lo, float hi) { return (uint32_t)f2bf(lo) | ((uint32_t)f2bf(hi) << 16); }
__device__ __forceinline__ float lo2f(uint32_t u) { return __uint_as_float(u << 16); }
__device__ __forceinline__ float hi2f(uint32_t u) { return __uint_as_float(u & 0xffff0000u); }
__device__ __forceinline__ float sigmoid_f(float x) { return 1.f / (1.f + __expf(-x)); }
__device__ __forceinline__ float silu_f(float x) { return x / (1.f + __expf(-x)); }
__device__ __forceinline__ float softplus_f(float x) { return fmaxf(x, 0.f) + __logf(1.f + __expf(-fabsf(x))); }
__device__ __forceinline__ float tanh_f(float x) { return 1.f - 2.f / (1.f + __expf(2.f * x)); }
__device__ __forceinline__ float gelu_f(float x) {
  return 0.5f * x * (1.f + tanh_f(0.7978845608028654f * (x + 0.044715f * x * x * x)));
}
__device__ __forceinline__ U4 zero4() { U4 r; r.a[0] = r.a[1] = r.a[2] = r.a[3] = 0; return r; }
__device__ __forceinline__ f32x16 mfma32(bf16x8 a, bf16x8 b, f32x16 c) {
#ifdef CPU_EMU
  return emu_mfma32(a, b, c);
#else
  return __builtin_amdgcn_mfma_f32_32x32x16_bf16(a, b, c, 0, 0, 0);
#endif
}
__device__ __forceinline__ f32x16 zero16() { f32x16 z; for (int i = 0; i < 16; i++) z[i] = 0.f; return z; }
__device__ __forceinline__ int acc_row(int reg, int lane) { return (reg & 3) + 8 * (reg >> 2) + 4 * (lane >> 5); }
template <int CTRL> __device__ __forceinline__ float dpp_mov(float v) {
#ifdef CPU_EMU
  int l = threadIdx.x & 63, src;
  if (CTRL == 0xB1) src = l ^ 1; else if (CTRL == 0x4E) src = l ^ 2;
  else if (CTRL == 0x141) src = (l & ~7) | (7 - (l & 7)); else src = (l & ~15) | (15 - (l & 15));
  return emu_lane_read(v, src);
#else
  return __int_as_float(__builtin_amdgcn_update_dpp(0, __float_as_int(v), CTRL, 0xF, 0xF, true));
#endif
}
__device__ __forceinline__ float sum16(float v) {
  v += dpp_mov<0xB1>(v); v += dpp_mov<0x4E>(v); v += dpp_mov<0x141>(v); v += dpp_mov<0x140>(v); return v;
}
__device__ __forceinline__ float sum32(float v) {
  v = sum16(v);
#ifdef CPU_EMU
  int l = threadIdx.x & 63; float o = emu_lane_read(v, ((l >> 4) > 0 ? ((l >> 4) - 1) * 16 + 15 : 0));
  if ((l >> 4) & 1) v += o;
#else
  v += __int_as_float(__builtin_amdgcn_update_dpp(0, __float_as_int(v), 0x142, 0xA, 0xF, false));
#endif
  return v;
}
__device__ __forceinline__ float sum64(float v) {
  v = sum16(v);
#ifdef CPU_EMU
  return emu_lane_read(v, 0) + emu_lane_read(v, 16) + emu_lane_read(v, 32) + emu_lane_read(v, 48);
#else
  int iv = __float_as_int(v);
  return __int_as_float(__builtin_amdgcn_readlane(iv, 0)) + __int_as_float(__builtin_amdgcn_readlane(iv, 16)) +
         __int_as_float(__builtin_amdgcn_readlane(iv, 32)) + __int_as_float(__builtin_amdgcn_readlane(iv, 48));
#endif
}

__device__ __forceinline__ const bf16x8& ldsfrag(const bf16* p) { return *(const bf16x8*)p; }

__device__ __forceinline__ int chunk_row0(int b, int pc, int T, int nC) {
  return pc < nC ? b * CTX + pc * T : ROWS_C + b * SEQ + (pc - nC) * T;
}
__device__ __forceinline__ int ord_chunk(int d, int vc, int nC, int nAll) {
  return d == 0 ? vc : (vc < nC ? nC - 1 - vc : nAll - 1 - (vc - nC));
}
struct RowInfo { int isctx, b, t, seq0, len; };
__device__ __forceinline__ RowInfo row_info(int m) {
  RowInfo r;
  if (m < ROWS_C) { r.isctx = 1; r.b = m / CTX; r.t = m - r.b * CTX; r.seq0 = r.b * CTX; r.len = CTX; }
  else { int q = m - ROWS_C; r.isctx = 0; r.b = q / SEQ; r.t = q - r.b * SEQ; r.seq0 = ROWS_C + r.b * SEQ; r.len = SEQ; }
  return r;
}

template <class AL, class BL, class EP>
__device__ __forceinline__ void gemm_tile(unsigned char* sm, int m0, int n0, int K, AL al, BL bl, EP ep) {
  bf16* sA0 = (bf16*)sm;
  int tid_ = threadIdx.x; OPAQUE(tid_);
  const int tid = tid_, lane = tid & 63, w = tid >> 6, wm = w >> 1, wn = w & 1;
  f32x16 acc[2][2];
#pragma unroll
  for (int i = 0; i < 2; i++)
#pragma unroll
    for (int j = 0; j < 2; j++) acc[i][j] = zero16();
  const int lr = tid >> 2, lk = (tid & 3) * 8;
  U4 ra0 = al(m0 + lr, lk), ra1 = al(m0 + lr + 64, lk), rb0 = bl(n0 + lr, lk), rb1 = bl(n0 + lr + 64, lk);
  {
    bf16* sA = sA0; bf16* sB = sA + 128 * 40;
    *(U4*)&sA[lr * 40 + lk] = ra0; *(U4*)&sA[(lr + 64) * 40 + lk] = ra1;
    *(U4*)&sB[lr * 40 + lk] = rb0; *(U4*)&sB[(lr + 64) * 40 + lk] = rb1;
  }
  if (32 < K) { ra0 = al(m0 + lr, 32 + lk); ra1 = al(m0 + lr + 64, 32 + lk); rb0 = bl(n0 + lr, 32 + lk); rb1 = bl(n0 + lr + 64, 32 + lk); }
  __syncthreads();
  int cur = 0;
#pragma unroll 2
  for (int k0 = 0; k0 < K; k0 += 32) {
    bf16* sA = sA0 + cur * (256 * 40); bf16* sB = sA + 128 * 40;
    if (k0 + 32 < K) {
      bf16* nA = sA0 + (cur ^ 1) * (256 * 40); bf16* nB = nA + 128 * 40;
      *(U4*)&nA[lr * 40 + lk] = ra0; *(U4*)&nA[(lr + 64) * 40 + lk] = ra1;
      *(U4*)&nB[lr * 40 + lk] = rb0; *(U4*)&nB[(lr + 64) * 40 + lk] = rb1;
      if (k0 + 64 < K) {
        ra0 = al(m0 + lr, k0 + 64 + lk); ra1 = al(m0 + lr + 64, k0 + 64 + lk);
        rb0 = bl(n0 + lr, k0 + 64 + lk); rb1 = bl(n0 + lr + 64, k0 + 64 + lk);
      }
    }
#pragma unroll
    for (int ks = 0; ks < 32; ks += 16) {
      bf16x8 fa[2], fb[2];
#pragma unroll
      for (int i = 0; i < 2; i++) fa[i] = ldsfrag(&sA[(wm * 64 + i * 32 + (lane & 31)) * 40 + ks + 8 * (lane >> 5)]);
#pragma unroll
      for (int j = 0; j < 2; j++) fb[j] = ldsfrag(&sB[(wn * 64 + j * 32 + (lane & 31)) * 40 + ks + 8 * (lane >> 5)]);
#pragma unroll
      for (int i = 0; i < 2; i++)
#pragma unroll
        for (int j = 0; j < 2; j++) acc[i][j] = mfma32(fa[i], fb[j], acc[i][j]);
    }
    __syncthreads();
    cur ^= 1;
  }
#pragma unroll
  for (int i = 0; i < 2; i++)
#pragma unroll
   for (int j = 0; j < 2; j++)
#pragma unroll
    for (int r = 0; r < 16; r++)
      ep(m0 + wm * 64 + i * 32 + acc_row(r, lane), n0 + wn * 64 + j * 32 + (lane & 31), acc[i][j][r]);
}

template <class AL, class BL, class EP>
__device__ __forceinline__ void gemm_tile_big(unsigned char* sm, int m0, int n0, int K, AL al, BL bl, EP ep) {
  bf16* sA0 = (bf16*)sm;
  int tid_ = threadIdx.x; OPAQUE(tid_);
  const int tid = tid_, lane = tid & 63, w = tid >> 6, wm = w >> 1, wn = w & 1;
  f32x16 acc[4][2];
#pragma unroll
  for (int i = 0; i < 4; i++)
#pragma unroll
    for (int j = 0; j < 2; j++) acc[i][j] = zero16();
  const int lr = tid >> 2, lk = (tid & 3) * 8;
  U4 ra[4], rb[2];
#pragma unroll
  for (int i = 0; i < 4; i++) ra[i] = al(m0 + lr + 64 * i, lk);
#pragma unroll
  for (int i = 0; i < 2; i++) rb[i] = bl(n0 + lr + 64 * i, lk);
  {
    bf16* sA = sA0; bf16* sB = sA + 256 * 40;
#pragma unroll
    for (int i = 0; i < 4; i++) *(U4*)&sA[(lr + 64 * i) * 40 + lk] = ra[i];
#pragma unroll
    for (int i = 0; i < 2; i++) *(U4*)&sB[(lr + 64 * i) * 40 + lk] = rb[i];
  }
  if (32 < K) {
#pragma unroll
    for (int i = 0; i < 4; i++) ra[i] = al(m0 + lr + 64 * i, 32 + lk);
#pragma unroll
    for (int i = 0; i < 2; i++) rb[i] = bl(n0 + lr + 64 * i, 32 + lk);
  }
  __syncthreads();
  int cur = 0;
#pragma unroll 2
  for (int k0 = 0; k0 < K; k0 += 32) {
    bf16* sA = sA0 + cur * (384 * 40); bf16* sB = sA + 256 * 40;
    if (k0 + 32 < K) {
      bf16* nA = sA0 + (cur ^ 1) * (384 * 40); bf16* nB = nA + 256 * 40;
#pragma unroll
      for (int i = 0; i < 4; i++) *(U4*)&nA[(lr + 64 * i) * 40 + lk] = ra[i];
#pragma unroll
      for (int i = 0; i < 2; i++) *(U4*)&nB[(lr + 64 * i) * 40 + lk] = rb[i];
      if (k0 + 64 < K) {
#pragma unroll
        for (int i = 0; i < 4; i++) ra[i] = al(m0 + lr + 64 * i, k0 + 64 + lk);
#pragma unroll
        for (int i = 0; i < 2; i++) rb[i] = bl(n0 + lr + 64 * i, k0 + 64 + lk);
      }
    }
#pragma unroll
    for (int ks = 0; ks < 32; ks += 16) {
      bf16x8 fa[4], fb[2];
#pragma unroll
      for (int i = 0; i < 4; i++) fa[i] = ldsfrag(&sA[(wm * 128 + i * 32 + (lane & 31)) * 40 + ks + 8 * (lane >> 5)]);
#pragma unroll
      for (int j = 0; j < 2; j++) fb[j] = ldsfrag(&sB[(wn * 64 + j * 32 + (lane & 31)) * 40 + ks + 8 * (lane >> 5)]);
#pragma unroll
      for (int i = 0; i < 4; i++)
#pragma unroll
        for (int j = 0; j < 2; j++) acc[i][j] = mfma32(fa[i], fb[j], acc[i][j]);
    }
    __syncthreads();
    cur ^= 1;
  }
#pragma unroll
  for (int i = 0; i < 4; i++)
#pragma unroll
    for (int j = 0; j < 2; j++)
#pragma unroll
      for (int r = 0; r < 16; r++)
        ep(m0 + wm * 128 + i * 32 + acc_row(r, lane), n0 + wn * 64 + j * 32 + (lane & 31), acc[i][j][r]);
}

#define ITEM_LOOP(var, count, base) _Pragma("unroll 1") for (int var = (int)((blockIdx.x + gridDim.x - ((unsigned)(base) % gridDim.x)) % gridDim.x); var < (count); var += gridDim.x)
#define WS(T, off) ((T*)(P.ws + (off)))

__device__ __forceinline__ void transpose_tile(const float* src, int ld, int Ksz, int Nsz, bf16* dst, int kt, int nt, unsigned char* sm, bool perm = false) {
  float* s = (float*)sm;
  const int tid = threadIdx.x;
#pragma unroll 8
  for (int i = tid; i < 4096; i += 256) {
    int kk = i >> 6, nn = i & 63;
    int k = kt * 64 + kk, n = nt * 64 + nn;
    s[kk * 65 + nn] = (n < Nsz && k < Ksz) ? src[(size_t)k * ld + n] : 0.f;
  }
  __syncthreads();
#pragma unroll 8
  for (int i = tid; i < 4096; i += 256) {
    int nn = i >> 6, kk = i & 63;
    int ktd = perm ? (kt < 4 ? kt + 8 : (kt >= 8 && kt < 12) ? kt - 8 : kt) : kt;
    dst[(size_t)(nt * 64 + nn) * Ksz + ktd * 64 + kk] = f2bf(s[kk * 65 + nn]);
  }
  __syncthreads();
}

struct S5c { float lr, li, dt; };
__device__ __forceinline__ void s5_pow(const Params& P, int l, int d, int g, int p, float e, float& re, float& im) {
  int idx = ((l * 2 + d) * 16 + g) * 64 + p;
  float dt = __expf(P.s5_log_dt[(l * 2 + d) * 16 + g]);
  float ar = P.s5_a_re[idx] * dt * e, ai = P.s5_a_im[idx] * dt * e;
  float m = expf(ar);
  re = m * cosf(ai); im = m * sinf(ai);
}
__device__ __forceinline__ void s5_bbar_coef(const Params& P, int l, int d, int g, int p, float& re, float& im) {
  int idx = ((l * 2 + d) * 16 + g) * 64 + p;
  float lr = P.s5_a_re[idx], li = P.s5_a_im[idx];
  float br, bi; s5_pow(P, l, d, g, p, 1.f, br, bi);
  br -= 1.f;
  float den = lr * lr + li * li;
  re = (br * lr + bi * li) / den;
  im = (bi * lr - br * li) / den;
}

__device__ __forceinline__ void phase_prologue(const Params& P, unsigned char* sm) {
  const int tid = threadIdx.x;
  const int N_TIN = 2 * 16 * (NINP / 64);
  const int N_TOUT = 2 * 16 * 16;
  const int N_TL = 2 * 2 * 4;
  const int N_TA = 2 * 2 * 4;
  const int N_TG = 2 * 16;
  const int N_MOD = 2 * 48;
  const int N_S5K = 2 * 16 * 2 * 32;
  const int N_S5W1 = 2 * 16 * 32;
  const int N_S5B2 = 2 * 16 * 32;
  const int total = N_TIN + N_TOUT + N_TL + N_TA + N_TG + N_MOD + N_S5K + N_S5W1 + N_S5B2;
#pragma unroll 1
  for (int it = blockIdx.x; it < total; it += gridDim.x) {
    int i = it;
    if (i < N_TIN) {
      int l = i / (16 * (NINP / 64)), r = i % (16 * (NINP / 64));
      transpose_tile(P.w_in + (size_t)l * D * NIN, NIN, D, NIN, WS(bf16, OFF_WTIN) + (size_t)l * NINP * D, r % 16, r / 16, sm);
      continue;
    }
    i -= N_TIN;
    if (i < N_TOUT) {
      int l = i / 256, r = i % 256;
      transpose_tile(P.w_out + (size_t)l * D * D, D, D, D, WS(bf16, OFF_WTOUT) + (size_t)l * D * D, r % 16, r / 16, sm, true);
      continue;
    }
    i -= N_TOUT;
    if (i < N_TL) {
      int ld = i / 4, nt = i % 4;
      transpose_tile(P.rw_w2 + (size_t)ld * 64 * 256, 256, 64, 256, WS(bf16, OFF_W2T) + (size_t)ld * 256 * 64, 0, nt, sm);
      continue;
    }
    i -= N_TL;
    if (i < N_TA) {
      int ld = i / 4, nt = i % 4;
      transpose_tile(P.rw_a2 + (size_t)ld * 64 * 256, 256, 64, 256, WS(bf16, OFF_A2T) + (size_t)ld * 256 * 64, 0, nt, sm);
      continue;
    }
    i -= N_TA;
    if (i < N_TG) {
      int l = i / 16, r = i % 16;
      transpose_tile(P.s5_glu_w + (size_t)l * 256 * 256, 256, 256, 256, WS(bf16, OFF_GLUT) + (size_t)l * 256 * 256, r % 4, r / 4, sm);
      continue;
    }
    i -= N_TG;
    if (i < N_MOD) {
      int l = i / 48, ct = i % 48;
      float* ssil = (float*)sm;
      float* red = ssil + NMOD * 1024;
#pragma unroll 8
      for (int e = tid; e < NMOD * 1024; e += 256) {
        int r = e >> 10, k = e & 1023;
        float v = r < BATCH ? P.c[r * 1024 + k] : P.c_ctx[k];
        ssil[e] = silu_f(v);
      }
      __syncthreads();
      int kq = tid >> 6, jj = tid & 63, j = ct * 64 + jj;
      float acc[NMOD];
      for (int r = 0; r < NMOD; r++) acc[r] = 0.f;
      const float* wp = P.ada_w + (size_t)l * D * 3072 + j;
#pragma unroll 16
      for (int k = kq * 256; k < kq * 256 + 256; k++) {
        float wv = wp[(size_t)k * 3072];
#pragma unroll
        for (int r = 0; r < NMOD; r++) acc[r] += ssil[r * 1024 + k] * wv;
      }
#pragma unroll
      for (int r = 0; r < NMOD; r++) red[(kq * NMOD + r) * 64 + jj] = acc[r];
      __syncthreads();
#pragma unroll 8
      for (int e = tid; e < NMOD * 64; e += 256) {
        int r = e >> 6, j2 = e & 63;
        float s = red[(0 * NMOD + r) * 64 + j2] + red[(1 * NMOD + r) * 64 + j2] + red[(2 * NMOD + r) * 64 + j2] + red[(3 * NMOD + r) * 64 + j2];
        WS(float, OFF_MOD)[((size_t)l * NMOD + r) * 3072 + ct * 64 + j2] = s + P.ada_b[l * 3072 + ct * 64 + j2];
      }
      __syncthreads();
      continue;
    }
    i -= N_MOD;
    if (i < N_S5K) {
      int m = i & 31, d = (i >> 5) & 1, g = (i >> 6) & 15, l = i >> 10;
      float* spw = (float*)sm;
      if (tid < 64) {
        float pr, pi, cr, ci;
        s5_pow(P, l, d, g, tid, (float)m, pr, pi);
        s5_bbar_coef(P, l, d, g, tid, cr, ci);
        spw[tid * 2] = pr * cr - pi * ci; spw[tid * 2 + 1] = pr * ci + pi * cr;
      }
      __syncthreads();
      int c = tid >> 4, cp = tid & 15;
      size_t bb = ((size_t)((l * 2 + d) * 16 + g) * 64) * 16;
      size_t cb = ((size_t)((l * 2 + d) * 16 + g) * 16 + c) * 64;
      float s = 0.f;
#pragma unroll 8
      for (int p = 0; p < 64; p++) {
        float wr = spw[p * 2], wi = spw[p * 2 + 1];
        float br = P.s5_b_re[bb + p * 16 + cp], bi = P.s5_b_im[bb + p * 16 + cp];
        float zr = wr * br - wi * bi, zi = wr * bi + wi * br;
        float cr = P.s5_c_re[cb + p], ci = P.s5_c_im[cb + p];
        s += cr * zr - ci * zi;
      }
      WS(float, OFF_S5K)[((size_t)(((l * 16 + g) * 2 + d) * 32 + m)) * 256 + tid] = s;
      __syncthreads();
      continue;
    }
    i -= N_S5K;
    if (i < N_S5W1) {
      int j = i & 31, g = (i >> 5) & 15, l = i >> 9;
      int pp = tid, d = pp >> 7, ri = (pp >> 6) & 1, p = pp & 63;
      float e = d == 0 ? (float)(T5 - 1 - j) : (float)j;
      float pr, pi, cr, ci;
      s5_pow(P, l, d, g, p, e, pr, pi);
      s5_bbar_coef(P, l, d, g, p, cr, ci);
      float wr = pr * cr - pi * ci, wi = pr * ci + pi * cr;
      size_t bb = ((size_t)((l * 2 + d) * 16 + g) * 64 + p) * 16;
      bf16* dst = WS(bf16, OFF_W1T) + ((size_t)(l * 16 + g) * 256 + pp) * 512 + j * 16;
      for (int cp = 0; cp < 16; cp++) {
        float br = P.s5_b_re[bb + cp], bi = P.s5_b_im[bb + cp];
        float zr = wr * br - wi * bi, zi = wr * bi + wi * br;
        dst[cp] = f2bf(ri == 0 ? zr : zi);
      }
      if (j == 0 && ri == 0) {
        float tr, ti; s5_pow(P, l, d, g, p, (float)T5, tr, ti);
        float* lt = WS(float, OFF_S5LT) + ((size_t)((l * 16 + g) * 2 + d) * 64 + p) * 2;
        lt[0] = tr; lt[1] = ti;
      }
      continue;
    }
    i -= N_S5W1;
    {
      int t = i & 31, g = (i >> 5) & 15, l = i >> 9;
      int kk = tid, d = kk >> 7, ri = (kk >> 6) & 1, p = kk & 63;
      float e = d == 0 ? (float)(t + 1) : (float)(T5 - t);
      float pr, pi; s5_pow(P, l, d, g, p, e, pr, pi);
      for (int c = 0; c < 16; c++) {
        size_t cb = ((size_t)((l * 2 + d) * 16 + g) * 16 + c) * 64 + p;
        float cr = P.s5_c_re[cb], ci = P.s5_c_im[cb];
        float zr = cr * pr - ci * pi, zi = cr * pi + ci * pr;
        WS(bf16, OFF_BT2)[((size_t)(l * 16 + g) * 512 + t * 16 + c) * 768 + 512 + kk] = f2bf(ri == 0 ? zr : -zi);
      }
    }
  }
}

__device__ __forceinline__ void s5_toeplitz_items(const Params& P, int item) {
  int t = item & 31, g = (item >> 5) & 15, l = item >> 9;
  const float* K = WS(float, OFF_S5K) + (size_t)((l * 16 + g) * 2) * 32 * 256;
  bf16* dst = WS(bf16, OFF_BT2) + ((size_t)(l * 16 + g) * 512 + t * 16) * 768;
#pragma unroll 8
  for (int e = threadIdx.x; e < 16 * 512; e += 256) {
    int c = e >> 9, k = e & 511, j = k >> 4, cp = k & 15;
    float v;
    if (j < t) v = K[((0 * 32) + (t - j)) * 256 + c * 16 + cp];
    else if (j > t) v = K[((1 * 32) + (j - t)) * 256 + c * 16 + cp];
    else v = K[(0 * 32) * 256 + c * 16 + cp] + K[(1 * 32) * 256 + c * 16 + cp];
    dst[(size_t)c * 768 + k] = f2bf(v);
  }
}

__device__ __forceinline__ void phase_normmod(const Params& P, int l) {
  const int lane = threadIdx.x & 63, w = threadIdx.x >> 6;
  const int nrow_items = ROWS / 4;
  const int n_toe = (l == 0) ? 2 * 16 * 32 : 0;
#pragma unroll 1
  for (int it = blockIdx.x; it < nrow_items + n_toe; it += gridDim.x) {
    if (it >= nrow_items) { s5_toeplitz_items(P, it - nrow_items); continue; }
    int m = it * 4 + w;
    RowInfo ri = row_info(m);
    const float* src;
    if (ri.isctx) src = (l == 0 ? P.ctx : WS(float, OFF_HC)) + (size_t)m * D;
    else src = (l == 0 ? P.x : P.out) + (size_t)(m - ROWS_C) * D;
    const float* mod = WS(float, OFF_MOD) + ((size_t)l * NMOD + (ri.isctx ? BATCH : ri.b)) * 3072;
    F4 v[4]; float ss = 0.f;
    for (int q = 0; q < 4; q++) {
      v[q] = *(const F4*)(src + q * 256 + lane * 4);
      for (int e = 0; e < 4; e++) ss += v[q].a[e] * v[q].a[e];
    }
    ss = sum64(ss);
    float rstd = rsqrtf(ss * (1.f / 1024.f) + 1e-6f);
    bf16* dst = WS(bf16, OFF_R) + (size_t)m * D;
    for (int q = 0; q < 4; q++) {
      int c0 = q * 256 + lane * 4;
      float o[4];
      for (int e = 0; e < 4; e++) {
        int c = c0 + e;
        o[e] = v[q].a[e] * rstd * P.norm_pre[l * D + c] * (1.f + mod[1024 + c]) + mod[c];
      }
      U2 pk; pk.a[0] = pack2(o[0], o[1]); pk.a[1] = pack2(o[2], o[3]);
      *(U2*)(dst + c0) = pk;
    }
  }
}

__device__ __forceinline__ void phase_inproj(const Params& P, int l, unsigned char* sm) {
  const bf16* A = WS(bf16, OFF_R);
  const bf16* Bt = WS(bf16, OFF_WTIN) + (size_t)l * NINP * D;
  bf16* C = WS(bf16, OFF_PROJ);
  const int NT = NINP / 128, MT = ROWS / 256;
  const int total = MT * NT, per = total / 8;
  const int nfull = (total / (int)gridDim.x) * (int)gridDim.x;
#pragma unroll 1
  for (int it0 = blockIdx.x; it0 < nfull; it0 += gridDim.x) {
    int it = total % 8 == 0 ? (it0 & 7) * per + (it0 >> 3) : it0;
    int mt = it / NT, nt = it % NT;
    gemm_tile_big(sm, mt * 256, nt * 128, D,
      [&](int m, int k) { return *(const U4*)(A + (size_t)m * D + k); },
      [&](int n, int k) { return *(const U4*)(Bt + (size_t)n * D + k); },
      [&](int m, int n, float v) { if (n < NIN) C[(size_t)m * NIN + n] = f2bf(v); });
  }
#pragma unroll 1
  for (int q = blockIdx.x; q < 2 * (total - nfull); q += gridDim.x) {
    int it0 = nfull + (q >> 1), half = q & 1;
    int it = total % 8 == 0 ? (it0 & 7) * per + (it0 >> 3) : it0;
    int mt = it / NT, nt = it % NT;
    gemm_tile(sm, mt * 256 + half * 128, nt * 128, D,
      [&](int m, int k) { return *(const U4*)(A + (size_t)m * D + k); },
      [&](int n, int k) { return *(const U4*)(Bt + (size_t)n * D + k); },
      [&](int m, int n, float v) { if (n < NIN) C[(size_t)m * NIN + n] = f2bf(v); });
  }
}

__device__ __forceinline__ void rw_lerp4(const Params& P, int l, int m, int ms, int col, float* o) {
  const bf16* pr = WS(bf16, OFF_PROJ);
  U2 z = *(const U2*)(pr + (size_t)m * NIN + col);
  U2 zs; zs.a[0] = zs.a[1] = 0;
  if (ms >= 0) zs = *(const U2*)(pr + (size_t)ms * NIN + col);
  const float* mu = P.rw_mu + l * 1024 + col;
#pragma unroll
  for (int e = 0; e < 2; e++) {
    float a0 = lo2f(z.a[e]), a1 = hi2f(z.a[e]), s0 = lo2f(zs.a[e]), s1 = hi2f(zs.a[e]);
    o[2 * e] = a0 + mu[2 * e] * (s0 - a0);
    o[2 * e + 1] = a1 + mu[2 * e + 1] * (s1 - a1);
  }
}
__device__ __forceinline__ void phase_rwprep(const Params& P, int l, unsigned char* sm) {
  const int lane = threadIdx.x & 63, w = threadIdx.x >> 6;
  const int MT = ROWS / 128;
  const int n_gemm = MT * 2 * 4;
  const int n_rows = ROWS / 4;
  bf16* XA = WS(bf16, OFF_XA);
#pragma unroll 1
  for (int it = blockIdx.x; it < n_gemm + n_rows; it += gridDim.x) {
    if (it < n_gemm) {
      int kind = it & 3, nt = (it >> 2) & 1, mt = it >> 3;
      int isA = kind >> 1, d = kind & 1;
      const bf16* Bt = (isA ? WS(bf16, OFF_A2T) : WS(bf16, OFF_W2T)) + (size_t)(l * 2 + d) * 256 * 64;
      const float* bias = (isA ? P.rw_a0 : P.rw_w0) + (l * 2 + d) * 256;
      gemm_tile(sm, mt * 128, nt * 128, 64,
        [&](int m, int k) {
          RowInfo ri = row_info(m);
          int ms;
          if (ri.isctx) ms = ri.t < CTX - 1 ? m + 1 : -1; else ms = ri.t < SEQ - 64 ? m + 64 : -1;
          int col = 768 + isA * 128 + d * 64 + k;
          const bf16* prj = WS(bf16, OFF_PROJ);
          U4 z = *(const U4*)(prj + (size_t)m * NIN + col);
          U4 zs = ms >= 0 ? *(const U4*)(prj + (size_t)ms * NIN + col) : zero4();
          const float* mu = P.rw_mu + l * 1024 + col;
          U4 r;
#pragma unroll
          for (int e = 0; e < 4; e++) {
            float a0 = lo2f(z.a[e]), a1 = hi2f(z.a[e]), s0 = lo2f(zs.a[e]), s1 = hi2f(zs.a[e]);
            float o0 = a0 + mu[2 * e] * (s0 - a0), o1 = a1 + mu[2 * e + 1] * (s1 - a1);
            if (!isA) { o0 = tanh_f(o0); o1 = tanh_f(o1); }
            r.a[e] = pack2(o0, o1);
          }
          return r;
        },
        [&](int n, int k) { return *(const U4*)(Bt + (size_t)n * 64 + k); },
        [&](int m, int n, float v) {
          v += bias[n];
          float o;
          if (!isA) { o = -__expf(-softplus_f(-v) - 0.5f); }
          else o = sigmoid_f(v);
          XA[(size_t)m * 1024 + isA * 512 + d * 256 + n] = f2bf(o);
        });
      continue;
    }
    int m = (it - n_gemm) * 4 + w;
    RowInfo ri = row_info(m);
    int ms_r, ms_k, ms_v;
    if (ri.isctx) { ms_r = ms_k = ri.t > 0 ? m - 1 : -1; ms_v = ri.t < CTX - 1 ? m + 1 : -1; }
    else {
      int gx = ri.t & 63;
      ms_r = gx > 0 ? m - 1 : -1; ms_k = gx < 63 ? m + 1 : -1; ms_v = ri.t >= 64 ? m - 64 : -1;
    }
    bf16* R = WS(bf16, OFF_R) + (size_t)m * 1024;
    float rr[4], kk[4], vv[4], kap[4];
    rw_lerp4(P, l, m, ms_r, lane * 4, rr);
    rw_lerp4(P, l, m, ms_k, 256 + lane * 4, kk);
    rw_lerp4(P, l, m, ms_v, 512 + lane * 4, vv);
    float ss = 0.f;
    for (int e = 0; e < 4; e++) { kap[e] = kk[e] * P.rw_kk[l * 256 + lane * 4 + e]; ss += kap[e] * kap[e]; }
    ss = sum16(ss);
    float rs = rsqrtf(ss + 1e-6f);
    U2 o;
    o.a[0] = pack2(rr[0], rr[1]); o.a[1] = pack2(rr[2], rr[3]); *(U2*)(R + lane * 4) = o;
    o.a[0] = pack2(kk[0], kk[1]); o.a[1] = pack2(kk[2], kk[3]); *(U2*)(R + 256 + lane * 4) = o;
    o.a[0] = pack2(vv[0], vv[1]); o.a[1] = pack2(vv[2], vv[3]); *(U2*)(R + 512 + lane * 4) = o;
    o.a[0] = pack2(kap[0] * rs, kap[1] * rs); o.a[1] = pack2(kap[2] * rs, kap[3] * rs); *(U2*)(R + 768 + lane * 4) = o;
  }
  {
    const int n_ssd = BATCH * NCH * 8, n_gla = BATCH * NCH * 8, n_s5 = 16 * ((M5 + 127) / 128) * 2, base0 = n_gemm + n_rows;
    ITEM_LOOP(i, n_ssd, base0) ssd_state_item(P, l, i, sm);
    ITEM_LOOP(i, n_gla, base0 + n_ssd) gla_state_item(P, l, i, sm);
    ITEM_LOOP(i, n_s5, base0 + n_ssd + n_gla) s5_state_tile(P, l, i, sm);
  }
}

__device__ __forceinline__ bf16x8 gfrag(const bf16* base, int ld, int row, int k) {
  return *(const bf16x8*)(base + (size_t)row * ld + k);
}
__device__ __forceinline__ void wave_sync() {
#ifdef CPU_EMU
  pthread_barrier_wait(&g_wavebar[threadIdx.x >> 6]);
#else
  __builtin_amdgcn_wave_barrier();
#endif
}
__device__ __forceinline__ void store_acc_T(bf16* dst, int ld, int row_base, int col, const f32x16& acc, int lane) {
#pragma unroll
  for (int g = 0; g < 4; g++) {
    U2 o; o.a[0] = pack2(acc[4 * g], acc[4 * g + 1]); o.a[1] = pack2(acc[4 * g + 2], acc[4 * g + 3]);
    *(U2*)&dst[col * ld + row_base + 8 * g + 4 * (lane >> 5)] = o;
  }
}
__device__ __forceinline__ void rwkv_chunk_item(const Params& P, int l, int item, unsigned char* sm, long long& pacc) {
  long long tp0_ = 0; if (PROBE_PHASE >= 33 && PROBE_PHASE <= 36) tp0_ = wall_clock64();
  int tid_ = threadIdx.x; OPAQUE(tid_);
  const int tid = tid_, lane = tid & 63, w = tid >> 6, ti = w >> 1, tj = w & 1;
  const int lr = lane & 31, lh = lane >> 5;
  const int d = item & 1, h = (item >> 1) & 3, rest = item >> 3;
  const int pc = rest % NCH, b = rest / NCH;
  const int row0 = chunk_row0(b, pc, TC, NCH_C);
  float* sL = (float*)sm;
  bf16* sG1t = (bf16*)sm;
  bf16* sKT = (bf16*)(sm + 16640);
  bf16* sBT = sKT + 64 * 72;
  bf16* sKD = sBT + 64 * 72;
  bf16* sRT = sKD + 64 * 72;
  bf16* sVt = sRT + 64 * 72;
  float* sGT = (float*)(sVt + 64 * 72);
  bf16* X0 = WS(bf16, OFF_XA) + (size_t)row0 * 1024 + d * 256 + h * 64;
  bf16* X1 = X0 + 512;
  bf16* P0 = WS(bf16, OFF_PROJ) + (size_t)row0 * NIN + (h * 2 + d) * 128;
  bf16* P1 = P0 + 64;
  const bf16* Rb = WS(bf16, OFF_R) + (size_t)row0 * 1024 + h * 64;
  float rq[16], kq[16], pq[16], vq[16];
#pragma unroll
  for (int i = 0; i < 16; i++) {
    const bf16* rp = Rb + (size_t)(w + 4 * i) * 1024 + lane;
    rq[i] = bf2f(rp[0]); kq[i] = bf2f(rp[256]); vq[i] = bf2f(rp[512]); pq[i] = bf2f(rp[768]);
  }
#pragma unroll 8
  for (int idx = tid; idx < 4096; idx += 256) {
    int p = idx >> 6, k = idx & 63;
    sL[p * 65 + k] = bf2f(X0[(size_t)p * 1024 + k]);
    sVt[idx] = X1[(size_t)p * 1024 + k];
  }
  __syncthreads();
  {
    const int k = tid & 63, qq = tid >> 6;
    float* qt = sGT + 64 + 128;
    float run = 0.f;
    if (d == 0) { for (int p = qq * 16; p < qq * 16 + 16; p++) { run += sL[p * 65 + k]; sL[p * 65 + k] = run; } }
    else { for (int p = qq * 16 + 15; p >= qq * 16; p--) { run += sL[p * 65 + k]; sL[p * 65 + k] = run; } }
    qt[qq * 64 + k] = run;
    __syncthreads();
    float off = 0.f;
    if (d == 0) { for (int j = 0; j < qq; j++) off += qt[j * 64 + k]; }
    else { for (int j = 3; j > qq; j--) off += qt[j * 64 + k]; }
    for (int p = qq * 16; p < qq * 16 + 16; p++) sL[p * 65 + k] += off;
    if (qq == 0) sGT[k] = qt[k] + qt[64 + k] + qt[128 + k] + qt[192 + k];
  }
  __syncthreads();
  if (PROBE_PHASE == 35) pacc += wall_clock64() - tp0_;
  {
    const int k = lane;
    const float ka = P.rw_ka[l * 256 + h * 64 + k], rk = P.rw_rk[l * 256 + h * 64 + k];
#pragma unroll
    for (int i = 0; i < 16; i++) {
      const int p = w + 4 * i;
      float incl = sL[p * 65 + k];
      int pp = d == 0 ? p - 1 : p + 1;
      float excl = (pp < 0 || pp > 63) ? 0.f : sL[pp * 65 + k];
      float rr = rq[i], kk = kq[i], kap = pq[i];
      float a = bf2f(sVt[p * 64 + k]);
      float kd = kk * (1.f + (a - 1.f) * ka), beta = kap * a;
      float ei = __expf(incl), eni = __expf(-incl), ee = __expf(excl);
      sKT[p * 72 + k] = f2bf(kap * ee);
      sBT[p * 72 + k] = f2bf(beta * eni);
      sKD[p * 72 + k] = f2bf(kd * eni);
      sRT[p * 72 + k] = f2bf(rr * ei);
      float bs = sum64(rr * kd * rk);
      if (lane == 0) WS(float, OFF_BON)[(size_t)(row0 + p) * 8 + h * 2 + d] = bs;
    }
  }
  __syncthreads();
#pragma unroll 8
  for (int idx = tid; idx < 4096; idx += 256) {
    int kk = idx >> 6, p = idx & 63;
    P0[(size_t)kk * NIN + p] = sKT[p * 72 + kk];
    P1[(size_t)kk * NIN + p] = sBT[p * 72 + kk];
    X1[(size_t)kk * 1024 + p] = sKD[p * 72 + kk];
    X0[(size_t)kk * 1024 + p] = sRT[kk * 72 + p];
  }
  if (PROBE_PHASE == 36) pacc += wall_clock64() - tp0_;
  f32x16 aA = zero16(), aB = zero16(), aC = zero16(), aD = zero16();
#pragma unroll
  for (int ks = 0; ks < 64; ks += 16) {
    bf16x8 fK = ldsfrag(&sKT[(ti * 32 + lr) * 72 + ks + 8 * lh]);
    bf16x8 fR = ldsfrag(&sRT[(ti * 32 + lr) * 72 + ks + 8 * lh]);
    bf16x8 fB = ldsfrag(&sBT[(tj * 32 + lr) * 72 + ks + 8 * lh]);
    bf16x8 fD = ldsfrag(&sKD[(tj * 32 + lr) * 72 + ks + 8 * lh]);
    aA = mfma32(fK, fB, aA); aB = mfma32(fK, fD, aB); aC = mfma32(fR, fB, aC); aD = mfma32(fR, fD, aD);
  }
  __syncthreads();
  {
    int s_ = tj * 32 + lr;
#pragma unroll
    for (int r = 0; r < 16; r++) {
      int p = ti * 32 + acc_row(r, lane);
      bool earlier = d == 0 ? s_ < p : s_ > p;
      bool eq = s_ == p;
      sL[p * 65 + s_] = earlier ? aA[r] : 0.f;
      sKT[p * 72 + s_] = f2bf(earlier ? aB[r] : 0.f);
      sBT[p * 72 + s_] = f2bf((earlier || eq) ? aC[r] : 0.f);
      sKD[p * 72 + s_] = f2bf((earlier || eq) ? aD[r] : 0.f);
    }
  }
#pragma unroll
  for (int i = 0; i < 16; i++) sVt[lane * 72 + w + 4 * i] = f2bf(vq[i]);
  __syncthreads();
  if (PROBE_PHASE == 33) pacc += wall_clock64() - tp0_;
  bf16x8 fKt[4];
#pragma unroll
  for (int q4 = 0; q4 < 4; q4++) fKt[q4] = gfrag(P0, NIN, tj * 32 + lr, q4 * 16 + 8 * lh);
  bf16* sTinv = sRT;
  {
    const int q = tid >> 2, seg = tid & 3;
    float x[16];
#pragma unroll
    for (int i = 0; i < 16; i++) x[i] = (q == seg * 16 + i) ? 1.f : 0.f;
    float* rowbuf = (float*)sRT;
#pragma unroll 1
    for (int Bi = 0; Bi < 4; Bi++) {
      const int B = d == 0 ? Bi : 3 - Bi;
      float* rb = rowbuf + (Bi & 1) * 1024;
      if (w == B) {
#pragma unroll 1
        for (int s_ = 0; s_ < 16; s_++) {
          const int pl = d == 0 ? s_ : 15 - s_, p = B * 16 + pl;
          if (q == p) {
#pragma unroll
            for (int i = 0; i < 4; i++) { F4 o; o.a[0] = x[4 * i]; o.a[1] = x[4 * i + 1]; o.a[2] = x[4 * i + 2]; o.a[3] = x[4 * i + 3]; *(F4*)&rb[pl * 64 + seg * 16 + 4 * i] = o; }
          }
          wave_sync();
          const bool later = d == 0 ? q > p : q < p;
          if (later) {
            const float m = sL[q * 65 + p];
#pragma unroll
            for (int i = 0; i < 4; i++) {
              F4 o = *(const F4*)&rb[pl * 64 + seg * 16 + 4 * i];
              x[4 * i] -= m * o.a[0]; x[4 * i + 1] -= m * o.a[1]; x[4 * i + 2] -= m * o.a[2]; x[4 * i + 3] -= m * o.a[3];
            }
          }
        }
      }
      __syncthreads();
      const bool laterblock = d == 0 ? w > B : w < B;
      if (laterblock) {
#pragma unroll 4
        for (int pl = 0; pl < 16; pl++) {
          const float m = sL[q * 65 + B * 16 + pl];
#pragma unroll
          for (int i = 0; i < 4; i++) {
            F4 o = *(const F4*)&rb[pl * 64 + seg * 16 + 4 * i];
            x[4 * i] -= m * o.a[0]; x[4 * i + 1] -= m * o.a[1]; x[4 * i + 2] -= m * o.a[2]; x[4 * i + 3] -= m * o.a[3];
          }
        }
      }
    }
    __syncthreads();
#pragma unroll
    for (int i = 0; i < 8; i++) *(uint32_t*)&sTinv[q * 72 + seg * 16 + 2 * i] = pack2(x[2 * i], x[2 * i + 1]);
  }
  __syncthreads();
  if (PROBE_PHASE == 34) pacc += wall_clock64() - tp0_;
  {
    f32x16 aBV = zero16(), aG1 = zero16();
#pragma unroll
    for (int ks = 0; ks < 64; ks += 16) {
      aBV = mfma32(ldsfrag(&sKT[(ti * 32 + lr) * 72 + ks + 8 * lh]), ldsfrag(&sVt[(tj * 32 + lr) * 72 + ks + 8 * lh]), aBV);
      aG1 = mfma32(ldsfrag(&sTinv[(ti * 32 + lr) * 72 + ks + 8 * lh]), fKt[ks >> 4], aG1);
    }
    __syncthreads();
    store_acc_T(sKT, 72, ti * 32, tj * 32 + lr, aBV, lane);
    store_acc_T(sG1t, 72, ti * 32, tj * 32 + lr, aG1, lane);
  }
  __syncthreads();
  bf16x8 fKd4[4], fBt4[4]; float rtc[16];
#pragma unroll
  for (int q4 = 0; q4 < 4; q4++) { fKd4[q4] = gfrag(X1, 1024, ti * 32 + lr, q4 * 16 + 8 * lh); fBt4[q4] = gfrag(P1, NIN, ti * 32 + lr, q4 * 16 + 8 * lh); }
#pragma unroll
  for (int r = 0; r < 16; r++) rtc[r] = bf2f(X0[(size_t)(ti * 32 + acc_row(r, lane)) * 1024 + tj * 32 + lr]);
  {
    f32x16 aG2 = zero16();
#pragma unroll
    for (int ks = 0; ks < 64; ks += 16)
      aG2 = mfma32(ldsfrag(&sTinv[(ti * 32 + lr) * 72 + ks + 8 * lh]), ldsfrag(&sKT[(tj * 32 + lr) * 72 + ks + 8 * lh]), aG2);
    __syncthreads();
    store_acc_T(sRT, 72, ti * 32, tj * 32 + lr, aG2, lane);
  }
  __syncthreads();
  bf16* sG2t = sRT;
  {
    f32x16 a1 = zero16(), a2 = zero16(), a3 = zero16();
#pragma unroll
    for (int ks = 0; ks < 64; ks += 16) {
      bf16x8 fC = ldsfrag(&sBT[(ti * 32 + lr) * 72 + ks + 8 * lh]);
      bf16x8 fDy = ldsfrag(&sKD[(ti * 32 + lr) * 72 + ks + 8 * lh]);
      a1 = mfma32(fC, ldsfrag(&sG1t[(tj * 32 + lr) * 72 + ks + 8 * lh]), a1);
      a2 = mfma32(fDy, ldsfrag(&sVt[(tj * 32 + lr) * 72 + ks + 8 * lh]), a2);
      a3 = mfma32(fC, ldsfrag(&sG2t[(tj * 32 + lr) * 72 + ks + 8 * lh]), a3);
    }
    int c = tj * 32 + lr;
#pragma unroll
    for (int r = 0; r < 16; r++) {
      int p = ti * 32 + acc_row(r, lane);
      X0[(size_t)p * 1024 + c] = f2bf(rtc[r] - a1[r]);
      P0[(size_t)p * NIN + c] = f2bf(a2[r] - a3[r]);
    }
  }
  {
    f32x16 a1 = zero16(), a2 = zero16(), a3 = zero16();
#pragma unroll
    for (int ks = 0; ks < 64; ks += 16) {
      bf16x8 fKd = fKd4[ks >> 4];
      bf16x8 fBt = fBt4[ks >> 4];
      a1 = mfma32(fKd, ldsfrag(&sVt[(tj * 32 + lr) * 72 + ks + 8 * lh]), a1);
      a2 = mfma32(fBt, ldsfrag(&sG2t[(tj * 32 + lr) * 72 + ks + 8 * lh]), a2);
      a3 = mfma32(fBt, ldsfrag(&sG1t[(tj * 32 + lr) * 72 + ks + 8 * lh]), a3);
    }
    __syncthreads();
    int c = tj * 32 + lr;
#pragma unroll
    for (int r = 0; r < 16; r++) {
      int kp = ti * 32 + acc_row(r, lane);
      float gt = __expf(sGT[kp]);
      a1[r] = gt * (a1[r] - a2[r]);
      X1[(size_t)kp * 1024 + c] = f2bf(gt * ((kp == c ? 1.f : 0.f) - a3[r]));
    }
    U4 o0, o1;
#pragma unroll
    for (int e = 0; e < 4; e++) { o0.a[e] = pack2(a1[2 * e], a1[2 * e + 1]); o1.a[e] = pack2(a1[8 + 2 * e], a1[8 + 2 * e + 1]); }
    bf16* lp = P1 + (size_t)(tid >> 2) * NIN + (tid & 3) * 16;
    *(U4*)lp = o0; *(U4*)(lp + 8) = o1;
  }
  __syncthreads();
}

struct RwStage { bf16x8 pm[4]; U4 l0, l1; };
__device__ __forceinline__ void rwkv_scan2_item(const Params& P, int l, int item, unsigned char* sm) {
  int tid_ = threadIdx.x; OPAQUE(tid_);
  const int tid = tid_, lane = tid & 63, w = tid >> 6, ti = w >> 1, tj = w & 1;
  const int lr = lane & 31, lh = lane >> 5;
  const int d = item & 1, h = (item >> 1) & 3, b = item >> 3;
  bf16* sS = (bf16*)sm;
  f32x16 acc = zero16();
  RwStage st[4];
  auto load = [&](RwStage& s_, int vc) {
    int pc = ord_chunk(d, vc < NCH ? vc : NCH - 1, NCH_C, NCH);
    int row0 = chunk_row0(b, pc, TC, NCH_C);
    const bf16* X1 = WS(bf16, OFF_XA) + (size_t)row0 * 1024 + 512 + d * 256 + h * 64;
    const bf16* P1 = WS(bf16, OFF_PROJ) + (size_t)row0 * NIN + (h * 2 + d) * 128 + 64;
#pragma unroll
    for (int q = 0; q < 4; q++) s_.pm[q] = gfrag(X1, 1024, ti * 32 + lr, q * 16 + 8 * lh);
    const bf16* lp = P1 + (size_t)(tid >> 2) * NIN + (tid & 3) * 16;
    s_.l0 = *(const U4*)lp; s_.l1 = *(const U4*)(lp + 8);
  };
#pragma unroll
  for (int j = 0; j < 4; j++) load(st[j], j);
#pragma unroll 1
  for (int v0 = 0; v0 < NCH; v0 += 4) {
#pragma unroll
    for (int j = 0; j < 4; j++) {
      const int vc = v0 + j;
      if (vc < NCH) {
        int pc = ord_chunk(d, vc, NCH_C, NCH);
        int row0 = chunk_row0(b, pc, TC, NCH_C);
        bf16* X1 = WS(bf16, OFF_XA) + (size_t)row0 * 1024 + 512 + d * 256 + h * 64;
        store_acc_T(sS, 72, ti * 32, tj * 32 + lr, acc, lane);
        RwStage cur = st[j];
        __syncthreads();
        load(st[j], vc + 4);
        for (int idx = tid; idx < 512; idx += 256) {
          int v = idx >> 3, c8 = idx & 7;
          *(U4*)(X1 + (size_t)v * 1024 + c8 * 8) = *(const U4*)(sS + v * 72 + c8 * 8);
        }
        f32x16 nw;
#pragma unroll
        for (int e = 0; e < 4; e++) {
          nw[2 * e] = lo2f(cur.l0.a[e]); nw[2 * e + 1] = hi2f(cur.l0.a[e]);
          nw[8 + 2 * e] = lo2f(cur.l1.a[e]); nw[8 + 2 * e + 1] = hi2f(cur.l1.a[e]);
        }
#pragma unroll
        for (int q = 0; q < 4; q++) nw = mfma32(cur.pm[q], ldsfrag(&sS[(tj * 32 + lr) * 72 + q * 16 + 8 * lh]), nw);
        acc = nw;
        __syncthreads();
      }
    }
  }
}

__device__ __forceinline__ void rwkv_out_item(const Params& P, int l, int item, unsigned char* sm) {
  int tid_ = threadIdx.x; OPAQUE(tid_);
  const int tid = tid_, lane = tid & 63, w = tid >> 6, ti = w >> 1, tj = w & 1;
  const int lr = lane & 31, lh = lane >> 5;
  const int h = item & 3, rest = item >> 2, pc = rest % NCH, b = rest / NCH;
  if (l == 1 && pc < NCH_C) return;
  const int row0 = chunk_row0(b, pc, TC, NCH_C);
  float* spart = (float*)sm;
  float vvh[16], ggh[16], bnh[16];
#pragma unroll
  for (int r = 0; r < 16; r++) {
    const int row = row0 + ti * 32 + acc_row(r, lane), c = h * 64 + tj * 32 + lr;
    vvh[r] = bf2f(WS(bf16, OFF_R)[(size_t)row * 1024 + 512 + c]);
    ggh[r] = bf2f(WS(bf16, OFF_PROJ)[(size_t)row * NIN + C_RWG + c]);
    const float* bon = WS(float, OFF_BON) + (size_t)row * 8 + h * 2;
    bnh[r] = bon[0] + bon[1];
  }
  f32x16 acc = zero16();
#pragma unroll
  for (int d = 0; d < 2; d++) {
    const bf16* X0 = WS(bf16, OFF_XA) + (size_t)row0 * 1024 + d * 256 + h * 64;
    const bf16* X1 = X0 + 512;
    const bf16* P0 = WS(bf16, OFF_PROJ) + (size_t)row0 * NIN + (h * 2 + d) * 128;
#pragma unroll
    for (int ks = 0; ks < 64; ks += 16)
      acc = mfma32(gfrag(X0, 1024, ti * 32 + lr, ks + 8 * lh), gfrag(X1, 1024, tj * 32 + lr, ks + 8 * lh), acc);
#pragma unroll
    for (int r = 0; r < 16; r++) acc[r] += bf2f(P0[(size_t)(ti * 32 + acc_row(r, lane)) * NIN + tj * 32 + lr]);
  }
#pragma unroll
  for (int r = 0; r < 16; r++) {
    int p = ti * 32 + acc_row(r, lane);
    float s1 = sum32(acc[r]), s2 = sum32(acc[r] * acc[r]);
    if (lr == 31) { spart[(p * 2 + tj) * 2] = s1; spart[(p * 2 + tj) * 2 + 1] = s2; }
  }
  __syncthreads();
  {
    int c = h * 64 + tj * 32 + lr;
    float lw_ = P.rw_ln_w[l * 256 + c], lb_ = P.rw_ln_b[l * 256 + c];
    bf16* yc = WS(bf16, OFF_R);
    const bf16* pr = WS(bf16, OFF_PROJ);
#pragma unroll
    for (int r = 0; r < 16; r++) {
      int p = ti * 32 + acc_row(r, lane);
      int row = row0 + p;
      float mu = (spart[(p * 2) * 2] + spart[(p * 2 + 1) * 2]) * (1.f / 64.f);
      float ex2 = (spart[(p * 2) * 2 + 1] + spart[(p * 2 + 1) * 2 + 1]) * (1.f / 64.f);
      float var = fmaxf(ex2 - mu * mu, 0.f);
      float yn = (acc[r] - mu) * rsqrtf(var + 64e-5f) * lw_ + lb_;
      yc[(size_t)row * 1024 + 512 + c] = f2bf((yn + bnh[r] * vvh[r]) * silu_f(ggh[r]));
    }
  }
  __syncthreads();
}

__device__ __forceinline__ float wave_scan64(float v, float* tmp, int lane, bool reverse) {
  const int idx = reverse ? 63 - lane : lane;
#pragma unroll
  for (int off = 1; off < 64; off <<= 1) {
    tmp[idx] = v; wave_sync();
    float o = idx >= off ? tmp[idx - off] : 0.f; wave_sync();
    v += o;
  }
  return v;
}
__device__ __forceinline__ float ssd_aneg(const Params& P, int l, int d, int h) { return -__expf(P.ssd_a_log[(l * 2 + d) * 4 + h]); }
__device__ __forceinline__ void ssd_state_item(const Params& P, int l, int item, unsigned char* sm) {
  int tid_ = threadIdx.x; OPAQUE(tid_);
  const int tid = tid_, lane = tid & 63, w = tid >> 6;
  const int d = item & 1, h = (item >> 1) & 3, rest = item >> 3;
  const int pc = rest % NCH, b = rest / NCH;
  const int isctx = pc < NCH_C, len = isctx ? CTX : SEQ, t0 = (isctx ? pc : pc - NCH_C) * TC;
  const int seq0 = isctx ? b * CTX : ROWS_C + b * SEQ;
  bf16* sRaw = (bf16*)sm;
  bf16* sVt = sRaw + 2 * 68 * 64;
  bf16* sBt = sVt + 64 * 72;
  float* sdt = (float*)(sBt + 64 * 72);
  float* sdw = sdt + 64;
  const bf16* pr = WS(bf16, OFF_PROJ);
#pragma unroll 8
  for (int idx = tid; idx < 2 * 68 * 8; idx += 256) {
    int which = idx / (68 * 8), rem = idx % (68 * 8), tr = rem >> 3, c8 = rem & 7;
    int t = t0 - 2 + tr;
    int col = C_SSD + (which == 0 ? h * 64 : 256 + (h >> 1) * 64) + c8 * 8;
    U4 v = (t >= 0 && t < len) ? *(const U4*)(pr + (size_t)(seq0 + t) * NIN + col) : zero4();
    *(U4*)&sRaw[(which * 68 + tr) * 64 + c8 * 8] = v;
  }
  if (tid < 64) {
    float raw = bf2f(pr[(size_t)(seq0 + t0 + tid) * NIN + C_SSDDT + d * 4 + h]);
    sdt[tid] = softplus_f(raw + P.ssd_dt_bias[(l * 2 + d) * 4 + h]);
  }
  __syncthreads();
  if (w == 0) {
    float la = sdt[lane] * ssd_aneg(P, l, d, h);
    float incl = wave_scan64(la, sdw, lane, d == 0);
    wave_sync();
    sdw[lane] = __expf(incl - la);
    if (lane == (d == 0 ? 0 : 63)) WS(float, OFF_SSDDEC)[((size_t)(d * BATCH + b) * NCH + pc) * 4 + h] = __expf(incl);
  }
  __syncthreads();
#pragma unroll
  for (int which = 0; which < 2; which++) {
    const int c = tid & 63;
    const int ch = which == 0 ? h * 64 + c : 256 + (h >> 1) * 64 + c;
    float cw[5], cb = P.ssd_conv_b[l * 512 + ch];
#pragma unroll
    for (int i = 0; i < 5; i++) cw[i] = P.ssd_conv_w[(l * 5 + i) * 512 + ch];
    const int tb = (tid >> 6) * 16;
    float w0 = bf2f(sRaw[(which * 68 + tb) * 64 + c]), w1 = bf2f(sRaw[(which * 68 + tb + 1) * 64 + c]);
    float w2 = bf2f(sRaw[(which * 68 + tb + 2) * 64 + c]), w3 = bf2f(sRaw[(which * 68 + tb + 3) * 64 + c]);
#pragma unroll 4
    for (int t = tb; t < tb + 16; t++) {
      float w4 = bf2f(sRaw[(which * 68 + t + 4) * 64 + c]);
      float acc = cb + w0 * cw[0] + w1 * cw[1] + w2 * cw[2] + w3 * cw[3] + w4 * cw[4];
      w0 = w1; w1 = w2; w2 = w3; w3 = w4;
      float v = silu_f(acc);
      if (which == 0) sVt[c * 72 + t] = f2bf(v * sdt[t] * sdw[t]);
      else sBt[c * 72 + t] = f2bf(v);
    }
  }
  __syncthreads();
  {
    int ti = w >> 1, tj = w & 1;
    f32x16 acc = zero16();
    for (int ks = 0; ks < 64; ks += 16)
      acc = mfma32(ldsfrag(&sVt[(ti * 32 + (lane & 31)) * 72 + ks + 8 * (lane >> 5)]),
                   ldsfrag(&sBt[(tj * 32 + (lane & 31)) * 72 + ks + 8 * (lane >> 5)]), acc);
    bf16* st = WS(bf16, OFF_SSDST) + ((size_t)((d * BATCH + b) * NCH + pc) * 4 + h) * 4096;
    for (int r = 0; r < 16; r++) st[(ti * 32 + acc_row(r, lane)) * 64 + tj * 32 + (lane & 31)] = f2bf(acc[r]);
  }
  __syncthreads();
}

__device__ __forceinline__ void gla_la(const Params& P, int l, int d, int h, const float* sGl, float* dst) {
  const int k = threadIdx.x & 31;
  float gw[16], gb = P.gla_gb[(l * 2 + d) * 128 + h * 32 + k];
  const float* g2 = P.gla_g2 + (size_t)(l * 2 + d) * 16 * 128 + h * 32 + k;
#pragma unroll
  for (int r = 0; r < 16; r++) gw[r] = g2[r * 128];
#pragma unroll 2
  for (int t = threadIdx.x >> 5; t < 64; t += 8) {
    float acc = gb;
#pragma unroll
    for (int r = 0; r < 16; r++) acc += sGl[t * 32 + d * 16 + r] * gw[r];
    dst[t * 32 + k] = -softplus_f(-acc) * (1.f / 16.f);
  }
}
__device__ __forceinline__ void gla_state_item(const Params& P, int l, int item, unsigned char* sm) {
  int tid_ = threadIdx.x; OPAQUE(tid_);
  const int tid = tid_, lane = tid & 63, w = tid >> 6;
  const int d = item & 1, h = (item >> 1) & 3, rest = item >> 3;
  const int pc = rest % NCH, b = rest / NCH;
  const int row0 = chunk_row0(b, pc, TC, NCH_C);
  float* sGl = (float*)sm;
  float* sLa = sGl + 2048;
  bf16* sVt = (bf16*)(sLa + 2048);
  bf16* sKt = sVt + 64 * 72;
  const bf16* pr = WS(bf16, OFF_PROJ);
  float kh[8], vh[16];
#pragma unroll
  for (int i = 0; i < 8; i++) kh[i] = bf2f(pr[(size_t)(row0 + (tid >> 5) + 8 * i) * NIN + C_GLAK + h * 32 + (tid & 31)]);
#pragma unroll
  for (int i = 0; i < 16; i++) vh[i] = bf2f(pr[(size_t)(row0 + (tid >> 6) + 4 * i) * NIN + C_GLAV + h * 64 + (tid & 63)]);
#pragma unroll 8
  for (int idx = tid; idx < 64 * 32; idx += 256) {
    int t = idx >> 5, c = idx & 31;
    sGl[idx] = bf2f(pr[(size_t)(row0 + t) * NIN + C_GLAGL + c]);
  }
  __syncthreads();
  gla_la(P, l, d, h, sGl, sLa);
  __syncthreads();
  {
    float* segtot = (float*)(sKt + 32 * 72);
    const int k = tid & 31, sg = tid >> 5;
    float run = 0.f, loc[8];
#pragma unroll
    for (int j = 0; j < 8; j++) {
      int tau = sg * 8 + j, t = d == 0 ? 63 - tau : tau;
      float la = sLa[t * 32 + k]; loc[j] = run; run += la;
    }
    segtot[sg * 32 + k] = run;
    __syncthreads();
    float off = 0.f, tot = 0.f;
#pragma unroll
    for (int j = 0; j < 8; j++) { float v = segtot[j * 32 + k]; tot += v; if (j < sg) off += v; }
#pragma unroll
    for (int j = 0; j < 8; j++) {
      int tau = sg * 8 + j, t = d == 0 ? 63 - tau : tau;
      sLa[t * 32 + k] = loc[j] + off;
    }
    if (sg == 0) WS(float, OFF_GLADEC)[(((size_t)(d * BATCH + b) * NCH + pc) * 4 + h) * 32 + k] = __expf(tot);
  }
  __syncthreads();
#pragma unroll
  for (int i = 0; i < 16; i++) sVt[(tid & 63) * 72 + (tid >> 6) + 4 * i] = f2bf(vh[i]);
#pragma unroll
  for (int i = 0; i < 8; i++) {
    const int t = (tid >> 5) + 8 * i, k = tid & 31;
    sKt[k * 72 + t] = f2bf(kh[i] * __expf(sLa[t * 32 + k]));
  }
  __syncthreads();
  if (w < 2) {
    f32x16 acc = zero16();
    for (int ks = 0; ks < 64; ks += 16)
      acc = mfma32(ldsfrag(&sVt[(w * 32 + (lane & 31)) * 72 + ks + 8 * (lane >> 5)]),
                   ldsfrag(&sKt[(lane & 31) * 72 + ks + 8 * (lane >> 5)]), acc);
    bf16* st = WS(bf16, OFF_GLAST) + ((size_t)((d * BATCH + b) * NCH + pc) * 4 + h) * 2048;
    for (int r = 0; r < 16; r++) st[(w * 32 + acc_row(r, lane)) * 32 + (lane & 31)] = f2bf(acc[r]);
  }
  __syncthreads();
}

__device__ __forceinline__ U4 s5_u_load(const Params& P, int g, int n, int k8) {
  if (n >= M5) return zero4();
  int b = n / NCH5, pc = n - b * NCH5;
  int row = chunk_row0(b, pc, T5, NC5) + (k8 >> 4);
  return *(const U4*)(WS(bf16, OFF_PROJ) + (size_t)row * NIN + C_S5 + g * 16 + (k8 & 15));
}
__device__ __forceinline__ void s5_state_tile(const Params& P, int l, int item, unsigned char* sm) {
  const int MT5 = (M5 + 127) / 128;
  int nt = item & 1, mt = (item >> 1) % MT5, g = (item >> 1) / MT5;
  const bf16* Bt = WS(bf16, OFF_W1T) + (size_t)(l * 16 + g) * 256 * 512;
  float* S = WS(float, OFF_S5ST) + (size_t)g * M5 * 256;
  gemm_tile(sm, mt * 128, nt * 128, 512,
    [&](int m, int k) { return s5_u_load(P, g, m, k); },
    [&](int n, int k) { return *(const U4*)(Bt + (size_t)n * 512 + k); },
    [&](int m, int n, float v) { if (m < M5) S[(size_t)m * 256 + n] = v; });
}

__device__ __forceinline__ void phase_D(const Params& P, int l, unsigned char* sm, long long& pacc) {
  const int n_rw = BATCH * NCH * 8, n_ssd = BATCH * NCH * 8, n_gla = BATCH * NCH * 8;
  const int n_s5 = 16 * ((M5 + 127) / 128) * 2;
  { long long t0_ = 0; if (PROBE_PHASE == 30) t0_ = wall_clock64();
  ITEM_LOOP(i, n_rw, 0) rwkv_chunk_item(P, l, i, sm, pacc);
  if (PROBE_PHASE == 30) pacc += wall_clock64() - t0_; }
  chunk_scans(P, l, n_rw);
}

__device__ __forceinline__ void chunk_scans(const Params& P, int l, int base) {
  const int tid = threadIdx.x;
  const int n_ssd = 2 * BATCH * 4 * 4, n_gla = 2 * BATCH * 4 * 2, n_s5 = 16 * BATCH;
#pragma unroll 1
  for (int it = (int)((blockIdx.x + gridDim.x - ((unsigned)base % gridDim.x)) % gridDim.x); it < n_ssd + n_gla + n_s5; it += gridDim.x) {
    int i = it;
    if (i < n_ssd) {
      int q = i & 3, h = (i >> 2) & 3, rest = i >> 4, b = rest % BATCH, d = rest / BATCH;
      float S[4] = {0.f, 0.f, 0.f, 0.f};
#pragma unroll 1
      for (int v0 = 0; v0 < NCH; v0 += 8) {
        U2 cv[8]; float dec[8];
#pragma unroll
        for (int j = 0; j < 8; j++) {
          int vc = v0 + j < NCH ? v0 + j : NCH - 1;
          size_t ci = ((size_t)(d * BATCH + b) * NCH + ord_chunk(d, vc, NCH_C, NCH)) * 4 + h;
          cv[j] = *(const U2*)(WS(bf16, OFF_SSDST) + ci * 4096 + q * 1024 + tid * 4);
          dec[j] = WS(float, OFF_SSDDEC)[ci];
        }
#pragma unroll
        for (int j = 0; j < 8; j++) {
          if (v0 + j < NCH) {
            size_t ci = ((size_t)(d * BATCH + b) * NCH + ord_chunk(d, v0 + j, NCH_C, NCH)) * 4 + h;
            U2 o; o.a[0] = pack2(S[0], S[1]); o.a[1] = pack2(S[2], S[3]);
            *(U2*)(WS(bf16, OFF_SSDST) + ci * 4096 + q * 1024 + tid * 4) = o;
            S[0] = dec[j] * S[0] + lo2f(cv[j].a[0]); S[1] = dec[j] * S[1] + hi2f(cv[j].a[0]);
            S[2] = dec[j] * S[2] + lo2f(cv[j].a[1]); S[3] = dec[j] * S[3] + hi2f(cv[j].a[1]);
          }
        }
      }
      continue;
    }
    i -= n_ssd;
    if (i < n_gla) {
      int q = i & 1, h = (i >> 1) & 3, rest = i >> 3, b = rest % BATCH, d = rest / BATCH;
      float S[4] = {0.f, 0.f, 0.f, 0.f};
      int e0 = q * 1024 + tid * 4, k0 = e0 & 31;
#pragma unroll 1
      for (int v0 = 0; v0 < NCH; v0 += 8) {
        U2 cv[8]; F4 dec[8];
#pragma unroll
        for (int j = 0; j < 8; j++) {
          int vc = v0 + j < NCH ? v0 + j : NCH - 1;
          size_t ci = ((size_t)(d * BATCH + b) * NCH + ord_chunk(d, vc, NCH_C, NCH)) * 4 + h;
          cv[j] = *(const U2*)(WS(bf16, OFF_GLAST) + ci * 2048 + e0);
          dec[j] = *(const F4*)(WS(float, OFF_GLADEC) + ci * 32 + k0);
        }
#pragma unroll
        for (int j = 0; j < 8; j++) {
          if (v0 + j < NCH) {
            size_t ci = ((size_t)(d * BATCH + b) * NCH + ord_chunk(d, v0 + j, NCH_C, NCH)) * 4 + h;
            U2 o; o.a[0] = pack2(S[0], S[1]); o.a[1] = pack2(S[2], S[3]);
            *(U2*)(WS(bf16, OFF_GLAST) + ci * 2048 + e0) = o;
            S[0] = dec[j].a[0] * S[0] + lo2f(cv[j].a[0]); S[1] = dec[j].a[1] * S[1] + hi2f(cv[j].a[0]);
            S[2] = dec[j].a[2] * S[2] + lo2f(cv[j].a[1]); S[3] = dec[j].a[3] * S[3] + hi2f(cv[j].a[1]);
          }
        }
      }
      continue;
    }
    i -= n_gla;
    if (i < n_s5) {
      int b = i % BATCH, g = i / BATCH;
      if (tid < 128) {
        int d = tid >> 6, p = tid & 63;
        const float* lt = WS(float, OFF_S5LT) + ((size_t)((l * 16 + g) * 2 + d) * 64 + p) * 2;
        float lr = lt[0], li = lt[1], xr = 0.f, xi = 0.f;
#pragma unroll 1
        for (int v0 = 0; v0 < NCH5; v0 += 8) {
          float sr[8], si[8];
#pragma unroll
          for (int j = 0; j < 8; j++) {
            int vc = v0 + j < NCH5 ? v0 + j : NCH5 - 1;
            const float* sp = WS(float, OFF_S5ST) + ((size_t)g * M5 + b * NCH5 + ord_chunk(d, vc, NC5, NCH5)) * 256 + d * 128 + p;
            sr[j] = sp[0]; si[j] = sp[64];
          }
#pragma unroll
          for (int j = 0; j < 8; j++) {
            if (v0 + j < NCH5) {
              float* sp = WS(float, OFF_S5ST) + ((size_t)g * M5 + b * NCH5 + ord_chunk(d, v0 + j, NC5, NCH5)) * 256 + d * 128 + p;
              sp[0] = xr; sp[64] = xi;
              float nr = lr * xr - li * xi + sr[j], ni = lr * xi + li * xr + si[j];
              xr = nr; xi = ni;
            }
          }
        }
      }
      continue;
    }
  }
}

__device__ __forceinline__ void ssd_out_item(const Params& P, int l, int item, unsigned char* sm, long long& pacc) {
  long long tp0_ = 0; if (PROBE_PHASE == 55 || PROBE_PHASE == 56) tp0_ = wall_clock64();
  int tid_ = threadIdx.x; OPAQUE(tid_);
  const int tid = tid_, lane = tid & 63, w = tid >> 6;
  const int h = item & 3, rest = item >> 2, pc = rest % NCH, b = rest / NCH;
  if (l == 1 && pc < NCH_C) return;
  const int isctx = pc < NCH_C, len = isctx ? CTX : SEQ, t0 = (isctx ? pc : pc - NCH_C) * TC;
  const int seq0 = isctx ? b * CTX : ROWS_C + b * SEQ;
  bf16* sRaw = (bf16*)sm;
  bf16* sA2 = (bf16*)sm;
  bf16* sB2 = (bf16*)(sm + 26112);
  bf16* sC = (bf16*)(sm + 26112 + 25600);
  float* sdt = (float*)(sm + 26112 + 25600 + 9216);
  float* scf = sdt + 128; float* scr = scf + 64; float* spart = scr + 64;
  const bf16* pr = WS(bf16, OFF_PROJ);
#pragma unroll 8
  for (int idx = tid; idx < 3 * 68 * 8; idx += 256) {
    int which = idx / (68 * 8), rem = idx % (68 * 8), tr = rem >> 3, c8 = rem & 7;
    int t = t0 - 2 + tr;
    int col = C_SSD + (which == 0 ? h * 64 : which == 1 ? 256 + (h >> 1) * 64 : 384 + (h >> 1) * 64) + c8 * 8;
    U4 v = (t >= 0 && t < len) ? *(const U4*)(pr + (size_t)(seq0 + t) * NIN + col) : zero4();
    *(U4*)&sRaw[(which * 68 + tr) * 64 + c8 * 8] = v;
  }
  u32x4 stv0, stv1, stv2, stv3;
  {
    const bf16* stb = WS(bf16, OFF_SSDST);
    const size_t o0 = ((size_t)((0 * BATCH + b) * NCH + pc) * 4 + h) * 4096, o1 = ((size_t)((1 * BATCH + b) * NCH + pc) * 4 + h) * 4096;
    const int p_ = (tid >> 3) & 31, c8_ = tid & 7;
    stv0 = *(const u32x4*)(stb + o0 + p_ * 64 + c8_ * 8);
    stv1 = *(const u32x4*)(stb + o0 + (p_ + 32) * 64 + c8_ * 8);
    stv2 = *(const u32x4*)(stb + o1 + p_ * 64 + c8_ * 8);
    stv3 = *(const u32x4*)(stb + o1 + (p_ + 32) * 64 + c8_ * 8);
  }
  float zv[16];
#pragma unroll
  for (int r = 0; r < 16; r++)
    zv[r] = bf2f(pr[(size_t)(seq0 + t0 + (w >> 1) * 32 + acc_row(r, lane)) * NIN + C_SSDZ + h * 64 + (w & 1) * 32 + (lane & 31)]);
  if (tid < 128) {
    int d = tid >> 6, t = tid & 63;
    float raw = bf2f(pr[(size_t)(seq0 + t0 + t) * NIN + C_SSDDT + d * 4 + h]);
    sdt[tid] = softplus_f(raw + P.ssd_dt_bias[(l * 2 + d) * 4 + h]);
  }
  __syncthreads();
  if (w == 0) { float v = wave_scan64(sdt[lane] * ssd_aneg(P, l, 0, h), scf, lane, false); wave_sync(); scf[lane] = v; }
  if (w == 1) { float v = wave_scan64(sdt[64 + lane] * ssd_aneg(P, l, 1, h), scr, lane, true); wave_sync(); scr[lane] = v; }
#pragma unroll
  for (int which = 0; which < 3; which++) {
    const int c = tid & 63;
    const int ch = which == 0 ? h * 64 + c : which == 1 ? 256 + (h >> 1) * 64 + c : 384 + (h >> 1) * 64 + c;
    float cw[5], cb = P.ssd_conv_b[l * 512 + ch];
#pragma unroll
    for (int i = 0; i < 5; i++) cw[i] = P.ssd_conv_w[(l * 5 + i) * 512 + ch];
    const int tb = (tid >> 6) * 16;
    float w0 = bf2f(sRaw[(which * 68 + tb) * 64 + c]), w1 = bf2f(sRaw[(which * 68 + tb + 1) * 64 + c]);
    float w2 = bf2f(sRaw[(which * 68 + tb + 2) * 64 + c]), w3 = bf2f(sRaw[(which * 68 + tb + 3) * 64 + c]);
#pragma unroll 4
    for (int t = tb; t < tb + 16; t++) {
      float w4 = bf2f(sRaw[(which * 68 + t + 4) * 64 + c]);
      float acc = cb + w0 * cw[0] + w1 * cw[1] + w2 * cw[2] + w3 * cw[3] + w4 * cw[4];
      w0 = w1; w1 = w2; w2 = w3; w3 = w4;
      bf16 v = f2bf(silu_f(acc));
      if (which == 0) sB2[c * 200 + t] = v;
      else if (which == 1) sB2[t * 200 + 64 + c] = v;
      else sC[t * 72 + c] = v;
    }
  }
  __syncthreads();
  const int ti = w >> 1, tj = w & 1;
  {
    f32x16 g = zero16();
    for (int ks = 0; ks < 64; ks += 16)
      g = mfma32(ldsfrag(&sC[(ti * 32 + (lane & 31)) * 72 + ks + 8 * (lane >> 5)]),
                 ldsfrag(&sB2[(tj * 32 + (lane & 31)) * 200 + 64 + ks + 8 * (lane >> 5)]), g);
    int j = tj * 32 + (lane & 31);
    float cfj = scf[j], crj = scr[j], d0j = sdt[j], d1j = sdt[64 + j];
    for (int r = 0; r < 16; r++) {
      int i = ti * 32 + acc_row(r, lane);
      float mlt = 0.f;
      if (j <= i) mlt += __expf(scf[i] - cfj) * d0j;
      if (j >= i) mlt += __expf(scr[i] - crj) * d1j;
      sA2[i * 200 + j] = f2bf(g[r] * mlt);
    }
  }
#pragma unroll 8
  for (int idx = tid; idx < 64 * 64; idx += 256) {
    int i = idx >> 6, n = idx & 63;
    float cv = bf2f(sC[i * 72 + n]);
    sA2[i * 200 + 64 + n] = f2bf(cv * __expf(scf[i]));
    sA2[i * 200 + 128 + n] = f2bf(cv * __expf(scr[i]));
  }
  __syncthreads();
  {
    const int p_ = (tid >> 3) & 31, c8_ = tid & 7;
    *(u32x4*)&sB2[p_ * 200 + 64 + c8_ * 8] = stv0;
    *(u32x4*)&sB2[(p_ + 32) * 200 + 64 + c8_ * 8] = stv1;
    *(u32x4*)&sB2[p_ * 200 + 128 + c8_ * 8] = stv2;
    *(u32x4*)&sB2[(p_ + 32) * 200 + 128 + c8_ * 8] = stv3;
  }
  __syncthreads();
  {
    f32x16 acc = zero16();
    for (int ks = 0; ks < 192; ks += 16)
      acc = mfma32(ldsfrag(&sA2[(ti * 32 + (lane & 31)) * 200 + ks + 8 * (lane >> 5)]),
                   ldsfrag(&sB2[(tj * 32 + (lane & 31)) * 200 + ks + 8 * (lane >> 5)]), acc);
    int p = tj * 32 + (lane & 31);
    float dd = P.ssd_d[l * 4 + h];
    bf16* yc = WS(bf16, OFF_R);
    for (int r = 0; r < 16; r++) {
      int i = ti * 32 + acc_row(r, lane);
      int row = seq0 + t0 + i;
      float xv = bf2f(sB2[p * 200 + i]);
      float y = acc[r] + dd * xv;
      float z = zv[r];
      y *= silu_f(z);
      yc[(size_t)row * 1024 + h * 64 + p] = f2bf(y);
      float s2 = sum32(y * y);
      if ((lane & 31) == 31) spart[i * 2 + tj] = s2;
    }
  }
  __syncthreads();
  if (tid < 64) WS(float, OFF_SSQ)[(size_t)(seq0 + t0 + tid) * 4 + h] = spart[tid * 2] + spart[tid * 2 + 1];
  __syncthreads();
}

__device__ __forceinline__ void gla_out_item(const Params& P, int l, int item, unsigned char* sm) {
  int tid_ = threadIdx.x; OPAQUE(tid_);
  const int tid = tid_, lane = tid & 63, w = tid >> 6;
  const int h = item & 3, rest = item >> 2, pc = rest % NCH, b = rest / NCH;
  if (l == 1 && pc < NCH_C) return;
  const int row0 = chunk_row0(b, pc, TC, NCH_C);
  bf16* sA2 = (bf16*)sm;
  bf16* sB2 = sA2 + 64 * 136;
  bf16* sKf = sB2 + 64 * 136;
  bf16* sKr = sKf + 64 * 40;
  float* sbf = (float*)(sKr + 64 * 40);
  float* sbr = sbf + 2048;
  float* spart = sbr + 2048;
  float* sGl = (float*)sB2;
  const bf16* pr = WS(bf16, OFF_PROJ);
  float qh[8], kh[8], vh[16], gh[16];
  u32x4 sth0, sth1;
#pragma unroll
  for (int i = 0; i < 8; i++) {
    const bf16* rp = pr + (size_t)(row0 + (tid >> 5) + 8 * i) * NIN + h * 32 + (tid & 31);
    qh[i] = bf2f(rp[C_GLA]); kh[i] = bf2f(rp[C_GLAK]);
  }
#pragma unroll
  for (int i = 0; i < 16; i++) vh[i] = bf2f(pr[(size_t)(row0 + (tid >> 6) + 4 * i) * NIN + C_GLAV + h * 64 + (tid & 63)]);
#pragma unroll
  for (int r = 0; r < 16; r++)
    gh[r] = bf2f(pr[(size_t)(row0 + (w >> 1) * 32 + acc_row(r, lane)) * NIN + C_GLAG + h * 64 + (w & 1) * 32 + (lane & 31)]);
  {
    const bf16* st0 = WS(bf16, OFF_GLAST) + ((size_t)((0 * BATCH + b) * NCH + pc) * 4 + h) * 2048;
    const bf16* st1 = WS(bf16, OFF_GLAST) + ((size_t)((1 * BATCH + b) * NCH + pc) * 4 + h) * 2048;
    sth0 = *(const u32x4*)(st0 + (tid >> 2) * 32 + (tid & 3) * 8);
    sth1 = *(const u32x4*)(st1 + (tid >> 2) * 32 + (tid & 3) * 8);
  }
#pragma unroll 8
  for (int idx = tid; idx < 64 * 32; idx += 256) {
    int t = idx >> 5, c = idx & 31;
    sGl[idx] = bf2f(pr[(size_t)(row0 + t) * NIN + C_GLAGL + c]);
  }
  __syncthreads();
  gla_la(P, l, 0, h, sGl, sbf);
  gla_la(P, l, 1, h, sGl, sbr);
  __syncthreads();
  {
    float* segtot = spart + 128;
    const int k = tid & 31, sg = tid >> 5;
    float rf = 0.f, rr_ = 0.f, lf[8], lr_[8];
#pragma unroll
    for (int j = 0; j < 8; j++) {
      int tf = sg * 8 + j, tr = 63 - tf;
      rf += sbf[tf * 32 + k]; lf[j] = rf;
      rr_ += sbr[tr * 32 + k]; lr_[j] = rr_;
    }
    segtot[sg * 32 + k] = rf; segtot[256 + sg * 32 + k] = rr_;
    __syncthreads();
    float of = 0.f, orr = 0.f;
#pragma unroll
    for (int j = 0; j < 8; j++) { if (j < sg) { of += segtot[j * 32 + k]; orr += segtot[256 + j * 32 + k]; } }
#pragma unroll
    for (int j = 0; j < 8; j++) {
      int tf = sg * 8 + j, tr = 63 - tf;
      sbf[tf * 32 + k] = lf[j] + of;
      sbr[tr * 32 + k] = lr_[j] + orr;
    }
  }
  __syncthreads();
#pragma unroll
  for (int i = 0; i < 8; i++) {
    const int idx = tid + 256 * i, t = idx >> 5, k = idx & 31;
    float q = qh[i] * 0.17677669529663687f;
    float kv = kh[i];
    float bf_ = sbf[idx], br_ = sbr[idx];
    sA2[t * 136 + 64 + k] = f2bf(q * __expf(bf_));
    sA2[t * 136 + 96 + k] = f2bf(q * __expf(br_));
    sKf[t * 40 + k] = f2bf(kv * __expf(-bf_));
    sKr[t * 40 + k] = f2bf(kv * __expf(-br_));
  }
#pragma unroll
  for (int i = 0; i < 16; i++) sB2[(tid & 63) * 136 + (tid >> 6) + 4 * i] = f2bf(vh[i]);
  *(u32x4*)&sB2[(tid >> 2) * 136 + 64 + (tid & 3) * 8] = sth0;
  *(u32x4*)&sB2[(tid >> 2) * 136 + 96 + (tid & 3) * 8] = sth1;
  __syncthreads();
  const int ti = w >> 1, tj = w & 1;
  {
    f32x16 pf = zero16(), pv = zero16();
    for (int ks = 0; ks < 32; ks += 16) {
      pf = mfma32(ldsfrag(&sA2[(ti * 32 + (lane & 31)) * 136 + 64 + ks + 8 * (lane >> 5)]),
                  ldsfrag(&sKf[(tj * 32 + (lane & 31)) * 40 + ks + 8 * (lane >> 5)]), pf);
      pv = mfma32(ldsfrag(&sA2[(ti * 32 + (lane & 31)) * 136 + 96 + ks + 8 * (lane >> 5)]),
                  ldsfrag(&sKr[(tj * 32 + (lane & 31)) * 40 + ks + 8 * (lane >> 5)]), pv);
    }
    int j = tj * 32 + (lane & 31);
    for (int r = 0; r < 16; r++) {
      int i = ti * 32 + acc_row(r, lane);
      float v = (j < i) ? pf[r] : (j > i) ? pv[r] : pf[r] + pv[r];
      sA2[i * 136 + j] = f2bf(v);
    }
  }
  __syncthreads();
  {
    f32x16 acc = zero16();
    for (int ks = 0; ks < 128; ks += 16)
      acc = mfma32(ldsfrag(&sA2[(ti * 32 + (lane & 31)) * 136 + ks + 8 * (lane >> 5)]),
                   ldsfrag(&sB2[(tj * 32 + (lane & 31)) * 136 + ks + 8 * (lane >> 5)]), acc);
    for (int r = 0; r < 16; r++) {
      int i = ti * 32 + acc_row(r, lane);
      float s2 = sum32(acc[r] * acc[r]);
      if ((lane & 31) == 31) spart[i * 2 + tj] = s2;
    }
    __syncthreads();
    int v = tj * 32 + (lane & 31);
    float gn = P.gla_norm[l * 256 + h * 64 + v];
    bf16* yc = WS(bf16, OFF_R);
    for (int r = 0; r < 16; r++) {
      int i = ti * 32 + acc_row(r, lane);
      int row = row0 + i;
      float rstd = rsqrtf((spart[i * 2] + spart[i * 2 + 1]) * (1.f / 64.f) + 1e-6f);
      float g = gh[r];
      yc[(size_t)row * 1024 + 768 + h * 64 + v] = f2bf(acc[r] * rstd * gn * silu_f(g));
    }
  }
  __syncthreads();
}

__device__ __forceinline__ void s5_out_tile(const Params& P, int l, int item, unsigned char* sm) {
  const int MT5 = (M5 + 127) / 128;
  int nt = item & 3, mt = (item >> 2) % MT5, g = (item >> 2) / MT5;
  const bf16* Bt = WS(bf16, OFF_BT2) + (size_t)(l * 16 + g) * 512 * 768;
  const float* X = WS(float, OFF_S5ST) + (size_t)g * M5 * 256;
  const bf16* pr = WS(bf16, OFF_PROJ);
  bf16* ys = WS(bf16, OFF_YS5);
  gemm_tile(sm, mt * 128, nt * 128, 768,
    [&](int m, int k) {
      if (k < 512) return s5_u_load(P, g, m, k);
      if (m >= M5) return zero4();
      const float* xp = X + (size_t)m * 256 + (k - 512);
      F4 a = *(const F4*)xp, b2 = *(const F4*)(xp + 4);
      U4 r; r.a[0] = pack2(a.a[0], a.a[1]); r.a[1] = pack2(a.a[2], a.a[3]); r.a[2] = pack2(b2.a[0], b2.a[1]); r.a[3] = pack2(b2.a[2], b2.a[3]);
      return r;
    },
    [&](int n, int k) { return *(const U4*)(Bt + (size_t)n * 768 + k); },
    [&](int m, int n, float v) {
      if (m >= M5) return;
      int b = m / NCH5, pc = m - b * NCH5;
      int row = chunk_row0(b, pc, T5, NC5) + (n >> 4);
      int ch = g * 16 + (n & 15);
      float u = bf2f(pr[(size_t)row * NIN + C_S5 + ch]);
      ys[(size_t)row * 256 + ch] = f2bf(gelu_f(v + P.s5_d[l * 256 + ch] * u));
    });
}

__device__ __forceinline__ void phase_E(const Params& P, int l, unsigned char* sm, long long& pacc) {
  const int n_rw = BATCH * 8;
  ITEM_LOOP(i, n_rw, 0) rwkv_scan2_item(P, l, i, sm);
  const int n_ssd = BATCH * NCH * 4, n_gla = BATCH * NCH * 4, n_s5 = 16 * ((M5 + 127) / 128) * 4;
  ITEM_LOOP(i, n_ssd, n_rw) ssd_out_item(P, l, i, sm, pacc);
  ITEM_LOOP(i, n_gla, n_rw + n_ssd) gla_out_item(P, l, i, sm);
  ITEM_LOOP(i, n_s5, n_rw + n_ssd + n_gla) s5_out_tile(P, l, i, sm);
}
__device__ __forceinline__ void phase_F(const Params& P, int l, unsigned char* sm, long long& pacc) {
  const int n_rw = BATCH * NCH * 4;
  ITEM_LOOP(i, n_rw, 0) rwkv_out_item(P, l, i, sm);
}

__device__ __forceinline__ void phase_G(const Params& P, int l, unsigned char* sm) {
  const int lane = threadIdx.x & 63, w = threadIdx.x >> 6;
  const int n_glu = (ROWS / 128) * 2, n_rows = ROWS / 4;
  const bf16* Bt = WS(bf16, OFF_GLUT) + (size_t)l * 256 * 256;
  const bf16* pr = WS(bf16, OFF_PROJ);
  bf16* yc = WS(bf16, OFF_R);
#pragma unroll 1
  for (int it = blockIdx.x; it < n_glu + n_rows; it += gridDim.x) {
    if (it < n_glu) {
      int nt = it & 1, mt = it >> 1;
      if (l == 1 && mt < ROWS_C / 128) continue;
      gemm_tile(sm, mt * 128, nt * 128, 256,
        [&](int m, int k) { return *(const U4*)(WS(bf16, OFF_YS5) + (size_t)m * 256 + k); },
        [&](int n, int k) { return *(const U4*)(Bt + (size_t)n * 256 + k); },
        [&](int m, int n, float v) {
          float y = bf2f(WS(bf16, OFF_YS5)[(size_t)m * 256 + n]);
          float g = bf2f(pr[(size_t)m * NIN + C_S5G + n]);
          yc[(size_t)m * 1024 + 256 + n] = f2bf(y * sigmoid_f(v + P.s5_glu_b[l * 256 + n]) * silu_f(g));
        });
      continue;
    }
    int m = (it - n_glu) * 4 + w;
    const float* sq = WS(float, OFF_SSQ) + (size_t)m * 4;
    float rstd = rsqrtf((sq[0] + sq[1] + sq[2] + sq[3]) * (1.f / 256.f) + 1e-6f);
    bf16* p = yc + (size_t)m * 1024 + lane * 4;
    U2 v = *(U2*)p;
    const float* gn = P.ssd_norm + l * 256 + lane * 4;
    U2 o;
    o.a[0] = pack2(lo2f(v.a[0]) * rstd * gn[0], hi2f(v.a[0]) * rstd * gn[1]);
    o.a[1] = pack2(lo2f(v.a[1]) * rstd * gn[2], hi2f(v.a[1]) * rstd * gn[3]);
    *(U2*)p = o;
  }
  { const int n_rw = BATCH * NCH * 4; ITEM_LOOP(i, n_rw, n_glu + n_rows) rwkv_out_item(P, l, i, sm); }
}

__device__ __forceinline__ void phase_outproj(const Params& P, int l, unsigned char* sm) {
  const bf16* A = WS(bf16, OFF_R);
  const bf16* Bt = WS(bf16, OFF_WTOUT) + (size_t)l * D * D;
  bf16* Y = WS(bf16, OFF_PROJ);
  const int NT = D / 128, MT = ROWS / 256;
  const int total = MT * NT, per = total / 8;
  const int nfull = (total / (int)gridDim.x) * (int)gridDim.x;
#pragma unroll 1
  for (int it0 = blockIdx.x; it0 < nfull; it0 += gridDim.x) {
    int it = total % 8 == 0 ? (it0 & 7) * per + (it0 >> 3) : it0;
    int mt = it / NT, nt = it % NT;
    if (l == 1 && mt < ROWS_C / 256) continue;
    gemm_tile_big(sm, mt * 256, nt * 128, D,
      [&](int m, int k) { return *(const U4*)(A + (size_t)m * D + k); },
      [&](int n, int k) { return *(const U4*)(Bt + (size_t)n * D + k); },
      [&](int m, int n, float v) { Y[(size_t)m * D + n] = f2bf(v); });
  }
#pragma unroll 1
  for (int q = blockIdx.x; q < 2 * (total - nfull); q += gridDim.x) {
    int it0 = nfull + (q >> 1), half = q & 1;
    int it = total % 8 == 0 ? (it0 & 7) * per + (it0 >> 3) : it0;
    int mt = it / NT, nt = it % NT;
    if (l == 1 && mt < ROWS_C / 256) continue;
    gemm_tile(sm, mt * 256 + half * 128, nt * 128, D,
      [&](int m, int k) { return *(const U4*)(A + (size_t)m * D + k); },
      [&](int n, int k) { return *(const U4*)(Bt + (size_t)n * D + k); },
      [&](int m, int n, float v) { Y[(size_t)m * D + n] = f2bf(v); });
  }
}

__device__ __forceinline__ void phase_post(const Params& P, int l) {
  const int lane = threadIdx.x & 63, w = threadIdx.x >> 6;
  const int first = (l == 1) ? ROWS_C / 4 : 0;
#pragma unroll 1
  for (int it = first + blockIdx.x; it < ROWS / 4; it += gridDim.x) {
    int m = it * 4 + w;
    RowInfo ri = row_info(m);
    const bf16* y = WS(bf16, OFF_PROJ) + (size_t)m * D + lane * 16;
    const float* hres; float* dst;
    if (ri.isctx) { hres = P.ctx + (size_t)m * D; dst = WS(float, OFF_HC) + (size_t)m * D; }
    else { hres = (l == 0 ? P.x : P.out) + (size_t)(m - ROWS_C) * D; dst = P.out + (size_t)(m - ROWS_C) * D; }
    const int mrow = ri.isctx ? BATCH : ri.b;
    const float* mod = WS(float, OFF_MOD) + ((size_t)l * NMOD + mrow) * 3072 + 2048;
    const int c0 = lane * 16;
    U4 y0 = *(const U4*)y, y1 = *(const U4*)(y + 8);
    float v[16]; float ss = 0.f;
#pragma unroll
    for (int e = 0; e < 4; e++) { v[2 * e] = lo2f(y0.a[e]); v[2 * e + 1] = hi2f(y0.a[e]); v[8 + 2 * e] = lo2f(y1.a[e]); v[8 + 2 * e + 1] = hi2f(y1.a[e]); }
#pragma unroll
    for (int e = 0; e < 16; e++) ss += v[e] * v[e];
    ss = sum64(ss);
    float rstd = rsqrtf(ss * (1.f / 1024.f) + 1e-6f);
    float hn[16]; float ss2 = 0.f;
#pragma unroll
    for (int q = 0; q < 4; q++) {
      F4 hr = *(const F4*)(hres + c0 + 4 * q), gm = *(const F4*)(mod + c0 + 4 * q), np = *(const F4*)(P.norm_post + l * D + c0 + 4 * q), o;
#pragma unroll
      for (int e = 0; e < 4; e++) { o.a[e] = hr.a[e] + gm.a[e] * (v[4 * q + e] * rstd * np.a[e]); hn[4 * q + e] = o.a[e]; ss2 += o.a[e] * o.a[e]; }
      *(F4*)(dst + c0 + 4 * q) = o;
    }
    if (l == 0) {
      ss2 = sum64(ss2);
      float rstd2 = rsqrtf(ss2 * (1.f / 1024.f) + 1e-6f);
      const float* mod1 = WS(float, OFF_MOD) + ((size_t)1 * NMOD + mrow) * 3072;
      bf16* hd = WS(bf16, OFF_R) + (size_t)m * D + c0;
      U4 o0, o1;
#pragma unroll
      for (int q = 0; q < 4; q++) {
        F4 np = *(const F4*)(P.norm_pre + 1 * D + c0 + 4 * q), sc = *(const F4*)(mod1 + 1024 + c0 + 4 * q), sh = *(const F4*)(mod1 + c0 + 4 * q);
        float t0 = hn[4 * q] * rstd2 * np.a[0] * (1.f + sc.a[0]) + sh.a[0], t1 = hn[4 * q + 1] * rstd2 * np.a[1] * (1.f + sc.a[1]) + sh.a[1];
        float t2 = hn[4 * q + 2] * rstd2 * np.a[2] * (1.f + sc.a[2]) + sh.a[2], t3 = hn[4 * q + 3] * rstd2 * np.a[3] * (1.f + sc.a[3]) + sh.a[3];
        if (q < 2) { o0.a[2 * q] = pack2(t0, t1); o0.a[2 * q + 1] = pack2(t2, t3); }
        else { o1.a[2 * (q - 2)] = pack2(t0, t1); o1.a[2 * (q - 2) + 1] = pack2(t2, t3); }
      }
      *(U4*)hd = o0; *(U4*)(hd + 8) = o1;
    }
  }
}

constexpr int NPHASE = 19;
__device__ __forceinline__ void run_phase(const Params& P, int ph, unsigned char* sm) {
  if (ph == 0) { phase_prologue(P, sm); return; }
  int l = (ph - 1) / 9, s = (ph - 1) % 9;
  switch (s) {
    case 0: if (l == 0) phase_normmod(P, l); break;
    case 1: phase_inproj(P, l, sm); break;
    case 2: phase_rwprep(P, l, sm); break;
    case 3: { long long dummy = 0; phase_D(P, l, sm, dummy); } break;
    case 4: { long long dummy = 0; phase_E(P, l, sm, dummy); } break;
    case 5: break;
    case 6: phase_G(P, l, sm); break;
    case 7: phase_outproj(P, l, sm); break;
    default: phase_post(P, l); break;
  }
}

#ifndef CPU_EMU
#define XB_TMO      128
#define XB_XCNT(j)  (256  + 64 * (j))
#define XB_XSUB(j)  (1280 + 64 * (j))
#define XB_XGEN(j)  (2304 + 64 * (j))
#define XB_TOP      3328
#define XB_TOPGEN   3392
#define XCD_BAR_WORDS 3456
#define XB_SPIN_CAP (1u << 18)
#define LAS __attribute__((address_space(3)))

__device__ __forceinline__ unsigned xb_ld(unsigned* p)              { return __hip_atomic_load(p, __ATOMIC_RELAXED, __HIP_MEMORY_SCOPE_AGENT); }
__device__ __forceinline__ unsigned xb_add(unsigned* p, unsigned v) { return __hip_atomic_fetch_add(p, v, __ATOMIC_RELAXED, __HIP_MEMORY_SCOPE_AGENT); }
__device__ __forceinline__ unsigned xb_xcc_id() { return (unsigned)__builtin_amdgcn_s_getreg((3 << 11) | 20) & 0xFu; }
#define XB_SPIN(cond, bar) do { unsigned _sp = 0; while (cond) { __builtin_amdgcn_s_sleep(1); \
    if ((++_sp & 255u) == 0u) { if (xb_ld(&(bar)[XB_TMO])) break; if (_sp > XB_SPIN_CAP) { atomicAdd(&(bar)[XB_TMO], 1u); break; } } } } while (0)

struct XcdBarrier {
    unsigned* bar; unsigned x;
    volatile LAS unsigned* st;
};

__device__ __forceinline__ XcdBarrier xcd_barrier_post(unsigned* bar, volatile LAS unsigned* st) {
    XcdBarrier b; b.bar = bar; b.x = xb_xcc_id(); b.st = st;
    if (threadIdx.x == 0) (void)xb_add(&bar[XB_XCNT(b.x)], 1u);
    return b;
}
__device__ __forceinline__ void xcd_barrier_complete(unsigned* bar, unsigned x, unsigned& nloc, unsigned& nx) {
    const unsigned G = gridDim.x * gridDim.y * gridDim.z;
    unsigned sum, cnt, mine, sp = 0u;
    for (;;) {
        sum = 0u; cnt = 0u; mine = 0u;
#pragma unroll
        for (unsigned j = 0; j < 16; ++j) { const unsigned c = xb_ld(&bar[XB_XCNT(j)]); sum += c; cnt += (c > 0u) ? 1u : 0u; mine = (j == x) ? c : mine; }
        if (sum == G) break;
        __builtin_amdgcn_s_sleep(1);
        if ((++sp & 255u) == 0u) { if (xb_ld(&bar[XB_TMO])) break; if (sp > XB_SPIN_CAP) { atomicAdd(&bar[XB_TMO], 1u); break; } }
    }
    nloc = mine > 0u ? mine : 1u; nx = cnt > 0u ? cnt : 1u;
}

__device__ __forceinline__ void xcd_barrier(const XcdBarrier& b) {
    asm volatile("s_waitcnt vmcnt(0)" ::: "memory");
    __syncthreads();
    if (threadIdx.x == 0) {
        unsigned* bar = b.bar;
        __builtin_amdgcn_s_waitcnt(0);
        unsigned nloc = b.st[0], nx = b.st[1];
        if (nloc == 0u) { xcd_barrier_complete(bar, b.x, nloc, nx); b.st[0] = nloc; b.st[1] = nx; }
        const unsigned old = xb_add(&bar[XB_XSUB(b.x)], 1u);
        const unsigned gen = old / nloc;
        if (old + 1u == (gen + 1u) * nloc) {
            __builtin_amdgcn_fence(__ATOMIC_RELEASE, "agent");
            asm volatile("s_waitcnt vmcnt(0)" ::: "memory");
            const unsigned og = xb_add(&bar[XB_TOP], 1u);
            const unsigned tg = og / nx;
            if (og + 1u == (tg + 1u) * nx) xb_add(&bar[XB_TOPGEN], 1u);
            else XB_SPIN(xb_ld(&bar[XB_TOPGEN]) == tg, bar);
            __builtin_amdgcn_fence(__ATOMIC_ACQUIRE, "agent");
            xb_add(&bar[XB_XGEN(b.x)], 1u);
            asm volatile("s_waitcnt vmcnt(0)" ::: "memory");
        } else {
            XB_SPIN(xb_ld(&bar[XB_XGEN(b.x)]) == gen, bar);
            __builtin_amdgcn_fence(__ATOMIC_ACQUIRE, "agent");
            asm volatile("s_waitcnt vmcnt(0)" ::: "memory");
        }
    }
    __syncthreads();
}


#define PH(bit, call) { long long t0_ = 0; if (PROBE_PHASE == (bit)) t0_ = wall_clock64(); call; xcd_barrier(xb); if (PROBE_PHASE == (bit)) pacc += wall_clock64() - t0_; }
template <int L> __device__ __forceinline__ void run_layer(const Params& P, unsigned char* sm, const XcdBarrier& xb, long long& pacc) {
  if (L == 0) PH(0, phase_normmod(P, L))
  PH(1, phase_inproj(P, L, sm))
  PH(2, phase_rwprep(P, L, sm))
  PH(3, phase_D(P, L, sm, pacc))
  PH(4, phase_E(P, L, sm, pacc))
  PH(6, phase_G(P, L, sm))
  PH(7, phase_outproj(P, L, sm))
  if (L == 0) PH(8, phase_post(P, L))
  else phase_post(P, L);
}
__global__ void __launch_bounds__(256, 2) mega_kernel(Params P) {
  __shared__ __attribute__((aligned(16))) unsigned char sm[SMEM_BYTES];
  __shared__ uint4 xb_words;
  cg::grid_group grid = cg::this_grid();
  long long pacc = 0;
  if (threadIdx.x == 0) xb_words = make_uint4(0u, 0u, 0u, 0u);
  __syncthreads();
  XcdBarrier xb = xcd_barrier_post((unsigned*)(P.ws + OFF_BAR), (volatile LAS unsigned*)&xb_words);
  if (P.ws == nullptr) grid.sync();
  PH(9, phase_prologue(P, sm))
  run_layer<0>(P, sm, xb, pacc);
  run_layer<1>(P, sm, xb, pacc);
  if (PROBE_PHASE >= 0 && blockIdx.x == 0 && threadIdx.x == 0) {
    long long t1 = wall_clock64();
    while (wall_clock64() - t1 < pacc) { __builtin_amdgcn_s_sleep(10); }
  }
}
__global__ void __launch_bounds__(256, 2) phase_kernel(Params P, int ph) {
  __shared__ __attribute__((aligned(16))) unsigned char sm[SMEM_BYTES];
  run_phase(P, ph, sm);
}

extern "C" void kernel_launch(void* const* d_in, const int* in_sizes, int n_in, void* d_out, int out_size,
                              void* d_ws, size_t ws_size, hipStream_t stream) {
  Params P{};
  const float** pp = (const float**)&P;
  for (int i = 0; i < 39; i++) pp[i] = (const float*)d_in[i];
  P.out = (float*)d_out;
  P.ws = (unsigned char*)d_ws;
  if (ws_size < WS_TOTAL) fprintf(stderr, "workspace too small: %zu < %zu\n", ws_size, (size_t)WS_TOTAL);
#if USE_COOP
  static int grid_blocks = 0;
  if (!grid_blocks) {
    int dev = 0, cus = 0, per_cu = 0;
    hipGetDevice(&dev);
    hipDeviceGetAttribute(&cus, hipDeviceAttributeMultiprocessorCount, dev);
    hipOccupancyMaxActiveBlocksPerMultiprocessor(&per_cu, mega_kernel, 256, 0);
    if (per_cu > 2) per_cu = 2;
    grid_blocks = cus * per_cu;
  }
  hipMemsetAsync((unsigned char*)d_ws + OFF_BAR, 0, 3456 * 4, stream);
  void* args[] = {&P};
  hipError_t e = hipLaunchCooperativeKernel((void*)mega_kernel, dim3(grid_blocks), dim3(256), args, 0, stream);
  if (e != hipSuccess) fprintf(stderr, "cooperative launch failed: %s (grid %d)\n", hipGetErrorString(e), grid_blocks);
#else
  for (int ph = 0; ph < NPHASE; ph++) phase_kernel<<<1024, 256, 0, stream>>>(P, ph);
#endif
}
#endif
```
